# Optimizing an MI355X kernel written in HIP

```python
import math
import jax
import jax.numpy as jnp
from jax import lax
import numpy as np

D_MODEL = 1024
BATCH = 8
SEQ = 8192
DEPTH = 2

CHUNK = 64
Q_BLOCK = 128
EPS = 1e-6
RET_HEADS = 4
RET_DK = 64
RET_DV = 64
RET_THETA = 10000.0
DIFF_HEADS = 4
DIFF_DK = 64
DIFF_DV = 2 * DIFF_DK
ROPE_THETA = 500000.0
ROPE_DIMS = DIFF_DK // 4
GLA_HEADS = 4
GLA_DK = 32
GLA_DV = 64
GLA_RANK = 16
GLA_TAU = 16.0
RET_W = RET_HEADS * RET_DV
DIFF_W = DIFF_HEADS * DIFF_DV
GLA_W = GLA_HEADS * GLA_DV
MIX_WIDTH = RET_W + DIFF_W + GLA_W
IN_SPLITS = (RET_HEADS * RET_DK, RET_HEADS * RET_DK, RET_W, RET_W,
             DIFF_HEADS * 2 * DIFF_DK, DIFF_HEADS * 2 * DIFF_DK, DIFF_W,
             GLA_HEADS * GLA_DK, GLA_HEADS * GLA_DK, GLA_W, GLA_RANK, GLA_W)
IN_WIDTH = sum(IN_SPLITS)
N_EXPERTS = 32
N_GROUPS = 8
EXPERTS_PER_GROUP = N_EXPERTS // N_GROUPS
TOP_K = 2
GROUP_SCORE_K = 2
D_EXPERT = 512
MOE_BLOCK = 256

kernel_name = "hybrid_ret_diff_gla_grouped_moe_adaln"


def rms_norm(x, g):
    x32 = x.astype(jnp.float32)
    y = x32 * lax.rsqrt(jnp.mean(x32 * x32, axis=-1, keepdims=True) + EPS)
    return (y * g.astype(jnp.float32)).astype(x.dtype)


def split_cols(p, sizes):
    idx = np.cumsum(np.array(sizes))[:-1].tolist()
    return jnp.split(p, idx, axis=-1)


def apply_rotary(x, positions, theta, rot_dims):
    half = rot_dims // 2
    inv_freq = 1.0 / (theta ** (jnp.arange(half, dtype=jnp.float32) / half))
    ang = positions.astype(jnp.float32)[..., None] * inv_freq
    cos = jnp.cos(ang)[:, :, None, :]
    sin = jnp.sin(ang)[:, :, None, :]
    xr = x[..., :rot_dims].astype(jnp.float32)
    x1, x2 = xr[..., :half], xr[..., half:]
    rot = jnp.concatenate([x1 * cos - x2 * sin, x1 * sin + x2 * cos], axis=-1).astype(x.dtype)
    return jnp.concatenate([rot, x[..., rot_dims:]], axis=-1)


def retention(q, k, v, positions):
    B_, S_, H, dk = q.shape
    dv = v.shape[-1]
    n_c = S_ // CHUNK
    q = apply_rotary(q, positions, RET_THETA, dk)
    k = apply_rotary(k, positions, RET_THETA, dk) * (dk ** -0.5)
    log_g = jnp.log(1.0 - 2.0 ** (-5.0 - jnp.arange(H, dtype=jnp.float32)))
    j = jnp.arange(CHUNK, dtype=jnp.float32)
    intra_decay = jnp.exp(log_g[:, None, None] * jnp.abs(j[:, None] - j[None, :]))
    q_decay = jnp.exp(log_g[:, None] * (j + 1.0))
    k_decay = jnp.exp(log_g[:, None] * (CHUNK - 1.0 - j))
    chunk_decay = jnp.exp(log_g * CHUNK)
    qc = q.reshape(B_, n_c, CHUNK, H, dk)
    kc = k.reshape(B_, n_c, CHUNK, H, dk)
    vc = v.reshape(B_, n_c, CHUNK, H, dv)
    scores = jnp.einsum('bnthd,bnshd->bnhts', qc, kc) * intra_decay
    intra = jnp.einsum('bnhts,bnshe->bnthe', scores, vc)
    kv = jnp.einsum('bnshd,hs,bnshe->bnhde', kc, k_decay, vc)

    def step(state, kv_i):
        return state * chunk_decay[None, :, None, None] + kv_i, state

    init = jnp.zeros((B_, H, dk, dv), kv.dtype)
    _, prev = lax.scan(step, init, jnp.moveaxis(kv, 1, 0))
    prev = jnp.moveaxis(prev, 0, 1)
    cross = jnp.einsum('bnthd,ht,bnhde->bnthe', qc, q_decay, prev)
    return (intra + cross).reshape(B_, S_, H, dv)


def diff_attention(q, k, v, positions, q_g, k_g, lq1, lk1, lq2, lk2, sub_g, lam_init):
    B_, S_, H, _, dk = q.shape
    dv = v.shape[-1]
    q = rms_norm(q, q_g)
    k = rms_norm(k, k_g)
    q = apply_rotary(q.reshape(B_, S_, 2 * H, dk), positions, ROPE_THETA, ROPE_DIMS)
    q = q.reshape(B_, S_, H, 2, dk) * (dk ** -0.5)
    k = apply_rotary(k.reshape(B_, S_, 2 * H, dk), positions, ROPE_THETA, ROPE_DIMS)
    k = k.reshape(B_, S_, H, 2, dk)
    lam = (jnp.exp(jnp.sum((lq1 * lk1).astype(jnp.float32)))
           - jnp.exp(jnp.sum((lq2 * lk2).astype(jnp.float32))) + lam_init)
    n_q = S_ // Q_BLOCK
    key_chunk = jnp.arange(S_) // CHUNK
    qb = jnp.swapaxes(q.reshape(B_, n_q, Q_BLOCK, H, 2, dk), 0, 1)

    def block(args):
        qi, bi = args
        s = jnp.einsum('bqhcd,bkhcd->bhcqk', qi, k).astype(jnp.float32)
        q_chunk = (bi * Q_BLOCK + jnp.arange(Q_BLOCK)) // CHUNK
        mask = key_chunk[None, :] <= q_chunk[:, None]
        p = jax.nn.softmax(jnp.where(mask, s, -jnp.inf), axis=-1)
        a = p[:, :, 0] - lam * p[:, :, 1]
        return jnp.einsum('bhqk,bkhe->bqhe', a.astype(v.dtype), v)

    o = lax.map(block, (qb, jnp.arange(n_q)))
    o = jnp.swapaxes(o, 0, 1).reshape(B_, S_, H, dv)
    return rms_norm(o, sub_g) * (1.0 - lam_init)


def gated_linear_attention(q, k, v, log_a):
    B_, S_, H, dk = q.shape
    dv = v.shape[-1]
    n_c = S_ // CHUNK
    q = q * (dk ** -0.5)
    to_chunks = lambda t: jnp.swapaxes(t.reshape(B_, n_c, CHUNK, H, t.shape[-1]), 0, 1)

    def step(state, inp):
        qi, ki, vi, la = inp
        g = jnp.cumsum(la.astype(jnp.float32), axis=1)
        dmat = jnp.exp(-jnp.abs(g[:, :, None] - g[:, None, :]))
        a = jnp.einsum('bthd,bshd,btshd->bhts', qi, ki, dmat)
        o = (jnp.einsum('bhts,bshe->bthe', a, vi)
             + jnp.einsum('bthd,bhde->bthe', qi * jnp.exp(g), state))
        g_last = g[:, -1]
        k_dec = ki * jnp.exp(g_last[:, None] - g)
        state = jnp.exp(g_last)[..., None] * state + jnp.einsum('bshd,bshe->bhde', k_dec, vi)
        return state, o

    init = jnp.zeros((B_, H, dk, dv), jnp.float32)
    _, o = lax.scan(step, init, (to_chunks(q), to_chunks(k), to_chunks(v), to_chunks(log_a)))
    return jnp.swapaxes(o, 0, 1).reshape(B_, S_, H, dv)


def route(h, router_w, router_b):
    t = h.shape[0]
    scores = jax.nn.sigmoid((h @ router_w).astype(jnp.float32))
    biased = scores + router_b.astype(jnp.float32)
    grp = biased.reshape(t, N_GROUPS, EXPERTS_PER_GROUP)
    group_score = jnp.sum(lax.top_k(grp, GROUP_SCORE_K)[0], axis=-1)
    g_sel = jnp.argmax(group_score, axis=-1)
    in_group = (jnp.arange(N_EXPERTS) // EXPERTS_PER_GROUP)[None, :] == g_sel[:, None]
    _, idx = lax.top_k(jnp.where(in_group, biased, -jnp.inf), TOP_K)
    w = jnp.take_along_axis(scores, idx, axis=-1)
    return idx, w / jnp.sum(w, axis=-1, keepdims=True)


def moe(h, idx, gates, w_gate, w_up, w_down):
    t, d = h.shape
    n_a = t * TOP_K
    e_flat = idx.reshape(n_a)
    tok_flat = jnp.repeat(jnp.arange(t, dtype=jnp.int32), TOP_K)
    g_flat = gates.reshape(n_a)
    order = jnp.argsort(e_flat)
    e_s, tok_s, g_s = e_flat[order], tok_flat[order], g_flat[order]
    counts = jnp.bincount(e_flat, length=N_EXPERTS)
    starts = jnp.cumsum(counts) - counts
    padded = ((counts + MOE_BLOCK - 1) // MOE_BLOCK) * MOE_BLOCK
    pad_ends = jnp.cumsum(padded)
    pad_starts = pad_ends - padded
    dest = pad_starts[e_s] + jnp.arange(n_a) - starts[e_s]
    n_blocks = -(-n_a // MOE_BLOCK) + N_EXPERTS
    p_len = n_blocks * MOE_BLOCK
    tok_buf = jnp.full((p_len,), t, jnp.int32).at[dest].set(tok_s)
    gate_buf = jnp.zeros((p_len,), g_s.dtype).at[dest].set(g_s)
    block_expert = jnp.minimum(
        jnp.searchsorted(pad_ends, jnp.arange(n_blocks) * MOE_BLOCK, side='right'), N_EXPERTS - 1)
    h_pad = jnp.concatenate([h, jnp.zeros((1, d), h.dtype)], axis=0)

    def expert_block(args):
        toks, gts, e = args
        xb = h_pad[toks]
        u = jax.nn.silu(xb @ w_gate[e]) * (xb @ w_up[e])
        return (u @ w_down[e]) * gts[:, None].astype(xb.dtype)

    y = lax.map(expert_block, (tok_buf.reshape(n_blocks, MOE_BLOCK),
                               gate_buf.reshape(n_blocks, MOE_BLOCK), block_expert))
    out = jnp.zeros((t + 1, d), y.dtype).at[tok_buf].add(y.reshape(p_len, d))
    return out[:t]


def setup_inputs(seed: int = 0) -> dict:
    key = jax.random.key(seed)
    ks = jax.random.split(key, 26)
    f32 = jnp.float32
    nrm = lambda k, shape, s: jax.random.normal(k, shape, f32) * s
    gain = lambda k, shape: 1.0 + 0.02 * jax.random.normal(k, shape, f32)
    x = jax.random.normal(ks[0], (BATCH, SEQ, D_MODEL), f32)
    c = jax.random.normal(ks[1], (BATCH, D_MODEL), f32)
    offsets = jax.random.randint(ks[2], (BATCH, 1), 0, 1024) * CHUNK
    positions = (offsets + jnp.arange(SEQ, dtype=jnp.int32)[None, :]).astype(jnp.int32)
    return {
        "x": x,
        "c": c,
        "positions": positions,
        "w_mod": nrm(ks[3], (DEPTH, D_MODEL, 6 * D_MODEL), 0.01),
        "b_mod": nrm(ks[4], (DEPTH, 6 * D_MODEL), 0.02),
        "norm1_g": gain(ks[5], (DEPTH, D_MODEL)),
        "norm2_g": gain(ks[6], (DEPTH, D_MODEL)),
        "w_in": nrm(ks[7], (DEPTH, D_MODEL, IN_WIDTH), D_MODEL ** -0.5),
        "ret_norm_g": gain(ks[8], (DEPTH, RET_DV)),
        "diff_q_g": gain(ks[9], (DEPTH, DIFF_DK)),
        "diff_k_g": gain(ks[10], (DEPTH, DIFF_DK)),
        "lam_q1": nrm(ks[11], (DEPTH, DIFF_DK), 0.1),
        "lam_k1": nrm(ks[12], (DEPTH, DIFF_DK), 0.1),
        "lam_q2": nrm(ks[13], (DEPTH, DIFF_DK), 0.1),
        "lam_k2": nrm(ks[14], (DEPTH, DIFF_DK), 0.1),
        "diff_sub_g": gain(ks[15], (DEPTH, DIFF_DV)),
        "gla_w_a2": nrm(ks[16], (DEPTH, GLA_RANK, GLA_HEADS * GLA_DK), GLA_RANK ** -0.5),
        "gla_b_a": nrm(ks[17], (DEPTH, GLA_HEADS * GLA_DK), 0.1),
        "gla_norm_g": gain(ks[18], (DEPTH, GLA_DV)),
        "w_out": nrm(ks[19], (DEPTH, MIX_WIDTH, D_MODEL), MIX_WIDTH ** -0.5),
        "router_w": nrm(ks[20], (D_MODEL, N_EXPERTS), D_MODEL ** -0.5),
        "router_b": nrm(ks[21], (N_EXPERTS,), 0.01),
        "w_gate": nrm(ks[22], (DEPTH, N_EXPERTS, D_MODEL, D_EXPERT), D_MODEL ** -0.5),
        "w_up": nrm(ks[23], (DEPTH, N_EXPERTS, D_MODEL, D_EXPERT), D_MODEL ** -0.5),
        "w_down": nrm(ks[24], (DEPTH, N_EXPERTS, D_EXPERT, D_MODEL), D_EXPERT ** -0.5),
    }


def reference(x, c, positions, w_mod, b_mod, norm1_g, norm2_g, w_in, ret_norm_g,
              diff_q_g, diff_k_g, lam_q1, lam_k1, lam_q2, lam_k2, diff_sub_g,
              gla_w_a2, gla_b_a, gla_norm_g, w_out, router_w, router_b,
              w_gate, w_up, w_down):
    B_, S_, D = x.shape
    heads = lambda t, n: t.reshape(B_, S_, n, -1)
    c_act = jax.nn.silu(c)
    for l in range(DEPTH):
        lam_init = 0.8 - 0.6 * math.exp(-0.3 * l)
        mod = c_act @ w_mod[l] + b_mod[l]
        sh1, sc1, gt1, sh2, sc2, gt2 = jnp.split(mod[:, None, :], 6, axis=-1)
        h = rms_norm(x, norm1_g[l]) * (1.0 + sc1) + sh1
        (rq, rk, rv, rg, dq, dk_, dv_, gq, gk, gv, ga, gr) = split_cols(h @ w_in[l], IN_SPLITS)
        out_r = rms_norm(retention(heads(rq, RET_HEADS), heads(rk, RET_HEADS),
                                   heads(rv, RET_HEADS), positions),
                         ret_norm_g[l]) * jax.nn.silu(heads(rg, RET_HEADS))
        out_d = diff_attention(dq.reshape(B_, S_, DIFF_HEADS, 2, DIFF_DK),
                               dk_.reshape(B_, S_, DIFF_HEADS, 2, DIFF_DK),
                               heads(dv_, DIFF_HEADS), positions, diff_q_g[l], diff_k_g[l],
                               lam_q1[l], lam_k1[l], lam_q2[l], lam_k2[l], diff_sub_g[l],
                               lam_init)
        log_a = jax.nn.log_sigmoid((ga @ gla_w_a2[l] + gla_b_a[l]).astype(jnp.float32)) / GLA_TAU
        out_g = rms_norm(gated_linear_attention(heads(gq, GLA_HEADS), heads(gk, GLA_HEADS),
                                                heads(gv, GLA_HEADS), heads(log_a, GLA_HEADS)),
                         gla_norm_g[l]) * jax.nn.silu(heads(gr, GLA_HEADS))
        mixed = jnp.concatenate([out_r.reshape(B_, S_, RET_W), out_d.reshape(B_, S_, DIFF_W),
                                 out_g.reshape(B_, S_, GLA_W)], axis=-1)
        x = x + gt1 * (mixed @ w_out[l])
        h2 = (rms_norm(x, norm2_g[l]) * (1.0 + sc2) + sh2).reshape(B_ * S_, D)
        idx, gates = route(h2, router_w, router_b)
        y = moe(h2, idx, gates, w_gate[l], w_up[l], w_down[l]).reshape(B_, S_, D)
        x = x + gt2 * y
    return x
```

```cpp
#include <hip/hip_runtime.h>
#include <cstdio>
#include <cstdint>

#ifndef MK_N_LAUNCHES
#define MK_N_LAUNCHES 0
#endif
#ifndef DBG_GROUPS
#define DBG_GROUPS 7
#endif
#ifndef DBG_MOE
#define DBG_MOE 1
#endif

#define LAS __attribute__((address_space(3)))
#define GAS __attribute__((address_space(1)))
typedef unsigned short bf16;
typedef short bf16x8 __attribute__((ext_vector_type(8)));
typedef short s16x4 __attribute__((ext_vector_type(4)));
typedef float f32x4 __attribute__((ext_vector_type(4)));
typedef float f32x16 __attribute__((ext_vector_type(16)));
typedef float f32x2 __attribute__((ext_vector_type(2)));
typedef unsigned u32x4 __attribute__((ext_vector_type(4)));
typedef unsigned u32x2 __attribute__((ext_vector_type(2)));
typedef __bf16 bf16x2_t __attribute__((ext_vector_type(2)));

constexpr int BATCH = 8, SEQ = 8192, DM = 1024, T = BATCH * SEQ, DEPTH = 2;
constexpr int NP = 3584;
constexpr int C_RQ = 0, C_RK = 256, C_RV = 512, C_RG = 768, C_DQ = 1024, C_DK = 1536, C_DV = 2048, C_GQ = 2560, C_GK = 2688, C_GV = 2816, C_LA = 3072, C_GR = 3200, C_PAD = 3456;
constexpr int IN_W = 3344;
constexpr int NCLS = 48, TPAD = T + NCLS * 256, MAXTILES = TPAD / 256;
constexpr float EPS = 1e-6f, LOG2E = 1.4426950408889634f;

constexpr size_t MiB = 1u << 20;
constexpr size_t WS_CTL = 0, CTL_ZERO_BYTES = 1 * MiB;
constexpr size_t WS_MOD = 1 * MiB;
constexpr size_t WS_SCAL = WS_MOD + 400 * 1024;
constexpr size_t WS_CSR = 2 * MiB;
constexpr size_t WS_CSD = 19 * MiB;
constexpr size_t WS_WIN = 24 * MiB;
constexpr size_t WS_WOUT = 38 * MiB;
constexpr size_t WS_W1 = 42 * MiB;
constexpr size_t WS_W2 = 170 * MiB;
constexpr size_t WS_ACT = 234 * MiB;
constexpr size_t WS_P = 362 * MiB;
constexpr size_t WS_H2S = WS_P;
constexpr size_t WS_U = WS_P + 152 * MiB;
constexpr size_t WS_EST = 810 * MiB;
constexpr size_t WS_EGL = WS_EST + 8 * MiB, WS_ASR = WS_EST + 12 * MiB, WS_ASG = WS_ASR + 256 * 1024;
constexpr size_t WS_ROUTE = 824 * MiB;
constexpr size_t WS_TOKS = WS_ROUTE + 1 * MiB, WS_GAS = WS_TOKS + 512 * 1024, WS_GBS = WS_GAS + 512 * 1024, WS_TINFO = WS_GBS + 512 * 1024;
constexpr size_t WS_END = 828 * MiB;
static_assert((size_t)TPAD * 1024 * 2 <= 152 * MiB && WS_U + 152 * MiB <= WS_P + (size_t)T * NP * 2, "aliases fit inside P");
static_assert((size_t)T * NP * 2 == 448 * MiB && WS_P + 448 * MiB == WS_EST, "P size");
constexpr int CW_BAR = 4096;
constexpr int CW_CNT = 16384;

constexpr int RING_BYTES = 131072, LDSCTL_OFF = RING_BYTES, MISC_OFF = LDSCTL_OFF + 320, PTR_OFF = MISC_OFF + 128, LDS_BYTES = 147456;
constexpr int NWAVES = 8;

__device__ __forceinline__ unsigned pk2(float lo, float hi) { f32x2 v = {lo, hi}; bf16x2_t b = __builtin_convertvector(v, bf16x2_t); return __builtin_bit_cast(unsigned, b); }
__device__ __forceinline__ float bflo(unsigned w) { return __uint_as_float(w << 16); }
__device__ __forceinline__ float bfhi(unsigned w) { return __uint_as_float(w & 0xffff0000u); }
template <int K> __device__ __forceinline__ float sx(float v) { static_assert(K >= 1 && K < 32, "sx"); return __int_as_float(__builtin_amdgcn_ds_swizzle(__float_as_int(v), (K << 10) | 0x1f)); }
__device__ __forceinline__ float sum_halves(float v) { auto rr = __builtin_amdgcn_permlane32_swap(__float_as_uint(v), __float_as_uint(v), false, false); return __uint_as_float(rr[0]) + __uint_as_float(rr[1]); }
__device__ __forceinline__ float max_halves(float v) { auto rr = __builtin_amdgcn_permlane32_swap(__float_as_uint(v), __float_as_uint(v), false, false); return fmaxf(__uint_as_float(rr[0]), __uint_as_float(rr[1])); }
__device__ __forceinline__ float wave_sum(float v) { v += sx<1>(v); v += sx<2>(v); v += sx<4>(v); v += sx<8>(v); v += sx<16>(v); return sum_halves(v); }
__device__ __forceinline__ float wave_max(float v) { v = fmaxf(v, sx<1>(v)); v = fmaxf(v, sx<2>(v)); v = fmaxf(v, sx<4>(v)); v = fmaxf(v, sx<8>(v)); v = fmaxf(v, sx<16>(v)); return max_halves(v); }
__device__ __forceinline__ float silu_f(float x) { return x / (1.0f + __expf(-x)); }
__device__ __forceinline__ int olane() { int l; asm volatile("v_mbcnt_lo_u32_b32 %0, -1, 0\n\tv_mbcnt_hi_u32_b32 %0, -1, %0" : "=v"(l)); return l; }
__device__ __forceinline__ int otid_w(int wave) { return wave * 64 + olane(); }
#define otid() otid_w(g_wave)
template <class Tp> __device__ __forceinline__ const Tp* inptr(const LAS unsigned char* lds, int k) {
    const LAS unsigned* q = (const LAS unsigned*)(lds + PTR_OFF) + 2 * k; const unsigned lo = __builtin_amdgcn_readfirstlane(q[0]), hi = __builtin_amdgcn_readfirstlane(q[1]);
    return (const Tp*)(((unsigned long long)hi << 32) | lo); }
#define INF(k) inptr<float>(lds, k)
#define LDS_WAIT() asm volatile("s_waitcnt lgkmcnt(0)" ::: "memory")
#define VM_WAIT() asm volatile("s_waitcnt vmcnt(0)" ::: "memory")

namespace pg8 {
constexpr int BM = 256, BK = 64, HALF = 128, HTB = HALF * BK * 2, STAGE_BYTES = 8 * HTB, NXCD = 8, WGM = 8;
__device__ __forceinline__ int lds_byte(int r, int c) { const int st = (r >> 4) * 2 + (c >> 5), rr = r & 15, cc = c & 31, ob = rr * 64 + cc * 2; return st * 1024 + (ob ^ (((ob >> 9) & 1) << 5)); }
__device__ __forceinline__ void stage_rc(int b, int& R, int& C) { const int st = b / 1024, sb = b % 1024, swz = sb ^ (((sb >> 9) & 1) << 5); R = (st >> 1) * 16 + swz / 64; C = (st & 1) * 32 + (swz % 64) / 2; }
__device__ __forceinline__ int perm32(int rho) { const int n = rho >> 4, i = rho & 15; return 8 * (i >> 2) + 4 * n + (i & 3); }

struct Unit { int pm, pn, e0, e1; };
struct Gemm { const bf16* A; const bf16* Bt; int K, lda, ldb; };

template <int NM, int NN> struct StaticOrder {
    static constexpr int nM = NM, nN = NN, nwg = NM * NN;
    int G, c;
    __device__ void init(int G_, int c_) { G = G_; c = c_; }
    __device__ bool next(int i, Unit& u) const {
        const int L = i * G + c; if (L >= nwg) return false;
        int wgid = L; { constexpr int q = nwg / NXCD, r = nwg % NXCD; const int xcd = wgid % NXCD, off = wgid / NXCD; wgid = (xcd < r ? xcd * (q + 1) : r * (q + 1) + (xcd - r) * q) + off; }
        constexpr int nig = WGM * nN; static_assert(NM % WGM == 0, "row tiles in whole groups");
        const int gid = wgid / nig, fm = gid * WGM;
        u.pm = fm + ((wgid % nig) % WGM); u.pn = (wgid % nig) / WGM; u.e0 = 0; u.e1 = 0; return true;
    }
    __device__ __forceinline__ const char* a_base(const Gemm& g, const Unit& u) const { return (const char*)g.A + (size_t)u.pm * BM * g.lda * 2; }
    __device__ __forceinline__ const char* b_lo(const Gemm& g, const Unit& u) const { return (const char*)g.Bt + (size_t)u.pn * BM * g.ldb * 2; }
    __device__ __forceinline__ const char* b_hi(const Gemm& g, const Unit& u) const { return b_lo(g, u); }
};
template <int NPN, int WHICH  >
struct MoeOrder {
    const int* tinfo; int G, c;
    __device__ bool next(int i, Unit& u) const {
        const int nT = __builtin_amdgcn_readfirstlane(tinfo[0]);
        const int L = i * G + c; if (L >= nT * NPN) return false;
        const int gF = nT >> 3, full = gF * 8 * NPN;
        if (L < full) { u.pm = (L / (8 * NPN)) * 8 + (L & 7); u.pn = (L >> 3) % NPN; }
        else { const int rT = nT - 8 * gF; int Lr = L - full, pn = 0; while (Lr >= rT) { Lr -= rT; ++pn; } u.pm = gF * 8 + Lr; u.pn = pn; }
        const int code = __builtin_amdgcn_readfirstlane(tinfo[1 + u.pm]); u.e0 = code & 0xff; u.e1 = (code >> 8) & 0xff; return true;
    }
    __device__ __forceinline__ const char* a_base(const Gemm& g, const Unit& u) const { return (const char*)g.A + (size_t)u.pm * BM * g.lda * 2; }
    __device__ __forceinline__ const char* b_lo(const Gemm& g, const Unit& u) const {
        if (WHICH == 1) return (const char*)g.Bt + ((size_t)(u.pn < 4 ? u.e0 : u.e1) * 1024 * 1024 + (size_t)(u.pn & 3) * BM * 1024) * 2;
        return (const char*)g.Bt + ((size_t)u.e0 * 1024 * 512 + (size_t)u.pn * BM * 512) * 2;
    }
    __device__ __forceinline__ const char* b_hi(const Gemm& g, const Unit& u) const {
        if (WHICH == 1) return b_lo(g, u);
        return (const char*)g.Bt + ((size_t)u.e1 * 1024 * 512 + (size_t)u.pn * BM * 512) * 2 - (size_t)8 * BK * 2;
    }
};

struct EpiStoreBf16 {
    static constexpr bool PERM = true;
    bf16* O; int ldc;
    __device__ __forceinline__ void operator()(const f32x4 (&acc)[2][2][4][2], const Unit& u, int wr, int wc, int fr, int fq) const {
        const int row0 = u.pm * BM + wr * 64 + fr, col0 = u.pn * BM + wc * 32 + 8 * fq;
#pragma unroll
        for (int ai = 0; ai < 2; ++ai)
#pragma unroll
            for (int m = 0; m < 4; ++m) { bf16* rowp = O + (size_t)(row0 + ai * HALF + m * 16) * ldc + col0;
#pragma unroll
                for (int bj = 0; bj < 2; ++bj) { const f32x4 v0 = acc[ai][bj][m][0], v1 = acc[ai][bj][m][1];
                    u32x4 w; w.x = pk2(v0[0], v0[1]); w.y = pk2(v0[2], v0[3]); w.z = pk2(v1[0], v1[1]); w.w = pk2(v1[2], v1[3]);
                    *(u32x4*)(rowp + bj * HALF) = w; } }
    }
};
struct EpiResid {
    static constexpr bool PERM = false;
    const float* xin; float* out; const float* gate;
    __device__ __forceinline__ void operator()(const f32x4 (&acc)[2][2][4][2], const Unit& u, int wr, int wc, int fr, int fq) const {
        const int col0 = u.pn * BM + wc * 32 + 4 * fq; const int b = (u.pm * BM) >> 13;
        f32x4 gv[2][2];
#pragma unroll
        for (int bj = 0; bj < 2; ++bj)
#pragma unroll
            for (int n = 0; n < 2; ++n) gv[bj][n] = *(const f32x4*)(gate + (size_t)b * 6144 + col0 + bj * HALF + n * 16);
#pragma unroll
        for (int ai = 0; ai < 2; ++ai)
#pragma unroll
            for (int m = 0; m < 4; ++m) { const size_t off = (size_t)(u.pm * BM + ai * HALF + wr * 64 + m * 16 + fr) * DM + col0;
#pragma unroll
                for (int bj = 0; bj < 2; ++bj)
#pragma unroll
                    for (int n = 0; n < 2; ++n) { const f32x4 xv = *(const f32x4*)(xin + off + bj * HALF + n * 16); *(f32x4*)(out + off + bj * HALF + n * 16) = xv + gv[bj][n] * acc[ai][bj][m][n]; } }
    }
};
struct EpiMoe1 {
    static constexpr bool PERM = true;
    bf16* U; const float* gaS; const float* gbS;
    __device__ __forceinline__ void operator()(const f32x4 (&acc)[2][2][4][2], const Unit& u, int wr, int wc, int fr, int fq) const {
        const float* gs = (u.pn < 4) ? gaS : gbS; const int ucol = u.pn * 128 + wc * 32 + 8 * fq;
#pragma unroll
        for (int ai = 0; ai < 2; ++ai)
#pragma unroll
            for (int m = 0; m < 4; ++m) { const int slot = u.pm * BM + ai * HALF + wr * 64 + m * 16 + fr; const float w = gs[slot];
                float r[8];
#pragma unroll
                for (int n = 0; n < 2; ++n)
#pragma unroll
                    for (int i = 0; i < 4; ++i) { const float g = acc[ai][0][m][n][i], up = acc[ai][1][m][n][i]; r[n * 4 + i] = silu_f(g) * up * w; }
                u32x4 o; o.x = pk2(r[0], r[1]); o.y = pk2(r[2], r[3]); o.z = pk2(r[4], r[5]); o.w = pk2(r[6], r[7]);
                *(u32x4*)(U + (size_t)slot * 1024 + ucol) = o; }
    }
};
struct EpiMoe2 {
    static constexpr bool PERM = false;
    float* x; const int* tokS; const float* gate;
    __device__ __forceinline__ void operator()(const f32x4 (&acc)[2][2][4][2], const Unit& u, int wr, int wc, int fr, int fq) const {
        const int col0 = u.pn * BM + wc * 32 + 4 * fq;
#pragma unroll
        for (int ai = 0; ai < 2; ++ai)
#pragma unroll
            for (int m = 0; m < 4; ++m) { const int slot = u.pm * BM + ai * HALF + wr * 64 + m * 16 + fr; const int tok = tokS[slot];
                if (tok >= 0) { const int b = tok >> 13; float* xp = x + (size_t)tok * DM + col0; const float* gp = gate + (size_t)b * 6144 + col0;
#pragma unroll
                    for (int bj = 0; bj < 2; ++bj)
#pragma unroll
                        for (int n = 0; n < 2; ++n) { const f32x4 gv = *(const f32x4*)(gp + bj * HALF + n * 16); const f32x4 xv = *(const f32x4*)(xp + bj * HALF + n * 16);
                            *(f32x4*)(xp + bj * HALF + n * 16) = xv + (DBG_MOE ? 1.f : 0.f) * gv * acc[ai][bj][m][n]; } } }
    }
};

template <class Epi, class Sched, int KSPLIT  >
__device__ __forceinline__ void gemm_phase(LAS unsigned char* lds, const Gemm g, const Sched& S, const Epi& E, const int g_wave) {
    const int tid = otid(), wid = __builtin_amdgcn_readfirstlane(tid >> 6), lane = tid & 63, wr = wid >> 2, wc = wid & 3, fr = lane & 15, fq = lane >> 4;
    const int K = g.K, nt = K / BK;
    unsigned voffA[2], voffB[2];
#pragma unroll
    for (int i = 0; i < 2; ++i) { int R, C; stage_rc(tid * 16 + i * 8192, R, C); const int Rb = Epi::PERM ? ((R & ~31) + perm32(R & 31)) : R;
        voffA[i] = (unsigned)(R * g.lda + C) * 2u; voffB[i] = (unsigned)(Rb * g.ldb + C) * 2u; }
    const size_t kstep = (size_t)(BK * 2);
    const size_t hstepA = (size_t)HALF * g.lda * 2, hstepB = (size_t)HALF * g.ldb * 2;
    const unsigned ldsw = (unsigned)wid * 1024u;
    const int aoff = lds_byte(wr * 64 + fr, fq * 8), boff = lds_byte(wc * 32 + fr, fq * 8);
#define PG8_SA(b, h) (((b) * 2 + (h)) * HTB)
#define PG8_SB(b, h) ((4 + (b) * 2 + (h)) * HTB)
#define PG8_STAGE(bufoff, gbase, voff) do { _Pragma("unroll") for (int _i = 0; _i < 2; ++_i) \
        __builtin_amdgcn_global_load_lds((const unsigned*)((const char*)(gbase) + (voff)[_i]), (LAS unsigned*)(lds + (bufoff) + ldsw + _i * 8192), 16, 0, 0); } while (0)
#define PG8_LDA(dst, b, h) do { _Pragma("unroll") for (int m = 0; m < 4; ++m) _Pragma("unroll") for (int k = 0; k < 2; ++k) dst[m][k] = *(const LAS bf16x8*)(lds + PG8_SA(b, h) + aoff + m * 2048 + k * 1024); } while (0)
#define PG8_LDB(dst, b, h) do { _Pragma("unroll") for (int n = 0; n < 2; ++n) _Pragma("unroll") for (int k = 0; k < 2; ++k) dst[n][k] = *(const LAS bf16x8*)(lds + PG8_SB(b, h) + boff + n * 2048 + k * 1024); } while (0)
#define PG8_MMA(ai, bj, At, Bt) do { __builtin_amdgcn_s_setprio(1); _Pragma("unroll") for (int m = 0; m < 4; ++m) _Pragma("unroll") for (int n = 0; n < 2; ++n) _Pragma("unroll") for (int k = 0; k < 2; ++k) \
        acc[ai][bj][m][n] = __builtin_amdgcn_mfma_f32_16x16x32_bf16(Bt[n][k], At[m][k], acc[ai][bj][m][n], 0, 0, 0); __builtin_amdgcn_s_setprio(0); } while (0)
#define PG8_WAIT_V(n) asm volatile("s_waitcnt vmcnt(" #n ")" ::: "memory")
#define PG8_WAIT_L(n) asm volatile("s_waitcnt lgkmcnt(" #n ")" ::: "memory")
#define PG8_BAR __builtin_amdgcn_s_barrier()
#define PG8_SCHED __builtin_amdgcn_sched_barrier(0)
    Unit cur, nxt; int ui = 0;
    if (!S.next(0, cur)) return;
    f32x4 acc[2][2][4][2];
#pragma unroll
    for (int a = 0; a < 2; ++a)
#pragma unroll
        for (int b = 0; b < 2; ++b)
#pragma unroll
            for (int m = 0; m < 4; ++m)
#pragma unroll
                for (int n = 0; n < 2; ++n) acc[a][b][m][n] = (f32x4){0.f, 0.f, 0.f, 0.f};
    bf16x8 At[4][2], B0[2][2], B1[2][2];
    const char* cA = S.a_base(g, cur); const char* cB = S.b_lo(g, cur); const char* cBh = S.b_hi(g, cur);
    PG8_STAGE(PG8_SB(0, 0), cB, voffB); PG8_STAGE(PG8_SB(0, 1), cB + hstepB, voffB); PG8_STAGE(PG8_SA(0, 0), cA, voffA); PG8_STAGE(PG8_SA(0, 1), cA + hstepA, voffA);
    if (wr == 1) PG8_BAR;
    PG8_WAIT_V(2); PG8_BAR;
    PG8_STAGE(PG8_SB(1, 0), cB + kstep, voffB); PG8_STAGE(PG8_SA(1, 0), cA + kstep, voffA); PG8_STAGE(PG8_SB(1, 1), cB + hstepB + kstep, voffB);
    PG8_WAIT_V(6); PG8_BAR;
    for (;;) {
        const bool has_next = S.next(ui + 1, nxt);
        const char* nA = has_next ? S.a_base(g, nxt) : cA; const char* nB = has_next ? S.b_lo(g, nxt) : cB; const char* nBh = has_next ? S.b_hi(g, nxt) : cBh;
        for (int t = 0; t < nt; t += 2) {
            const bool last = (t == nt - 2);
            const char* a1 = cA + (size_t)(t + 1) * kstep;
            const char* bsel = (KSPLIT != 0 && (t + 2) >= KSPLIT) ? cBh : cB;
            const char* a2 = last ? nA : cA + (size_t)(t + 2) * kstep; const char* b2 = last ? nB : bsel + (size_t)(t + 2) * kstep;
            const char* a3 = a2 + kstep; const char* b3 = b2 + kstep;
            PG8_LDB(B0, 0, 0); PG8_LDB(B1, 0, 1); PG8_SCHED; PG8_LDA(At, 0, 0); PG8_STAGE(PG8_SA(1, 1), a1 + hstepA, voffA);
            PG8_WAIT_V(8); PG8_WAIT_L(0); PG8_BAR; PG8_MMA(0, 0, At, B0); PG8_MMA(0, 1, At, B1); PG8_BAR; PG8_SCHED;
            PG8_LDA(At, 0, 1); PG8_STAGE(PG8_SB(0, 0), b2, voffB); PG8_STAGE(PG8_SB(0, 1), b2 + hstepB, voffB); PG8_STAGE(PG8_SA(0, 0), a2, voffA);
            PG8_WAIT_V(8); PG8_WAIT_L(0); PG8_BAR; PG8_MMA(1, 0, At, B0); PG8_MMA(1, 1, At, B1); PG8_BAR; PG8_SCHED;
            PG8_LDB(B0, 1, 0); PG8_LDB(B1, 1, 1); PG8_SCHED; PG8_LDA(At, 1, 0); PG8_STAGE(PG8_SA(0, 1), a2 + hstepA, voffA);
            PG8_WAIT_V(8); PG8_WAIT_L(0); PG8_BAR; PG8_MMA(0, 0, At, B0); PG8_MMA(0, 1, At, B1); PG8_BAR; PG8_SCHED;
            PG8_LDA(At, 1, 1); PG8_STAGE(PG8_SB(1, 0), b3, voffB); PG8_STAGE(PG8_SB(1, 1), b3 + hstepB, voffB); PG8_STAGE(PG8_SA(1, 0), a3, voffA);
            PG8_WAIT_V(8); PG8_WAIT_L(0); PG8_BAR; PG8_MMA(1, 0, At, B0); PG8_MMA(1, 1, At, B1); PG8_BAR; PG8_SCHED;
        }
        if (wr == 0) PG8_BAR;
        E(acc, cur, wr, wc, fr, fq);
        if (!has_next) break;
#pragma unroll
        for (int a = 0; a < 2; ++a)
#pragma unroll
            for (int b = 0; b < 2; ++b)
#pragma unroll
                for (int m = 0; m < 4; ++m)
#pragma unroll
                    for (int n = 0; n < 2; ++n) acc[a][b][m][n] = (f32x4){0.f, 0.f, 0.f, 0.f};
        cur = nxt; cA = nA; cB = nB; cBh = nBh; ++ui;
        if (wr == 1) PG8_BAR;
    }
    PG8_WAIT_V(0);
    PG8_BAR;
#undef PG8_SA
#undef PG8_SB
#undef PG8_STAGE
#undef PG8_LDA
#undef PG8_LDB
#undef PG8_MMA
#undef PG8_WAIT_V
#undef PG8_WAIT_L
#undef PG8_BAR
#undef PG8_SCHED
}
}

#define XB_TMO      128
#define XB_XCNT(j)  (256  + 64 * (j))
#define XB_XSUB(j)  (1280 + 64 * (j))
#define XB_XGEN(j)  (2304 + 64 * (j))
#define XB_TOP      3328
#define XB_TOPGEN   3392
#define XCD_BAR_WORDS 3456
#define XB_SPIN_CAP (1u << 21)
__device__ __forceinline__ unsigned xb_ld(unsigned* p)              { return __hip_atomic_load(p, __ATOMIC_RELAXED, __HIP_MEMORY_SCOPE_AGENT); }
__device__ __forceinline__ unsigned xb_add(unsigned* p, unsigned v) { return __hip_atomic_fetch_add(p, v, __ATOMIC_RELAXED, __HIP_MEMORY_SCOPE_AGENT); }
__device__ __forceinline__ unsigned xb_xcc_id() { return (unsigned)__builtin_amdgcn_s_getreg((3 << 11) | 20) & 0xFu; }
#define XB_SPIN(cond, bar) do { unsigned _sp = 0; while (cond) { __builtin_amdgcn_s_sleep(1); \
    if ((++_sp & 255u) == 0u) { if (xb_ld(&(bar)[XB_TMO])) break; if (_sp > XB_SPIN_CAP) { atomicAdd(&(bar)[XB_TMO], 1u); break; } } } } while (0)
struct XcdBarrier { unsigned* bar; unsigned x; volatile LAS unsigned* st; };
__device__ __forceinline__ XcdBarrier xcd_barrier_post(unsigned* bar, volatile LAS unsigned* st, bool leader) {
    XcdBarrier b; b.bar = bar; b.x = xb_xcc_id(); b.st = st;
    if (leader) (void)xb_add(&bar[XB_XCNT(b.x)], 1u);
    return b;
}
__device__ __forceinline__ void xcd_barrier_complete(unsigned* bar, unsigned x, unsigned& nloc, unsigned& nx) {
    const unsigned G = gridDim.x * gridDim.y * gridDim.z;
    unsigned sum, cnt, mine, sp = 0u;
    for (;;) {
        sum = 0u; cnt = 0u; mine = 0u;
#pragma unroll
        for (unsigned j = 0; j < 16; ++j) { const unsigned c = xb_ld(&bar[XB_XCNT(j)]); sum += c; cnt += (c > 0u) ? 1u : 0u; mine = (j == x) ? c : mine; }
        if (sum == G) break;
        __builtin_amdgcn_s_sleep(1);
        if ((++sp & 255u) == 0u) { if (xb_ld(&bar[XB_TMO])) break; if (sp > XB_SPIN_CAP) { atomicAdd(&bar[XB_TMO], 1u); break; } }
    }
    nloc = mine > 0u ? mine : 1u; nx = cnt > 0u ? cnt : 1u;
}
__device__ __forceinline__ void xcd_barrier(const XcdBarrier& b, bool leader) {
    asm volatile("s_waitcnt vmcnt(0)" ::: "memory");
    __syncthreads();
    if (leader) {
        unsigned* bar = b.bar;
        __builtin_amdgcn_s_waitcnt(0);
        unsigned nloc = b.st[0], nx = b.st[1];
        if (nloc == 0u) { xcd_barrier_complete(bar, b.x, nloc, nx); b.st[0] = nloc; b.st[1] = nx; }
        const unsigned old = xb_add(&bar[XB_XSUB(b.x)], 1u);
        const unsigned gen = old / nloc;
        if (old + 1u == (gen + 1u) * nloc) {
            __builtin_amdgcn_fence(__ATOMIC_RELEASE, "agent");
            asm volatile("s_waitcnt vmcnt(0)" ::: "memory");
            const unsigned og = xb_add(&bar[XB_TOP], 1u);
            const unsigned tg = og / nx;
            if (og + 1u == (tg + 1u) * nx) xb_add(&bar[XB_TOPGEN], 1u);
            else XB_SPIN(xb_ld(&bar[XB_TOPGEN]) == tg, bar);
            __builtin_amdgcn_fence(__ATOMIC_ACQUIRE, "agent");
            xb_add(&bar[XB_XGEN(b.x)], 1u);
            asm volatile("s_waitcnt vmcnt(0)" ::: "memory");
        } else {
            XB_SPIN(xb_ld(&bar[XB_XGEN(b.x)]) == gen, bar);
            __builtin_amdgcn_fence(__ATOMIC_ACQUIRE, "agent");
            asm volatile("s_waitcnt vmcnt(0)" ::: "memory");
        }
    }
    __syncthreads();
}

__device__ __forceinline__ int tr_row(int kind, int n) {
    if (kind == 0) return n;
    if (kind == 1) return n < 3072 ? n : (n < 3088 ? -1 : n + 112);
    return (n >> 7) * 256 + (n & 127) + (kind == 3 ? 128 : 0);
}
__device__ __forceinline__ void tr_item(const float* W, int K, int N, bf16* WT, int ldt, int kind, LAS float* scr, int item, int lane) {
    const int nblk = (N + 31) / 32, kb = item / nblk, nb = item % nblk, k0 = 64 * kb, n0 = 32 * nb;
    const bool inr = (n0 + (lane & 31)) < N;
#pragma unroll 8
    for (int i = 0; i < 32; ++i) { const int kk = 2 * i + (lane >> 5); scr[kk * 33 + (lane & 31)] = inr ? W[(size_t)(k0 + kk) * N + n0 + (lane & 31)] : 0.f; }
    LDS_WAIT(); asm volatile("" ::: "memory");
    const int c = lane & 7;
#pragma unroll
    for (int j = 0; j < 4; ++j) { const int n = (lane >> 3) + 8 * j; const LAS float* s = scr + (8 * c) * 33 + n;
        u32x4 o; o.x = pk2(s[0 * 33], s[1 * 33]); o.y = pk2(s[2 * 33], s[3 * 33]); o.z = pk2(s[4 * 33], s[5 * 33]); o.w = pk2(s[6 * 33], s[7 * 33]);
        const int gn = n0 + n; const int r = (gn < N) ? tr_row(kind, gn) : -1;
        if (r >= 0) *(u32x4*)(WT + (size_t)r * ldt + k0 + 8 * c) = o; }
    LDS_WAIT(); asm volatile("" ::: "memory");
}

namespace lin {
constexpr int L_QL = 0, L_QU = 9216, L_KL = 18432, L_KU = 27648, L_KLT = 36864, L_VT = 46080, L_AM = 55296, L_ST = 64512, L_OUT = 73728, L_G = 90368, L_GL = 98560, L_END = 98816;
constexpr int NSEG = 16, LSEG = 8;
#define MFMA16(a, b, c) __builtin_amdgcn_mfma_f32_16x16x32_bf16(a, b, c, 0, 0, 0)
__device__ __forceinline__ bf16x8 frag(const LAS unsigned char* base, int pitchB, int r0, int ks, int lane) {
    return *(const LAS bf16x8*)(base + (r0 + (lane & 15)) * pitchB + (32 * ks + 8 * (lane >> 4)) * 2);
}
template <int DK, bool RET, bool PH2>
__device__ __forceinline__ void unit(LAS unsigned char* lds, const bf16* P, bf16* MIX, const f32x2* csr, int b, int h, int seg,
                                     const float* b_a, const float* gnorm, float* Est, float* Aseg, const int g_wave) {
    constexpr int PQ = (DK + 8) * 2;
    constexpr int PS = 144;
    constexpr int NT = DK / 32;
    const int tid = otid(), lane = tid & 63, wid = __builtin_amdgcn_readfirstlane(tid >> 6);
    const int row = tid >> 3, c8 = tid & 7;
    const int entry = (b * 4 + h) * NSEG + seg;
    const float lng = RET ? __logf(1.0f - exp2f(-5.0f - (float)h)) : 0.f;
    const int cq = RET ? C_RQ + h * 64 : C_GQ + h * 32, ck = RET ? C_RK + h * 64 : C_GK + h * 32, cv = RET ? C_RV + h * 64 : C_GV + h * 64, cg = RET ? C_RG + h * 64 : C_GR + h * 64;
    f32x4 st[NT]; float ac[NT];
    int eb[NT], db[NT];
#pragma unroll
    for (int j = 0; j < NT; ++j) { const int i = wid + 8 * j; if (DK == 64) { eb[j] = i >> 2; db[j] = i & 3; } else { eb[j] = i >> 1; db[j] = i & 1; } st[j] = (f32x4){0.f, 0.f, 0.f, 0.f}; ac[j] = 1.f; }
    if (PH2) {
        for (int sp = 0; sp < seg; ++sp) { const int en = (b * 4 + h) * NSEG + sp;
#pragma unroll
            for (int j = 0; j < NT; ++j) { const int d = db[j] * 16 + (lane & 15); const float a = Aseg[(size_t)en * DK + d];
#pragma unroll
                for (int r = 0; r < 4; ++r) { const int e = eb[j] * 16 + 4 * (lane >> 4) + r; st[j][r] = a * st[j][r] + Est[((size_t)en * 64 + e) * DK + d]; } } }
    }
    for (int c = 0; c < LSEG; ++c) {
        const size_t m0 = (size_t)b * SEQ + (size_t)(seg * LSEG + c) * 64;
        if (!RET) {
            const u32x2 w = *(const u32x2*)(P + (m0 + lane) * NP + C_LA + h * 32 + 4 * wid);
            float x[4] = {bflo(w.x), bfhi(w.x), bflo(w.y), bfhi(w.y)};
#pragma unroll
            for (int i = 0; i < 4; ++i) { const float z = x[i] + b_a[h * 32 + 4 * wid + i]; float v = (fminf(z, 0.f) - log1pf(__expf(-fabsf(z)))) * (1.0f / 16.0f);
#pragma unroll
                for (int o = 1; o < 64; o <<= 1) { const float u = __int_as_float(__builtin_amdgcn_ds_bpermute((lane - o) << 2, __float_as_int(v))); if (lane >= o) v += u; }
                ((LAS float*)(lds + L_G))[lane * 32 + 4 * wid + i] = v; if (lane == 63) ((LAS float*)(lds + L_GL))[4 * wid + i] = v; }
            __syncthreads();
        }
        {
            const size_t m = m0 + row;
            if (RET || c8 < 4) {
                const int d0 = 8 * c8;
                u32x4 kw = *(const u32x4*)(P + m * NP + ck + d0);
                u32x4 qw = (u32x4){0u, 0u, 0u, 0u}; if (PH2) qw = *(const u32x4*)(P + m * NP + cq + d0);
                float qv[8], kv[8], eg[8], ieg[8];
                { const unsigned* qp = (const unsigned*)&qw; const unsigned* kp = (const unsigned*)&kw;
#pragma unroll
                  for (int i = 0; i < 4; ++i) { qv[2 * i] = bflo(qp[i]); qv[2 * i + 1] = bfhi(qp[i]); kv[2 * i] = bflo(kp[i]); kv[2 * i + 1] = bfhi(kp[i]); } }
                if (RET) {
                    const u32x4 kw2 = *(const u32x4*)(P + m * NP + ck + (d0 ^ 32));
                    u32x4 qw2 = (u32x4){0u, 0u, 0u, 0u}; if (PH2) qw2 = *(const u32x4*)(P + m * NP + cq + (d0 ^ 32));
                    const unsigned* qp2 = (const unsigned*)&qw2; const unsigned* kp2 = (const unsigned*)&kw2;
                    const f32x4* cs4 = (const f32x4*)(csr + m * 32 + (d0 & 31));
                    const float g = (float)(row + 1) * lng; const float e1 = __expf(g), e2 = __expf(-g);
#pragma unroll
                    for (int i = 0; i < 4; ++i) { const f32x4 cc = cs4[i];
                        const float qa = bflo(qp2[i]), qb = bfhi(qp2[i]), ka = bflo(kp2[i]), kb = bfhi(kp2[i]);
                        if (c8 < 4) { const float q0 = qv[2 * i] * cc[0] - qa * cc[1], q1 = qv[2 * i + 1] * cc[2] - qb * cc[3]; const float k0 = kv[2 * i] * cc[0] - ka * cc[1], k1 = kv[2 * i + 1] * cc[2] - kb * cc[3];
                            qv[2 * i] = q0; qv[2 * i + 1] = q1; kv[2 * i] = k0; kv[2 * i + 1] = k1; }
                        else { const float q0 = qa * cc[1] + qv[2 * i] * cc[0], q1 = qb * cc[3] + qv[2 * i + 1] * cc[2]; const float k0 = ka * cc[1] + kv[2 * i] * cc[0], k1 = kb * cc[3] + kv[2 * i + 1] * cc[2];
                            qv[2 * i] = q0; qv[2 * i + 1] = q1; kv[2 * i] = k0; kv[2 * i + 1] = k1; } }
#pragma unroll
                    for (int i = 0; i < 8; ++i) { kv[i] *= 0.125f; eg[i] = e1; ieg[i] = e2; }
                } else {
#pragma unroll
                    for (int i = 0; i < 8; ++i) { const float g = ((const LAS float*)(lds + L_G))[row * 32 + d0 + i]; eg[i] = __expf(g); ieg[i] = __expf(-g); qv[i] *= 0.17677669529663687f; }
                }
                float kl[8];
#pragma unroll
                for (int i = 0; i < 8; ++i) kl[i] = kv[i] * ieg[i];
                if (PH2) {
                    u32x4 o;
                    o.x = pk2(qv[0] * eg[0], qv[1] * eg[1]); o.y = pk2(qv[2] * eg[2], qv[3] * eg[3]); o.z = pk2(qv[4] * eg[4], qv[5] * eg[5]); o.w = pk2(qv[6] * eg[6], qv[7] * eg[7]);
                    *(LAS u32x4*)(lds + L_QL + row * PQ + d0 * 2) = o;
                    o.x = pk2(qv[0] * ieg[0], qv[1] * ieg[1]); o.y = pk2(qv[2] * ieg[2], qv[3] * ieg[3]); o.z = pk2(qv[4] * ieg[4], qv[5] * ieg[5]); o.w = pk2(qv[6] * ieg[6], qv[7] * ieg[7]);
                    *(LAS u32x4*)(lds + L_QU + row * PQ + d0 * 2) = o;
                    o.x = pk2(kl[0], kl[1]); o.y = pk2(kl[2], kl[3]); o.z = pk2(kl[4], kl[5]); o.w = pk2(kl[6], kl[7]);
                    *(LAS u32x4*)(lds + L_KL + row * PQ + d0 * 2) = o;
                    o.x = pk2(kv[0] * eg[0], kv[1] * eg[1]); o.y = pk2(kv[2] * eg[2], kv[3] * eg[3]); o.z = pk2(kv[4] * eg[4], kv[5] * eg[5]); o.w = pk2(kv[6] * eg[6], kv[7] * eg[7]);
                    *(LAS u32x4*)(lds + L_KU + row * PQ + d0 * 2) = o;
                }
#pragma unroll
                for (int i = 0; i < 8; i += 2) { const unsigned w = pk2(kl[i], kl[i + 1]);
                    *(LAS unsigned short*)(lds + L_KLT + (d0 + i) * PS + row * 2) = (unsigned short)(w & 0xffffu); *(LAS unsigned short*)(lds + L_KLT + (d0 + i + 1) * PS + row * 2) = (unsigned short)(w >> 16); }
            }
            { const u32x4 vw = *(const u32x4*)(P + m * NP + cv + 8 * c8); const unsigned* vp = (const unsigned*)&vw;
#pragma unroll
              for (int i = 0; i < 4; ++i) { *(LAS unsigned short*)(lds + L_VT + (8 * c8 + 2 * i) * PS + row * 2) = (unsigned short)(vp[i] & 0xffffu); *(LAS unsigned short*)(lds + L_VT + (8 * c8 + 2 * i + 1) * PS + row * 2) = (unsigned short)(vp[i] >> 16); } }
        }
        __syncthreads();
#pragma unroll
        for (int j = 0; j < NT; ++j) {
            const int d = db[j] * 16 + (lane & 15);
            if (PH2) {
#pragma unroll
                for (int r = 0; r < 4; ++r) { const int e = eb[j] * 16 + 4 * (lane >> 4) + r; *(LAS unsigned short*)(lds + L_ST + e * PQ + d * 2) = (unsigned short)(pk2(st[j][r], 0.f) & 0xffffu); }
            }
            f32x4 u = (f32x4){0.f, 0.f, 0.f, 0.f};
#pragma unroll
            for (int ks = 0; ks < 2; ++ks) u = MFMA16(frag(lds + L_VT, PS, eb[j] * 16, ks, lane), frag(lds + L_KLT, PS, db[j] * 16, ks, lane), u);
            const float egl = RET ? __expf(64.f * lng) : __expf(((const LAS float*)(lds + L_GL))[d]);
#pragma unroll
            for (int r = 0; r < 4; ++r) st[j][r] = egl * (st[j][r] + u[r]);
            ac[j] *= egl;
        }
        if (PH2) {
#pragma unroll
            for (int j = 0; j < 2; ++j) { const int i = wid + 8 * j, tb = i >> 2, sb = i & 3;
                f32x4 lo = (f32x4){0.f, 0.f, 0.f, 0.f}, up = (f32x4){0.f, 0.f, 0.f, 0.f};
                if (sb <= tb) {
#pragma unroll
                    for (int ks = 0; ks < DK / 32; ++ks) lo = MFMA16(frag(lds + L_QL, PQ, tb * 16, ks, lane), frag(lds + L_KL, PQ, sb * 16, ks, lane), lo); }
                if (sb >= tb) {
#pragma unroll
                    for (int ks = 0; ks < DK / 32; ++ks) up = MFMA16(frag(lds + L_QU, PQ, tb * 16, ks, lane), frag(lds + L_KU, PQ, sb * 16, ks, lane), up); }
                const int s = sb * 16 + (lane & 15);
#pragma unroll
                for (int r = 0; r < 4; ++r) { const int t = tb * 16 + 4 * (lane >> 4) + r; const float v = (s <= t) ? lo[r] : up[r];
                    *(LAS unsigned short*)(lds + L_AM + t * PS + s * 2) = (unsigned short)(pk2(v, 0.f) & 0xffffu); } }
        }
        __syncthreads();
        if (PH2) {
#pragma unroll
            for (int j = 0; j < 2; ++j) { const int i = wid + 8 * j, tb = i >> 2, ob = i & 3;
                f32x4 o = (f32x4){0.f, 0.f, 0.f, 0.f};
#pragma unroll
                for (int ks = 0; ks < 2; ++ks) o = MFMA16(frag(lds + L_AM, PS, tb * 16, ks, lane), frag(lds + L_VT, PS, ob * 16, ks, lane), o);
#pragma unroll
                for (int ks = 0; ks < DK / 32; ++ks) o = MFMA16(frag(lds + L_QL, PQ, tb * 16, ks, lane), frag(lds + L_ST, PQ, ob * 16, ks, lane), o);
#pragma unroll
                for (int r = 0; r < 4; ++r) ((LAS float*)(lds + L_OUT))[(tb * 16 + 4 * (lane >> 4) + r) * 65 + ob * 16 + (lane & 15)] = o[r]; }
            __syncthreads();
            { const size_t m = m0 + row; const int e0 = 8 * c8; float v[8]; float ss = 0.f;
#pragma unroll
              for (int i = 0; i < 8; ++i) { v[i] = ((const LAS float*)(lds + L_OUT))[row * 65 + e0 + i]; ss += v[i] * v[i]; }
              ss += sx<1>(ss); ss += sx<2>(ss); ss += sx<4>(ss);
              const float rstd = rsqrtf(ss * (1.0f / 64.0f) + EPS);
              const u32x4 gw = *(const u32x4*)(P + m * NP + cg + e0); const unsigned* gp = (const unsigned*)&gw; float y[8];
#pragma unroll
              for (int i = 0; i < 4; ++i) { y[2 * i] = v[2 * i] * rstd * gnorm[e0 + 2 * i] * silu_f(bflo(gp[i])); y[2 * i + 1] = v[2 * i + 1] * rstd * gnorm[e0 + 2 * i + 1] * silu_f(bfhi(gp[i])); }
              const bool on = RET ? ((DBG_GROUPS & 1) != 0) : ((DBG_GROUPS & 4) != 0);
              u32x4 o; o.x = pk2(y[0], y[1]); o.y = pk2(y[2], y[3]); o.z = pk2(y[4], y[5]); o.w = pk2(y[6], y[7]); if (!on) o = (u32x4){0u, 0u, 0u, 0u};
              *(u32x4*)(MIX + m * DM + (RET ? 0 : 768) + h * 64 + e0) = o; }
        }
    }
    if (!PH2) {
#pragma unroll
        for (int j = 0; j < NT; ++j) { const int d = db[j] * 16 + (lane & 15);
#pragma unroll
            for (int r = 0; r < 4; ++r) { const int e = eb[j] * 16 + 4 * (lane >> 4) + r; Est[((size_t)entry * 64 + e) * DK + d] = st[j][r]; }
            if (eb[j] == 0 && (lane >> 4) == 0) Aseg[(size_t)entry * DK + d] = ac[j]; }
    }
    __syncthreads();
}
}

namespace att {
constexpr int A_K = 0, A_V = 16384, A_O0 = 49152, A_LS = 114688, A_END = 116736;
#define MFMA32(a, b, c) __builtin_amdgcn_mfma_f32_32x32x16_bf16(a, b, c, 0, 0, 0)
typedef short v4i16_t __attribute__((ext_vector_type(4)));
__device__ __forceinline__ s16x4 vtr(const LAS unsigned char* p) { return __builtin_bit_cast(s16x4, __builtin_amdgcn_ds_read_tr16_b64_v4i16((LAS v4i16_t*)p)); }
__device__ __forceinline__ int crow(int r, int hi) { return (r & 3) + 8 * (r >> 2) + 4 * hi; }
__device__ __forceinline__ void unit(LAS unsigned char* lds, const bf16* P, bf16* MIX, int b, int h, int jq, float lam, float negM, const float* subg, float oscale, const int g_wave) {
    const int tid = otid(), lane = tid & 63, r32 = lane & 31, hh = lane >> 5, wid = __builtin_amdgcn_readfirstlane(tid >> 6);
    const size_t rowbase = (size_t)b * SEQ;
    const int q0 = jq * 256 + wid * 32;
    const int ntile = 4 * jq + 4, my_nt = 4 * jq + (wid >> 1) + 1;
    const int krow = tid >> 3, kch = (tid & 7) ^ ((krow >> 1) & 7);
    const int vrow = (tid >> 2) & 63, vcol = (tid >> 8) * 32 + (tid & 3) * 8;
    const unsigned ldsw = (unsigned)wid * 1024u;
    const int q4 = (lane & 15) >> 2, p4 = lane & 3, gsel = (lane >> 4) & 1;
    const unsigned vrd = (unsigned)((4 * hh + q4) * 64 + gsel * 32 + p4 * 8);
#pragma unroll 1
    for (int comp = 0; comp < 2; ++comp) {
        bf16x8 qf[4];
        const char* Pb = (const char*)(P + rowbase * NP + h * 128);
        { const unsigned qo = (unsigned)(((q0 + r32) * NP + C_DQ + comp * 64 + hh * 8) * 2);
#pragma unroll
          for (int ks = 0; ks < 4; ++ks) qf[ks] = *(const bf16x8*)(Pb + qo + 32 * ks); }
        const unsigned kgo = (unsigned)((krow * NP + C_DK + comp * 64 + kch * 8) * 2), vgo = (unsigned)((vrow * NP + C_DV + vcol) * 2);
        f32x16 o[4];
#pragma unroll
        for (int e = 0; e < 4; ++e)
#pragma unroll
            for (int r = 0; r < 16; ++r) o[e][r] = 0.f;
        float l = 0.f;
#define ATT_STAGE(buf, tt) do { const char* Pt = Pb + (size_t)(tt) * 64 * NP * 2; \
            __builtin_amdgcn_global_load_lds((const unsigned*)(Pt + kgo), (LAS unsigned*)(lds + A_K + (buf) * 8192 + ldsw), 16, 0, 0); \
            __builtin_amdgcn_global_load_lds((const unsigned*)(Pt + vgo), (LAS unsigned*)(lds + A_V + (buf) * 16384 + ldsw), 16, 0, 0); \
            __builtin_amdgcn_global_load_lds((const unsigned*)(Pt + vgo + 128), (LAS unsigned*)(lds + A_V + (buf) * 16384 + 8192 + ldsw), 16, 0, 0); } while (0)
        ATT_STAGE(0, 0);
        VM_WAIT(); __syncthreads();
        for (int t = 0; t < ntile; ++t) {
            const int cur = t & 1;
            if (t + 1 < ntile) ATT_STAGE(cur ^ 1, t + 1);
            if (t < my_nt) {
                const LAS unsigned char* Kb = lds + A_K + cur * 8192; const LAS unsigned char* Vb = lds + A_V + cur * 16384;
                bf16x8 pa[4];
#pragma unroll
                for (int kb = 0; kb < 2; ++kb) {
                    f32x16 s0;
#pragma unroll
                    for (int r = 0; r < 16; ++r) s0[r] = negM;
#pragma unroll
                    for (int ks = 0; ks < 4; ++ks) { const int cc = 2 * ks + hh; const unsigned ko = (unsigned)(r32 * 128 + ((cc ^ ((r32 >> 1) & 7)) << 4));
                        const bf16x8 a0 = *(const LAS bf16x8*)(Kb + ko + kb * 4096);
                        s0 = MFMA32(a0, qf[ks], s0); }
#pragma unroll
                    for (int r = 0; r < 16; ++r) { s0[r] = __builtin_amdgcn_exp2f(s0[r]); l += s0[r]; }
                    u32x4 w;
                    w.x = pk2(s0[0], s0[1]); w.y = pk2(s0[2], s0[3]); w.z = pk2(s0[4], s0[5]); w.w = pk2(s0[6], s0[7]); pa[2 * kb] = __builtin_bit_cast(bf16x8, w);
                    w.x = pk2(s0[8], s0[9]); w.y = pk2(s0[10], s0[11]); w.z = pk2(s0[12], s0[13]); w.w = pk2(s0[14], s0[15]); pa[2 * kb + 1] = __builtin_bit_cast(bf16x8, w);
                    __builtin_amdgcn_sched_barrier(0);
                }
#pragma unroll
                for (int e = 0; e < 4; ++e) {
#pragma unroll
                    for (int kk = 0; kk < 4; ++kk) { const s16x4 lo = vtr(Vb + e * 4096 + kk * 1024 + vrd), hi = vtr(Vb + e * 4096 + kk * 1024 + 512 + vrd);
                        const bf16x8 vf = (bf16x8){lo[0], lo[1], lo[2], lo[3], hi[0], hi[1], hi[2], hi[3]};
                        o[e] = MFMA32(pa[kk], vf, o[e]); }
                    __builtin_amdgcn_sched_barrier(0); }
            }
            VM_WAIT(); __syncthreads();
        }
#undef ATT_STAGE
        l = sum_halves(l);
        LAS float* ls = (LAS float*)(lds + A_LS) + wid * 64 + comp * 32;
        if (hh == 0) ls[r32] = l;
        LDS_WAIT(); asm volatile("" ::: "memory");
        float inv[16];
#pragma unroll
        for (int r = 0; r < 16; ++r) inv[r] = 1.0f / ls[crow(r, hh)];
        LAS unsigned* o0 = (LAS unsigned*)(lds + A_O0) + wid * 2048 + lane;
        if (comp == 0) {
#pragma unroll
            for (int e = 0; e < 4; ++e)
#pragma unroll
                for (int i = 0; i < 8; ++i) o0[(e * 8 + i) * 64] = pk2(o[e][2 * i] * inv[2 * i], o[e][2 * i + 1] * inv[2 * i + 1]);
        } else {
            float ss[16];
#pragma unroll
            for (int r = 0; r < 16; ++r) ss[r] = 0.f;
#pragma unroll
            for (int e = 0; e < 4; ++e)
#pragma unroll
                for (int i = 0; i < 8; ++i) { const unsigned w = o0[(e * 8 + i) * 64];
                    const float v0 = bflo(w) - lam * o[e][2 * i] * inv[2 * i], v1 = bfhi(w) - lam * o[e][2 * i + 1] * inv[2 * i + 1];
                    o[e][2 * i] = v0; o[e][2 * i + 1] = v1; ss[2 * i] += v0 * v0; ss[2 * i + 1] += v1 * v1; }
#pragma unroll
            for (int r = 0; r < 16; ++r) { float s = ss[r]; s += sx<1>(s); s += sx<2>(s); s += sx<4>(s); s += sx<8>(s); s += sx<16>(s);
                ss[r] = rsqrtf(s * (1.0f / 128.0f) + EPS) * oscale; }
            LAS unsigned char* stg = lds + A_O0 + wid * 8192;
            const int lane_e = olane(), r32e = lane_e & 31;
            LDS_WAIT(); asm volatile("" ::: "memory");
#pragma unroll
            for (int e = 0; e < 4; ++e) { const float gsub = subg[32 * e + r32e];
#pragma unroll
                for (int r = 0; r < 16; ++r) { const float y = ((DBG_GROUPS & 2) != 0) ? o[e][r] * ss[r] * gsub : 0.f;
                    *(LAS unsigned short*)(stg + crow(r, hh) * 256 + (32 * e + r32) * 2) = (unsigned short)(pk2(y, 0.f) & 0xffffu); } }
            LDS_WAIT(); asm volatile("" ::: "memory");
            { unsigned ob = (unsigned)(((q0 + (lane_e >> 4)) * DM + 256 + (lane_e & 15) * 8) * 2); char* Mb = (char*)(MIX + rowbase * DM + h * 128);
#pragma unroll
              for (int i = 0; i < 8; ++i) { const u32x4 w = *(const LAS u32x4*)(stg + ((lane_e >> 4) + 4 * i) * 256 + (lane_e & 15) * 16); *(u32x4*)(Mb + ob + i * 4 * DM * 2) = w; } }
            LDS_WAIT(); asm volatile("" ::: "memory");
        }
    }
}
}

struct Args { const float* in[25]; float* out; unsigned char* ws; int ph_lo, ph_hi; };
static_assert(sizeof(Args) == 27 * 8 + 8, "Args has no padding");
constexpr int NPHASE = 1 + 9 * DEPTH;

__global__ void __launch_bounds__(NWAVES * 64, 2) fwd(Args args) {
    extern __shared__ __attribute__((aligned(16))) unsigned char lds_raw[];
    LAS unsigned char* lds = (LAS unsigned char*)lds_raw;
    const int wave = __builtin_amdgcn_readfirstlane((int)threadIdx.x >> 6); const int g_wave = wave; const int tid0 = otid();
    const int G = gridDim.x; const int bx = blockIdx.x; const int vcu = (G % 8 == 0) ? (bx % 8) * (G / 8) + bx / 8 : bx;
    const int gw = vcu * NWAVES + wave, NGW = G * NWAVES;
    __builtin_assume(gw >= 0 && gw < 4096 && vcu >= 0 && vcu < 512 && G > 0 && G <= 512);
    unsigned char* ws = args.ws;
    unsigned* ctl = (unsigned*)(ws + WS_CTL);
    for (int u = tid0; u < (LDS_BYTES - LDSCTL_OFF) / 4; u += NWAVES * 64) ((LAS unsigned*)(lds + LDSCTL_OFF))[u] = 0u;
    __syncthreads();
    XcdBarrier bar; bar.bar = ctl + CW_BAR; bar.x = 0; bar.st = nullptr;
    if (MK_N_LAUNCHES == 1) bar = xcd_barrier_post(ctl + CW_BAR, (volatile LAS unsigned*)(lds + MISC_OFF) + 8, tid0 == 0);
    const int lo = args.ph_lo, hi = args.ph_hi;
#ifndef PHMASK
#define PHMASK 0x3ff
#endif
#define IN(k) (lo <= (k) && (k) < hi)
#define PHON(j) ((PHMASK >> (j)) & 1)
#define SEAM(k) do { if (IN(k) && IN((k) + 1)) xcd_barrier(bar, otid() == 0); } while (0)
    if (tid0 == 0) {
#pragma unroll
        for (int k = 0; k < 25; ++k) ((LAS unsigned long long*)(lds + PTR_OFF))[k] = (unsigned long long)args.in[k];
    }
    __syncthreads();
    float* xout = args.out;
#define WSP(Tp, off) ((Tp*)(wsl + (off)))
#define WSL() unsigned char* wsl = ws; asm volatile("" : "+s"(wsl))

    if (PHON(0) && IN(0)) {
        const int tid = otid(), lane = tid & 63; WSL();
        const float* c_in = INF(1); const int* pos_in = (const int*)INF(2); const float* w_mod = INF(3); const float* b_mod = INF(4); const float* w_in = INF(7);
        const float* diff_q_g = INF(9); const float* diff_k_g = INF(10); const float* lam_q1 = INF(11); const float* lam_k1 = INF(12); const float* lam_q2 = INF(13); const float* lam_k2 = INF(14);
        const float* gla_w_a2 = INF(16); const float* w_out = INF(19); const float* w_gate = INF(22); const float* w_up = INF(23); const float* w_down = INF(24);
        float* mod = WSP(float, WS_MOD); float* scal = WSP(float, WS_SCAL); f32x2* csr = WSP(f32x2, WS_CSR); f32x2* csd = WSP(f32x2, WS_CSD);
        bf16* Win_t = WSP(bf16, WS_WIN); bf16* Wout_t = WSP(bf16, WS_WOUT); bf16* W1 = WSP(bf16, WS_W1); bf16* W2 = WSP(bf16, WS_W2);
        LAS float* scr = (LAS float*)(lds + wave * 8704);
        LAS float* sact = (LAS float*)(lds + 69632);
        for (int i = tid; i < 8 * 1024; i += NWAVES * 64) sact[i] = silu_f(c_in[i]);
        __syncthreads();
        constexpr int I_MOD = 2 * 384, I_TABR = 1024, I_TABD = 1024, I_LA = 256, I_ZERO = 256, I_SC = 2;
        constexpr int I_WIN = 16 * 105, I_WOUT = 16 * 32, I_GU = 16 * 16, I_DN = 8 * 32, I_LAYER = I_WIN + I_WOUT + 32 * (2 * I_GU + I_DN);
        constexpr int I_PRE = I_MOD + I_TABR + I_TABD + I_LA + I_ZERO + I_SC, NITEMS = I_PRE + 2 * I_LAYER;
        for (int it = gw; it < NITEMS; it += NGW) {
            int r = it;
            if (r < I_MOD) {
                const int l = r / 384, col = (r % 384) * 16 + (lane & 15), ks = lane >> 4;
                float acc[8] = {0.f, 0.f, 0.f, 0.f, 0.f, 0.f, 0.f, 0.f};
                const float* wp = w_mod + (size_t)l * 1024 * 6144 + col;
#pragma unroll 8
                for (int k = ks; k < 1024; k += 4) { const float w = wp[(size_t)k * 6144];
#pragma unroll
                    for (int b = 0; b < 8; ++b) acc[b] += sact[b * 1024 + k] * w; }
#pragma unroll
                for (int b = 0; b < 8; ++b) { float a = acc[b]; a += sx<16>(a); a = sum_halves(a); if (ks == 0) mod[((size_t)l * 8 + b) * 6144 + col] = a + b_mod[l * 6144 + col]; }
                continue; }
            r -= I_MOD;
            if (r < I_TABR) {
                const int i = lane & 31; const float inv_freq = exp2f(-((float)i * (1.0f / 32.0f)) * 13.287712379549449f);
                for (int s = 0; s < 32; ++s) { const int t = r * 64 + 2 * s + (lane >> 5); const float ang = (float)pos_in[t] * inv_freq; float sn, cs; sincosf(ang, &sn, &cs); csr[(size_t)t * 32 + i] = (f32x2){cs, sn}; }
                continue; }
            r -= I_TABR;
            if (r < I_TABD) {
                const int i = lane & 7; const float inv_freq = exp2f(-((float)i * (1.0f / 8.0f)) * 18.931568569324174f);
                for (int s = 0; s < 8; ++s) { const int t = r * 64 + 8 * s + (lane >> 3); const float ang = (float)pos_in[t] * inv_freq; float sn, cs; sincosf(ang, &sn, &cs); csd[(size_t)t * 8 + i] = (f32x2){cs, sn}; }
                continue; }
            r -= I_TABD;
            if (r < I_LA) {
                const int l = r >> 7, j = r & 127; float a2[16];
#pragma unroll
                for (int q = 0; q < 16; ++q) a2[q] = gla_w_a2[((size_t)l * 16 + q) * 128 + j];
                for (int i = 0; i < 16; ++i) { const int k = lane + 64 * i; const f32x4* wp = (const f32x4*)(w_in + ((size_t)l * 1024 + k) * IN_W + 3072); float s = 0.f;
#pragma unroll
                    for (int q = 0; q < 4; ++q) { const f32x4 w = wp[q]; s += w[0] * a2[4 * q] + w[1] * a2[4 * q + 1] + w[2] * a2[4 * q + 2] + w[3] * a2[4 * q + 3]; }
                    Win_t[((size_t)l * NP + C_LA + j) * 1024 + k] = (bf16)(pk2(s, 0.f) & 0xffffu); }
                continue; }
            r -= I_LA;
            if (r < I_ZERO) {
                const int l = r >> 7, j = r & 127; u32x4* p = (u32x4*)(Win_t + ((size_t)l * NP + C_PAD + j) * 1024);
                p[lane] = (u32x4){0u, 0u, 0u, 0u}; p[lane + 64] = (u32x4){0u, 0u, 0u, 0u};
                continue; }
            r -= I_ZERO;
            if (r < I_SC) {
                const int l = r; const float s1 = wave_sum(lam_q1[l * 64 + lane] * lam_k1[l * 64 + lane]), s2 = wave_sum(lam_q2[l * 64 + lane] * lam_k2[l * 64 + lane]);
                const float mq = wave_max(fabsf(diff_q_g[l * 64 + lane])), mk = wave_max(fabsf(diff_k_g[l * 64 + lane]));
                const float lam_init = 0.8f - 0.6f * expf(-0.3f * (float)l);
                if (lane == 0) { scal[l * 4 + 0] = expf(s1) - expf(s2) + lam_init; scal[l * 4 + 1] = -(8.0f * mq * mk * LOG2E + 0.5f); scal[l * 4 + 2] = 1.0f - lam_init; }
                continue; }
            r -= I_SC;
            const int l = r / I_LAYER; r -= l * I_LAYER;
            if (r < I_WIN) { tr_item(w_in + (size_t)l * 1024 * IN_W, 1024, IN_W, Win_t + (size_t)l * NP * 1024, 1024, 1, scr, r, lane); continue; } r -= I_WIN;
            if (r < I_WOUT) { tr_item(w_out + (size_t)l * 1024 * 1024, 1024, 1024, Wout_t + (size_t)l * 1024 * 1024, 1024, 0, scr, r, lane); continue; } r -= I_WOUT;
            const int e = r / (2 * I_GU + I_DN); r -= e * (2 * I_GU + I_DN); const size_t le = (size_t)l * 32 + e;
            if (r < I_GU) { tr_item(w_gate + le * 1024 * 512, 1024, 512, W1 + le * 1024 * 1024, 1024, 2, scr, r, lane); continue; } r -= I_GU;
            if (r < I_GU) { tr_item(w_up + le * 1024 * 512, 1024, 512, W1 + le * 1024 * 1024, 1024, 3, scr, r, lane); continue; } r -= I_GU;
            tr_item(w_down + le * 512 * 1024, 512, 1024, W2 + le * 1024 * 512, 512, 0, scr, r, lane);
        }
        __syncthreads();
    }
    SEAM(0);

    for (int l = 0; l < DEPTH; ++l) {
        const int pb = 1 + 9 * l;
#define XIN ((l == 0) ? INF(0) : (const float*)xout)
#define MODL (WSP(const float, WS_MOD) + (size_t)l * 8 * 6144)
        if (PHON(1) && IN(pb + 0)) {
            const int tid = otid(), lane = tid & 63; (void)tid; (void)lane; WSL();
            const float* xin = XIN; const float* modl = MODL; const float* norm1_g = INF(5); bf16* ACT = WSP(bf16, WS_ACT);
            const float* g1 = norm1_g + l * 1024;
            for (int m = gw; m < T; m += NGW) {
                const int b = m >> 13; const f32x4* xr = (const f32x4*)(xin + (size_t)m * DM) + lane; const float* mb = modl + (size_t)b * 6144;
                f32x4 v[4]; float s = 0.f;
#pragma unroll
                for (int j = 0; j < 4; ++j) { v[j] = xr[64 * j]; s += (v[j][0] * v[j][0] + v[j][1] * v[j][1]) + (v[j][2] * v[j][2] + v[j][3] * v[j][3]); }
                const float rstd = rsqrtf(wave_sum(s) * (1.0f / 1024.0f) + EPS);
                u32x2* o8 = (u32x2*)(ACT + (size_t)m * DM) + lane;
#pragma unroll
                for (int j = 0; j < 4; ++j) { const int k = 4 * lane + 256 * j; const f32x4 gg = *(const f32x4*)(g1 + k), sh = *(const f32x4*)(mb + k), sc = *(const f32x4*)(mb + 1024 + k);
                    const f32x4 y = v[j] * rstd * gg * (sc + 1.0f) + sh; u32x2 w; w.x = pk2(y[0], y[1]); w.y = pk2(y[2], y[3]); o8[64 * j] = w; }
            }
        }
        SEAM(pb + 0);
        if (PHON(2) && IN(pb + 1)) {
            const int tid = otid(), lane = tid & 63; (void)tid; (void)lane; WSL();
            bf16* ACT = WSP(bf16, WS_ACT); bf16* Win_t = WSP(bf16, WS_WIN); bf16* P = WSP(bf16, WS_P);
            pg8::Gemm g{ACT, Win_t + (size_t)l * NP * 1024, 1024, 1024, 1024}; pg8::StaticOrder<T / 256, NP / 256> S; S.init(G, bx);
            pg8::EpiStoreBf16 E{P, NP};
            pg8::gemm_phase<pg8::EpiStoreBf16, pg8::StaticOrder<T / 256, NP / 256>, 0>(lds, g, S, E, g_wave);
        }
        SEAM(pb + 1);
        if (PHON(3) && IN(pb + 2)) {
            const int tid = otid(), lane = tid & 63; (void)tid; (void)lane; WSL();
            const float* diff_q_g = INF(9); const float* diff_k_g = INF(10); const float* gla_b_a = INF(17); bf16* P = WSP(bf16, WS_P); bf16* ACT = WSP(bf16, WS_ACT); f32x2* csr = WSP(f32x2, WS_CSR); f32x2* csd = WSP(f32x2, WS_CSD);
            float* Eret = WSP(float, WS_EST); float* Egla = WSP(float, WS_EGL); float* Asr = WSP(float, WS_ASR); float* Asg = WSP(float, WS_ASG);
            const float* gq = diff_q_g + l * 64; const float* gk = diff_k_g + l * 64;
            for (int m = gw; m < T; m += NGW) {
                bf16* p = P + (size_t)m * NP + C_DQ + 16 * lane;
                const u32x4 w0 = *(const u32x4*)p, w1 = *(const u32x4*)(p + 8);
                float v[16];
                { const unsigned* a = (const unsigned*)&w0; const unsigned* c = (const unsigned*)&w1;
#pragma unroll
                  for (int i = 0; i < 4; ++i) { v[2 * i] = bflo(a[i]); v[2 * i + 1] = bfhi(a[i]); v[8 + 2 * i] = bflo(c[i]); v[8 + 2 * i + 1] = bfhi(c[i]); } }
                float ss = 0.f;
#pragma unroll
                for (int i = 0; i < 16; ++i) ss += v[i] * v[i];
                ss += sx<1>(ss); ss += sx<2>(ss);
                const float rstd = rsqrtf(ss * (1.0f / 64.0f) + EPS);
                const bool isq = lane < 32; const float* gg = (isq ? gq : gk) + (lane & 3) * 16;
#pragma unroll
                for (int i = 0; i < 16; ++i) v[i] = v[i] * rstd * gg[i];
                if ((lane & 3) == 0) { const f32x4* cs4 = (const f32x4*)(csd + (size_t)m * 8);
#pragma unroll
                    for (int i = 0; i < 4; ++i) { const f32x4 cc = cs4[i];
                        const float a0 = v[2 * i], b0 = v[2 * i + 8], a1 = v[2 * i + 1], b1 = v[2 * i + 9];
                        v[2 * i] = a0 * cc[0] - b0 * cc[1]; v[2 * i + 8] = a0 * cc[1] + b0 * cc[0]; v[2 * i + 1] = a1 * cc[2] - b1 * cc[3]; v[2 * i + 9] = a1 * cc[3] + b1 * cc[2]; } }
                const float qs = isq ? 0.125f * LOG2E : 1.0f;
                u32x4 o0, o1;
                o0.x = pk2(v[0] * qs, v[1] * qs); o0.y = pk2(v[2] * qs, v[3] * qs); o0.z = pk2(v[4] * qs, v[5] * qs); o0.w = pk2(v[6] * qs, v[7] * qs);
                o1.x = pk2(v[8] * qs, v[9] * qs); o1.y = pk2(v[10] * qs, v[11] * qs); o1.z = pk2(v[12] * qs, v[13] * qs); o1.w = pk2(v[14] * qs, v[15] * qs);
                *(u32x4*)p = o0; *(u32x4*)(p + 8) = o1;
            }
            for (int u = vcu; u < 1024; u += G) {
                const int r = u & 511, bh = r >> 4, seg = r & 15;
                if (u < 512) lin::unit<64, true, false>(lds, P, ACT, csr, bh >> 2, bh & 3, seg, nullptr, nullptr, Eret, Asr, g_wave);
                else lin::unit<32, false, false>(lds, P, ACT, csr, bh >> 2, bh & 3, seg, gla_b_a + l * 128, nullptr, Egla, Asg, g_wave);
            }
        }
        SEAM(pb + 2);
        if (PHON(4) && IN(pb + 3)) {
            const int tid = otid(), lane = tid & 63; (void)tid; (void)lane; WSL();
            const float* scal = WSP(const float, WS_SCAL); const float* diff_sub_g = INF(15); const float* ret_norm_g = INF(8); const float* gla_norm_g = INF(18); const float* gla_b_a = INF(17); bf16* P = WSP(bf16, WS_P); bf16* ACT = WSP(bf16, WS_ACT); f32x2* csr = WSP(f32x2, WS_CSR);
            float* Eret = WSP(float, WS_EST); float* Egla = WSP(float, WS_EGL); float* Asr = WSP(float, WS_ASR); float* Asg = WSP(float, WS_ASG);
            const float lam = scal[l * 4 + 0], negM = scal[l * 4 + 1], osc = scal[l * 4 + 2];
#ifndef NO_ATT
            for (int pu = vcu; pu < 512; pu += G) {
                const int bh = pu >> 4, jp = pu & 15;
                att::unit(lds, P, ACT, bh >> 2, bh & 3, jp, lam, negM, diff_sub_g + l * 128, osc, g_wave);
                att::unit(lds, P, ACT, bh >> 2, bh & 3, 31 - jp, lam, negM, diff_sub_g + l * 128, osc, g_wave);
            }
#endif
#ifndef NO_LIN2
            for (int u = vcu; u < 1024; u += G) {
                const int r = u & 511, bh = r >> 4, seg = r & 15;
                if (u < 512) lin::unit<64, true, true>(lds, P, ACT, csr, bh >> 2, bh & 3, seg, nullptr, ret_norm_g + l * 64, Eret, Asr, g_wave);
                else lin::unit<32, false, true>(lds, P, ACT, csr, bh >> 2, bh & 3, seg, gla_b_a + l * 128, gla_norm_g + l * 64, Egla, Asg, g_wave);
            }
#endif
        }
        SEAM(pb + 3);
        if (PHON(5) && IN(pb + 4)) {
            const int tid = otid(), lane = tid & 63; (void)tid; (void)lane; WSL();
            const float* xin = XIN; const float* modl = MODL; bf16* ACT = WSP(bf16, WS_ACT); bf16* Wout_t = WSP(bf16, WS_WOUT);
            pg8::Gemm g{ACT, Wout_t + (size_t)l * 1024 * 1024, 1024, 1024, 1024}; pg8::StaticOrder<T / 256, 4> S; S.init(G, bx);
            pg8::EpiResid E{xin, xout, modl + 2048};
            pg8::gemm_phase<pg8::EpiResid, pg8::StaticOrder<T / 256, 4>, 0>(lds, g, S, E, g_wave);
        }
        SEAM(pb + 4);
        if (PHON(6) && IN(pb + 5)) {
            const int tid = otid(), lane = tid & 63; (void)tid; (void)lane; WSL();
            const float* modl = MODL; const float* router_w = INF(20); const float* router_b = INF(21); const float* norm2_g = INF(6); bf16* ACT = WSP(bf16, WS_ACT); int* tokinfo = WSP(int, WS_ROUTE); int* tokS = WSP(int, WS_TOKS);
            constexpr int WR_PITCH = 2064, LG_OFF = 32 * WR_PITCH;
#pragma unroll 4
            for (int i = tid; i < 32768; i += NWAVES * 64) { const int k = i >> 5, e = i & 31; *(LAS unsigned short*)(lds + e * WR_PITCH + k * 2) = (unsigned short)(pk2(router_w[i], 0.f) & 0xffffu); }
            { int Gl = G; asm volatile("" : "+s"(Gl));
#pragma unroll 1
              for (int i = bx * NWAVES * 64 + tid; i < TPAD; i += Gl * NWAVES * 64) tokS[i] = -1; }
            __syncthreads();
            const float* g2 = norm2_g + l * 1024;
            LAS float* lg = (LAS float*)(lds + LG_OFF + wave * 2112);
            unsigned* cnt = ctl + CW_CNT + l * 64;
            for (int gi = gw; gi < T / 16; gi += NGW) {
                for (int rr = 0; rr < 16; ++rr) {
                    const int m = gi * 16 + rr; const int b = m >> 13; const f32x4* xr = (const f32x4*)(xout + (size_t)m * DM) + lane; const float* mb = modl + (size_t)b * 6144 + 3072;
                    f32x4 v[4]; float s = 0.f;
#pragma unroll
                    for (int j = 0; j < 4; ++j) { v[j] = xr[64 * j]; s += (v[j][0] * v[j][0] + v[j][1] * v[j][1]) + (v[j][2] * v[j][2] + v[j][3] * v[j][3]); }
                    const float rstd = rsqrtf(wave_sum(s) * (1.0f / 1024.0f) + EPS);
                    u32x2* o8 = (u32x2*)(ACT + (size_t)m * DM) + lane;
#pragma unroll
                    for (int j = 0; j < 4; ++j) { const int k = 4 * lane + 256 * j; const f32x4 gg = *(const f32x4*)(g2 + k), sh = *(const f32x4*)(mb + k), sc = *(const f32x4*)(mb + 1024 + k);
                        const f32x4 y = v[j] * rstd * gg * (sc + 1.0f) + sh; u32x2 w; w.x = pk2(y[0], y[1]); w.y = pk2(y[2], y[3]); o8[64 * j] = w; }
                }
                VM_WAIT();
                f32x4 a0 = (f32x4){0.f, 0.f, 0.f, 0.f}, a1 = a0;
                const bf16* ap = ACT + (size_t)(gi * 16 + (lane & 15)) * DM + 8 * (lane >> 4);
#pragma unroll 4
                for (int ks = 0; ks < 32; ++ks) { const bf16x8 a = *(const bf16x8*)(ap + 32 * ks);
                    const bf16x8 b0 = *(const LAS bf16x8*)(lds + (lane & 15) * WR_PITCH + (32 * ks + 8 * (lane >> 4)) * 2), b1 = *(const LAS bf16x8*)(lds + (16 + (lane & 15)) * WR_PITCH + (32 * ks + 8 * (lane >> 4)) * 2);
                    a0 = MFMA16(a, b0, a0); a1 = MFMA16(a, b1, a1); }
#pragma unroll
                for (int r = 0; r < 4; ++r) { lg[(4 * (lane >> 4) + r) * 33 + (lane & 15)] = a0[r]; lg[(4 * (lane >> 4) + r) * 33 + 16 + (lane & 15)] = a1[r]; }
                LDS_WAIT(); asm volatile("" ::: "memory");
                if (lane < 16) {
                    const int m = gi * 16 + lane; float best = -3.0e38f; int bcls = 0; float bwa = 0.f, bwb = 0.f;
#pragma unroll
                    for (int g = 0; g < 8; ++g) {
                        float s[4], a[4];
#pragma unroll
                        for (int i = 0; i < 4; ++i) { s[i] = 1.0f / (1.0f + __expf(-lg[lane * 33 + 4 * g + i])); a[i] = s[i] + router_b[4 * g + i]; }
                        int i1 = 0; float v1 = a[0];
                        if (a[1] > v1) { v1 = a[1]; i1 = 1; } if (a[2] > v1) { v1 = a[2]; i1 = 2; } if (a[3] > v1) { v1 = a[3]; i1 = 3; }
                        int i2 = -1; float v2 = -3.0e38f;
                        if (i1 != 0 && a[0] > v2) { v2 = a[0]; i2 = 0; } if (i1 != 1 && a[1] > v2) { v2 = a[1]; i2 = 1; } if (i1 != 2 && a[2] > v2) { v2 = a[2]; i2 = 2; } if (i1 != 3 && a[3] > v2) { v2 = a[3]; i2 = 3; }
                        const float gsum = v1 + v2;
                        const int ea = i1 < i2 ? i1 : i2, eb = i1 < i2 ? i2 : i1;
                        const float sa = ea == 0 ? s[0] : (ea == 1 ? s[1] : s[2]), sb = eb == 1 ? s[1] : (eb == 2 ? s[2] : s[3]);
                        const int pidx = (ea * (7 - ea)) / 2 + (eb - ea - 1);
                        if (gsum > best) { best = gsum; bcls = g * 6 + pidx; const float den = 1.0f / (sa + sb); bwa = sa * den; bwb = sb * den; }
                    }
                    const unsigned rank = atomicAdd(cnt + bcls, 1u);
                    *(u32x4*)(tokinfo + (size_t)m * 4) = (u32x4){(unsigned)bcls, rank, __float_as_uint(bwa), __float_as_uint(bwb)};
                }
                LDS_WAIT(); asm volatile("" ::: "memory");
            }
            __syncthreads();
        }
        SEAM(pb + 5);
        if (PHON(7) && IN(pb + 6)) {
            const int tid = otid(), lane = tid & 63; (void)tid; (void)lane; WSL();
            bf16* ACT = WSP(bf16, WS_ACT); bf16* H2S = WSP(bf16, WS_H2S); int* tokinfo = WSP(int, WS_ROUTE); int* tokS = WSP(int, WS_TOKS); float* gaS = WSP(float, WS_GAS); float* gbS = WSP(float, WS_GBS); int* tinfo = WSP(int, WS_TINFO);
            LAS int* cst = (LAS int*)lds;
            if (tid == 0) { const unsigned* cnt = ctl + CW_CNT + l * 64; int s = 0, nt = 0;
                for (int c = 0; c < NCLS; ++c) { const int n = (int)__hip_atomic_load(cnt + c, __ATOMIC_RELAXED, __HIP_MEMORY_SCOPE_AGENT); cst[c] = s; const int tl = (n + 255) >> 8;
                    if (bx == 0) { const int g = c / 6, p = c % 6; const int a = p < 3 ? 0 : (p < 5 ? 1 : 2); const int bb = p < 3 ? p + 1 : (p < 5 ? p - 1 : 3); const int code = (g * 4 + a) | ((g * 4 + bb) << 8);
                        for (int i = 0; i < tl; ++i) tinfo[1 + nt + i] = code; }
                    nt += tl; s += tl * 256; }
                if (bx == 0) tinfo[0] = nt; }
            __syncthreads();
            for (int m = gw; m < T; m += NGW) {
                const u32x4 inf = *(const u32x4*)(tokinfo + (size_t)m * 4);
                const int slot = cst[inf.x] + (int)inf.y;
                const u32x4* src = (const u32x4*)(ACT + (size_t)m * DM); u32x4* dst = (u32x4*)(H2S + (size_t)slot * DM);
                dst[lane] = src[lane]; dst[lane + 64] = src[lane + 64];
                if (lane == 0) { tokS[slot] = m; gaS[slot] = __uint_as_float(inf.z); gbS[slot] = __uint_as_float(inf.w); }
            }
            __syncthreads();
        }
        SEAM(pb + 6);
        if (PHON(8) && IN(pb + 7)) {
            const int tid = otid(), lane = tid & 63; (void)tid; (void)lane; WSL();
            bf16* H2S = WSP(bf16, WS_H2S); bf16* W1 = WSP(bf16, WS_W1); bf16* U = WSP(bf16, WS_U); float* gaS = WSP(float, WS_GAS); float* gbS = WSP(float, WS_GBS); int* tinfo = WSP(int, WS_TINFO);
            pg8::Gemm g{H2S, W1 + (size_t)l * 32 * 1024 * 1024, 1024, 1024, 1024}; pg8::MoeOrder<8, 1> S{tinfo, G, vcu};
            pg8::EpiMoe1 E{U, gaS, gbS};
            pg8::gemm_phase<pg8::EpiMoe1, pg8::MoeOrder<8, 1>, 0>(lds, g, S, E, g_wave);
        }
        SEAM(pb + 7);
        if (PHON(9) && IN(pb + 8)) {
            const int tid = otid(), lane = tid & 63; (void)tid; (void)lane; WSL();
            const float* modl = MODL; bf16* U = WSP(bf16, WS_U); bf16* W2 = WSP(bf16, WS_W2); int* tokS = WSP(int, WS_TOKS); int* tinfo = WSP(int, WS_TINFO);
            pg8::Gemm g{U, W2 + (size_t)l * 32 * 1024 * 512, 1024, 1024, 512}; pg8::MoeOrder<4, 2> S{tinfo, G, vcu};
            pg8::EpiMoe2 E{xout, tokS, modl + 5 * 1024};
            pg8::gemm_phase<pg8::EpiMoe2, pg8::MoeOrder<4, 2>, 8>(lds, g, S, E, g_wave);
        }
        SEAM(pb + 8);
    }
#undef IN
#undef SEAM
}

extern "C" void kernel_launch(void* const* d_in, const int* in_sizes, int n_in, void* d_out, int out_size, void* d_ws, size_t ws_size, hipStream_t stream) {
    static int grid = 0;
    if (grid == 0) {
        if (n_in != 25 || in_sizes[0] != T * DM || out_size != T * DM || ws_size < WS_END) { fprintf(stderr, "kernel_launch: unexpected shapes (n_in %d, in0 %d, out %d, ws %zu < %zu)\n", n_in, n_in > 0 ? in_sizes[0] : -1, out_size, ws_size, (size_t)WS_END); grid = -1; return; }
        int dev = 0, cus = 0, per_cu = 0;
        if (hipGetDevice(&dev) != hipSuccess || hipDeviceGetAttribute(&cus, hipDeviceAttributeMultiprocessorCount, dev) != hipSuccess) { grid = -1; return; }
        if (hipFuncSetAttribute((const void*)fwd, hipFuncAttributeMaxDynamicSharedMemorySize, LDS_BYTES) != hipSuccess) { fprintf(stderr, "kernel_launch: hipFuncSetAttribute failed\n"); grid = -1; return; }
        if (hipOccupancyMaxActiveBlocksPerMultiprocessor(&per_cu, (const void*)fwd, NWAVES * 64, LDS_BYTES) != hipSuccess || per_cu < 1) fprintf(stderr, "kernel_launch: occupancy query reports %d\n", per_cu);
        (void)hipGetLastError();
        grid = cus;
    }
    if (grid < 0) return;
    if (hipMemsetAsync((char*)d_ws + WS_CTL, 0, CTL_ZERO_BYTES, stream) != hipSuccess) return;
    Args a{};
    for (int i = 0; i < 25; ++i) a.in[i] = (const float*)d_in[i];
    a.out = (float*)d_out; a.ws = (unsigned char*)d_ws;
#if MK_N_LAUNCHES == 1
    a.ph_lo = 0; a.ph_hi = NPHASE;
    hipLaunchKernelGGL(fwd, dim3(grid), dim3(NWAVES * 64), LDS_BYTES, stream, a);
#else
    for (int p = 0; p < NPHASE; ++p) { a.ph_lo = p; a.ph_hi = p + 1; hipLaunchKernelGGL(fwd, dim3(grid), dim3(NWAVES * 64), LDS_BYTES, stream, a); }
#endif
}
```

```cpp
#include <hip/hip_runtime.h>
#include <cstdio>
#include <cstdint>

#ifndef MK_N_LAUNCHES
#define MK_N_LAUNCHES 1
#endif
#ifndef DBG_GROUPS
#define DBG_GROUPS 7
#endif
#ifndef DBG_MOE
#define DBG_MOE 1
#endif

#define LAS __attribute__((address_space(3)))
#define GAS __attribute__((address_space(1)))
typedef unsigned short bf16;
typedef short bf16x8 __attribute__((ext_vector_type(8)));
typedef short s16x4 __attribute__((ext_vector_type(4)));
typedef float f32x4 __attribute__((ext_vector_type(4)));
typedef float f32x16 __attribute__((ext_vector_type(16)));
typedef float f32x2 __attribute__((ext_vector_type(2)));
typedef unsigned u32x4 __attribute__((ext_vector_type(4)));
typedef unsigned u32x2 __attribute__((ext_vector_type(2)));
typedef __bf16 bf16x2_t __attribute__((ext_vector_type(2)));

constexpr int BATCH = 8, SEQ = 8192, DM = 1024, T = BATCH * SEQ, DEPTH = 2;
constexpr int NP = 3584;
constexpr int C_RQ = 0, C_RK = 256, C_RV = 512, C_RG = 768, C_DQ = 1024, C_DK = 1536, C_DV = 2048, C_GQ = 2560, C_GK = 2688, C_GV = 2816, C_LA = 3072, C_GR = 3200, C_PAD = 3456;
constexpr int IN_W = 3344;
constexpr int NCLS = 48, TPAD = T + NCLS * 256, MAXTILES = TPAD / 256;
constexpr float EPS = 1e-6f, LOG2E = 1.4426950408889634f;

constexpr size_t MiB = 1u << 20;
constexpr size_t WS_CTL = 0, CTL_ZERO_BYTES = 1 * MiB;
constexpr size_t WS_MOD = 1 * MiB;
constexpr size_t WS_SCAL = WS_MOD + 400 * 1024;
constexpr size_t WS_CSR = 2 * MiB;
constexpr size_t WS_CSD = 19 * MiB;
constexpr size_t WS_WIN = 24 * MiB;
constexpr size_t WS_WOUT = 38 * MiB;
constexpr size_t WS_W1 = 42 * MiB;
constexpr size_t WS_W2 = 170 * MiB;
constexpr size_t WS_ACT = 234 * MiB;
constexpr size_t WS_P = 362 * MiB;
constexpr size_t WS_H2S = WS_P;
constexpr size_t WS_U = WS_P + 152 * MiB;
constexpr size_t WS_EST = 810 * MiB;
constexpr size_t WS_EGL = WS_EST + 8 * MiB, WS_ASR = WS_EST + 12 * MiB, WS_ASG = WS_ASR + 256 * 1024;
constexpr size_t WS_ROUTE = 824 * MiB;
constexpr size_t WS_TOKS = WS_ROUTE + 1 * MiB, WS_GAS = WS_TOKS + 512 * 1024, WS_GBS = WS_GAS + 512 * 1024, WS_TINFO = WS_GBS + 512 * 1024;
constexpr size_t WS_END = 828 * MiB;
static_assert((size_t)TPAD * 1024 * 2 <= 152 * MiB && WS_U + 152 * MiB <= WS_P + (size_t)T * NP * 2, "aliases fit inside P");
static_assert((size_t)T * NP * 2 == 448 * MiB && WS_P + 448 * MiB == WS_EST, "P size");
constexpr int CW_BAR = 4096;
constexpr int CW_CNT = 16384;

constexpr int RING_BYTES = 131072, LDSCTL_OFF = RING_BYTES, MISC_OFF = LDSCTL_OFF + 320, PTR_OFF = MISC_OFF + 128, LDS_BYTES = 147456;
constexpr int NWAVES = 8;

__device__ __forceinline__ unsigned pk2(float lo, float hi) { f32x2 v = {lo, hi}; bf16x2_t b = __builtin_convertvector(v, bf16x2_t); return __builtin_bit_cast(unsigned, b); }
__device__ __forceinline__ float bflo(unsigned w) { return __uint_as_float(w << 16); }
__device__ __forceinline__ float bfhi(unsigned w) { return __uint_as_float(w & 0xffff0000u); }
template <int K> __device__ __forceinline__ float sx(float v) { static_assert(K >= 1 && K < 32, "sx"); return __int_as_float(__builtin_amdgcn_ds_swizzle(__float_as_int(v), (K << 10) | 0x1f)); }
__device__ __forceinline__ float sum_halves(float v) { auto rr = __builtin_amdgcn_permlane32_swap(__float_as_uint(v), __float_as_uint(v), false, false); return __uint_as_float(rr[0]) + __uint_as_float(rr[1]); }
__device__ __forceinline__ float max_halves(float v) { auto rr = __builtin_amdgcn_permlane32_swap(__float_as_uint(v), __float_as_uint(v), false, false); return fmaxf(__uint_as_float(rr[0]), __uint_as_float(rr[1])); }
__device__ __forceinline__ float wave_sum(float v) { v += sx<1>(v); v += sx<2>(v); v += sx<4>(v); v += sx<8>(v); v += sx<16>(v); return sum_halves(v); }
__device__ __forceinline__ float wave_max(float v) { v = fmaxf(v, sx<1>(v)); v = fmaxf(v, sx<2>(v)); v = fmaxf(v, sx<4>(v)); v = fmaxf(v, sx<8>(v)); v = fmaxf(v, sx<16>(v)); return max_halves(v); }
__device__ __forceinline__ float silu_f(float x) { return x / (1.0f + __expf(-x)); }
__device__ __forceinline__ int olane() { int l; asm volatile("v_mbcnt_lo_u32_b32 %0, -1, 0\n\tv_mbcnt_hi_u32_b32 %0, -1, %0" : "=v"(l)); return l; }
__device__ __forceinline__ int otid_w(int wave) { return wave * 64 + olane(); }
#define otid() otid_w(g_wave)
template <class Tp> __device__ __forceinline__ const Tp* inptr(const LAS unsigned char* lds, int k) {
    const LAS unsigned* q = (const LAS unsigned*)(lds + PTR_OFF) + 2 * k; const unsigned lo = __builtin_amdgcn_readfirstlane(q[0]), hi = __builtin_amdgcn_readfirstlane(q[1]);
    return (const Tp*)(((unsigned long long)hi << 32) | lo); }
#define INF(k) inptr<float>(lds, k)
#define LDS_WAIT() asm volatile("s_waitcnt lgkmcnt(0)" ::: "memory")
#define VM_WAIT() asm volatile("s_waitcnt vmcnt(0)" ::: "memory")

namespace pg8 {
constexpr int BM = 256, BK = 64, HALF = 128, HTB = HALF * BK * 2, STAGE_BYTES = 8 * HTB, NXCD = 8, WGM = 8;
__device__ __forceinline__ int lds_byte(int r, int c) { const int st = (r >> 4) * 2 + (c >> 5), rr = r & 15, cc = c & 31, ob = rr * 64 + cc * 2; return st * 1024 + (ob ^ (((ob >> 9) & 1) << 5)); }
__device__ __forceinline__ void stage_rc(int b, int& R, int& C) { const int st = b / 1024, sb = b % 1024, swz = sb ^ (((sb >> 9) & 1) << 5); R = (st >> 1) * 16 + swz / 64; C = (st & 1) * 32 + (swz % 64) / 2; }
__device__ __forceinline__ int perm32(int rho) { const int n = rho >> 4, i = rho & 15; return 8 * (i >> 2) + 4 * n + (i & 3); }

struct Unit { int pm, pn, e0, e1; };
struct Gemm { const bf16* A; const bf16* Bt; int K, lda, ldb; };

template <int NM, int NN> struct StaticOrder {
    static constexpr int nM = NM, nN = NN, nwg = NM * NN;
    int G, c;
    __device__ void init(int G_, int c_) { G = G_; c = c_; }
    __device__ bool next(int i, Unit& u) const {
        const int L = i * G + c; if (L >= nwg) return false;
        int wgid = L; { constexpr int q = nwg / NXCD, r = nwg % NXCD; const int xcd = wgid % NXCD, off = wgid / NXCD; wgid = (xcd < r ? xcd * (q + 1) : r * (q + 1) + (xcd - r) * q) + off; }
        constexpr int nig = WGM * nN; static_assert(NM % WGM == 0, "row tiles in whole groups");
        const int gid = wgid / nig, fm = gid * WGM;
        u.pm = fm + ((wgid % nig) % WGM); u.pn = (wgid % nig) / WGM; u.e0 = 0; u.e1 = 0; return true;
    }
    __device__ __forceinline__ const char* a_base(const Gemm& g, const Unit& u) const { return (const char*)g.A + (size_t)u.pm * BM * g.lda * 2; }
    __device__ __forceinline__ const char* b_lo(const Gemm& g, const Unit& u) const { return (const char*)g.Bt + (size_t)u.pn * BM * g.ldb * 2; }
    __device__ __forceinline__ const char* b_hi(const Gemm& g, const Unit& u) const { return b_lo(g, u); }
};
template <int NPN, int WHICH  >
struct MoeOrder {
    const int* tinfo; int G, c;
    __device__ bool next(int i, Unit& u) const {
        const int nT = __builtin_amdgcn_readfirstlane(tinfo[0]);
        const int L = i * G + c; if (L >= nT * NPN) return false;
        const int gF = nT >> 3, full = gF * 8 * NPN;
        if (L < full) { u.pm = (L / (8 * NPN)) * 8 + (L & 7); u.pn = (L >> 3) % NPN; }
        else { const int rT = nT - 8 * gF; int Lr = L - full, pn = 0; while (Lr >= rT) { Lr -= rT; ++pn; } u.pm = gF * 8 + Lr; u.pn = pn; }
        const int code = __builtin_amdgcn_readfirstlane(tinfo[1 + u.pm]); u.e0 = code & 0xff; u.e1 = (code >> 8) & 0xff; return true;
    }
    __device__ __forceinline__ const char* a_base(const Gemm& g, const Unit& u) const { return (const char*)g.A + (size_t)u.pm * BM * g.lda * 2; }
    __device__ __forceinline__ const char* b_lo(const Gemm& g, const Unit& u) const {
        if (WHICH == 1) return (const char*)g.Bt + ((size_t)(u.pn < 4 ? u.e0 : u.e1) * 1024 * 1024 + (size_t)(u.pn & 3) * BM * 1024) * 2;
        return (const char*)g.Bt + ((size_t)u.e0 * 1024 * 512 + (size_t)u.pn * BM * 512) * 2;
    }
    __device__ __forceinline__ const char* b_hi(const Gemm& g, const Unit& u) const {
        if (WHICH == 1) return b_lo(g, u);
        return (const char*)g.Bt + ((size_t)u.e1 * 1024 * 512 + (size_t)u.pn * BM * 512) * 2 - (size_t)8 * BK * 2;
    }
};

struct EpiStoreBf16 {
    static constexpr bool PERM = true;
    bf16* O; int ldc;
    __device__ __forceinline__ void operator()(const f32x4 (&acc)[2][2][4][2], const Unit& u, int wr, int wc, int fr, int fq) const {
        const int row0 = u.pm * BM + wr * 64 + fr, col0 = u.pn * BM + wc * 32 + 8 * fq;
#pragma unroll
        for (int ai = 0; ai < 2; ++ai)
#pragma unroll
            for (int m = 0; m < 4; ++m) { bf16* rowp = O + (size_t)(row0 + ai * HALF + m * 16) * ldc + col0;
#pragma unroll
                for (int bj = 0; bj < 2; ++bj) { const f32x4 v0 = acc[ai][bj][m][0], v1 = acc[ai][bj][m][1];
                    u32x4 w; w.x = pk2(v0[0], v0[1]); w.y = pk2(v0[2], v0[3]); w.z = pk2(v1[0], v1[1]); w.w = pk2(v1[2], v1[3]);
                    *(u32x4*)(rowp + bj * HALF) = w; } }
    }
};
struct EpiResid {
    static constexpr bool PERM = false;
    const float* xin; float* out; const float* gate;
    __device__ __forceinline__ void operator()(const f32x4 (&acc)[2][2][4][2], const Unit& u, int wr, int wc, int fr, int fq) const {
        const int col0 = u.pn * BM + wc * 32 + 4 * fq; const int b = (u.pm * BM) >> 13;
        f32x4 gv[2][2];
#pragma unroll
        for (int bj = 0; bj < 2; ++bj)
#pragma unroll
            for (int n = 0; n < 2; ++n) gv[bj][n] = *(const f32x4*)(gate + (size_t)b * 6144 + col0 + bj * HALF + n * 16);
#pragma unroll
        for (int ai = 0; ai < 2; ++ai)
#pragma unroll
            for (int m = 0; m < 4; ++m) { const size_t off = (size_t)(u.pm * BM + ai * HALF + wr * 64 + m * 16 + fr) * DM + col0;
#pragma unroll
                for (int bj = 0; bj < 2; ++bj)
#pragma unroll
                    for (int n = 0; n < 2; ++n) { const f32x4 xv = *(const f32x4*)(xin + off + bj * HALF + n * 16); *(f32x4*)(out + off + bj * HALF + n * 16) = xv + gv[bj][n] * acc[ai][bj][m][n]; } }
    }
};
struct EpiMoe1 {
    static constexpr bool PERM = true;
    bf16* U; const float* gaS; const float* gbS;
    __device__ __forceinline__ void operator()(const f32x4 (&acc)[2][2][4][2], const Unit& u, int wr, int wc, int fr, int fq) const {
        const float* gs = (u.pn < 4) ? gaS : gbS; const int ucol = u.pn * 128 + wc * 32 + 8 * fq;
#pragma unroll
        for (int ai = 0; ai < 2; ++ai)
#pragma unroll
            for (int m = 0; m < 4; ++m) { const int slot = u.pm * BM + ai * HALF + wr * 64 + m * 16 + fr; const float w = gs[slot];
                float r[8];
#pragma unroll
                for (int n = 0; n < 2; ++n)
#pragma unroll
                    for (int i = 0; i < 4; ++i) { const float g = acc[ai][0][m][n][i], up = acc[ai][1][m][n][i]; r[n * 4 + i] = silu_f(g) * up * w; }
                u32x4 o; o.x = pk2(r[0], r[1]); o.y = pk2(r[2], r[3]); o.z = pk2(r[4], r[5]); o.w = pk2(r[6], r[7]);
                *(u32x4*)(U + (size_t)slot * 1024 + ucol) = o; }
    }
};
struct EpiMoe2 {
    static constexpr bool PERM = false;
    float* x; const int* tokS; const float* gate;
    __device__ __forceinline__ void operator()(const f32x4 (&acc)[2][2][4][2], const Unit& u, int wr, int wc, int fr, int fq) const {
        const int col0 = u.pn * BM + wc * 32 + 4 * fq;
#pragma unroll
        for (int ai = 0; ai < 2; ++ai)
#pragma unroll
            for (int m = 0; m < 4; ++m) { const int slot = u.pm * BM + ai * HALF + wr * 64 + m * 16 + fr; const int tok = tokS[slot];
                if (tok >= 0) { const int b = tok >> 13; float* xp = x + (size_t)tok * DM + col0; const float* gp = gate + (size_t)b * 6144 + col0;
#pragma unroll
                    for (int bj = 0; bj < 2; ++bj)
#pragma unroll
                        for (int n = 0; n < 2; ++n) { const f32x4 gv = *(const f32x4*)(gp + bj * HALF + n * 16); const f32x4 xv = *(const f32x4*)(xp + bj * HALF + n * 16);
                            *(f32x4*)(xp + bj * HALF + n * 16) = xv + (DBG_MOE ? 1.f : 0.f) * gv * acc[ai][bj][m][n]; } } }
    }
};

template <class Epi, class Sched, int KSPLIT  >
__device__ __forceinline__ void gemm_phase(LAS unsigned char* lds, const Gemm g, const Sched& S, const Epi& E, const int g_wave) {
    const int tid = otid(), wid = __builtin_amdgcn_readfirstlane(tid >> 6), lane = tid & 63, wr = wid >> 2, wc = wid & 3, fr = lane & 15, fq = lane >> 4;
    const int K = g.K, nt = K / BK;
    unsigned voffA[2], voffB[2];
#pragma unroll
    for (int i = 0; i < 2; ++i) { int R, C; stage_rc(tid * 16 + i * 8192, R, C); const int Rb = Epi::PERM ? ((R & ~31) + perm32(R & 31)) : R;
        voffA[i] = (unsigned)(R * g.lda + C) * 2u; voffB[i] = (unsigned)(Rb * g.ldb + C) * 2u; }
    const size_t kstep = (size_t)(BK * 2);
    const size_t hstepA = (size_t)HALF * g.lda * 2, hstepB = (size_t)HALF * g.ldb * 2;
    const unsigned ldsw = (unsigned)wid * 1024u;
    const int aoff = lds_byte(wr * 64 + fr, fq * 8), boff = lds_byte(wc * 32 + fr, fq * 8);
#define PG8_SA(b, h) (((b) * 2 + (h)) * HTB)
#define PG8_SB(b, h) ((4 + (b) * 2 + (h)) * HTB)
#define PG8_STAGE(bufoff, gbase, voff) do { _Pragma("unroll") for (int _i = 0; _i < 2; ++_i) \
        __builtin_amdgcn_global_load_lds((const unsigned*)((const char*)(gbase) + (voff)[_i]), (LAS unsigned*)(lds + (bufoff) + ldsw + _i * 8192), 16, 0, 0); } while (0)
#define PG8_LDA(dst, b, h) do { _Pragma("unroll") for (int m = 0; m < 4; ++m) _Pragma("unroll") for (int k = 0; k < 2; ++k) dst[m][k] = *(const LAS bf16x8*)(lds + PG8_SA(b, h) + aoff + m * 2048 + k * 1024); } while (0)
#define PG8_LDB(dst, b, h) do { _Pragma("unroll") for (int n = 0; n < 2; ++n) _Pragma("unroll") for (int k = 0; k < 2; ++k) dst[n][k] = *(const LAS bf16x8*)(lds + PG8_SB(b, h) + boff + n * 2048 + k * 1024); } while (0)
#define PG8_MMA(ai, bj, At, Bt) do { __builtin_amdgcn_s_setprio(1); _Pragma("unroll") for (int m = 0; m < 4; ++m) _Pragma("unroll") for (int n = 0; n < 2; ++n) _Pragma("unroll") for (int k = 0; k < 2; ++k) \
        acc[ai][bj][m][n] = __builtin_amdgcn_mfma_f32_16x16x32_bf16(Bt[n][k], At[m][k], acc[ai][bj][m][n], 0, 0, 0); __builtin_amdgcn_s_setprio(0); } while (0)
#define PG8_WAIT_V(n) asm volatile("s_waitcnt vmcnt(" #n ")" ::: "memory")
#define PG8_WAIT_L(n) asm volatile("s_waitcnt lgkmcnt(" #n ")" ::: "memory")
#define PG8_BAR __builtin_amdgcn_s_barrier()
#define PG8_SCHED __builtin_amdgcn_sched_barrier(0)
    Unit cur, nxt; int ui = 0;
    if (!S.next(0, cur)) return;
    f32x4 acc[2][2][4][2];
#pragma unroll
    for (int a = 0; a < 2; ++a)
#pragma unroll
        for (int b = 0; b < 2; ++b)
#pragma unroll
            for (int m = 0; m < 4; ++m)
#pragma unroll
                for (int n = 0; n < 2; ++n) acc[a][b][m][n] = (f32x4){0.f, 0.f, 0.f, 0.f};
    bf16x8 At[4][2], B0[2][2], B1[2][2];
    const char* cA = S.a_base(g, cur); const char* cB = S.b_lo(g, cur); const char* cBh = S.b_hi(g, cur);
    PG8_STAGE(PG8_SB(0, 0), cB, voffB); PG8_STAGE(PG8_SB(0, 1), cB + hstepB, voffB); PG8_STAGE(PG8_SA(0, 0), cA, voffA); PG8_STAGE(PG8_SA(0, 1), cA + hstepA, voffA);
    if (wr == 1) PG8_BAR;
    PG8_WAIT_V(2); PG8_BAR;
    PG8_STAGE(PG8_SB(1, 0), cB + kstep, voffB); PG8_STAGE(PG8_SA(1, 0), cA + kstep, voffA); PG8_STAGE(PG8_SB(1, 1), cB + hstepB + kstep, voffB);
    PG8_WAIT_V(6); PG8_BAR;
    for (;;) {
        const bool has_next = S.next(ui + 1, nxt);
        const char* nA = has_next ? S.a_base(g, nxt) : cA; const char* nB = has_next ? S.b_lo(g, nxt) : cB; const char* nBh = has_next ? S.b_hi(g, nxt) : cBh;
        for (int t = 0; t < nt; t += 2) {
            const bool last = (t == nt - 2);
            const char* a1 = cA + (size_t)(t + 1) * kstep;
            const char* bsel = (KSPLIT != 0 && (t + 2) >= KSPLIT) ? cBh : cB;
            const char* a2 = last ? nA : cA + (size_t)(t + 2) * kstep; const char* b2 = last ? nB : bsel + (size_t)(t + 2) * kstep;
            const char* a3 = a2 + kstep; const char* b3 = b2 + kstep;
            PG8_LDB(B0, 0, 0); PG8_LDB(B1, 0, 1); PG8_SCHED; PG8_LDA(At, 0, 0); PG8_STAGE(PG8_SA(1, 1), a1 + hstepA, voffA);
            PG8_WAIT_V(8); PG8_WAIT_L(0); PG8_BAR; PG8_MMA(0, 0, At, B0); PG8_MMA(0, 1, At, B1); PG8_BAR; PG8_SCHED;
            PG8_LDA(At, 0, 1); PG8_STAGE(PG8_SB(0, 0), b2, voffB); PG8_STAGE(PG8_SB(0, 1), b2 + hstepB, voffB); PG8_STAGE(PG8_SA(0, 0), a2, voffA);
            PG8_WAIT_V(8); PG8_WAIT_L(0); PG8_BAR; PG8_MMA(1, 0, At, B0); PG8_MMA(1, 1, At, B1); PG8_BAR; PG8_SCHED;
            PG8_LDB(B0, 1, 0); PG8_LDB(B1, 1, 1); PG8_SCHED; PG8_LDA(At, 1, 0); PG8_STAGE(PG8_SA(0, 1), a2 + hstepA, voffA);
            PG8_WAIT_V(8); PG8_WAIT_L(0); PG8_BAR; PG8_MMA(0, 0, At, B0); PG8_MMA(0, 1, At, B1); PG8_BAR; PG8_SCHED;
            PG8_LDA(At, 1, 1); PG8_STAGE(PG8_SB(1, 0), b3, voffB); PG8_STAGE(PG8_SB(1, 1), b3 + hstepB, voffB); PG8_STAGE(PG8_SA(1, 0), a3, voffA);
            PG8_WAIT_V(8); PG8_WAIT_L(0); PG8_BAR; PG8_MMA(1, 0, At, B0); PG8_MMA(1, 1, At, B1); PG8_BAR; PG8_SCHED;
        }
        if (wr == 0) PG8_BAR;
        E(acc, cur, wr, wc, fr, fq);
        if (!has_next) break;
#pragma unroll
        for (int a = 0; a < 2; ++a)
#pragma unroll
            for (int b = 0; b < 2; ++b)
#pragma unroll
                for (int m = 0; m < 4; ++m)
#pragma unroll
                    for (int n = 0; n < 2; ++n) acc[a][b][m][n] = (f32x4){0.f, 0.f, 0.f, 0.f};
        cur = nxt; cA = nA; cB = nB; cBh = nBh; ++ui;
        if (wr == 1) PG8_BAR;
    }
    PG8_WAIT_V(0);
    PG8_BAR;
#undef PG8_SA
#undef PG8_SB
#undef PG8_STAGE
#undef PG8_LDA
#undef PG8_LDB
#undef PG8_MMA
#undef PG8_WAIT_V
#undef PG8_WAIT_L
#undef PG8_BAR
#undef PG8_SCHED
}
}

#define XB_TMO      128
#define XB_XCNT(j)  (256  + 64 * (j))
#define XB_XSUB(j)  (1280 + 64 * (j))
#define XB_XGEN(j)  (2304 + 64 * (j))
#define XB_TOP      3328
#define XB_TOPGEN   3392
#define XCD_BAR_WORDS 3456
#define XB_SPIN_CAP (1u << 21)
__device__ __forceinline__ unsigned xb_ld(unsigned* p)              { return __hip_atomic_load(p, __ATOMIC_RELAXED, __HIP_MEMORY_SCOPE_AGENT); }
__device__ __forceinline__ unsigned xb_add(unsigned* p, unsigned v) { return __hip_atomic_fetch_add(p, v, __ATOMIC_RELAXED, __HIP_MEMORY_SCOPE_AGENT); }
__device__ __forceinline__ unsigned xb_xcc_id() { return (unsigned)__builtin_amdgcn_s_getreg((3 << 11) | 20) & 0xFu; }
#define XB_SPIN(cond, bar) do { unsigned _sp = 0; while (cond) { __builtin_amdgcn_s_sleep(1); \
    if ((++_sp & 255u) == 0u) { if (xb_ld(&(bar)[XB_TMO])) break; if (_sp > XB_SPIN_CAP) { atomicAdd(&(bar)[XB_TMO], 1u); break; } } } } while (0)
struct XcdBarrier { unsigned* bar; unsigned x; volatile LAS unsigned* st; };
__device__ __forceinline__ XcdBarrier xcd_barrier_post(unsigned* bar, volatile LAS unsigned* st, bool leader) {
    XcdBarrier b; b.bar = bar; b.x = xb_xcc_id(); b.st = st;
    if (leader) (void)xb_add(&bar[XB_XCNT(b.x)], 1u);
    return b;
}
__device__ __forceinline__ void xcd_barrier_complete(unsigned* bar, unsigned x, unsigned& nloc, unsigned& nx) {
    const unsigned G = gridDim.x * gridDim.y * gridDim.z;
    unsigned sum, cnt, mine, sp = 0u;
    for (;;) {
        sum = 0u; cnt = 0u; mine = 0u;
#pragma unroll
        for (unsigned j = 0; j < 16; ++j) { const unsigned c = xb_ld(&bar[XB_XCNT(j)]); sum += c; cnt += (c > 0u) ? 1u : 0u; mine = (j == x) ? c : mine; }
        if (sum == G) break;
        __builtin_amdgcn_s_sleep(1);
        if ((++sp & 255u) == 0u) { if (xb_ld(&bar[XB_TMO])) break; if (sp > XB_SPIN_CAP) { atomicAdd(&bar[XB_TMO], 1u); break; } }
    }
    nloc = mine > 0u ? mine : 1u; nx = cnt > 0u ? cnt : 1u;
}
__device__ __forceinline__ void xcd_barrier(const XcdBarrier& b, bool leader) {
    asm volatile("s_waitcnt vmcnt(0)" ::: "memory");
    __syncthreads();
    if (leader) {
        unsigned* bar = b.bar;
        __builtin_amdgcn_s_waitcnt(0);
        unsigned nloc = b.st[0], nx = b.st[1];
        if (nloc == 0u) { xcd_barrier_complete(bar, b.x, nloc, nx); b.st[0] = nloc; b.st[1] = nx; }
        const unsigned old = xb_add(&bar[XB_XSUB(b.x)], 1u);
        const unsigned gen = old / nloc;
        if (old + 1u == (gen + 1u) * nloc) {
            __builtin_amdgcn_fence(__ATOMIC_RELEASE, "agent");
            asm volatile("s_waitcnt vmcnt(0)" ::: "memory");
            const unsigned og = xb_add(&bar[XB_TOP], 1u);
            const unsigned tg = og / nx;
            if (og + 1u == (tg + 1u) * nx) xb_add(&bar[XB_TOPGEN], 1u);
            else XB_SPIN(xb_ld(&bar[XB_TOPGEN]) == tg, bar);
            __builtin_amdgcn_fence(__ATOMIC_ACQUIRE, "agent");
            xb_add(&bar[XB_XGEN(b.x)], 1u);
            asm volatile("s_waitcnt vmcnt(0)" ::: "memory");
        } else {
            XB_SPIN(xb_ld(&bar[XB_XGEN(b.x)]) == gen, bar);
            __builtin_amdgcn_fence(__ATOMIC_ACQUIRE, "agent");
            asm volatile("s_waitcnt vmcnt(0)" ::: "memory");
        }
    }
    __syncthreads();
}

__device__ __forceinline__ int tr_row(int kind, int n) {
    if (kind == 0) return n;
    if (kind == 1) return n < 3072 ? n : (n < 3088 ? -1 : n + 112);
    return (n >> 7) * 256 + (n & 127) + (kind == 3 ? 128 : 0);
}
__device__ __forceinline__ void tr_item(const float* W, int K, int N, bf16* WT, int ldt, int kind, LAS float* scr, int item, int lane) {
    const int nblk = (N + 31) / 32, kb = item / nblk, nb = item % nblk, k0 = 64 * kb, n0 = 32 * nb;
    const bool inr = (n0 + (lane & 31)) < N;
#pragma unroll 8
    for (int i = 0; i < 32; ++i) { const int kk = 2 * i + (lane >> 5); scr[kk * 33 + (lane & 31)] = inr ? W[(size_t)(k0 + kk) * N + n0 + (lane & 31)] : 0.f; }
    LDS_WAIT(); asm volatile("" ::: "memory");
    const int c = lane & 7;
#pragma unroll
    for (int j = 0; j < 4; ++j) { const int n = (lane >> 3) + 8 * j; const LAS float* s = scr + (8 * c) * 33 + n;
        u32x4 o; o.x = pk2(s[0 * 33], s[1 * 33]); o.y = pk2(s[2 * 33], s[3 * 33]); o.z = pk2(s[4 * 33], s[5 * 33]); o.w = pk2(s[6 * 33], s[7 * 33]);
        const int gn = n0 + n; const int r = (gn < N) ? tr_row(kind, gn) : -1;
        if (r >= 0) *(u32x4*)(WT + (size_t)r * ldt + k0 + 8 * c) = o; }
    LDS_WAIT(); asm volatile("" ::: "memory");
}

namespace lin {
constexpr int L_QL = 0, L_QU = 9216, L_KL = 18432, L_KU = 27648, L_KLT = 36864, L_VT = 46080, L_AM = 55296, L_ST = 64512, L_OUT = 73728, L_G = 90368, L_GL = 98560, L_END = 98816;
constexpr int NSEG = 16, LSEG = 8;
#define MFMA16(a, b, c) __builtin_amdgcn_mfma_f32_16x16x32_bf16(a, b, c, 0, 0, 0)
__device__ __forceinline__ bf16x8 frag(const LAS unsigned char* base, int pitchB, int r0, int ks, int lane) {
    return *(const LAS bf16x8*)(base + (r0 + (lane & 15)) * pitchB + (32 * ks + 8 * (lane >> 4)) * 2);
}
template <int DK, bool RET, bool PH2>
__device__ __forceinline__ void unit(LAS unsigned char* lds, const bf16* P, bf16* MIX, const f32x2* csr, int b, int h, int seg,
                                     const float* b_a, const float* gnorm, float* Est, float* Aseg, const int g_wave) {
    constexpr int PQ = (DK + 8) * 2;
    constexpr int PS = 144;
    constexpr int NT = DK / 32;
    const int tid = otid(), lane = tid & 63, wid = __builtin_amdgcn_readfirstlane(tid >> 6);
    const int row = tid >> 3, c8 = tid & 7;
    const int entry = (b * 4 + h) * NSEG + seg;
    const float lng = RET ? __logf(1.0f - exp2f(-5.0f - (float)h)) : 0.f;
    const int cq = RET ? C_RQ + h * 64 : C_GQ + h * 32, ck = RET ? C_RK + h * 64 : C_GK + h * 32, cv = RET ? C_RV + h * 64 : C_GV + h * 64, cg = RET ? C_RG + h * 64 : C_GR + h * 64;
    f32x4 st[NT]; float ac[NT];
    int eb[NT], db[NT];
#pragma unroll
    for (int j = 0; j < NT; ++j) { const int i = wid + 8 * j; if (DK == 64) { eb[j] = i >> 2; db[j] = i & 3; } else { eb[j] = i >> 1; db[j] = i & 1; } st[j] = (f32x4){0.f, 0.f, 0.f, 0.f}; ac[j] = 1.f; }
    if (PH2) {
        for (int sp = 0; sp < seg; ++sp) { const int en = (b * 4 + h) * NSEG + sp;
#pragma unroll
            for (int j = 0; j < NT; ++j) { const int d = db[j] * 16 + (lane & 15); const float a = Aseg[(size_t)en * DK + d];
#pragma unroll
                for (int r = 0; r < 4; ++r) { const int e = eb[j] * 16 + 4 * (lane >> 4) + r; st[j][r] = a * st[j][r] + Est[((size_t)en * 64 + e) * DK + d]; } } }
    }
    for (int c = 0; c < LSEG; ++c) {
        const size_t m0 = (size_t)b * SEQ + (size_t)(seg * LSEG + c) * 64;
        if (!RET) {
            const u32x2 w = *(const u32x2*)(P + (m0 + lane) * NP + C_LA + h * 32 + 4 * wid);
            float x[4] = {bflo(w.x), bfhi(w.x), bflo(w.y), bfhi(w.y)};
#pragma unroll
            for (int i = 0; i < 4; ++i) { const float z = x[i] + b_a[h * 32 + 4 * wid + i]; float v = (fminf(z, 0.f) - log1pf(__expf(-fabsf(z)))) * (1.0f / 16.0f);
#pragma unroll
                for (int o = 1; o < 64; o <<= 1) { const float u = __int_as_float(__builtin_amdgcn_ds_bpermute((lane - o) << 2, __float_as_int(v))); if (lane >= o) v += u; }
                ((LAS float*)(lds + L_G))[lane * 32 + 4 * wid + i] = v; if (lane == 63) ((LAS float*)(lds + L_GL))[4 * wid + i] = v; }
            __syncthreads();
        }
        {
            const size_t m = m0 + row;
            if (RET || c8 < 4) {
                const int d0 = 8 * c8;
                u32x4 kw = *(const u32x4*)(P + m * NP + ck + d0);
                u32x4 qw = (u32x4){0u, 0u, 0u, 0u}; if (PH2) qw = *(const u32x4*)(P + m * NP + cq + d0);
                float qv[8], kv[8], eg[8], ieg[8];
                { const unsigned* qp = (const unsigned*)&qw; const unsigned* kp = (const unsigned*)&kw;
#pragma unroll
                  for (int i = 0; i < 4; ++i) { qv[2 * i] = bflo(qp[i]); qv[2 * i + 1] = bfhi(qp[i]); kv[2 * i] = bflo(kp[i]); kv[2 * i + 1] = bfhi(kp[i]); } }
                if (RET) {
                    const u32x4 kw2 = *(const u32x4*)(P + m * NP + ck + (d0 ^ 32));
                    u32x4 qw2 = (u32x4){0u, 0u, 0u, 0u}; if (PH2) qw2 = *(const u32x4*)(P + m * NP + cq + (d0 ^ 32));
                    const unsigned* qp2 = (const unsigned*)&qw2; const unsigned* kp2 = (const unsigned*)&kw2;
                    const f32x4* cs4 = (const f32x4*)(csr + m * 32 + (d0 & 31));
                    const float g = (float)(row + 1) * lng; const float e1 = __expf(g), e2 = __expf(-g);
#pragma unroll
                    for (int i = 0; i < 4; ++i) { const f32x4 cc = cs4[i];
                        const float qa = bflo(qp2[i]), qb = bfhi(qp2[i]), ka = bflo(kp2[i]), kb = bfhi(kp2[i]);
                        if (c8 < 4) { const float q0 = qv[2 * i] * cc[0] - qa * cc[1], q1 = qv[2 * i + 1] * cc[2] - qb * cc[3]; const float k0 = kv[2 * i] * cc[0] - ka * cc[1], k1 = kv[2 * i + 1] * cc[2] - kb * cc[3];
                            qv[2 * i] = q0; qv[2 * i + 1] = q1; kv[2 * i] = k0; kv[2 * i + 1] = k1; }
                        else { const float q0 = qa * cc[1] + qv[2 * i] * cc[0], q1 = qb * cc[3] + qv[2 * i + 1] * cc[2]; const float k0 = ka * cc[1] + kv[2 * i] * cc[0], k1 = kb * cc[3] + kv[2 * i + 1] * cc[2];
                            qv[2 * i] = q0; qv[2 * i + 1] = q1; kv[2 * i] = k0; kv[2 * i + 1] = k1; } }
#pragma unroll
                    for (int i = 0; i < 8; ++i) { kv[i] *= 0.125f; eg[i] = e1; ieg[i] = e2; }
                } else {
#pragma unroll
                    for (int i = 0; i < 8; ++i) { const float g = ((const LAS float*)(lds + L_G))[row * 32 + d0 + i]; eg[i] = __expf(g); ieg[i] = __expf(-g); qv[i] *= 0.17677669529663687f; }
                }
                float kl[8];
#pragma unroll
                for (int i = 0; i < 8; ++i) kl[i] = kv[i] * ieg[i];
                if (PH2) {
                    u32x4 o;
                    o.x = pk2(qv[0] * eg[0], qv[1] * eg[1]); o.y = pk2(qv[2] * eg[2], qv[3] * eg[3]); o.z = pk2(qv[4] * eg[4], qv[5] * eg[5]); o.w = pk2(qv[6] * eg[6], qv[7] * eg[7]);
                    *(LAS u32x4*)(lds + L_QL + row * PQ + d0 * 2) = o;
                    o.x = pk2(qv[0] * ieg[0], qv[1] * ieg[1]); o.y = pk2(qv[2] * ieg[2], qv[3] * ieg[3]); o.z = pk2(qv[4] * ieg[4], qv[5] * ieg[5]); o.w = pk2(qv[6] * ieg[6], qv[7] * ieg[7]);
                    *(LAS u32x4*)(lds + L_QU + row * PQ + d0 * 2) = o;
                    o.x = pk2(kl[0], kl[1]); o.y = pk2(kl[2], kl[3]); o.z = pk2(kl[4], kl[5]); o.w = pk2(kl[6], kl[7]);
                    *(LAS u32x4*)(lds + L_KL + row * PQ + d0 * 2) = o;
                    o.x = pk2(kv[0] * eg[0], kv[1] * eg[1]); o.y = pk2(kv[2] * eg[2], kv[3] * eg[3]); o.z = pk2(kv[4] * eg[4], kv[5] * eg[5]); o.w = pk2(kv[6] * eg[6], kv[7] * eg[7]);
                    *(LAS u32x4*)(lds + L_KU + row * PQ + d0 * 2) = o;
                }
#pragma unroll
                for (int i = 0; i < 8; i += 2) { const unsigned w = pk2(kl[i], kl[i + 1]);
                    *(LAS unsigned short*)(lds + L_KLT + (d0 + i) * PS + row * 2) = (unsigned short)(w & 0xffffu); *(LAS unsigned short*)(lds + L_KLT + (d0 + i + 1) * PS + row * 2) = (unsigned short)(w >> 16); }
            }
            { const u32x4 vw = *(const u32x4*)(P + m * NP + cv + 8 * c8); const unsigned* vp = (const unsigned*)&vw;
#pragma unroll
              for (int i = 0; i < 4; ++i) { *(LAS unsigned short*)(lds + L_VT + (8 * c8 + 2 * i) * PS + row * 2) = (unsigned short)(vp[i] & 0xffffu); *(LAS unsigned short*)(lds + L_VT + (8 * c8 + 2 * i + 1) * PS + row * 2) = (unsigned short)(vp[i] >> 16); } }
        }
        __syncthreads();
#pragma unroll
        for (int j = 0; j < NT; ++j) {
            const int d = db[j] * 16 + (lane & 15);
            if (PH2) {
#pragma unroll
                for (int r = 0; r < 4; ++r) { const int e = eb[j] * 16 + 4 * (lane >> 4) + r; *(LAS unsigned short*)(lds + L_ST + e * PQ + d * 2) = (unsigned short)(pk2(st[j][r], 0.f) & 0xffffu); }
            }
            f32x4 u = (f32x4){0.f, 0.f, 0.f, 0.f};
#pragma unroll
            for (int ks = 0; ks < 2; ++ks) u = MFMA16(frag(lds + L_VT, PS, eb[j] * 16, ks, lane), frag(lds + L_KLT, PS, db[j] * 16, ks, lane), u);
            const float egl = RET ? __expf(64.f * lng) : __expf(((const LAS float*)(lds + L_GL))[d]);
#pragma unroll
            for (int r = 0; r < 4; ++r) st[j][r] = egl * (st[j][r] + u[r]);
            ac[j] *= egl;
        }
        if (PH2) {
#pragma unroll
            for (int j = 0; j < 2; ++j) { const int i = wid + 8 * j, tb = i >> 2, sb = i & 3;
                f32x4 lo = (f32x4){0.f, 0.f, 0.f, 0.f}, up = (f32x4){0.f, 0.f, 0.f, 0.f};
                if (sb <= tb) {
#pragma unroll
                    for (int ks = 0; ks < DK / 32; ++ks) lo = MFMA16(frag(lds + L_QL, PQ, tb * 16, ks, lane), frag(lds + L_KL, PQ, sb * 16, ks, lane), lo); }
                if (sb >= tb) {
#pragma unroll
                    for (int ks = 0; ks < DK / 32; ++ks) up = MFMA16(frag(lds + L_QU, PQ, tb * 16, ks, lane), frag(lds + L_KU, PQ, sb * 16, ks, lane), up); }
                const int s = sb * 16 + (lane & 15);
#pragma unroll
                for (int r = 0; r < 4; ++r) { const int t = tb * 16 + 4 * (lane >> 4) + r; const float v = (s <= t) ? lo[r] : up[r];
                    *(LAS unsigned short*)(lds + L_AM + t * PS + s * 2) = (unsigned short)(pk2(v, 0.f) & 0xffffu); } }
        }
        __syncthreads();
        if (PH2) {
#pragma unroll
            for (int j = 0; j < 2; ++j) { const int i = wid + 8 * j, tb = i >> 2, ob = i & 3;
                f32x4 o = (f32x4){0.f, 0.f, 0.f, 0.f};
#pragma unroll
                for (int ks = 0; ks < 2; ++ks) o = MFMA16(frag(lds + L_AM, PS, tb * 16, ks, lane), frag(lds + L_VT, PS, ob * 16, ks, lane), o);
#pragma unroll
                for (int ks = 0; ks < DK / 32; ++ks) o = MFMA16(frag(lds + L_QL, PQ, tb * 16, ks, lane), frag(lds + L_ST, PQ, ob * 16, ks, lane), o);
#pragma unroll
                for (int r = 0; r < 4; ++r) ((LAS float*)(lds + L_OUT))[(tb * 16 + 4 * (lane >> 4) + r) * 65 + ob * 16 + (lane & 15)] = o[r]; }
            __syncthreads();
            { const size_t m = m0 + row; const int e0 = 8 * c8; float v[8]; float ss = 0.f;
#pragma unroll
              for (int i = 0; i < 8; ++i) { v[i] = ((const LAS float*)(lds + L_OUT))[row * 65 + e0 + i]; ss += v[i] * v[i]; }
              ss += sx<1>(ss); ss += sx<2>(ss); ss += sx<4>(ss);
              const float rstd = rsqrtf(ss * (1.0f / 64.0f) + EPS);
              const u32x4 gw = *(const u32x4*)(P + m * NP + cg + e0); const unsigned* gp = (const unsigned*)&gw; float y[8];
#pragma unroll
              for (int i = 0; i < 4; ++i) { y[2 * i] = v[2 * i] * rstd * gnorm[e0 + 2 * i] * silu_f(bflo(gp[i])); y[2 * i + 1] = v[2 * i + 1] * rstd * gnorm[e0 + 2 * i + 1] * silu_f(bfhi(gp[i])); }
              const bool on = RET ? ((DBG_GROUPS & 1) != 0) : ((DBG_GROUPS & 4) != 0);
              u32x4 o; o.x = pk2(y[0], y[1]); o.y = pk2(y[2], y[3]); o.z = pk2(y[4], y[5]); o.w = pk2(y[6], y[7]); if (!on) o = (u32x4){0u, 0u, 0u, 0u};
              *(u32x4*)(MIX + m * DM + (RET ? 0 : 768) + h * 64 + e0) = o; }
        }
    }
    if (!PH2) {
#pragma unroll
        for (int j = 0; j < NT; ++j) { const int d = db[j] * 16 + (lane & 15);
#pragma unroll
            for (int r = 0; r < 4; ++r) { const int e = eb[j] * 16 + 4 * (lane >> 4) + r; Est[((size_t)entry * 64 + e) * DK + d] = st[j][r]; }
            if (eb[j] == 0 && (lane >> 4) == 0) Aseg[(size_t)entry * DK + d] = ac[j]; }
    }
    __syncthreads();
}
}

namespace att {
constexpr int A_K = 0, A_V = 16384, A_O0 = 49152, A_LS = 114688, A_END = 116736;
#define MFMA32(a, b, c) __builtin_amdgcn_mfma_f32_32x32x16_bf16(a, b, c, 0, 0, 0)
typedef short v4i16_t __attribute__((ext_vector_type(4)));
__device__ __forceinline__ s16x4 vtr(const LAS unsigned char* p) { return __builtin_bit_cast(s16x4, __builtin_amdgcn_ds_read_tr16_b64_v4i16((LAS v4i16_t*)p)); }
__device__ __forceinline__ int crow(int r, int hi) { return (r & 3) + 8 * (r >> 2) + 4 * hi; }
__device__ __forceinline__ void unit(LAS unsigned char* lds, const bf16* P, bf16* MIX, int b, int h, int jq, float lam, float negM, const float* subg, float oscale, const int g_wave) {
    const int tid = otid(), lane = tid & 63, r32 = lane & 31, hh = lane >> 5, wid = __builtin_amdgcn_readfirstlane(tid >> 6);
    const size_t rowbase = (size_t)b * SEQ;
    const int q0 = jq * 256 + wid * 32;
    const int ntile = 4 * jq + 4, my_nt = 4 * jq + (wid >> 1) + 1;
    const int krow = tid >> 3, kch = (tid & 7) ^ ((krow >> 1) & 7);
    const int vrow = (tid >> 2) & 63, vcol = (tid >> 8) * 32 + (tid & 3) * 8;
    const unsigned ldsw = (unsigned)wid * 1024u;
    const int q4 = (lane & 15) >> 2, p4 = lane & 3, gsel = (lane >> 4) & 1;
    const unsigned vrd = (unsigned)((4 * hh + q4) * 64 + gsel * 32 + p4 * 8);
#pragma unroll 1
    for (int comp = 0; comp < 2; ++comp) {
        bf16x8 qf[4];
        const char* Pb = (const char*)(P + rowbase * NP + h * 128);
        { const unsigned qo = (unsigned)(((q0 + r32) * NP + C_DQ + comp * 64 + hh * 8) * 2);
#pragma unroll
          for (int ks = 0; ks < 4; ++ks) qf[ks] = *(const bf16x8*)(Pb + qo + 32 * ks); }
        const unsigned kgo = (unsigned)((krow * NP + C_DK + comp * 64 + kch * 8) * 2), vgo = (unsigned)((vrow * NP + C_DV + vcol) * 2);
        f32x16 o[4];
#pragma unroll
        for (int e = 0; e < 4; ++e)
#pragma unroll
            for (int r = 0; r < 16; ++r) o[e][r] = 0.f;
        float l = 0.f;
#define ATT_STAGE(buf, tt) do { const char* Pt = Pb + (size_t)(tt) * 64 * NP * 2; \
            __builtin_amdgcn_global_load_lds((const unsigned*)(Pt + kgo), (LAS unsigned*)(lds + A_K + (buf) * 8192 + ldsw), 16, 0, 0); \
            __builtin_amdgcn_global_load_lds((const unsigned*)(Pt + vgo), (LAS unsigned*)(lds + A_V + (buf) * 16384 + ldsw), 16, 0, 0); \
            __builtin_amdgcn_global_load_lds((const unsigned*)(Pt + vgo + 128), (LAS unsigned*)(lds + A_V + (buf) * 16384 + 8192 + ldsw), 16, 0, 0); } while (0)
        ATT_STAGE(0, 0);
        VM_WAIT(); __syncthreads();
        for (int t = 0; t < ntile; ++t) {
            const int cur = t & 1;
            if (t + 1 < ntile) ATT_STAGE(cur ^ 1, t + 1);
            if (t < my_nt) {
                const LAS unsigned char* Kb = lds + A_K + cur * 8192; const LAS unsigned char* Vb = lds + A_V + cur * 16384;
                bf16x8 pa[4];
#pragma unroll
                for (int kb = 0; kb < 2; ++kb) {
                    f32x16 s0;
#pragma unroll
                    for (int r = 0; r < 16; ++r) s0[r] = negM;
#pragma unroll
                    for (int ks = 0; ks < 4; ++ks) { const int cc = 2 * ks + hh; const unsigned ko = (unsigned)(r32 * 128 + ((cc ^ ((r32 >> 1) & 7)) << 4));
                        const bf16x8 a0 = *(const LAS bf16x8*)(Kb + ko + kb * 4096);
                        s0 = MFMA32(a0, qf[ks], s0); }
#pragma unroll
                    for (int r = 0; r < 16; ++r) { s0[r] = __builtin_amdgcn_exp2f(s0[r]); l += s0[r]; }
                    u32x4 w;
                    w.x = pk2(s0[0], s0[1]); w.y = pk2(s0[2], s0[3]); w.z = pk2(s0[4], s0[5]); w.w = pk2(s0[6], s0[7]); pa[2 * kb] = __builtin_bit_cast(bf16x8, w);
                    w.x = pk2(s0[8], s0[9]); w.y = pk2(s0[10], s0[11]); w.z = pk2(s0[12], s0[13]); w.w = pk2(s0[14], s0[15]); pa[2 * kb + 1] = __builtin_bit_cast(bf16x8, w);
                    __builtin_amdgcn_sched_barrier(0);
                }
#pragma unroll
                for (int e = 0; e < 4; ++e) {
#pragma unroll
                    for (int kk = 0; kk < 4; ++kk) { const s16x4 lo = vtr(Vb + e * 4096 + kk * 1024 + vrd), hi = vtr(Vb + e * 4096 + kk * 1024 + 512 + vrd);
                        const bf16x8 vf = (bf16x8){lo[0], lo[1], lo[2], lo[3], hi[0], hi[1], hi[2], hi[3]};
                        o[e] = MFMA32(pa[kk], vf, o[e]); }
                    __builtin_amdgcn_sched_barrier(0); }
            }
            VM_WAIT(); __syncthreads();
        }
#undef ATT_STAGE
        l = sum_halves(l);
        LAS float* ls = (LAS float*)(lds + A_LS) + wid * 64 + comp * 32;
        if (hh == 0) ls[r32] = l;
        LDS_WAIT(); asm volatile("" ::: "memory");
        float inv[16];
#pragma unroll
        for (int r = 0; r < 16; ++r) inv[r] = 1.0f / ls[crow(r, hh)];
        LAS unsigned* o0 = (LAS unsigned*)(lds + A_O0) + wid * 2048 + lane;
        if (comp == 0) {
#pragma unroll
            for (int e = 0; e < 4; ++e)
#pragma unroll
                for (int i = 0; i < 8; ++i) o0[(e * 8 + i) * 64] = pk2(o[e][2 * i] * inv[2 * i], o[e][2 * i + 1] * inv[2 * i + 1]);
        } else {
            float ss[16];
#pragma unroll
            for (int r = 0; r < 16; ++r) ss[r] = 0.f;
#pragma unroll
            for (int e = 0; e < 4; ++e)
#pragma unroll
                for (int i = 0; i < 8; ++i) { const unsigned w = o0[(e * 8 + i) * 64];
                    const float v0 = bflo(w) - lam * o[e][2 * i] * inv[2 * i], v1 = bfhi(w) - lam * o[e][2 * i + 1] * inv[2 * i + 1];
                    o[e][2 * i] = v0; o[e][2 * i + 1] = v1; ss[2 * i] += v0 * v0; ss[2 * i + 1] += v1 * v1; }
#pragma unroll
            for (int r = 0; r < 16; ++r) { float s = ss[r]; s += sx<1>(s); s += sx<2>(s); s += sx<4>(s); s += sx<8>(s); s += sx<16>(s);
                ss[r] = rsqrtf(s * (1.0f / 128.0f) + EPS) * oscale; }
            LAS unsigned char* stg = lds + A_O0 + wid * 8192;
            const int lane_e = olane(), r32e = lane_e & 31;
            LDS_WAIT(); asm volatile("" ::: "memory");
#pragma unroll
            for (int e = 0; e < 4; ++e) { const float gsub = subg[32 * e + r32e];
#pragma unroll
                for (int r = 0; r < 16; ++r) { const float y = ((DBG_GROUPS & 2) != 0) ? o[e][r] * ss[r] * gsub : 0.f;
                    *(LAS unsigned short*)(stg + crow(r, hh) * 256 + (32 * e + r32) * 2) = (unsigned short)(pk2(y, 0.f) & 0xffffu); } }
            LDS_WAIT(); asm volatile("" ::: "memory");
            { unsigned ob = (unsigned)(((q0 + (lane_e >> 4)) * DM + 256 + (lane_e & 15) * 8) * 2); char* Mb = (char*)(MIX + rowbase * DM + h * 128);
#pragma unroll
              for (int i = 0; i < 8; ++i) { const u32x4 w = *(const LAS u32x4*)(stg + ((lane_e >> 4) + 4 * i) * 256 + (lane_e & 15) * 16); *(u32x4*)(Mb + ob + i * 4 * DM * 2) = w; } }
            LDS_WAIT(); asm volatile("" ::: "memory");
        }
    }
}
}

struct Args { const float* in[25]; float* out; unsigned char* ws; int ph_lo, ph_hi; };
static_assert(sizeof(Args) == 27 * 8 + 8, "Args has no padding");
constexpr int NPHASE = 1 + 9 * DEPTH;

__global__ void __launch_bounds__(NWAVES * 64, 2) fwd(Args args) {
    extern __shared__ __attribute__((aligned(16))) unsigned char lds_raw[];
    LAS unsigned char* lds = (LAS unsigned char*)lds_raw;
    const int wave = __builtin_amdgcn_readfirstlane((int)threadIdx.x >> 6); const int g_wave = wave; const int tid0 = otid();
    const int G = gridDim.x; const int bx = blockIdx.x; const int vcu = (G % 8 == 0) ? (bx % 8) * (G / 8) + bx / 8 : bx;
    const int gw = vcu * NWAVES + wave, NGW = G * NWAVES;
    __builtin_assume(gw >= 0 && gw < 4096 && vcu >= 0 && vcu < 512 && G > 0 && G <= 512);
    unsigned char* ws = args.ws;
    unsigned* ctl = (unsigned*)(ws + WS_CTL);
    for (int u = tid0; u < (LDS_BYTES - LDSCTL_OFF) / 4; u += NWAVES * 64) ((LAS unsigned*)(lds + LDSCTL_OFF))[u] = 0u;
    __syncthreads();
    XcdBarrier bar; bar.bar = ctl + CW_BAR; bar.x = 0; bar.st = nullptr;
    if (MK_N_LAUNCHES == 1) bar = xcd_barrier_post(ctl + CW_BAR, (volatile LAS unsigned*)(lds + MISC_OFF) + 8, tid0 == 0);
    const int lo = args.ph_lo, hi = args.ph_hi;
#ifndef PHMASK
#define PHMASK 0x3ff
#endif
#define IN(k) (lo <= (k) && (k) < hi)
#define PHON(j) ((PHMASK >> (j)) & 1)
#define SEAM(k) do { if (IN(k) && IN((k) + 1)) xcd_barrier(bar, otid() == 0); } while (0)
    if (tid0 == 0) {
#pragma unroll
        for (int k = 0; k < 25; ++k) ((LAS unsigned long long*)(lds + PTR_OFF))[k] = (unsigned long long)args.in[k];
    }
    __syncthreads();
    float* xout = args.out;
#define WSP(Tp, off) ((Tp*)(wsl + (off)))
#define WSL() unsigned char* wsl = ws; asm volatile("" : "+s"(wsl))

    if (PHON(0) && IN(0)) {
        const int tid = otid(), lane = tid & 63; WSL();
        const float* c_in = INF(1); const int* pos_in = (const int*)INF(2); const float* w_mod = INF(3); const float* b_mod = INF(4); const float* w_in = INF(7);
        const float* diff_q_g = INF(9); const float* diff_k_g = INF(10); const float* lam_q1 = INF(11); const float* lam_k1 = INF(12); const float* lam_q2 = INF(13); const float* lam_k2 = INF(14);
        const float* gla_w_a2 = INF(16); const float* w_out = INF(19); const float* w_gate = INF(22); const float* w_up = INF(23); const float* w_down = INF(24);
        float* mod = WSP(float, WS_MOD); float* scal = WSP(float, WS_SCAL); f32x2* csr = WSP(f32x2, WS_CSR); f32x2* csd = WSP(f32x2, WS_CSD);
        bf16* Win_t = WSP(bf16, WS_WIN); bf16* Wout_t = WSP(bf16, WS_WOUT); bf16* W1 = WSP(bf16, WS_W1); bf16* W2 = WSP(bf16, WS_W2);
        LAS float* scr = (LAS float*)(lds + wave * 8704);
        LAS float* sact = (LAS float*)(lds + 69632);
        for (int i = tid; i < 8 * 1024; i += NWAVES * 64) sact[i] = silu_f(c_in[i]);
        __syncthreads();
        constexpr int I_MOD = 2 * 384, I_TABR = 1024, I_TABD = 1024, I_LA = 256, I_ZERO = 256, I_SC = 2;
        constexpr int I_WIN = 16 * 105, I_WOUT = 16 * 32, I_GU = 16 * 16, I_DN = 8 * 32, I_LAYER = I_WIN + I_WOUT + 32 * (2 * I_GU + I_DN);
        constexpr int I_PRE = I_MOD + I_TABR + I_TABD + I_LA + I_ZERO + I_SC, NITEMS = I_PRE + 2 * I_LAYER;
        for (int it = gw; it < NITEMS; it += NGW) {
            int r = it;
            if (r < I_MOD) {
                const int l = r / 384, col = (r % 384) * 16 + (lane & 15), ks = lane >> 4;
                float acc[8] = {0.f, 0.f, 0.f, 0.f, 0.f, 0.f, 0.f, 0.f};
                const float* wp = w_mod + (size_t)l * 1024 * 6144 + col;
#pragma unroll 8
                for (int k = ks; k < 1024; k += 4) { const float w = wp[(size_t)k * 6144];
#pragma unroll
                    for (int b = 0; b < 8; ++b) acc[b] += sact[b * 1024 + k] * w; }
#pragma unroll
                for (int b = 0; b < 8; ++b) { float a = acc[b]; a += sx<16>(a); a = sum_halves(a); if (ks == 0) mod[((size_t)l * 8 + b) * 6144 + col] = a + b_mod[l * 6144 + col]; }
                continue; }
            r -= I_MOD;
            if (r < I_TABR) {
                const int i = lane & 31; const float inv_freq = exp2f(-((float)i * (1.0f / 32.0f)) * 13.287712379549449f);
                for (int s = 0; s < 32; ++s) { const int t = r * 64 + 2 * s + (lane >> 5); const float ang = (float)pos_in[t] * inv_freq; float sn, cs; sincosf(ang, &sn, &cs); csr[(size_t)t * 32 + i] = (f32x2){cs, sn}; }
                continue; }
            r -= I_TABR;
            if (r < I_TABD) {
                const int i = lane & 7; const float inv_freq = exp2f(-((float)i * (1.0f / 8.0f)) * 18.931568569324174f);
                for (int s = 0; s < 8; ++s) { const int t = r * 64 + 8 * s + (lane >> 3); const float ang = (float)pos_in[t] * inv_freq; float sn, cs; sincosf(ang, &sn, &cs); csd[(size_t)t * 8 + i] = (f32x2){cs, sn}; }
                continue; }
            r -= I_TABD;
            if (r < I_LA) {
                const int l = r >> 7, j = r & 127; float a2[16];
#pragma unroll
                for (int q = 0; q < 16; ++q) a2[q] = gla_w_a2[((size_t)l * 16 + q) * 128 + j];
                for (int i = 0; i < 16; ++i) { const int k = lane + 64 * i; const f32x4* wp = (const f32x4*)(w_in + ((size_t)l * 1024 + k) * IN_W + 3072); float s = 0.f;
#pragma unroll
                    for (int q = 0; q < 4; ++q) { const f32x4 w = wp[q]; s += w[0] * a2[4 * q] + w[1] * a2[4 * q + 1] + w[2] * a2[4 * q + 2] + w[3] * a2[4 * q + 3]; }
                    Win_t[((size_t)l * NP + C_LA + j) * 1024 + k] = (bf16)(pk2(s, 0.f) & 0xffffu); }
                continue; }
            r -= I_LA;
            if (r < I_ZERO) {
                const int l = r >> 7, j = r & 127; u32x4* p = (u32x4*)(Win_t + ((size_t)l * NP + C_PAD + j) * 1024);
                p[lane] = (u32x4){0u, 0u, 0u, 0u}; p[lane + 64] = (u32x4){0u, 0u, 0u, 0u};
                continue; }
            r -= I_ZERO;
            if (r < I_SC) {
                const int l = r; const float s1 = wave_sum(lam_q1[l * 64 + lane] * lam_k1[l * 64 + lane]), s2 = wave_sum(lam_q2[l * 64 + lane] * lam_k2[l * 64 + lane]);
                const float mq = wave_max(fabsf(diff_q_g[l * 64 + lane])), mk = wave_max(fabsf(diff_k_g[l * 64 + lane]));
                const float lam_init = 0.8f - 0.6f * expf(-0.3f * (float)l);
                if (lane == 0) { scal[l * 4 + 0] = expf(s1) - expf(s2) + lam_init; scal[l * 4 + 1] = -(8.0f * mq * mk * LOG2E + 0.5f); scal[l * 4 + 2] = 1.0f - lam_init; }
                continue; }
            r -= I_SC;
            const int l = r / I_LAYER; r -= l * I_LAYER;
            if (r < I_WIN) { tr_item(w_in + (size_t)l * 1024 * IN_W, 1024, IN_W, Win_t + (size_t)l * NP * 1024, 1024, 1, scr, r, lane); continue; } r -= I_WIN;
            if (r < I_WOUT) { tr_item(w_out + (size_t)l * 1024 * 1024, 1024, 1024, Wout_t + (size_t)l * 1024 * 1024, 1024, 0, scr, r, lane); continue; } r -= I_WOUT;
            const int e = r / (2 * I_GU + I_DN); r -= e * (2 * I_GU + I_DN); const size_t le = (size_t)l * 32 + e;
            if (r < I_GU) { tr_item(w_gate + le * 1024 * 512, 1024, 512, W1 + le * 1024 * 1024, 1024, 2, scr, r, lane); continue; } r -= I_GU;
            if (r < I_GU) { tr_item(w_up + le * 1024 * 512, 1024, 512, W1 + le * 1024 * 1024, 1024, 3, scr, r, lane); continue; } r -= I_GU;
            tr_item(w_down + le * 512 * 1024, 512, 1024, W2 + le * 1024 * 512, 512, 0, scr, r, lane);
        }
        __syncthreads();
    }
    SEAM(0);

    for (int l = 0; l < DEPTH; ++l) {
        const int pb = 1 + 9 * l;
#define XIN ((l == 0) ? INF(0) : (const float*)xout)
#define MODL (WSP(const float, WS_MOD) + (size_t)l * 8 * 6144)
        if (PHON(1) && IN(pb + 0)) {
            const int tid = otid(), lane = tid & 63; (void)tid; (void)lane; WSL();
            const float* xin = XIN; const float* modl = MODL; const float* norm1_g = INF(5); bf16* ACT = WSP(bf16, WS_ACT);
            const float* g1 = norm1_g + l * 1024;
            for (int m = gw; m < T; m += NGW) {
                const int b = m >> 13; const f32x4* xr = (const f32x4*)(xin + (size_t)m * DM) + lane; const float* mb = modl + (size_t)b * 6144;
                f32x4 v[4]; float s = 0.f;
#pragma unroll
                for (int j = 0; j < 4; ++j) { v[j] = xr[64 * j]; s += (v[j][0] * v[j][0] + v[j][1] * v[j][1]) + (v[j][2] * v[j][2] + v[j][3] * v[j][3]); }
                const float rstd = rsqrtf(wave_sum(s) * (1.0f / 1024.0f) + EPS);
                u32x2* o8 = (u32x2*)(ACT + (size_t)m * DM) + lane;
#pragma unroll
                for (int j = 0; j < 4; ++j) { const int k = 4 * lane + 256 * j; const f32x4 gg = *(const f32x4*)(g1 + k), sh = *(const f32x4*)(mb + k), sc = *(const f32x4*)(mb + 1024 + k);
                    const f32x4 y = v[j] * rstd * gg * (sc + 1.0f) + sh; u32x2 w; w.x = pk2(y[0], y[1]); w.y = pk2(y[2], y[3]); o8[64 * j] = w; }
            }
        }
        SEAM(pb + 0);
        if (PHON(2) && IN(pb + 1)) {
            const int tid = otid(), lane = tid & 63; (void)tid; (void)lane; WSL();
            bf16* ACT = WSP(bf16, WS_ACT); bf16* Win_t = WSP(bf16, WS_WIN); bf16* P = WSP(bf16, WS_P);
            pg8::Gemm g{ACT, Win_t + (size_t)l * NP * 1024, 1024, 1024, 1024}; pg8::StaticOrder<T / 256, NP / 256> S; S.init(G, bx);
            pg8::EpiStoreBf16 E{P, NP};
            pg8::gemm_phase<pg8::EpiStoreBf16, pg8::StaticOrder<T / 256, NP / 256>, 0>(lds, g, S, E, g_wave);
        }
        SEAM(pb + 1);
        if (PHON(3) && IN(pb + 2)) {
            const int tid = otid(), lane = tid & 63; (void)tid; (void)lane; WSL();
            const float* diff_q_g = INF(9); const float* diff_k_g = INF(10); const float* gla_b_a = INF(17); bf16* P = WSP(bf16, WS_P); bf16* ACT = WSP(bf16, WS_ACT); f32x2* csr = WSP(f32x2, WS_CSR); f32x2* csd = WSP(f32x2, WS_CSD);
            float* Eret = WSP(float, WS_EST); float* Egla = WSP(float, WS_EGL); float* Asr = WSP(float, WS_ASR); float* Asg = WSP(float, WS_ASG);
            const float* gq = diff_q_g + l * 64; const float* gk = diff_k_g + l * 64;
            for (int m = gw; m < T; m += NGW) {
                bf16* p = P + (size_t)m * NP + C_DQ + 16 * lane;
                const u32x4 w0 = *(const u32x4*)p, w1 = *(const u32x4*)(p + 8);
                float v[16];
                { const unsigned* a = (const unsigned*)&w0; const unsigned* c = (const unsigned*)&w1;
#pragma unroll
                  for (int i = 0; i < 4; ++i) { v[2 * i] = bflo(a[i]); v[2 * i + 1] = bfhi(a[i]); v[8 + 2 * i] = bflo(c[i]); v[8 + 2 * i + 1] = bfhi(c[i]); } }
                float ss = 0.f;
#pragma unroll
                for (int i = 0; i < 16; ++i) ss += v[i] * v[i];
                ss += sx<1>(ss); ss += sx<2>(ss);
                const float rstd = rsqrtf(ss * (1.0f / 64.0f) + EPS);
                const bool isq = lane < 32; const float* gg = (isq ? gq : gk) + (lane & 3) * 16;
#pragma unroll
                for (int i = 0; i < 16; ++i) v[i] = v[i] * rstd * gg[i];
                if ((lane & 3) == 0) { const f32x4* cs4 = (const f32x4*)(csd + (size_t)m * 8);
#pragma unroll
                    for (int i = 0; i < 4; ++i) { const f32x4 cc = cs4[i];
                        const float a0 = v[2 * i], b0 = v[2 * i + 8], a1 = v[2 * i + 1], b1 = v[2 * i + 9];
                        v[2 * i] = a0 * cc[0] - b0 * cc[1]; v[2 * i + 8] = a0 * cc[1] + b0 * cc[0]; v[2 * i + 1] = a1 * cc[2] - b1 * cc[3]; v[2 * i + 9] = a1 * cc[3] + b1 * cc[2]; } }
                const float qs = isq ? 0.125f * LOG2E : 1.0f;
                u32x4 o0, o1;
                o0.x = pk2(v[0] * qs, v[1] * qs); o0.y = pk2(v[2] * qs, v[3] * qs); o0.z = pk2(v[4] * qs, v[5] * qs); o0.w = pk2(v[6] * qs, v[7] * qs);
                o1.x = pk2(v[8] * qs, v[9] * qs); o1.y = pk2(v[10] * qs, v[11] * qs); o1.z = pk2(v[12] * qs, v[13] * qs); o1.w = pk2(v[14] * qs, v[15] * qs);
                *(u32x4*)p = o0; *(u32x4*)(p + 8) = o1;
            }
            for (int u = vcu; u < 1024; u += G) {
                const int r = u & 511, bh = r >> 4, seg = r & 15;
                if (u < 512) lin::unit<64, true, false>(lds, P, ACT, csr, bh >> 2, bh & 3, seg, nullptr, nullptr, Eret, Asr, g_wave);
                else lin::unit<32, false, false>(lds, P, ACT, csr, bh >> 2, bh & 3, seg, gla_b_a + l * 128, nullptr, Egla, Asg, g_wave);
            }
        }
        SEAM(pb + 2);
        if (PHON(4) && IN(pb + 3)) {
            const int tid = otid(), lane = tid & 63; (void)tid; (void)lane; WSL();
            const float* scal = WSP(const float, WS_SCAL); const float* diff_sub_g = INF(15); const float* ret_norm_g = INF(8); const float* gla_norm_g = INF(18); const float* gla_b_a = INF(17); bf16* P = WSP(bf16, WS_P); bf16* ACT = WSP(bf16, WS_ACT); f32x2* csr = WSP(f32x2, WS_CSR);
            float* Eret = WSP(float, WS_EST); float* Egla = WSP(float, WS_EGL); float* Asr = WSP(float, WS_ASR); float* Asg = WSP(float, WS_ASG);
            const float lam = scal[l * 4 + 0], negM = scal[l * 4 + 1], osc = scal[l * 4 + 2];
#ifndef NO_ATT
            for (int pu = vcu; pu < 512; pu += G) {
                const int bh = pu >> 4, jp = pu & 15;
                att::unit(lds, P, ACT, bh >> 2, bh & 3, jp, lam, negM, diff_sub_g + l * 128, osc, g_wave);
                att::unit(lds, P, ACT, bh >> 2, bh & 3, 31 - jp, lam, negM, diff_sub_g + l * 128, osc, g_wave);
            }
#endif
#ifndef NO_LIN2
            for (int u = vcu; u < 1024; u += G) {
                const int r = u & 511, bh = r >> 4, seg = r & 15;
                if (u < 512) lin::unit<64, true, true>(lds, P, ACT, csr, bh >> 2, bh & 3, seg, nullptr, ret_norm_g + l * 64, Eret, Asr, g_wave);
                else lin::unit<32, false, true>(lds, P, ACT, csr, bh >> 2, bh & 3, seg, gla_b_a + l * 128, gla_norm_g + l * 64, Egla, Asg, g_wave);
            }
#endif
        }
        SEAM(pb + 3);
        if (PHON(5) && IN(pb + 4)) {
            const int tid = otid(), lane = tid & 63; (void)tid; (void)lane; WSL();
            const float* xin = XIN; const float* modl = MODL; bf16* ACT = WSP(bf16, WS_ACT); bf16* Wout_t = WSP(bf16, WS_WOUT);
            pg8::Gemm g{ACT, Wout_t + (size_t)l * 1024 * 1024, 1024, 1024, 1024}; pg8::StaticOrder<T / 256, 4> S; S.init(G, bx);
            pg8::EpiResid E{xin, xout, modl + 2048};
            pg8::gemm_phase<pg8::EpiResid, pg8::StaticOrder<T / 256, 4>, 0>(lds, g, S, E, g_wave);
        }
        SEAM(pb + 4);
        if (PHON(6) && IN(pb + 5)) {
            const int tid = otid(), lane = tid & 63; (void)tid; (void)lane; WSL();
            const float* modl = MODL; const float* router_w = INF(20); const float* router_b = INF(21); const float* norm2_g = INF(6); bf16* ACT = WSP(bf16, WS_ACT); int* tokinfo = WSP(int, WS_ROUTE); int* tokS = WSP(int, WS_TOKS);
            constexpr int WR_PITCH = 2064, LG_OFF = 32 * WR_PITCH;
#pragma unroll 4
            for (int i = tid; i < 32768; i += NWAVES * 64) { const int k = i >> 5, e = i & 31; *(LAS unsigned short*)(lds + e * WR_PITCH + k * 2) = (unsigned short)(pk2(router_w[i], 0.f) & 0xffffu); }
            { int Gl = G; asm volatile("" : "+s"(Gl));
#pragma unroll 1
              for (int i = bx * NWAVES * 64 + tid; i < TPAD; i += Gl * NWAVES * 64) tokS[i] = -1; }
            __syncthreads();
            const float* g2 = norm2_g + l * 1024;
            LAS float* lg = (LAS float*)(lds + LG_OFF + wave * 2112);
            unsigned* cnt = ctl + CW_CNT + l * 64;
            for (int gi = gw; gi < T / 16; gi += NGW) {
                for (int rr = 0; rr < 16; ++rr) {
                    const int m = gi * 16 + rr; const int b = m >> 13; const f32x4* xr = (const f32x4*)(xout + (size_t)m * DM) + lane; const float* mb = modl + (size_t)b * 6144 + 3072;
                    f32x4 v[4]; float s = 0.f;
#pragma unroll
                    for (int j = 0; j < 4; ++j) { v[j] = xr[64 * j]; s += (v[j][0] * v[j][0] + v[j][1] * v[j][1]) + (v[j][2] * v[j][2] + v[j][3] * v[j][3]); }
                    const float rstd = rsqrtf(wave_sum(s) * (1.0f / 1024.0f) + EPS);
                    u32x2* o8 = (u32x2*)(ACT + (size_t)m * DM) + lane;
#pragma unroll
                    for (int j = 0; j < 4; ++j) { const int k = 4 * lane + 256 * j; const f32x4 gg = *(const f32x4*)(g2 + k), sh = *(const f32x4*)(mb + k), sc = *(const f32x4*)(mb + 1024 + k);
                        const f32x4 y = v[j] * rstd * gg * (sc + 1.0f) + sh; u32x2 w; w.x = pk2(y[0], y[1]); w.y = pk2(y[2], y[3]); o8[64 * j] = w; }
                }
                VM_WAIT();
                f32x4 a0 = (f32x4){0.f, 0.f, 0.f, 0.f}, a1 = a0;
                const bf16* ap = ACT + (size_t)(gi * 16 + (lane & 15)) * DM + 8 * (lane >> 4);
#pragma unroll 4
                for (int ks = 0; ks < 32; ++ks) { const bf16x8 a = *(const bf16x8*)(ap + 32 * ks);
                    const bf16x8 b0 = *(const LAS bf16x8*)(lds + (lane & 15) * WR_PITCH + (32 * ks + 8 * (lane >> 4)) * 2), b1 = *(const LAS bf16x8*)(lds + (16 + (lane & 15)) * WR_PITCH + (32 * ks + 8 * (lane >> 4)) * 2);
                    a0 = MFMA16(a, b0, a0); a1 = MFMA16(a, b1, a1); }
#pragma unroll
                for (int r = 0; r < 4; ++r) { lg[(4 * (lane >> 4) + r) * 33 + (lane & 15)] = a0[r]; lg[(4 * (lane >> 4) + r) * 33 + 16 + (lane & 15)] = a1[r]; }
                LDS_WAIT(); asm volatile("" ::: "memory");
                if (lane < 16) {
                    const int m = gi * 16 + lane; float best = -3.0e38f; int bcls = 0; float bwa = 0.f, bwb = 0.f;
#pragma unroll
                    for (int g = 0; g < 8; ++g) {
                        float s[4], a[4];
#pragma unroll
                        for (int i = 0; i < 4; ++i) { s[i] = 1.0f / (1.0f + __expf(-lg[lane * 33 + 4 * g + i])); a[i] = s[i] + router_b[4 * g + i]; }
                        int i1 = 0; float v1 = a[0];
                        if (a[1] > v1) { v1 = a[1]; i1 = 1; } if (a[2] > v1) { v1 = a[2]; i1 = 2; } if (a[3] > v1) { v1 = a[3]; i1 = 3; }
                        int i2 = -1; float v2 = -3.0e38f;
                        if (i1 != 0 && a[0] > v2) { v2 = a[0]; i2 = 0; } if (i1 != 1 && a[1] > v2) { v2 = a[1]; i2 = 1; } if (i1 != 2 && a[2] > v2) { v2 = a[2]; i2 = 2; } if (i1 != 3 && a[3] > v2) { v2 = a[3]; i2 = 3; }
                        const float gsum = v1 + v2;
                        const int ea = i1 < i2 ? i1 : i2, eb = i1 < i2 ? i2 : i1;
                        const float sa = ea == 0 ? s[0] : (ea == 1 ? s[1] : s[2]), sb = eb == 1 ? s[1] : (eb == 2 ? s[2] : s[3]);
                        const int pidx = (ea * (7 - ea)) / 2 + (eb - ea - 1);
                        if (gsum > best) { best = gsum; bcls = g * 6 + pidx; const float den = 1.0f / (sa + sb); bwa = sa * den; bwb = sb * den; }
                    }
                    const unsigned rank = atomicAdd(cnt + bcls, 1u);
                    *(u32x4*)(tokinfo + (size_t)m * 4) = (u32x4){(unsigned)bcls, rank, __float_as_uint(bwa), __float_as_uint(bwb)};
                }
                LDS_WAIT(); asm volatile("" ::: "memory");
            }
            __syncthreads();
        }
        SEAM(pb + 5);
        if (PHON(7) && IN(pb + 6)) {
            const int tid = otid(), lane = tid & 63; (void)tid; (void)lane; WSL();
            bf16* ACT = WSP(bf16, WS_ACT); bf16* H2S = WSP(bf16, WS_H2S); int* tokinfo = WSP(int, WS_ROUTE); int* tokS = WSP(int, WS_TOKS); float* gaS = WSP(float, WS_GAS); float* gbS = WSP(float, WS_GBS); int* tinfo = WSP(int, WS_TINFO);
            LAS int* cst = (LAS int*)lds;
            if (tid == 0) { const unsigned* cnt = ctl + CW_CNT + l * 64; int s = 0, nt = 0;
                for (int c = 0; c < NCLS; ++c) { const int n = (int)__hip_atomic_load(cnt + c, __ATOMIC_RELAXED, __HIP_MEMORY_SCOPE_AGENT); cst[c] = s; const int tl = (n + 255) >> 8;
                    if (bx == 0) { const int g = c / 6, p = c % 6; const int a = p < 3 ? 0 : (p < 5 ? 1 : 2); const int bb = p < 3 ? p + 1 : (p < 5 ? p - 1 : 3); const int code = (g * 4 + a) | ((g * 4 + bb) << 8);
                        for (int i = 0; i < tl; ++i) tinfo[1 + nt + i] = code; }
                    nt += tl; s += tl * 256; }
                if (bx == 0) tinfo[0] = nt; }
            __syncthreads();
            for (int m = gw; m < T; m += NGW) {
                const u32x4 inf = *(const u32x4*)(tokinfo + (size_t)m * 4);
                const int slot = cst[inf.x] + (int)inf.y;
                const u32x4* src = (const u32x4*)(ACT + (size_t)m * DM); u32x4* dst = (u32x4*)(H2S + (size_t)slot * DM);
                dst[lane] = src[lane]; dst[lane + 64] = src[lane + 64];
                if (lane == 0) { tokS[slot] = m; gaS[slot] = __uint_as_float(inf.z); gbS[slot] = __uint_as_float(inf.w); }
            }
            __syncthreads();
        }
        SEAM(pb + 6);
        if (PHON(8) && IN(pb + 7)) {
            const int tid = otid(), lane = tid & 63; (void)tid; (void)lane; WSL();
            bf16* H2S = WSP(bf16, WS_H2S); bf16* W1 = WSP(bf16, WS_W1); bf16* U = WSP(bf16, WS_U); float* gaS = WSP(float, WS_GAS); float* gbS = WSP(float, WS_GBS); int* tinfo = WSP(int, WS_TINFO);
            pg8::Gemm g{H2S, W1 + (size_t)l * 32 * 1024 * 1024, 1024, 1024, 1024}; pg8::MoeOrder<8, 1> S{tinfo, G, vcu};
            pg8::EpiMoe1 E{U, gaS, gbS};
            pg8::gemm_phase<pg8::EpiMoe1, pg8::MoeOrder<8, 1>, 0>(lds, g, S, E, g_wave);
        }
        SEAM(pb + 7);
        if (PHON(9) && IN(pb + 8)) {
            const int tid = otid(), lane = tid & 63; (void)tid; (void)lane; WSL();
            const float* modl = MODL; bf16* U = WSP(bf16, WS_U); bf16* W2 = WSP(bf16, WS_W2); int* tokS = WSP(int, WS_TOKS); int* tinfo = WSP(int, WS_TINFO);
            pg8::Gemm g{U, W2 + (size_t)l * 32 * 1024 * 512, 1024, 1024, 512}; pg8::MoeOrder<4, 2> S{tinfo, G, vcu};
            pg8::EpiMoe2 E{xout, tokS, modl + 5 * 1024};
            pg8::gemm_phase<pg8::EpiMoe2, pg8::MoeOrder<4, 2>, 8>(lds, g, S, E, g_wave);
        }
        SEAM(pb + 8);
    }
#undef IN
#undef SEAM
}

extern "C" void kernel_launch(void* const* d_in, const int* in_sizes, int n_in, void* d_out, int out_size, void* d_ws, size_t ws_size, hipStream_t stream) {
    static int grid = 0;
    if (grid == 0) {
        if (n_in != 25 || in_sizes[0] != T * DM || out_size != T * DM || ws_size < WS_END) { fprintf(stderr, "kernel_launch: unexpected shapes (n_in %d, in0 %d, out %d, ws %zu < %zu)\n", n_in, n_in > 0 ? in_sizes[0] : -1, out_size, ws_size, (size_t)WS_END); grid = -1; return; }
        int dev = 0, cus = 0, per_cu = 0;
        if (hipGetDevice(&dev) != hipSuccess || hipDeviceGetAttribute(&cus, hipDeviceAttributeMultiprocessorCount, dev) != hipSuccess) { grid = -1; return; }
        if (hipFuncSetAttribute((const void*)fwd, hipFuncAttributeMaxDynamicSharedMemorySize, LDS_BYTES) != hipSuccess) { fprintf(stderr, "kernel_launch: hipFuncSetAttribute failed\n"); grid = -1; return; }
        if (hipOccupancyMaxActiveBlocksPerMultiprocessor(&per_cu, (const void*)fwd, NWAVES * 64, LDS_BYTES) != hipSuccess || per_cu < 1) fprintf(stderr, "kernel_launch: occupancy query reports %d\n", per_cu);
        (void)hipGetLastError();
        grid = cus;
    }
    if (grid < 0) return;
    if (hipMemsetAsync((char*)d_ws + WS_CTL, 0, CTL_ZERO_BYTES, stream) != hipSuccess) return;
    Args a{};
    for (int i = 0; i < 25; ++i) a.in[i] = (const float*)d_in[i];
    a.out = (float*)d_out; a.ws = (unsigned char*)d_ws;
#if MK_N_LAUNCHES == 1
    a.ph_lo = 0; a.ph_hi = NPHASE;
    hipLaunchKernelGGL(fwd, dim3(grid), dim3(NWAVES * 64), LDS_BYTES, stream, a);
#else
    for (int p = 0; p < NPHASE; ++p) { a.ph_lo = p; a.ph_hi = p + 1; hipLaunchKernelGGL(fwd, dim3(grid), dim3(NWAVES * 64), LDS_BYTES, stream, a); }
#endif
}
```

```cpp
#include <hip/hip_runtime.h>
#include <cstdio>
#include <cstdint>

#ifndef MK_N_LAUNCHES
#define MK_N_LAUNCHES 1
#endif
#ifndef DBG_GROUPS
#define DBG_GROUPS 7
#endif
#ifndef DBG_MOE
#define DBG_MOE 1
#endif
#ifndef RPT_PHASE
#define RPT_PHASE 0
#endif
#ifndef RPT_N
#define RPT_N 1
#endif

#define LAS __attribute__((address_space(3)))
#define GAS __attribute__((address_space(1)))
typedef unsigned short bf16;
typedef short bf16x8 __attribute__((ext_vector_type(8)));
typedef short s16x4 __attribute__((ext_vector_type(4)));
typedef float f32x4 __attribute__((ext_vector_type(4)));
typedef float f32x16 __attribute__((ext_vector_type(16)));
typedef float f32x2 __attribute__((ext_vector_type(2)));
typedef unsigned u32x4 __attribute__((ext_vector_type(4)));
typedef unsigned u32x2 __attribute__((ext_vector_type(2)));
typedef __bf16 bf16x2_t __attribute__((ext_vector_type(2)));

constexpr int BATCH = 8, SEQ = 8192, DM = 1024, T = BATCH * SEQ, DEPTH = 2;
constexpr int NP = 3584;
constexpr int C_RQ = 0, C_RK = 256, C_RV = 512, C_RG = 768, C_DQ = 1024, C_DK = 1536, C_DV = 2048, C_GQ = 2560, C_GK = 2688, C_GV = 2816, C_LA = 3072, C_GR = 3200, C_PAD = 3456;
constexpr int IN_W = 3344;
constexpr int NCLS = 48, TPAD = T + NCLS * 256, MAXTILES = TPAD / 256;
constexpr float EPS = 1e-6f, LOG2E = 1.4426950408889634f;

constexpr size_t MiB = 1u << 20;
constexpr size_t WS_CTL = 0, CTL_ZERO_BYTES = 1 * MiB;
constexpr size_t WS_MOD = 1 * MiB;
constexpr size_t WS_SCAL = WS_MOD + 400 * 1024;
constexpr size_t WS_CSR = 2 * MiB;
constexpr size_t WS_CSD = 19 * MiB;
constexpr size_t WS_WIN = 24 * MiB;
constexpr size_t WS_WOUT = 38 * MiB;
constexpr size_t WS_W1 = 42 * MiB;
constexpr size_t WS_W2 = 170 * MiB;
constexpr size_t WS_ACT = 234 * MiB;
constexpr size_t WS_P = 362 * MiB;
constexpr size_t WS_H2S = WS_P;
constexpr size_t WS_U = WS_P + 152 * MiB;
constexpr size_t WS_EST = 810 * MiB;
constexpr size_t WS_EGL = WS_EST + 8 * MiB, WS_ASR = WS_EST + 12 * MiB, WS_ASG = WS_ASR + 256 * 1024;
constexpr size_t WS_ROUTE = 824 * MiB;
constexpr size_t WS_TOKS = WS_ROUTE + 1 * MiB, WS_GAS = WS_TOKS + 512 * 1024, WS_GBS = WS_GAS + 512 * 1024, WS_TINFO = WS_GBS + 512 * 1024;
constexpr size_t WS_END = 828 * MiB;
static_assert((size_t)TPAD * 1024 * 2 <= 152 * MiB && WS_U + 152 * MiB <= WS_P + (size_t)T * NP * 2, "aliases fit inside P");
static_assert((size_t)T * NP * 2 == 448 * MiB && WS_P + 448 * MiB == WS_EST, "P size");
constexpr int CW_BAR = 4096;
constexpr int CW_CNT = 16384;

constexpr int RING_BYTES = 131072, LDSCTL_OFF = RING_BYTES, MISC_OFF = LDSCTL_OFF + 320, PTR_OFF = MISC_OFF + 128, LDS_BYTES = 147456;
constexpr int NWAVES = 8;

__device__ __forceinline__ unsigned pk2(float lo, float hi) { f32x2 v = {lo, hi}; bf16x2_t b = __builtin_convertvector(v, bf16x2_t); return __builtin_bit_cast(unsigned, b); }
__device__ __forceinline__ float bflo(unsigned w) { return __uint_as_float(w << 16); }
__device__ __forceinline__ float bfhi(unsigned w) { return __uint_as_float(w & 0xffff0000u); }
template <int K> __device__ __forceinline__ float sx(float v) { static_assert(K >= 1 && K < 32, "sx"); return __int_as_float(__builtin_amdgcn_ds_swizzle(__float_as_int(v), (K << 10) | 0x1f)); }
__device__ __forceinline__ float sum_halves(float v) { auto rr = __builtin_amdgcn_permlane32_swap(__float_as_uint(v), __float_as_uint(v), false, false); return __uint_as_float(rr[0]) + __uint_as_float(rr[1]); }
__device__ __forceinline__ float max_halves(float v) { auto rr = __builtin_amdgcn_permlane32_swap(__float_as_uint(v), __float_as_uint(v), false, false); return fmaxf(__uint_as_float(rr[0]), __uint_as_float(rr[1])); }
__device__ __forceinline__ float wave_sum(float v) { v += sx<1>(v); v += sx<2>(v); v += sx<4>(v); v += sx<8>(v); v += sx<16>(v); return sum_halves(v); }
__device__ __forceinline__ float wave_max(float v) { v = fmaxf(v, sx<1>(v)); v = fmaxf(v, sx<2>(v)); v = fmaxf(v, sx<4>(v)); v = fmaxf(v, sx<8>(v)); v = fmaxf(v, sx<16>(v)); return max_halves(v); }
__device__ __forceinline__ float silu_f(float x) { return x * __builtin_amdgcn_rcpf(1.0f + __expf(-x)); }
__device__ __forceinline__ int olane() { int l; asm volatile("v_mbcnt_lo_u32_b32 %0, -1, 0\n\tv_mbcnt_hi_u32_b32 %0, -1, %0" : "=v"(l)); return l; }
__device__ __forceinline__ int otid_w(int wave) { return wave * 64 + olane(); }
#define otid() otid_w(g_wave)
template <class Tp> __device__ __forceinline__ const Tp* inptr(const LAS unsigned char* lds, int k) {
    const LAS unsigned* q = (const LAS unsigned*)(lds + PTR_OFF) + 2 * k; const unsigned lo = __builtin_amdgcn_readfirstlane(q[0]), hi = __builtin_amdgcn_readfirstlane(q[1]);
    return (const Tp*)(((unsigned long long)hi << 32) | lo); }
#define INF(k) inptr<float>(lds, k)
#define LDS_WAIT() asm volatile("s_waitcnt lgkmcnt(0)" ::: "memory")
#define VM_WAIT() asm volatile("s_waitcnt vmcnt(0)" ::: "memory")

namespace pg8 {
constexpr int BM = 256, BK = 64, HALF = 128, HTB = HALF * BK * 2, STAGE_BYTES = 8 * HTB, NXCD = 8, WGM = 8;
__device__ __forceinline__ int lds_byte(int r, int c) { const int st = (r >> 4) * 2 + (c >> 5), rr = r & 15, cc = c & 31, ob = rr * 64 + cc * 2; return st * 1024 + (ob ^ (((ob >> 9) & 1) << 5)); }
__device__ __forceinline__ void stage_rc(int b, int& R, int& C) { const int st = b / 1024, sb = b % 1024, swz = sb ^ (((sb >> 9) & 1) << 5); R = (st >> 1) * 16 + swz / 64; C = (st & 1) * 32 + (swz % 64) / 2; }
__device__ __forceinline__ int perm32(int rho) { const int n = rho >> 4, i = rho & 15; return 8 * (i >> 2) + 4 * n + (i & 3); }

struct Unit { int pm, pn, e0, e1; };
struct Gemm { const bf16* A; const bf16* Bt; int K, lda, ldb; };

template <int NM, int NN> struct StaticOrder {
    static constexpr int nM = NM, nN = NN, nwg = NM * NN;
    int G, c;
    __device__ void init(int G_, int c_) { G = G_; c = c_; }
    __device__ bool next(int i, Unit& u) const {
        const int L = i * G + c; if (L >= nwg) return false;
        int wgid = L; { constexpr int q = nwg / NXCD, r = nwg % NXCD; const int xcd = wgid % NXCD, off = wgid / NXCD; wgid = (xcd < r ? xcd * (q + 1) : r * (q + 1) + (xcd - r) * q) + off; }
        constexpr int nig = WGM * nN; static_assert(NM % WGM == 0, "row tiles in whole groups");
        const int gid = wgid / nig, fm = gid * WGM;
        u.pm = fm + ((wgid % nig) % WGM); u.pn = (wgid % nig) / WGM; u.e0 = 0; u.e1 = 0; return true;
    }
    __device__ __forceinline__ const char* a_base(const Gemm& g, const Unit& u) const { return (const char*)g.A + (size_t)u.pm * BM * g.lda * 2; }
    __device__ __forceinline__ const char* b_lo(const Gemm& g, const Unit& u) const { return (const char*)g.Bt + (size_t)u.pn * BM * g.ldb * 2; }
    __device__ __forceinline__ const char* b_hi(const Gemm& g, const Unit& u) const { return b_lo(g, u); }
};
template <int NPN, int WHICH  >
struct MoeOrder {
    const int* tinfo; int G, c;
    __device__ bool next(int i, Unit& u) const {
        const int nT = __builtin_amdgcn_readfirstlane(tinfo[0]);
        const int L = i * G + c; if (L >= nT * NPN) return false;
        const int gF = nT >> 3, full = gF * 8 * NPN;
        if (L < full) { u.pm = (L / (8 * NPN)) * 8 + (L & 7); u.pn = (L >> 3) % NPN; }
        else { const int rT = nT - 8 * gF; int Lr = L - full, pn = 0; while (Lr >= rT) { Lr -= rT; ++pn; } u.pm = gF * 8 + Lr; u.pn = pn; }
        const int code = __builtin_amdgcn_readfirstlane(tinfo[1 + u.pm]); u.e0 = code & 0xff; u.e1 = (code >> 8) & 0xff; return true;
    }
    __device__ __forceinline__ const char* a_base(const Gemm& g, const Unit& u) const { return (const char*)g.A + (size_t)u.pm * BM * g.lda * 2; }
    __device__ __forceinline__ const char* b_lo(const Gemm& g, const Unit& u) const {
        if (WHICH == 1) return (const char*)g.Bt + ((size_t)(u.pn < 4 ? u.e0 : u.e1) * 1024 * 1024 + (size_t)(u.pn & 3) * BM * 1024) * 2;
        return (const char*)g.Bt + ((size_t)u.e0 * 1024 * 512 + (size_t)u.pn * BM * 512) * 2;
    }
    __device__ __forceinline__ const char* b_hi(const Gemm& g, const Unit& u) const {
        if (WHICH == 1) return b_lo(g, u);
        return (const char*)g.Bt + ((size_t)u.e1 * 1024 * 512 + (size_t)u.pn * BM * 512) * 2 - (size_t)8 * BK * 2;
    }
};

struct EpiStoreBf16 {
    static constexpr bool PERM = true;
    bf16* O; int ldc;
    __device__ __forceinline__ void operator()(const f32x4 (&acc)[2][2][4][2], const Unit& u, int wr, int wc, int fr, int fq) const {
        const int row0 = u.pm * BM + wr * 64 + fr, col0 = u.pn * BM + wc * 32 + 8 * fq;
#pragma unroll
        for (int ai = 0; ai < 2; ++ai)
#pragma unroll
            for (int m = 0; m < 4; ++m) { bf16* rowp = O + (size_t)(row0 + ai * HALF + m * 16) * ldc + col0;
#pragma unroll
                for (int bj = 0; bj < 2; ++bj) { const f32x4 v0 = acc[ai][bj][m][0], v1 = acc[ai][bj][m][1];
                    u32x4 w; w.x = pk2(v0[0], v0[1]); w.y = pk2(v0[2], v0[3]); w.z = pk2(v1[0], v1[1]); w.w = pk2(v1[2], v1[3]);
                    *(u32x4*)(rowp + bj * HALF) = w; } }
    }
};
struct EpiResid {
    static constexpr bool PERM = false;
    const float* xin; float* out; const float* gate;
    __device__ __forceinline__ void operator()(const f32x4 (&acc)[2][2][4][2], const Unit& u, int wr, int wc, int fr, int fq) const {
        const int col0 = u.pn * BM + wc * 32 + 4 * fq; const int b = (u.pm * BM) >> 13;
        f32x4 gv[2][2];
#pragma unroll
        for (int bj = 0; bj < 2; ++bj)
#pragma unroll
            for (int n = 0; n < 2; ++n) gv[bj][n] = *(const f32x4*)(gate + (size_t)b * 6144 + col0 + bj * HALF + n * 16);
#pragma unroll
        for (int ai = 0; ai < 2; ++ai)
#pragma unroll
            for (int m = 0; m < 4; ++m) { const size_t off = (size_t)(u.pm * BM + ai * HALF + wr * 64 + m * 16 + fr) * DM + col0;
#pragma unroll
                for (int bj = 0; bj < 2; ++bj)
#pragma unroll
                    for (int n = 0; n < 2; ++n) { const f32x4 xv = *(const f32x4*)(xin + off + bj * HALF + n * 16); *(f32x4*)(out + off + bj * HALF + n * 16) = xv + gv[bj][n] * acc[ai][bj][m][n]; } }
    }
};
struct EpiMoe1 {
    static constexpr bool PERM = true;
    bf16* U; const float* gaS; const float* gbS;
    __device__ __forceinline__ void operator()(const f32x4 (&acc)[2][2][4][2], const Unit& u, int wr, int wc, int fr, int fq) const {
        const float* gs = (u.pn < 4) ? gaS : gbS; const int ucol = u.pn * 128 + wc * 32 + 8 * fq;
#pragma unroll
        for (int ai = 0; ai < 2; ++ai)
#pragma unroll
            for (int m = 0; m < 4; ++m) { const int slot = u.pm * BM + ai * HALF + wr * 64 + m * 16 + fr; const float w = gs[slot];
                float r[8];
#pragma unroll
                for (int n = 0; n < 2; ++n)
#pragma unroll
                    for (int i = 0; i < 4; ++i) { const float g = acc[ai][0][m][n][i], up = acc[ai][1][m][n][i]; r[n * 4 + i] = silu_f(g) * up * w; }
                u32x4 o; o.x = pk2(r[0], r[1]); o.y = pk2(r[2], r[3]); o.z = pk2(r[4], r[5]); o.w = pk2(r[6], r[7]);
                *(u32x4*)(U + (size_t)slot * 1024 + ucol) = o; }
    }
};
struct EpiMoe2 {
    static constexpr bool PERM = false;
    float* x; const int* tokS; const float* gate;
    __device__ __forceinline__ void operator()(const f32x4 (&acc)[2][2][4][2], const Unit& u, int wr, int wc, int fr, int fq) const {
        const int col0 = u.pn * BM + wc * 32 + 4 * fq;
#pragma unroll
        for (int ai = 0; ai < 2; ++ai)
#pragma unroll
            for (int m = 0; m < 4; ++m) { const int slot = u.pm * BM + ai * HALF + wr * 64 + m * 16 + fr; const int tok = tokS[slot];
                if (tok >= 0) { const int b = tok >> 13; float* xp = x + (size_t)tok * DM + col0; const float* gp = gate + (size_t)b * 6144 + col0;
#pragma unroll
                    for (int bj = 0; bj < 2; ++bj)
#pragma unroll
                        for (int n = 0; n < 2; ++n) { const f32x4 gv = *(const f32x4*)(gp + bj * HALF + n * 16); const f32x4 xv = *(const f32x4*)(xp + bj * HALF + n * 16);
                            *(f32x4*)(xp + bj * HALF + n * 16) = xv + (DBG_MOE ? 1.f : 0.f) * gv * acc[ai][bj][m][n]; } } }
    }
};

template <class Epi, class Sched, int KSPLIT  >
__device__ __forceinline__ void gemm_phase(LAS unsigned char* lds, const Gemm g, const Sched& S, const Epi& E, const int g_wave) {
    const int tid = otid(), wid = __builtin_amdgcn_readfirstlane(tid >> 6), lane = tid & 63, wr = wid >> 2, wc = wid & 3, fr = lane & 15, fq = lane >> 4;
    const int K = g.K, nt = K / BK;
    unsigned voffA[2], voffB[2];
#pragma unroll
    for (int i = 0; i < 2; ++i) { int R, C; stage_rc(tid * 16 + i * 8192, R, C); const int Rb = Epi::PERM ? ((R & ~31) + perm32(R & 31)) : R;
        voffA[i] = (unsigned)(R * g.lda + C) * 2u; voffB[i] = (unsigned)(Rb * g.ldb + C) * 2u; }
    const size_t kstep = (size_t)(BK * 2);
    const size_t hstepA = (size_t)HALF * g.lda * 2, hstepB = (size_t)HALF * g.ldb * 2;
    const unsigned ldsw = (unsigned)wid * 1024u;
    const int aoff = lds_byte(wr * 64 + fr, fq * 8), boff = lds_byte(wc * 32 + fr, fq * 8);
#define PG8_SA(b, h) (((b) * 2 + (h)) * HTB)
#define PG8_SB(b, h) ((4 + (b) * 2 + (h)) * HTB)
#define PG8_STAGE(bufoff, gbase, voff) do { _Pragma("unroll") for (int _i = 0; _i < 2; ++_i) \
        __builtin_amdgcn_global_load_lds((const unsigned*)((const char*)(gbase) + (voff)[_i]), (LAS unsigned*)(lds + (bufoff) + ldsw + _i * 8192), 16, 0, 0); } while (0)
#define PG8_LDA(dst, b, h) do { _Pragma("unroll") for (int m = 0; m < 4; ++m) _Pragma("unroll") for (int k = 0; k < 2; ++k) dst[m][k] = *(const LAS bf16x8*)(lds + PG8_SA(b, h) + aoff + m * 2048 + k * 1024); } while (0)
#define PG8_LDB(dst, b, h) do { _Pragma("unroll") for (int n = 0; n < 2; ++n) _Pragma("unroll") for (int k = 0; k < 2; ++k) dst[n][k] = *(const LAS bf16x8*)(lds + PG8_SB(b, h) + boff + n * 2048 + k * 1024); } while (0)
#define PG8_MMA(ai, bj, At, Bt) do { __builtin_amdgcn_s_setprio(1); _Pragma("unroll") for (int m = 0; m < 4; ++m) _Pragma("unroll") for (int n = 0; n < 2; ++n) _Pragma("unroll") for (int k = 0; k < 2; ++k) \
        acc[ai][bj][m][n] = __builtin_amdgcn_mfma_f32_16x16x32_bf16(Bt[n][k], At[m][k], acc[ai][bj][m][n], 0, 0, 0); __builtin_amdgcn_s_setprio(0); } while (0)
#define PG8_WAIT_V(n) asm volatile("s_waitcnt vmcnt(" #n ")" ::: "memory")
#define PG8_WAIT_L(n) asm volatile("s_waitcnt lgkmcnt(" #n ")" ::: "memory")
#define PG8_BAR __builtin_amdgcn_s_barrier()
#define PG8_SCHED __builtin_amdgcn_sched_barrier(0)
    Unit cur, nxt; int ui = 0;
    if (!S.next(0, cur)) return;
    f32x4 acc[2][2][4][2];
#pragma unroll
    for (int a = 0; a < 2; ++a)
#pragma unroll
        for (int b = 0; b < 2; ++b)
#pragma unroll
            for (int m = 0; m < 4; ++m)
#pragma unroll
                for (int n = 0; n < 2; ++n) acc[a][b][m][n] = (f32x4){0.f, 0.f, 0.f, 0.f};
    bf16x8 At[4][2], B0[2][2], B1[2][2];
    const char* cA = S.a_base(g, cur); const char* cB = S.b_lo(g, cur); const char* cBh = S.b_hi(g, cur);
    PG8_STAGE(PG8_SB(0, 0), cB, voffB); PG8_STAGE(PG8_SB(0, 1), cB + hstepB, voffB); PG8_STAGE(PG8_SA(0, 0), cA, voffA); PG8_STAGE(PG8_SA(0, 1), cA + hstepA, voffA);
    if (wr == 1) PG8_BAR;
    PG8_WAIT_V(2); PG8_BAR;
    PG8_STAGE(PG8_SB(1, 0), cB + kstep, voffB); PG8_STAGE(PG8_SA(1, 0), cA + kstep, voffA); PG8_STAGE(PG8_SB(1, 1), cB + hstepB + kstep, voffB);
    PG8_WAIT_V(6); PG8_BAR;
    for (;;) {
        const bool has_next = S.next(ui + 1, nxt);
        const char* nA = has_next ? S.a_base(g, nxt) : cA; const char* nB = has_next ? S.b_lo(g, nxt) : cB; const char* nBh = has_next ? S.b_hi(g, nxt) : cBh;
        for (int t = 0; t < nt; t += 2) {
            const bool last = (t == nt - 2);
            const char* a1 = cA + (size_t)(t + 1) * kstep;
            const char* bsel = (KSPLIT != 0 && (t + 2) >= KSPLIT) ? cBh : cB;
            const char* a2 = last ? nA : cA + (size_t)(t + 2) * kstep; const char* b2 = last ? nB : bsel + (size_t)(t + 2) * kstep;
            const char* a3 = a2 + kstep; const char* b3 = b2 + kstep;
            PG8_LDB(B0, 0, 0); PG8_LDB(B1, 0, 1); PG8_SCHED; PG8_LDA(At, 0, 0); PG8_STAGE(PG8_SA(1, 1), a1 + hstepA, voffA);
            PG8_WAIT_V(8); PG8_WAIT_L(0); PG8_BAR; PG8_MMA(0, 0, At, B0); PG8_MMA(0, 1, At, B1); PG8_BAR; PG8_SCHED;
            PG8_LDA(At, 0, 1); PG8_STAGE(PG8_SB(0, 0), b2, voffB); PG8_STAGE(PG8_SB(0, 1), b2 + hstepB, voffB); PG8_STAGE(PG8_SA(0, 0), a2, voffA);
            PG8_WAIT_V(8); PG8_WAIT_L(0); PG8_BAR; PG8_MMA(1, 0, At, B0); PG8_MMA(1, 1, At, B1); PG8_BAR; PG8_SCHED;
            PG8_LDB(B0, 1, 0); PG8_LDB(B1, 1, 1); PG8_SCHED; PG8_LDA(At, 1, 0); PG8_STAGE(PG8_SA(0, 1), a2 + hstepA, voffA);
            PG8_WAIT_V(8); PG8_WAIT_L(0); PG8_BAR; PG8_MMA(0, 0, At, B0); PG8_MMA(0, 1, At, B1); PG8_BAR; PG8_SCHED;
            PG8_LDA(At, 1, 1); PG8_STAGE(PG8_SB(1, 0), b3, voffB); PG8_STAGE(PG8_SB(1, 1), b3 + hstepB, voffB); PG8_STAGE(PG8_SA(1, 0), a3, voffA);
            PG8_WAIT_V(8); PG8_WAIT_L(0); PG8_BAR; PG8_MMA(1, 0, At, B0); PG8_MMA(1, 1, At, B1); PG8_BAR; PG8_SCHED;
        }
        if (wr == 0) PG8_BAR;
        E(acc, cur, wr, wc, fr, fq);
        if (!has_next) break;
#pragma unroll
        for (int a = 0; a < 2; ++a)
#pragma unroll
            for (int b = 0; b < 2; ++b)
#pragma unroll
                for (int m = 0; m < 4; ++m)
#pragma unroll
                    for (int n = 0; n < 2; ++n) acc[a][b][m][n] = (f32x4){0.f, 0.f, 0.f, 0.f};
        cur = nxt; cA = nA; cB = nB; cBh = nBh; ++ui;
        if (wr == 1) PG8_BAR;
    }
    PG8_WAIT_V(0);
    PG8_BAR;
#undef PG8_SA
#undef PG8_SB
#undef PG8_STAGE
#undef PG8_LDA
#undef PG8_LDB
#undef PG8_MMA
#undef PG8_WAIT_V
#undef PG8_WAIT_L
#undef PG8_BAR
#undef PG8_SCHED
}
}

#define XB_TMO      128
#define XB_XCNT(j)  (256  + 64 * (j))
#define XB_XSUB(j)  (1280 + 64 * (j))
#define XB_XGEN(j)  (2304 + 64 * (j))
#define XB_TOP      3328
#define XB_TOPGEN   3392
#define XCD_BAR_WORDS 3456
#define XB_SPIN_CAP (1u << 21)
__device__ __forceinline__ unsigned xb_ld(unsigned* p)              { return __hip_atomic_load(p, __ATOMIC_RELAXED, __HIP_MEMORY_SCOPE_AGENT); }
__device__ __forceinline__ unsigned xb_add(unsigned* p, unsigned v) { return __hip_atomic_fetch_add(p, v, __ATOMIC_RELAXED, __HIP_MEMORY_SCOPE_AGENT); }
__device__ __forceinline__ unsigned xb_xcc_id() { return (unsigned)__builtin_amdgcn_s_getreg((3 << 11) | 20) & 0xFu; }
#define XB_SPIN(cond, bar) do { unsigned _sp = 0; while (cond) { __builtin_amdgcn_s_sleep(1); \
    if ((++_sp & 255u) == 0u) { if (xb_ld(&(bar)[XB_TMO])) break; if (_sp > XB_SPIN_CAP) { atomicAdd(&(bar)[XB_TMO], 1u); break; } } } } while (0)
struct XcdBarrier { unsigned* bar; unsigned x; volatile LAS unsigned* st; };
__device__ __forceinline__ XcdBarrier xcd_barrier_post(unsigned* bar, volatile LAS unsigned* st, bool leader) {
    XcdBarrier b; b.bar = bar; b.x = xb_xcc_id(); b.st = st;
    if (leader) (void)xb_add(&bar[XB_XCNT(b.x)], 1u);
    return b;
}
__device__ __forceinline__ void xcd_barrier_complete(unsigned* bar, unsigned x, unsigned& nloc, unsigned& nx) {
    const unsigned G = gridDim.x * gridDim.y * gridDim.z;
    unsigned sum, cnt, mine, sp = 0u;
    for (;;) {
        sum = 0u; cnt = 0u; mine = 0u;
#pragma unroll
        for (unsigned j = 0; j < 16; ++j) { const unsigned c = xb_ld(&bar[XB_XCNT(j)]); sum += c; cnt += (c > 0u) ? 1u : 0u; mine = (j == x) ? c : mine; }
        if (sum == G) break;
        __builtin_amdgcn_s_sleep(1);
        if ((++sp & 255u) == 0u) { if (xb_ld(&bar[XB_TMO])) break; if (sp > XB_SPIN_CAP) { atomicAdd(&bar[XB_TMO], 1u); break; } }
    }
    nloc = mine > 0u ? mine : 1u; nx = cnt > 0u ? cnt : 1u;
}
__device__ __forceinline__ void xcd_barrier(const XcdBarrier& b, bool leader) {
    asm volatile("s_waitcnt vmcnt(0)" ::: "memory");
    __syncthreads();
    if (leader) {
        unsigned* bar = b.bar;
        __builtin_amdgcn_s_waitcnt(0);
        unsigned nloc = b.st[0], nx = b.st[1];
        if (nloc == 0u) { xcd_barrier_complete(bar, b.x, nloc, nx); b.st[0] = nloc; b.st[1] = nx; }
        const unsigned old = xb_add(&bar[XB_XSUB(b.x)], 1u);
        const unsigned gen = old / nloc;
        if (old + 1u == (gen + 1u) * nloc) {
            __builtin_amdgcn_fence(__ATOMIC_RELEASE, "agent");
            asm volatile("s_waitcnt vmcnt(0)" ::: "memory");
            const unsigned og = xb_add(&bar[XB_TOP], 1u);
            const unsigned tg = og / nx;
            if (og + 1u == (tg + 1u) * nx) xb_add(&bar[XB_TOPGEN], 1u);
            else XB_SPIN(xb_ld(&bar[XB_TOPGEN]) == tg, bar);
            __builtin_amdgcn_fence(__ATOMIC_ACQUIRE, "agent");
            xb_add(&bar[XB_XGEN(b.x)], 1u);
            asm volatile("s_waitcnt vmcnt(0)" ::: "memory");
        } else {
            XB_SPIN(xb_ld(&bar[XB_XGEN(b.x)]) == gen, bar);
            __builtin_amdgcn_fence(__ATOMIC_ACQUIRE, "agent");
            asm volatile("s_waitcnt vmcnt(0)" ::: "memory");
        }
    }
    __syncthreads();
}

__device__ __forceinline__ int tr_row(int kind, int n) {
    if (kind == 0) return n;
    if (kind == 1) return n < 3072 ? n : (n < 3088 ? -1 : n + 112);
    return (n >> 7) * 256 + (n & 127) + (kind == 3 ? 128 : 0);
}
__device__ __forceinline__ void tr_item(const float* W, int K, int N, bf16* WT, int ldt, int kind, LAS unsigned char* scr, int item, int lane) {
    const int nblk = (N + 63) / 64, kb = item / nblk, nb = item % nblk, k0 = 64 * kb, n0 = 64 * nb;
    const int n4 = (lane & 15) * 4; const bool inr = (n0 + n4) < N;
    f32x4 v[16];
#pragma unroll
    for (int i = 0; i < 16; ++i) { const int kk = 4 * i + (lane >> 4); v[i] = inr ? *(const f32x4*)(W + (size_t)(k0 + kk) * N + n0 + n4) : (f32x4){0.f, 0.f, 0.f, 0.f}; }
#pragma unroll
    for (int i = 0; i < 16; ++i) { const int kk = 4 * i + (lane >> 4); const unsigned w0 = pk2(v[i][0], v[i][1]), w1 = pk2(v[i][2], v[i][3]);
        *(LAS unsigned short*)(scr + (n4 + 0) * 132 + kk * 2) = (unsigned short)(w0 & 0xffffu); *(LAS unsigned short*)(scr + (n4 + 1) * 132 + kk * 2) = (unsigned short)(w0 >> 16);
        *(LAS unsigned short*)(scr + (n4 + 2) * 132 + kk * 2) = (unsigned short)(w1 & 0xffffu); *(LAS unsigned short*)(scr + (n4 + 3) * 132 + kk * 2) = (unsigned short)(w1 >> 16); }
    LDS_WAIT(); asm volatile("" ::: "memory");
#pragma unroll
    for (int j = 0; j < 8; ++j) { const int idx = lane + 64 * j, n = idx >> 3, c = idx & 7; const LAS unsigned* sp = (const LAS unsigned*)(scr + n * 132 + c * 16);
        u32x4 o; o.x = sp[0]; o.y = sp[1]; o.z = sp[2]; o.w = sp[3];
        const int gn = n0 + n; const int r = (gn < N) ? tr_row(kind, gn) : -1;
        if (r >= 0) *(u32x4*)(WT + (size_t)r * ldt + k0 + 8 * c) = o; }
    LDS_WAIT(); asm volatile("" ::: "memory");
}

namespace lin {
constexpr int L_QL = 0, L_QU = 9216, L_KL = 18432, L_KU = 27648, L_KLT = 36864, L_VT = 46080, L_AM = 55296, L_ST = 64512, L_OUT = 73728, L_G = 90368, L_GL = 98560, L_END = 98816;
constexpr int NSEG = 16, LSEG = 8;
#define MFMA16(a, b, c) __builtin_amdgcn_mfma_f32_16x16x32_bf16(a, b, c, 0, 0, 0)
__device__ __forceinline__ bf16x8 frag(const LAS unsigned char* base, int pitchB, int r0, int ks, int lane) {
    return *(const LAS bf16x8*)(base + (r0 + (lane & 15)) * pitchB + (32 * ks + 8 * (lane >> 4)) * 2);
}
typedef short v4i16_t __attribute__((ext_vector_type(4)));
__device__ __forceinline__ bf16x8 trfrag(const LAS unsigned char* base, int pitchB, int k0, int n0, int lane) {
    const LAS unsigned char* p = base + (k0 + 8 * (lane >> 4) + ((lane & 15) >> 2)) * pitchB + (n0 + 4 * (lane & 3)) * 2;
    const s16x4 lo = __builtin_bit_cast(s16x4, __builtin_amdgcn_ds_read_tr16_b64_v4i16((LAS v4i16_t*)p));
    const s16x4 hi = __builtin_bit_cast(s16x4, __builtin_amdgcn_ds_read_tr16_b64_v4i16((LAS v4i16_t*)(p + 4 * pitchB)));
    return (bf16x8){lo[0], lo[1], lo[2], lo[3], hi[0], hi[1], hi[2], hi[3]};
}
template <int DK, bool RET, bool PH2>
__device__ __forceinline__ void unit(LAS unsigned char* lds, const bf16* P, bf16* MIX, const f32x2* csr, int b, int h, int seg,
                                     const float* b_a, const float* gnorm, float* Est, float* Aseg, const int g_wave) {
    constexpr int PQ = (DK + 8) * 2;
    constexpr int PS = 144;
    constexpr int NT = DK / 32;
    const int tid = otid(), lane = tid & 63, wid = __builtin_amdgcn_readfirstlane(tid >> 6);
    const int row = tid >> 3, c8 = tid & 7;
    const int entry = (b * 4 + h) * NSEG + seg;
    const float lng = RET ? __logf(1.0f - exp2f(-5.0f - (float)h)) : 0.f;
    const int cq = RET ? C_RQ + h * 64 : C_GQ + h * 32, ck = RET ? C_RK + h * 64 : C_GK + h * 32, cv = RET ? C_RV + h * 64 : C_GV + h * 64, cg = RET ? C_RG + h * 64 : C_GR + h * 64;
    f32x4 st[NT]; float ac[NT];
    int eb[NT], db[NT];
#pragma unroll
    for (int j = 0; j < NT; ++j) { const int i = wid + 8 * j; if (DK == 64) { eb[j] = i >> 2; db[j] = i & 3; } else { eb[j] = i >> 1; db[j] = i & 1; } st[j] = (f32x4){0.f, 0.f, 0.f, 0.f}; ac[j] = 1.f; }
    if (PH2) {
#pragma unroll 4
        for (int sp = 0; sp < seg; ++sp) { const int en = (b * 4 + h) * NSEG + sp;
#pragma unroll
            for (int j = 0; j < NT; ++j) { const int d = db[j] * 16 + (lane & 15); const float a = Aseg[(size_t)en * DK + d];
#pragma unroll
                for (int r = 0; r < 4; ++r) { const int e = eb[j] * 16 + 4 * (lane >> 4) + r; st[j][r] = a * st[j][r] + Est[((size_t)en * 64 + e) * DK + d]; } } }
    }
    float gn8[8] = {0.f, 0.f, 0.f, 0.f, 0.f, 0.f, 0.f, 0.f}, ba4[4] = {0.f, 0.f, 0.f, 0.f};
    if (PH2) {
#pragma unroll
        for (int i = 0; i < 8; ++i) gn8[i] = gnorm[8 * c8 + i]; }
    if (!RET) {
#pragma unroll
        for (int i = 0; i < 4; ++i) ba4[i] = b_a[h * 32 + 4 * wid + i]; }
    u32x4 rq_ = (u32x4){0u, 0u, 0u, 0u}, rk_ = rq_, rq2_ = rq_, rk2_ = rq_, pv = rq_, pgt = rq_; f32x4 pcs[4]; u32x2 pla = (u32x2){0u, 0u};
#pragma unroll
    for (int i = 0; i < 4; ++i) pcs[i] = (f32x4){0.f, 0.f, 0.f, 0.f};
    const int d0 = 8 * c8; const bool qk_on = RET || c8 < 4;
#define LIN_LOAD(cc) do { const size_t mr_ = (size_t)b * SEQ + (size_t)(seg * LSEG + (cc)) * 64 + row; \
        if (!RET) pla = *(const u32x2*)(P + ((size_t)b * SEQ + (size_t)(seg * LSEG + (cc)) * 64 + lane) * NP + C_LA + h * 32 + 4 * wid); \
        if (qk_on) { rk_ = *(const u32x4*)(P + mr_ * NP + ck + d0); if (PH2) rq_ = *(const u32x4*)(P + mr_ * NP + cq + d0); \
            if (RET) { rk2_ = *(const u32x4*)(P + mr_ * NP + ck + (d0 ^ 32)); if (PH2) rq2_ = *(const u32x4*)(P + mr_ * NP + cq + (d0 ^ 32)); \
                const f32x4* cs4_ = (const f32x4*)(csr + mr_ * 32 + (d0 & 31)); pcs[0] = cs4_[0]; pcs[1] = cs4_[1]; pcs[2] = cs4_[2]; pcs[3] = cs4_[3]; } } \
        pv = *(const u32x4*)(P + mr_ * NP + cv + 8 * c8); if (PH2) pgt = *(const u32x4*)(P + mr_ * NP + cg + 8 * c8); } while (0)
    LIN_LOAD(0);
    for (int c = 0; c < LSEG; ++c) {
        const size_t m0 = (size_t)b * SEQ + (size_t)(seg * LSEG + c) * 64;
        if (!RET) {
            const u32x2 w = pla;
            float x[4] = {bflo(w.x), bfhi(w.x), bflo(w.y), bfhi(w.y)};
#pragma unroll
            for (int i = 0; i < 4; ++i) { const float z = x[i] + ba4[i]; float v = (fminf(z, 0.f) - log1pf(__expf(-fabsf(z)))) * (1.0f / 16.0f);
#pragma unroll
                for (int o = 1; o < 64; o <<= 1) { const float u = __int_as_float(__builtin_amdgcn_ds_bpermute((lane - o) << 2, __float_as_int(v))); if (lane >= o) v += u; }
                ((LAS float*)(lds + L_G))[lane * 32 + 4 * wid + i] = v; if (lane == 63) ((LAS float*)(lds + L_GL))[4 * wid + i] = v; }
            __syncthreads();
        }
        u32x4 gcur = pgt;
        {
            if (qk_on) {
                const u32x4 kw = rk_, qw = rq_;
                float qv[8], kv[8], eg[8], ieg[8];
                { const unsigned* qp = (const unsigned*)&qw; const unsigned* kp = (const unsigned*)&kw;
#pragma unroll
                  for (int i = 0; i < 4; ++i) { qv[2 * i] = bflo(qp[i]); qv[2 * i + 1] = bfhi(qp[i]); kv[2 * i] = bflo(kp[i]); kv[2 * i + 1] = bfhi(kp[i]); } }
                if (RET) {
                    const u32x4 kw2 = rk2_, qw2 = rq2_;
                    const unsigned* qp2 = (const unsigned*)&qw2; const unsigned* kp2 = (const unsigned*)&kw2;
                    const float g = (float)(row + 1) * lng; const float e1 = __expf(g), e2 = __expf(-g);
#pragma unroll
                    for (int i = 0; i < 4; ++i) { const f32x4 cc = pcs[i];
                        const float qa = bflo(qp2[i]), qb = bfhi(qp2[i]), ka = bflo(kp2[i]), kb = bfhi(kp2[i]);
                        if (c8 < 4) { const float q0 = qv[2 * i] * cc[0] - qa * cc[1], q1 = qv[2 * i + 1] * cc[2] - qb * cc[3]; const float k0 = kv[2 * i] * cc[0] - ka * cc[1], k1 = kv[2 * i + 1] * cc[2] - kb * cc[3];
                            qv[2 * i] = q0; qv[2 * i + 1] = q1; kv[2 * i] = k0; kv[2 * i + 1] = k1; }
                        else { const float q0 = qa * cc[1] + qv[2 * i] * cc[0], q1 = qb * cc[3] + qv[2 * i + 1] * cc[2]; const float k0 = ka * cc[1] + kv[2 * i] * cc[0], k1 = kb * cc[3] + kv[2 * i + 1] * cc[2];
                            qv[2 * i] = q0; qv[2 * i + 1] = q1; kv[2 * i] = k0; kv[2 * i + 1] = k1; } }
#pragma unroll
                    for (int i = 0; i < 8; ++i) { kv[i] *= 0.125f; eg[i] = e1; ieg[i] = e2; }
                } else {
#pragma unroll
                    for (int i = 0; i < 8; ++i) { const float g = ((const LAS float*)(lds + L_G))[row * 32 + d0 + i]; eg[i] = __expf(g); ieg[i] = __expf(-g); qv[i] *= 0.17677669529663687f; }
                }
                float kl[8];
#pragma unroll
                for (int i = 0; i < 8; ++i) kl[i] = kv[i] * ieg[i];
                if (PH2) {
                    u32x4 o;
                    o.x = pk2(qv[0] * eg[0], qv[1] * eg[1]); o.y = pk2(qv[2] * eg[2], qv[3] * eg[3]); o.z = pk2(qv[4] * eg[4], qv[5] * eg[5]); o.w = pk2(qv[6] * eg[6], qv[7] * eg[7]);
                    *(LAS u32x4*)(lds + L_QL + row * PQ + d0 * 2) = o;
                    o.x = pk2(qv[0] * ieg[0], qv[1] * ieg[1]); o.y = pk2(qv[2] * ieg[2], qv[3] * ieg[3]); o.z = pk2(qv[4] * ieg[4], qv[5] * ieg[5]); o.w = pk2(qv[6] * ieg[6], qv[7] * ieg[7]);
                    *(LAS u32x4*)(lds + L_QU + row * PQ + d0 * 2) = o;
                    o.x = pk2(kv[0] * eg[0], kv[1] * eg[1]); o.y = pk2(kv[2] * eg[2], kv[3] * eg[3]); o.z = pk2(kv[4] * eg[4], kv[5] * eg[5]); o.w = pk2(kv[6] * eg[6], kv[7] * eg[7]);
                    *(LAS u32x4*)(lds + L_KU + row * PQ + d0 * 2) = o;
                }
                { u32x4 o; o.x = pk2(kl[0], kl[1]); o.y = pk2(kl[2], kl[3]); o.z = pk2(kl[4], kl[5]); o.w = pk2(kl[6], kl[7]);
                  *(LAS u32x4*)(lds + L_KL + row * PQ + d0 * 2) = o; }
            }
            *(LAS u32x4*)(lds + L_VT + row * PS + c8 * 16) = pv;
        }
        if (c + 1 < LSEG) LIN_LOAD(c + 1);
        __syncthreads();
#pragma unroll
        for (int j = 0; j < NT; ++j) {
            const int d = db[j] * 16 + (lane & 15);
            if (PH2) {
#pragma unroll
                for (int r = 0; r < 4; ++r) { const int e = eb[j] * 16 + 4 * (lane >> 4) + r; *(LAS unsigned short*)(lds + L_ST + e * PQ + d * 2) = (unsigned short)(pk2(st[j][r], 0.f) & 0xffffu); }
            }
            f32x4 u = (f32x4){0.f, 0.f, 0.f, 0.f};
#pragma unroll
            for (int ks = 0; ks < 2; ++ks) u = MFMA16(trfrag(lds + L_VT, PS, 32 * ks, eb[j] * 16, lane), trfrag(lds + L_KL, PQ, 32 * ks, db[j] * 16, lane), u);
            const float egl = RET ? __expf(64.f * lng) : __expf(((const LAS float*)(lds + L_GL))[d]);
#pragma unroll
            for (int r = 0; r < 4; ++r) st[j][r] = egl * (st[j][r] + u[r]);
            ac[j] *= egl;
        }
        if (PH2) {
#pragma unroll
            for (int j = 0; j < 2; ++j) { const int i = wid + 8 * j, tb = i >> 2, sb = i & 3;
                f32x4 lo = (f32x4){0.f, 0.f, 0.f, 0.f}, up = (f32x4){0.f, 0.f, 0.f, 0.f};
                if (sb <= tb) {
#pragma unroll
                    for (int ks = 0; ks < DK / 32; ++ks) lo = MFMA16(frag(lds + L_QL, PQ, tb * 16, ks, lane), frag(lds + L_KL, PQ, sb * 16, ks, lane), lo); }
                if (sb >= tb) {
#pragma unroll
                    for (int ks = 0; ks < DK / 32; ++ks) up = MFMA16(frag(lds + L_QU, PQ, tb * 16, ks, lane), frag(lds + L_KU, PQ, sb * 16, ks, lane), up); }
                const int s = sb * 16 + (lane & 15);
#pragma unroll
                for (int r = 0; r < 4; ++r) { const int t = tb * 16 + 4 * (lane >> 4) + r; const float v = (s <= t) ? lo[r] : up[r];
                    *(LAS unsigned short*)(lds + L_AM + t * PS + s * 2) = (unsigned short)(pk2(v, 0.f) & 0xffffu); } }
        }
        __syncthreads();
        if (PH2) {
#pragma unroll
            for (int j = 0; j < 2; ++j) { const int i = wid + 8 * j, tb = i >> 2, ob = i & 3;
                f32x4 o = (f32x4){0.f, 0.f, 0.f, 0.f};
#pragma unroll
                for (int ks = 0; ks < 2; ++ks) o = MFMA16(frag(lds + L_AM, PS, tb * 16, ks, lane), trfrag(lds + L_VT, PS, 32 * ks, ob * 16, lane), o);
#pragma unroll
                for (int ks = 0; ks < DK / 32; ++ks) o = MFMA16(frag(lds + L_QL, PQ, tb * 16, ks, lane), frag(lds + L_ST, PQ, ob * 16, ks, lane), o);
#pragma unroll
                for (int r = 0; r < 4; ++r) ((LAS float*)(lds + L_OUT))[(tb * 16 + 4 * (lane >> 4) + r) * 65 + ob * 16 + (lane & 15)] = o[r]; }
            __syncthreads();
            { const size_t m = m0 + row; const int e0 = 8 * c8; float v[8]; float ss = 0.f;
#pragma unroll
              for (int i = 0; i < 8; ++i) { v[i] = ((const LAS float*)(lds + L_OUT))[row * 65 + e0 + i]; ss += v[i] * v[i]; }
              ss += sx<1>(ss); ss += sx<2>(ss); ss += sx<4>(ss);
              const float rstd = rsqrtf(ss * (1.0f / 64.0f) + EPS);
              const u32x4 gw = gcur; const unsigned* gp = (const unsigned*)&gw; float y[8];
#pragma unroll
              for (int i = 0; i < 4; ++i) { y[2 * i] = v[2 * i] * rstd * gn8[2 * i] * silu_f(bflo(gp[i])); y[2 * i + 1] = v[2 * i + 1] * rstd * gn8[2 * i + 1] * silu_f(bfhi(gp[i])); }
              const bool on = RET ? ((DBG_GROUPS & 1) != 0) : ((DBG_GROUPS & 4) != 0);
              u32x4 o; o.x = pk2(y[0], y[1]); o.y = pk2(y[2], y[3]); o.z = pk2(y[4], y[5]); o.w = pk2(y[6], y[7]); if (!on) o = (u32x4){0u, 0u, 0u, 0u};
              *(u32x4*)(MIX + m * DM + (RET ? 0 : 768) + h * 64 + e0) = o; }
        }
    }
#undef LIN_LOAD
    if (!PH2) {
#pragma unroll
        for (int j = 0; j < NT; ++j) { const int d = db[j] * 16 + (lane & 15);
#pragma unroll
            for (int r = 0; r < 4; ++r) { const int e = eb[j] * 16 + 4 * (lane >> 4) + r; Est[((size_t)entry * 64 + e) * DK + d] = st[j][r]; }
            if (eb[j] == 0 && (lane >> 4) == 0) Aseg[(size_t)entry * DK + d] = ac[j]; }
    }
    __syncthreads();
}
}

namespace att {
constexpr int A_K = 0, A_V = 16384, A_O0 = 49152, A_LS = 114688, A_END = 116736;
#define MFMA32(a, b, c) __builtin_amdgcn_mfma_f32_32x32x16_bf16(a, b, c, 0, 0, 0)
typedef short v4i16_t __attribute__((ext_vector_type(4)));
__device__ __forceinline__ s16x4 vtr(const LAS unsigned char* p) { return __builtin_bit_cast(s16x4, __builtin_amdgcn_ds_read_tr16_b64_v4i16((LAS v4i16_t*)p)); }
__device__ __forceinline__ int crow(int r, int hi) { return (r & 3) + 8 * (r >> 2) + 4 * hi; }
__device__ __forceinline__ void unit(LAS unsigned char* lds, const bf16* P, bf16* MIX, int b, int h, int jq, float lam, float negM, const float* subg, float oscale, const int g_wave) {
    const int tid = otid(), lane = tid & 63, r32 = lane & 31, hh = lane >> 5, wid = __builtin_amdgcn_readfirstlane(tid >> 6);
    const size_t rowbase = (size_t)b * SEQ;
    const int q0 = jq * 256 + wid * 32;
    const int ntile = 4 * jq + 4, my_nt = 4 * jq + (wid >> 1) + 1;
    const int krow = tid >> 3, kch = (tid & 7) ^ ((krow >> 1) & 7);
    const int vrow = (tid >> 2) & 63, vcol = (tid >> 8) * 32 + (tid & 3) * 8;
    const unsigned ldsw = (unsigned)wid * 1024u;
    const int q4 = (lane & 15) >> 2, p4 = lane & 3, gsel = (lane >> 4) & 1;
    const unsigned vrd = (unsigned)((4 * hh + q4) * 64 + gsel * 32 + p4 * 8);
#pragma unroll 1
    for (int comp = 0; comp < 2; ++comp) {
        bf16x8 qf[4];
        const char* Pb = (const char*)(P + rowbase * NP + h * 128);
        { const unsigned qo = (unsigned)(((q0 + r32) * NP + C_DQ + comp * 64 + hh * 8) * 2);
#pragma unroll
          for (int ks = 0; ks < 4; ++ks) qf[ks] = *(const bf16x8*)(Pb + qo + 32 * ks); }
        const unsigned kgo = (unsigned)((krow * NP + C_DK + comp * 64 + kch * 8) * 2), vgo = (unsigned)((vrow * NP + C_DV + vcol) * 2);
        f32x16 o[4];
#pragma unroll
        for (int e = 0; e < 4; ++e)
#pragma unroll
            for (int r = 0; r < 16; ++r) o[e][r] = 0.f;
        float l = 0.f;
#define ATT_STAGE(buf, tt) do { const char* Pt = Pb + (size_t)(tt) * 64 * NP * 2; \
            __builtin_amdgcn_global_load_lds((const unsigned*)(Pt + kgo), (LAS unsigned*)(lds + A_K + (buf) * 8192 + ldsw), 16, 0, 0); \
            __builtin_amdgcn_global_load_lds((const unsigned*)(Pt + vgo), (LAS unsigned*)(lds + A_V + (buf) * 16384 + ldsw), 16, 0, 0); \
            __builtin_amdgcn_global_load_lds((const unsigned*)(Pt + vgo + 128), (LAS unsigned*)(lds + A_V + (buf) * 16384 + 8192 + ldsw), 16, 0, 0); } while (0)
        ATT_STAGE(0, 0);
        VM_WAIT(); __syncthreads();
        for (int t = 0; t < ntile; ++t) {
            const int cur = t & 1;
            if (t + 1 < ntile) ATT_STAGE(cur ^ 1, t + 1);
            if (t < my_nt) {
                const LAS unsigned char* Kb = lds + A_K + cur * 8192; const LAS unsigned char* Vb = lds + A_V + cur * 16384;
                bf16x8 pa[4];
#pragma unroll
                for (int kb = 0; kb < 2; ++kb) {
                    f32x16 s0;
#pragma unroll
                    for (int r = 0; r < 16; ++r) s0[r] = negM;
#pragma unroll
                    for (int ks = 0; ks < 4; ++ks) { const int cc = 2 * ks + hh; const unsigned ko = (unsigned)(r32 * 128 + ((cc ^ ((r32 >> 1) & 7)) << 4));
                        const bf16x8 a0 = *(const LAS bf16x8*)(Kb + ko + kb * 4096);
                        s0 = MFMA32(a0, qf[ks], s0); }
#pragma unroll
                    for (int r = 0; r < 16; ++r) { s0[r] = __builtin_amdgcn_exp2f(s0[r]); l += s0[r]; }
                    u32x4 w;
                    w.x = pk2(s0[0], s0[1]); w.y = pk2(s0[2], s0[3]); w.z = pk2(s0[4], s0[5]); w.w = pk2(s0[6], s0[7]); pa[2 * kb] = __builtin_bit_cast(bf16x8, w);
                    w.x = pk2(s0[8], s0[9]); w.y = pk2(s0[10], s0[11]); w.z = pk2(s0[12], s0[13]); w.w = pk2(s0[14], s0[15]); pa[2 * kb + 1] = __builtin_bit_cast(bf16x8, w);
                    __builtin_amdgcn_sched_barrier(0);
                }
#pragma unroll
                for (int e = 0; e < 4; ++e) {
#pragma unroll
                    for (int kk = 0; kk < 4; ++kk) { const s16x4 lo = vtr(Vb + e * 4096 + kk * 1024 + vrd), hi = vtr(Vb + e * 4096 + kk * 1024 + 512 + vrd);
                        const bf16x8 vf = (bf16x8){lo[0], lo[1], lo[2], lo[3], hi[0], hi[1], hi[2], hi[3]};
                        o[e] = MFMA32(pa[kk], vf, o[e]); }
                    __builtin_amdgcn_sched_barrier(0); }
            }
            VM_WAIT(); __syncthreads();
        }
#undef ATT_STAGE
        l = sum_halves(l);
        LAS float* ls = (LAS float*)(lds + A_LS) + wid * 64 + comp * 32;
        if (hh == 0) ls[r32] = l;
        LDS_WAIT(); asm volatile("" ::: "memory");
        float inv[16];
#pragma unroll
        for (int r = 0; r < 16; ++r) inv[r] = 1.0f / ls[crow(r, hh)];
        LAS unsigned* o0 = (LAS unsigned*)(lds + A_O0) + wid * 2048 + lane;
        if (comp == 0) {
#pragma unroll
            for (int e = 0; e < 4; ++e)
#pragma unroll
                for (int i = 0; i < 8; ++i) o0[(e * 8 + i) * 64] = pk2(o[e][2 * i] * inv[2 * i], o[e][2 * i + 1] * inv[2 * i + 1]);
        } else {
            float ss[16];
#pragma unroll
            for (int r = 0; r < 16; ++r) ss[r] = 0.f;
#pragma unroll
            for (int e = 0; e < 4; ++e)
#pragma unroll
                for (int i = 0; i < 8; ++i) { const unsigned w = o0[(e * 8 + i) * 64];
                    const float v0 = bflo(w) - lam * o[e][2 * i] * inv[2 * i], v1 = bfhi(w) - lam * o[e][2 * i + 1] * inv[2 * i + 1];
                    o[e][2 * i] = v0; o[e][2 * i + 1] = v1; ss[2 * i] += v0 * v0; ss[2 * i + 1] += v1 * v1; }
#pragma unroll
            for (int r = 0; r < 16; ++r) { float s = ss[r]; s += sx<1>(s); s += sx<2>(s); s += sx<4>(s); s += sx<8>(s); s += sx<16>(s);
                ss[r] = rsqrtf(s * (1.0f / 128.0f) + EPS) * oscale; }
            LAS unsigned char* stg = lds + A_O0 + wid * 8192;
            const int lane_e = olane(), r32e = lane_e & 31;
            LDS_WAIT(); asm volatile("" ::: "memory");
#pragma unroll
            for (int e = 0; e < 4; ++e) { const float gsub = subg[32 * e + r32e];
#pragma unroll
                for (int r = 0; r < 16; ++r) { const float y = ((DBG_GROUPS & 2) != 0) ? o[e][r] * ss[r] * gsub : 0.f;
                    *(LAS unsigned short*)(stg + crow(r, hh) * 256 + (32 * e + r32) * 2) = (unsigned short)(pk2(y, 0.f) & 0xffffu); } }
            LDS_WAIT(); asm volatile("" ::: "memory");
            { unsigned ob = (unsigned)(((q0 + (lane_e >> 4)) * DM + 256 + (lane_e & 15) * 8) * 2); char* Mb = (char*)(MIX + rowbase * DM + h * 128);
#pragma unroll
              for (int i = 0; i < 8; ++i) { const u32x4 w = *(const LAS u32x4*)(stg + ((lane_e >> 4) + 4 * i) * 256 + (lane_e & 15) * 16); *(u32x4*)(Mb + ob + i * 4 * DM * 2) = w; } }
            LDS_WAIT(); asm volatile("" ::: "memory");
        }
    }
}
}

struct Args { const float* in[25]; float* out; unsigned char* ws; int ph_lo, ph_hi; };
static_assert(sizeof(Args) == 27 * 8 + 8, "Args has no padding");
constexpr int NPHASE = 1 + 9 * DEPTH;

__global__ void __launch_bounds__(NWAVES * 64, 2) fwd(Args args) {
    extern __shared__ __attribute__((aligned(16))) unsigned char lds_raw[];
    LAS unsigned char* lds = (LAS unsigned char*)lds_raw;
    const int wave = __builtin_amdgcn_readfirstlane((int)threadIdx.x >> 6); const int g_wave = wave; const int tid0 = otid();
    const int G = gridDim.x; const int bx = blockIdx.x; const int vcu = (G % 8 == 0) ? (bx % 8) * (G / 8) + bx / 8 : bx;
    const int gw = vcu * NWAVES + wave, NGW = G * NWAVES;
    __builtin_assume(gw >= 0 && gw < 4096 && vcu >= 0 && vcu < 512 && G > 0 && G <= 512);
    unsigned char* ws = args.ws;
    unsigned* ctl = (unsigned*)(ws + WS_CTL);
    for (int u = tid0; u < (LDS_BYTES - LDSCTL_OFF) / 4; u += NWAVES * 64) ((LAS unsigned*)(lds + LDSCTL_OFF))[u] = 0u;
    __syncthreads();
    XcdBarrier bar; bar.bar = ctl + CW_BAR; bar.x = 0; bar.st = nullptr;
    if (MK_N_LAUNCHES == 1) bar = xcd_barrier_post(ctl + CW_BAR, (volatile LAS unsigned*)(lds + MISC_OFF) + 8, tid0 == 0);
    const int lo = args.ph_lo, hi = args.ph_hi;
#ifndef PHMASK
#define PHMASK 0x3ff
#endif
#define IN(k) (lo <= (k) && (k) < hi)
#define PHON(j) ((PHMASK >> (j)) & 1)
#define SEAM(k) do { if (IN(k) && IN((k) + 1)) xcd_barrier(bar, otid() == 0); } while (0)
    if (tid0 == 0) {
#pragma unroll
        for (int k = 0; k < 25; ++k) ((LAS unsigned long long*)(lds + PTR_OFF))[k] = (unsigned long long)args.in[k];
    }
    __syncthreads();
    float* xout = args.out;
#define WSP(Tp, off) ((Tp*)(wsl + (off)))
#define WSL() unsigned char* wsl = ws; asm volatile("" : "+s"(wsl))

    if (PHON(0) && IN(0)) {
        const int tid = otid(), lane = tid & 63; WSL();
        const float* c_in = INF(1); const int* pos_in = (const int*)INF(2); const float* w_mod = INF(3); const float* b_mod = INF(4); const float* w_in = INF(7);
        const float* diff_q_g = INF(9); const float* diff_k_g = INF(10); const float* lam_q1 = INF(11); const float* lam_k1 = INF(12); const float* lam_q2 = INF(13); const float* lam_k2 = INF(14);
        const float* gla_w_a2 = INF(16); const float* w_out = INF(19); const float* w_gate = INF(22); const float* w_up = INF(23); const float* w_down = INF(24);
        float* mod = WSP(float, WS_MOD); float* scal = WSP(float, WS_SCAL); f32x2* csr = WSP(f32x2, WS_CSR); f32x2* csd = WSP(f32x2, WS_CSD);
        bf16* Win_t = WSP(bf16, WS_WIN); bf16* Wout_t = WSP(bf16, WS_WOUT); bf16* W1 = WSP(bf16, WS_W1); bf16* W2 = WSP(bf16, WS_W2);
        LAS unsigned char* scr = lds + wave * 8704;
        LAS float* sact = (LAS float*)(lds + 69632);
        for (int i = tid; i < 8 * 1024; i += NWAVES * 64) sact[i] = silu_f(c_in[i]);
        __syncthreads();
        constexpr int I_MOD = 2 * 384, I_TABR = 1024, I_TABD = 1024, I_LA = 256, I_ZERO = 256, I_SC = 2;
        constexpr int I_WIN = 16 * 53, I_WOUT = 16 * 16, I_GU = 16 * 8, I_DN = 8 * 16, I_LAYER = I_WIN + I_WOUT + 32 * (2 * I_GU + I_DN);
        constexpr int I_PRE = I_MOD + I_TABR + I_TABD + I_LA + I_ZERO + I_SC, NITEMS = I_PRE + 2 * I_LAYER;
        _Pragma("unroll 1") for (int rep_ = 0; rep_ < 1 + (RPT_PHASE == 100 ? RPT_N : 0); ++rep_)
        for (int it = gw; it < NITEMS; it += NGW) {
            int r = it;
            if (r < I_MOD) {
                const int l = r / 384, col = (r % 384) * 16 + (lane & 15), ks = lane >> 4;
                float acc[8] = {0.f, 0.f, 0.f, 0.f, 0.f, 0.f, 0.f, 0.f};
                const float* wp = w_mod + (size_t)l * 1024 * 6144 + col;
#pragma unroll 16
                for (int k = ks; k < 1024; k += 4) { const float w = wp[(size_t)k * 6144];
#pragma unroll
                    for (int b = 0; b < 8; ++b) acc[b] += sact[b * 1024 + k] * w; }
#pragma unroll
                for (int b = 0; b < 8; ++b) { float a = acc[b]; a += sx<16>(a); a = sum_halves(a); if (ks == 0) mod[((size_t)l * 8 + b) * 6144 + col] = a + b_mod[l * 6144 + col]; }
                continue; }
            r -= I_MOD;
            if (r < I_TABR) {
                const int i = lane & 31; const float inv_freq = exp2f(-((float)i * (1.0f / 32.0f)) * 13.287712379549449f);
                for (int s = 0; s < 32; ++s) { const int t = r * 64 + 2 * s + (lane >> 5); const float ang = (float)pos_in[t] * inv_freq; float sn, cs; sincosf(ang, &sn, &cs); csr[(size_t)t * 32 + i] = (f32x2){cs, sn}; }
                continue; }
            r -= I_TABR;
            if (r < I_TABD) {
                const int i = lane & 7; const float inv_freq = exp2f(-((float)i * (1.0f / 8.0f)) * 18.931568569324174f);
                for (int s = 0; s < 8; ++s) { const int t = r * 64 + 8 * s + (lane >> 3); const float ang = (float)pos_in[t] * inv_freq; float sn, cs; sincosf(ang, &sn, &cs); csd[(size_t)t * 8 + i] = (f32x2){cs, sn}; }
                continue; }
            r -= I_TABD;
            if (r < I_LA) {
                const int l = r >> 7, j = r & 127; float a2[16];
#pragma unroll
                for (int q = 0; q < 16; ++q) a2[q] = gla_w_a2[((size_t)l * 16 + q) * 128 + j];
                for (int i = 0; i < 16; ++i) { const int k = lane + 64 * i; const f32x4* wp = (const f32x4*)(w_in + ((size_t)l * 1024 + k) * IN_W + 3072); float s = 0.f;
#pragma unroll
                    for (int q = 0; q < 4; ++q) { const f32x4 w = wp[q]; s += w[0] * a2[4 * q] + w[1] * a2[4 * q + 1] + w[2] * a2[4 * q + 2] + w[3] * a2[4 * q + 3]; }
                    Win_t[((size_t)l * NP + C_LA + j) * 1024 + k] = (bf16)(pk2(s, 0.f) & 0xffffu); }
                continue; }
            r -= I_LA;
            if (r < I_ZERO) {
                const int l = r >> 7, j = r & 127; u32x4* p = (u32x4*)(Win_t + ((size_t)l * NP + C_PAD + j) * 1024);
                p[lane] = (u32x4){0u, 0u, 0u, 0u}; p[lane + 64] = (u32x4){0u, 0u, 0u, 0u};
                continue; }
            r -= I_ZERO;
            if (r < I_SC) {
                const int l = r; const float s1 = wave_sum(lam_q1[l * 64 + lane] * lam_k1[l * 64 + lane]), s2 = wave_sum(lam_q2[l * 64 + lane] * lam_k2[l * 64 + lane]);
                const float mq = wave_max(fabsf(diff_q_g[l * 64 + lane])), mk = wave_max(fabsf(diff_k_g[l * 64 + lane]));
                const float lam_init = 0.8f - 0.6f * expf(-0.3f * (float)l);
                if (lane == 0) { scal[l * 4 + 0] = expf(s1) - expf(s2) + lam_init; scal[l * 4 + 1] = -(8.0f * mq * mk * LOG2E + 0.5f); scal[l * 4 + 2] = 1.0f - lam_init; }
                continue; }
            r -= I_SC;
            const int l = r / I_LAYER; r -= l * I_LAYER;
            if (r < I_WIN) { tr_item(w_in + (size_t)l * 1024 * IN_W, 1024, IN_W, Win_t + (size_t)l * NP * 1024, 1024, 1, scr, r, lane); continue; } r -= I_WIN;
            if (r < I_WOUT) { tr_item(w_out + (size_t)l * 1024 * 1024, 1024, 1024, Wout_t + (size_t)l * 1024 * 1024, 1024, 0, scr, r, lane); continue; } r -= I_WOUT;
            const int e = r / (2 * I_GU + I_DN); r -= e * (2 * I_GU + I_DN); const size_t le = (size_t)l * 32 + e;
            if (r < I_GU) { tr_item(w_gate + le * 1024 * 512, 1024, 512, W1 + le * 1024 * 1024, 1024, 2, scr, r, lane); continue; } r -= I_GU;
            if (r < I_GU) { tr_item(w_up + le * 1024 * 512, 1024, 512, W1 + le * 1024 * 1024, 1024, 3, scr, r, lane); continue; } r -= I_GU;
            tr_item(w_down + le * 512 * 1024, 512, 1024, W2 + le * 1024 * 512, 512, 0, scr, r, lane);
        }
        __syncthreads();
    }
    SEAM(0);

    for (int l = 0; l < DEPTH; ++l) {
        const int pb = 1 + 9 * l;
#define XIN ((l == 0) ? INF(0) : (const float*)xout)
#define MODL (WSP(const float, WS_MOD) + (size_t)l * 8 * 6144)
        if (PHON(1) && IN(pb + 0)) {
            const int tid = otid(), lane = tid & 63; (void)tid; (void)lane; WSL();
            const float* xin = XIN; const float* modl = MODL; const float* norm1_g = INF(5); bf16* ACT = WSP(bf16, WS_ACT);
            const float* g1 = norm1_g + l * 1024;
            _Pragma("unroll 1") for (int rep_ = 0; rep_ < 1 + (RPT_PHASE == 1 ? RPT_N : 0); ++rep_)
            for (int m0 = gw; m0 < T; m0 += 4 * NGW) {
                f32x4 v[4][4];
#pragma unroll
                for (int q = 0; q < 4; ++q) { const int mq = m0 + q * NGW, m = mq < T ? mq : T - 1; const f32x4* xr = (const f32x4*)(xin + (size_t)m * DM) + lane;
#pragma unroll
                    for (int j = 0; j < 4; ++j) v[q][j] = xr[64 * j]; }
#pragma unroll
                for (int q = 0; q < 4; ++q) { const int m = m0 + q * NGW; if (m < T) {
                    const int b = m >> 13; const float* mb = modl + (size_t)b * 6144; float s = 0.f;
#pragma unroll
                    for (int j = 0; j < 4; ++j) s += (v[q][j][0] * v[q][j][0] + v[q][j][1] * v[q][j][1]) + (v[q][j][2] * v[q][j][2] + v[q][j][3] * v[q][j][3]);
                    const float rstd = rsqrtf(wave_sum(s) * (1.0f / 1024.0f) + EPS);
                    u32x2* o8 = (u32x2*)(ACT + (size_t)m * DM) + lane;
#pragma unroll
                    for (int j = 0; j < 4; ++j) { const int k = 4 * lane + 256 * j; const f32x4 gg = *(const f32x4*)(g1 + k), sh = *(const f32x4*)(mb + k), sc = *(const f32x4*)(mb + 1024 + k);
                        const f32x4 y = v[q][j] * rstd * gg * (sc + 1.0f) + sh; u32x2 w; w.x = pk2(y[0], y[1]); w.y = pk2(y[2], y[3]); o8[64 * j] = w; } } }
            }
        }
        SEAM(pb + 0);
        if (PHON(2) && IN(pb + 1)) {
            const int tid = otid(), lane = tid & 63; (void)tid; (void)lane; WSL();
            bf16* ACT = WSP(bf16, WS_ACT); bf16* Win_t = WSP(bf16, WS_WIN); bf16* P = WSP(bf16, WS_P);
            pg8::Gemm g{ACT, Win_t + (size_t)l * NP * 1024, 1024, 1024, 1024}; pg8::StaticOrder<T / 256, NP / 256> S; S.init(G, bx);
            pg8::EpiStoreBf16 E{P, NP};
            _Pragma("unroll 1") for (int rep_ = 0; rep_ < 1 + (RPT_PHASE == 2 ? RPT_N : 0); ++rep_)
            pg8::gemm_phase<pg8::EpiStoreBf16, pg8::StaticOrder<T / 256, NP / 256>, 0>(lds, g, S, E, g_wave);
        }
        SEAM(pb + 1);
        if (PHON(3) && IN(pb + 2)) {
            const int tid = otid(), lane = tid & 63; (void)tid; (void)lane; WSL();
            const float* diff_q_g = INF(9); const float* diff_k_g = INF(10); const float* gla_b_a = INF(17); bf16* P = WSP(bf16, WS_P); bf16* ACT = WSP(bf16, WS_ACT); f32x2* csr = WSP(f32x2, WS_CSR); f32x2* csd = WSP(f32x2, WS_CSD);
            float* Eret = WSP(float, WS_EST); float* Egla = WSP(float, WS_EGL); float* Asr = WSP(float, WS_ASR); float* Asg = WSP(float, WS_ASG);
            const float* gq = diff_q_g + l * 64; const float* gk = diff_k_g + l * 64;
            for (int m = gw; m < T; m += NGW) {
                bf16* p = P + (size_t)m * NP + C_DQ + 16 * lane;
                const u32x4 w0 = *(const u32x4*)p, w1 = *(const u32x4*)(p + 8);
                float v[16];
                { const unsigned* a = (const unsigned*)&w0; const unsigned* c = (const unsigned*)&w1;
#pragma unroll
                  for (int i = 0; i < 4; ++i) { v[2 * i] = bflo(a[i]); v[2 * i + 1] = bfhi(a[i]); v[8 + 2 * i] = bflo(c[i]); v[8 + 2 * i + 1] = bfhi(c[i]); } }
                float ss = 0.f;
#pragma unroll
                for (int i = 0; i < 16; ++i) ss += v[i] * v[i];
                ss += sx<1>(ss); ss += sx<2>(ss);
                const float rstd = rsqrtf(ss * (1.0f / 64.0f) + EPS);
                const bool isq = lane < 32; const float* gg = (isq ? gq : gk) + (lane & 3) * 16;
#pragma unroll
                for (int i = 0; i < 16; ++i) v[i] = v[i] * rstd * gg[i];
                if ((lane & 3) == 0) { const f32x4* cs4 = (const f32x4*)(csd + (size_t)m * 8);
#pragma unroll
                    for (int i = 0; i < 4; ++i) { const f32x4 cc = cs4[i];
                        const float a0 = v[2 * i], b0 = v[2 * i + 8], a1 = v[2 * i + 1], b1 = v[2 * i + 9];
                        v[2 * i] = a0 * cc[0] - b0 * cc[1]; v[2 * i + 8] = a0 * cc[1] + b0 * cc[0]; v[2 * i + 1] = a1 * cc[2] - b1 * cc[3]; v[2 * i + 9] = a1 * cc[3] + b1 * cc[2]; } }
                const float qs = isq ? 0.125f * LOG2E : 1.0f;
                u32x4 o0, o1;
                o0.x = pk2(v[0] * qs, v[1] * qs); o0.y = pk2(v[2] * qs, v[3] * qs); o0.z = pk2(v[4] * qs, v[5] * qs); o0.w = pk2(v[6] * qs, v[7] * qs);
                o1.x = pk2(v[8] * qs, v[9] * qs); o1.y = pk2(v[10] * qs, v[11] * qs); o1.z = pk2(v[12] * qs, v[13] * qs); o1.w = pk2(v[14] * qs, v[15] * qs);
                *(u32x4*)p = o0; *(u32x4*)(p + 8) = o1;
            }
            _Pragma("unroll 1") for (int rep_ = 0; rep_ < 1 + (RPT_PHASE == 31 ? RPT_N : 0); ++rep_)
            for (int u = vcu; u < 1024; u += G) {
                const int r = u & 511, bh = r >> 4, seg = r & 15;
                if (u < 512) lin::unit<64, true, false>(lds, P, ACT, csr, bh >> 2, bh & 3, seg, nullptr, nullptr, Eret, Asr, g_wave);
                else lin::unit<32, false, false>(lds, P, ACT, csr, bh >> 2, bh & 3, seg, gla_b_a + l * 128, nullptr, Egla, Asg, g_wave);
            }
        }
        SEAM(pb + 2);
        if (PHON(4) && IN(pb + 3)) {
            const int tid = otid(), lane = tid & 63; (void)tid; (void)lane; WSL();
            const float* scal = WSP(const float, WS_SCAL); const float* diff_sub_g = INF(15); const float* ret_norm_g = INF(8); const float* gla_norm_g = INF(18); const float* gla_b_a = INF(17); bf16* P = WSP(bf16, WS_P); bf16* ACT = WSP(bf16, WS_ACT); f32x2* csr = WSP(f32x2, WS_CSR);
            float* Eret = WSP(float, WS_EST); float* Egla = WSP(float, WS_EGL); float* Asr = WSP(float, WS_ASR); float* Asg = WSP(float, WS_ASG);
            const float lam = scal[l * 4 + 0], negM = scal[l * 4 + 1], osc = scal[l * 4 + 2];
#ifndef NO_ATT
            _Pragma("unroll 1") for (int rep_ = 0; rep_ < 1 + (RPT_PHASE == 41 ? RPT_N : 0); ++rep_)
            for (int pu = vcu; pu < 512; pu += G) {
                const int bh = pu >> 4, jp = pu & 15;
                att::unit(lds, P, ACT, bh >> 2, bh & 3, jp, lam, negM, diff_sub_g + l * 128, osc, g_wave);
                att::unit(lds, P, ACT, bh >> 2, bh & 3, 31 - jp, lam, negM, diff_sub_g + l * 128, osc, g_wave);
            }
#endif
#ifndef NO_LIN2
            _Pragma("unroll 1") for (int rep_ = 0; rep_ < 1 + (RPT_PHASE == 42 ? RPT_N : 0); ++rep_)
            for (int u = vcu; u < 1024; u += G) {
                const int r = u & 511, bh = r >> 4, seg = r & 15;
                if (u < 512) lin::unit<64, true, true>(lds, P, ACT, csr, bh >> 2, bh & 3, seg, nullptr, ret_norm_g + l * 64, Eret, Asr, g_wave);
                else lin::unit<32, false, true>(lds, P, ACT, csr, bh >> 2, bh & 3, seg, gla_b_a + l * 128, gla_norm_g + l * 64, Egla, Asg, g_wave);
            }
#endif
        }
        SEAM(pb + 3);
        if (PHON(5) && IN(pb + 4)) {
            const int tid = otid(), lane = tid & 63; (void)tid; (void)lane; WSL();
            const float* xin = XIN; const float* modl = MODL; bf16* ACT = WSP(bf16, WS_ACT); bf16* Wout_t = WSP(bf16, WS_WOUT);
            pg8::Gemm g{ACT, Wout_t + (size_t)l * 1024 * 1024, 1024, 1024, 1024}; pg8::StaticOrder<T / 256, 4> S; S.init(G, bx);
            pg8::EpiResid E{xin, xout, modl + 2048};
            _Pragma("unroll 1") for (int rep_ = 0; rep_ < 1 + ((RPT_PHASE == 5 && l == 0) ? RPT_N : 0); ++rep_)
            pg8::gemm_phase<pg8::EpiResid, pg8::StaticOrder<T / 256, 4>, 0>(lds, g, S, E, g_wave);
        }
        SEAM(pb + 4);
        if (PHON(6) && IN(pb + 5)) {
            const int tid = otid(), lane = tid & 63; (void)tid; (void)lane; WSL();
            const float* modl = MODL; const float* router_w = INF(20); const float* router_b = INF(21); const float* norm2_g = INF(6); bf16* ACT = WSP(bf16, WS_ACT); int* tokinfo = WSP(int, WS_ROUTE); int* tokS = WSP(int, WS_TOKS);
            constexpr int WR_PITCH = 2064, LG_OFF = 32 * WR_PITCH;
#pragma unroll 4
            for (int i = tid; i < 32768; i += NWAVES * 64) { const int k = i >> 5, e = i & 31; *(LAS unsigned short*)(lds + e * WR_PITCH + k * 2) = (unsigned short)(pk2(router_w[i], 0.f) & 0xffffu); }
            { int Gl = G; asm volatile("" : "+s"(Gl));
#pragma unroll 1
              for (int i = bx * NWAVES * 64 + tid; i < TPAD; i += Gl * NWAVES * 64) tokS[i] = -1; }
            __syncthreads();
            const float* g2 = norm2_g + l * 1024;
            LAS float* lg = (LAS float*)(lds + LG_OFF + wave * 2112);
            unsigned* cnt = ctl + CW_CNT + l * 64;
            for (int gi = gw; gi < T / 16; gi += NGW) {
                for (int r4 = 0; r4 < 16; r4 += 4) {
                    f32x4 v[4][4];
#pragma unroll
                    for (int q = 0; q < 4; ++q) { const f32x4* xr = (const f32x4*)(xout + (size_t)(gi * 16 + r4 + q) * DM) + lane;
#pragma unroll
                        for (int j = 0; j < 4; ++j) v[q][j] = xr[64 * j]; }
#pragma unroll
                    for (int q = 0; q < 4; ++q) { const int m = gi * 16 + r4 + q; const int b = m >> 13; const float* mb = modl + (size_t)b * 6144 + 3072; float s = 0.f;
#pragma unroll
                        for (int j = 0; j < 4; ++j) s += (v[q][j][0] * v[q][j][0] + v[q][j][1] * v[q][j][1]) + (v[q][j][2] * v[q][j][2] + v[q][j][3] * v[q][j][3]);
                        const float rstd = rsqrtf(wave_sum(s) * (1.0f / 1024.0f) + EPS);
                        u32x2* o8 = (u32x2*)(ACT + (size_t)m * DM) + lane;
#pragma unroll
                        for (int j = 0; j < 4; ++j) { const int k = 4 * lane + 256 * j; const f32x4 gg = *(const f32x4*)(g2 + k), sh = *(const f32x4*)(mb + k), sc = *(const f32x4*)(mb + 1024 + k);
                            const f32x4 y = v[q][j] * rstd * gg * (sc + 1.0f) + sh; u32x2 w; w.x = pk2(y[0], y[1]); w.y = pk2(y[2], y[3]); o8[64 * j] = w; } }
                }
                VM_WAIT();
                f32x4 a0 = (f32x4){0.f, 0.f, 0.f, 0.f}, a1 = a0;
                const bf16* ap = ACT + (size_t)(gi * 16 + (lane & 15)) * DM + 8 * (lane >> 4);
#pragma unroll 4
                for (int ks = 0; ks < 32; ++ks) { const bf16x8 a = *(const bf16x8*)(ap + 32 * ks);
                    const bf16x8 b0 = *(const LAS bf16x8*)(lds + (lane & 15) * WR_PITCH + (32 * ks + 8 * (lane >> 4)) * 2), b1 = *(const LAS bf16x8*)(lds + (16 + (lane & 15)) * WR_PITCH + (32 * ks + 8 * (lane >> 4)) * 2);
                    a0 = MFMA16(a, b0, a0); a1 = MFMA16(a, b1, a1); }
#pragma unroll
                for (int r = 0; r < 4; ++r) { lg[(4 * (lane >> 4) + r) * 33 + (lane & 15)] = a0[r]; lg[(4 * (lane >> 4) + r) * 33 + 16 + (lane & 15)] = a1[r]; }
                LDS_WAIT(); asm volatile("" ::: "memory");
                if (lane < 16) {
                    const int m = gi * 16 + lane; float best = -3.0e38f; int bcls = 0; float bwa = 0.f, bwb = 0.f;
#pragma unroll
                    for (int g = 0; g < 8; ++g) {
                        float s[4], a[4];
#pragma unroll
                        for (int i = 0; i < 4; ++i) { s[i] = 1.0f / (1.0f + __expf(-lg[lane * 33 + 4 * g + i])); a[i] = s[i] + router_b[4 * g + i]; }
                        int i1 = 0; float v1 = a[0];
                        if (a[1] > v1) { v1 = a[1]; i1 = 1; } if (a[2] > v1) { v1 = a[2]; i1 = 2; } if (a[3] > v1) { v1 = a[3]; i1 = 3; }
                        int i2 = -1; float v2 = -3.0e38f;
                        if (i1 != 0 && a[0] > v2) { v2 = a[0]; i2 = 0; } if (i1 != 1 && a[1] > v2) { v2 = a[1]; i2 = 1; } if (i1 != 2 && a[2] > v2) { v2 = a[2]; i2 = 2; } if (i1 != 3 && a[3] > v2) { v2 = a[3]; i2 = 3; }
                        const float gsum = v1 + v2;
                        const int ea = i1 < i2 ? i1 : i2, eb = i1 < i2 ? i2 : i1;
                        const float sa = ea == 0 ? s[0] : (ea == 1 ? s[1] : s[2]), sb = eb == 1 ? s[1] : (eb == 2 ? s[2] : s[3]);
                        const int pidx = (ea * (7 - ea)) / 2 + (eb - ea - 1);
                        if (gsum > best) { best = gsum; bcls = g * 6 + pidx; const float den = 1.0f / (sa + sb); bwa = sa * den; bwb = sb * den; }
                    }
                    const unsigned rank = atomicAdd(cnt + bcls, 1u);
                    *(u32x4*)(tokinfo + (size_t)m * 4) = (u32x4){(unsigned)bcls, rank, __float_as_uint(bwa), __float_as_uint(bwb)};
                }
                LDS_WAIT(); asm volatile("" ::: "memory");
            }
            __syncthreads();
        }
        SEAM(pb + 5);
        if (PHON(7) && IN(pb + 6)) {
            const int tid = otid(), lane = tid & 63; (void)tid; (void)lane; WSL();
            bf16* ACT = WSP(bf16, WS_ACT); bf16* H2S = WSP(bf16, WS_H2S); int* tokinfo = WSP(int, WS_ROUTE); int* tokS = WSP(int, WS_TOKS); float* gaS = WSP(float, WS_GAS); float* gbS = WSP(float, WS_GBS); int* tinfo = WSP(int, WS_TINFO);
            LAS int* cst = (LAS int*)lds;
            if (tid == 0) { const unsigned* cnt = ctl + CW_CNT + l * 64; int s = 0, nt = 0;
                for (int c = 0; c < NCLS; ++c) { const int n = (int)__hip_atomic_load(cnt + c, __ATOMIC_RELAXED, __HIP_MEMORY_SCOPE_AGENT); cst[c] = s; const int tl = (n + 255) >> 8;
                    if (bx == 0) { const int g = c / 6, p = c % 6; const int a = p < 3 ? 0 : (p < 5 ? 1 : 2); const int bb = p < 3 ? p + 1 : (p < 5 ? p - 1 : 3); const int code = (g * 4 + a) | ((g * 4 + bb) << 8);
                        for (int i = 0; i < tl; ++i) tinfo[1 + nt + i] = code; }
                    nt += tl; s += tl * 256; }
                if (bx == 0) tinfo[0] = nt; }
            __syncthreads();
            _Pragma("unroll 1") for (int rep_ = 0; rep_ < 1 + (RPT_PHASE == 7 ? RPT_N : 0); ++rep_)
            for (int m = gw; m < T; m += NGW) {
                const u32x4 inf = *(const u32x4*)(tokinfo + (size_t)m * 4);
                const int slot = cst[inf.x] + (int)inf.y;
                const u32x4* src = (const u32x4*)(ACT + (size_t)m * DM); u32x4* dst = (u32x4*)(H2S + (size_t)slot * DM);
                dst[lane] = src[lane]; dst[lane + 64] = src[lane + 64];
                if (lane == 0) { tokS[slot] = m; gaS[slot] = __uint_as_float(inf.z); gbS[slot] = __uint_as_float(inf.w); }
            }
            __syncthreads();
        }
        SEAM(pb + 6);
        if (PHON(8) && IN(pb + 7)) {
            const int tid = otid(), lane = tid & 63; (void)tid; (void)lane; WSL();
            bf16* H2S = WSP(bf16, WS_H2S); bf16* W1 = WSP(bf16, WS_W1); bf16* U = WSP(bf16, WS_U); float* gaS = WSP(float, WS_GAS); float* gbS = WSP(float, WS_GBS); int* tinfo = WSP(int, WS_TINFO);
            pg8::Gemm g{H2S, W1 + (size_t)l * 32 * 1024 * 1024, 1024, 1024, 1024}; pg8::MoeOrder<8, 1> S{tinfo, G, vcu};
            pg8::EpiMoe1 E{U, gaS, gbS};
            _Pragma("unroll 1") for (int rep_ = 0; rep_ < 1 + (RPT_PHASE == 8 ? RPT_N : 0); ++rep_)
            pg8::gemm_phase<pg8::EpiMoe1, pg8::MoeOrder<8, 1>, 0>(lds, g, S, E, g_wave);
        }
        SEAM(pb + 7);
        if (PHON(9) && IN(pb + 8)) {
            const int tid = otid(), lane = tid & 63; (void)tid; (void)lane; WSL();
            const float* modl = MODL; bf16* U = WSP(bf16, WS_U); bf16* W2 = WSP(bf16, WS_W2); int* tokS = WSP(int, WS_TOKS); int* tinfo = WSP(int, WS_TINFO);
            pg8::Gemm g{U, W2 + (size_t)l * 32 * 1024 * 512, 1024, 1024, 512}; pg8::MoeOrder<4, 2> S{tinfo, G, vcu};
            pg8::EpiMoe2 E{xout, tokS, modl + 5 * 1024};
            pg8::gemm_phase<pg8::EpiMoe2, pg8::MoeOrder<4, 2>, 8>(lds, g, S, E, g_wave);
        }
        SEAM(pb + 8);
    }
#undef IN
#undef SEAM
}

extern "C" void kernel_launch(void* const* d_in, const int* in_sizes, int n_in, void* d_out, int out_size, void* d_ws, size_t ws_size, hipStream_t stream) {
    static int grid = 0;
    if (grid == 0) {
        if (n_in != 25 || in_sizes[0] != T * DM || out_size != T * DM || ws_size < WS_END) { fprintf(stderr, "kernel_launch: unexpected shapes (n_in %d, in0 %d, out %d, ws %zu < %zu)\n", n_in, n_in > 0 ? in_sizes[0] : -1, out_size, ws_size, (size_t)WS_END); grid = -1; return; }
        int dev = 0, cus = 0, per_cu = 0;
        if (hipGetDevice(&dev) != hipSuccess || hipDeviceGetAttribute(&cus, hipDeviceAttributeMultiprocessorCount, dev) != hipSuccess) { grid = -1; return; }
        if (hipFuncSetAttribute((const void*)fwd, hipFuncAttributeMaxDynamicSharedMemorySize, LDS_BYTES) != hipSuccess) { fprintf(stderr, "kernel_launch: hipFuncSetAttribute failed\n"); grid = -1; return; }
        if (hipOccupancyMaxActiveBlocksPerMultiprocessor(&per_cu, (const void*)fwd, NWAVES * 64, LDS_BYTES) != hipSuccess || per_cu < 1) fprintf(stderr, "kernel_launch: occupancy query reports %d\n", per_cu);
        (void)hipGetLastError();
        grid = cus;
    }
    if (grid < 0) return;
    if (hipMemsetAsync((char*)d_ws + WS_CTL, 0, CTL_ZERO_BYTES, stream) != hipSuccess) return;
    Args a{};
    for (int i = 0; i < 25; ++i) a.in[i] = (const float*)d_in[i];
    a.out = (float*)d_out; a.ws = (unsigned char*)d_ws;
#if MK_N_LAUNCHES == 1
    a.ph_lo = 0; a.ph_hi = NPHASE;
    hipLaunchKernelGGL(fwd, dim3(grid), dim3(NWAVES * 64), LDS_BYTES, stream, a);
#else
    for (int p = 0; p < NPHASE; ++p) { a.ph_lo = p; a.ph_hi = p + 1; hipLaunchKernelGGL(fwd, dim3(grid), dim3(NWAVES * 64), LDS_BYTES, stream, a); }
#endif
}
```

```cpp
#include <hip/hip_runtime.h>
#include <cstdio>
#include <cstdint>

#ifndef MK_N_LAUNCHES
#define MK_N_LAUNCHES 1
#endif
#ifndef DBG_GROUPS
#define DBG_GROUPS 7
#endif
#ifndef DBG_MOE
#define DBG_MOE 1
#endif
#ifndef RPT_PHASE
#define RPT_PHASE 0
#endif
#ifndef RPT_N
#define RPT_N 1
#endif

#define LAS __attribute__((address_space(3)))
#define GAS __attribute__((address_space(1)))
typedef unsigned short bf16;
typedef short bf16x8 __attribute__((ext_vector_type(8)));
typedef short s16x4 __attribute__((ext_vector_type(4)));
typedef float f32x4 __attribute__((ext_vector_type(4)));
typedef float f32x16 __attribute__((ext_vector_type(16)));
typedef float f32x2 __attribute__((ext_vector_type(2)));
typedef unsigned u32x4 __attribute__((ext_vector_type(4)));
typedef unsigned u32x2 __attribute__((ext_vector_type(2)));
typedef __bf16 bf16x2_t __attribute__((ext_vector_type(2)));
typedef int i32x4 __attribute__((ext_vector_type(4)));

constexpr int BATCH = 8, SEQ = 8192, DM = 1024, T = BATCH * SEQ, DEPTH = 2;
constexpr int NP = 3584;
constexpr int C_RQ = 0, C_RK = 256, C_RV = 512, C_RG = 768, C_DQ = 1024, C_DK = 1536, C_DV = 2048, C_GQ = 2560, C_GK = 2688, C_GV = 2816, C_LA = 3072, C_GR = 3200, C_PAD = 3456;
constexpr int IN_W = 3344;
constexpr int NCLS = 48, TPAD = T + NCLS * 256, MAXTILES = TPAD / 256;
constexpr float EPS = 1e-6f, LOG2E = 1.4426950408889634f;

constexpr size_t MiB = 1u << 20;
constexpr size_t WS_CTL = 0, CTL_ZERO_BYTES = 1 * MiB;
constexpr size_t WS_MOD = 1 * MiB;
constexpr size_t WS_SCAL = WS_MOD + 400 * 1024;
constexpr size_t WS_CSR = 2 * MiB;
constexpr size_t WS_CSD = 19 * MiB;
constexpr size_t WS_WIN = 24 * MiB;
constexpr size_t WS_WOUT = 38 * MiB;
constexpr size_t WS_W1 = 42 * MiB;
constexpr size_t WS_W2 = 170 * MiB;
constexpr size_t WS_ACT = 234 * MiB;
constexpr size_t WS_P = 362 * MiB;
constexpr size_t WS_H2S = WS_P;
constexpr size_t WS_U = WS_P + 152 * MiB;
constexpr size_t WS_EST = 810 * MiB;
constexpr size_t WS_EGL = WS_EST + 8 * MiB, WS_ASR = WS_EST + 12 * MiB, WS_ASG = WS_ASR + 256 * 1024;
constexpr size_t WS_ROUTE = 824 * MiB;
constexpr size_t WS_TOKS = WS_ROUTE + 1 * MiB, WS_GAS = WS_TOKS + 512 * 1024, WS_GBS = WS_GAS + 512 * 1024, WS_TINFO = WS_GBS + 512 * 1024;
constexpr size_t WS_SA1 = 828 * MiB, WS_SA2 = WS_SA1 + 256 * 1024, WS_SAS = WS_SA2 + 256 * 1024, WS_SWIN = WS_SA1 + 1024 * 1024, WS_SW1 = WS_SWIN + 256 * 1024;
constexpr size_t WS_H2Q = 830 * MiB;
constexpr size_t WS_END = 894 * MiB;
static_assert((size_t)TPAD * 1024 * 2 <= 152 * MiB && WS_U + 152 * MiB <= WS_P + (size_t)T * NP * 2, "aliases fit inside P");
static_assert((size_t)T * NP * 2 == 448 * MiB && WS_P + 448 * MiB == WS_EST, "P size");
constexpr int CW_BAR = 4096;
constexpr int CW_CNT = 16384;

constexpr int RING_BYTES = 131072, LDSCTL_OFF = RING_BYTES, MISC_OFF = LDSCTL_OFF + 320, PTR_OFF = MISC_OFF + 128, LDS_BYTES = 147456;
constexpr int NWAVES = 8;

__device__ __forceinline__ unsigned pk2(float lo, float hi) { f32x2 v = {lo, hi}; bf16x2_t b = __builtin_convertvector(v, bf16x2_t); return __builtin_bit_cast(unsigned, b); }
__device__ __forceinline__ float bflo(unsigned w) { return __uint_as_float(w << 16); }
__device__ __forceinline__ float bfhi(unsigned w) { return __uint_as_float(w & 0xffff0000u); }
template <int K> __device__ __forceinline__ float sx(float v) { static_assert(K >= 1 && K < 32, "sx"); return __int_as_float(__builtin_amdgcn_ds_swizzle(__float_as_int(v), (K << 10) | 0x1f)); }
__device__ __forceinline__ float sum_halves(float v) { auto rr = __builtin_amdgcn_permlane32_swap(__float_as_uint(v), __float_as_uint(v), false, false); return __uint_as_float(rr[0]) + __uint_as_float(rr[1]); }
__device__ __forceinline__ float max_halves(float v) { auto rr = __builtin_amdgcn_permlane32_swap(__float_as_uint(v), __float_as_uint(v), false, false); return fmaxf(__uint_as_float(rr[0]), __uint_as_float(rr[1])); }
__device__ __forceinline__ float wave_sum(float v) { v += sx<1>(v); v += sx<2>(v); v += sx<4>(v); v += sx<8>(v); v += sx<16>(v); return sum_halves(v); }
__device__ __forceinline__ float wave_max(float v) { v = fmaxf(v, sx<1>(v)); v = fmaxf(v, sx<2>(v)); v = fmaxf(v, sx<4>(v)); v = fmaxf(v, sx<8>(v)); v = fmaxf(v, sx<16>(v)); return max_halves(v); }
__device__ __forceinline__ float silu_f(float x) { return x * __builtin_amdgcn_rcpf(1.0f + __expf(-x)); }
__device__ __forceinline__ int olane() { int l; asm volatile("v_mbcnt_lo_u32_b32 %0, -1, 0\n\tv_mbcnt_hi_u32_b32 %0, -1, %0" : "=v"(l)); return l; }
__device__ __forceinline__ int otid_w(int wave) { return wave * 64 + olane(); }
#define otid() otid_w(g_wave)
template <class Tp> __device__ __forceinline__ const Tp* inptr(const LAS unsigned char* lds, int k) {
    const LAS unsigned* q = (const LAS unsigned*)(lds + PTR_OFF) + 2 * k; const unsigned lo = __builtin_amdgcn_readfirstlane(q[0]), hi = __builtin_amdgcn_readfirstlane(q[1]);
    return (const Tp*)(((unsigned long long)hi << 32) | lo); }
#define INF(k) inptr<float>(lds, k)
#define LDS_WAIT() asm volatile("s_waitcnt lgkmcnt(0)" ::: "memory")
#define VM_WAIT() asm volatile("s_waitcnt vmcnt(0)" ::: "memory")

namespace pg8 {
constexpr int BM = 256, BK = 64, HALF = 128, HTB = HALF * BK * 2, STAGE_BYTES = 8 * HTB, NXCD = 8, WGM = 8;
__device__ __forceinline__ int lds_byte(int r, int c) { const int st = (r >> 4) * 2 + (c >> 5), rr = r & 15, cc = c & 31, ob = rr * 64 + cc * 2; return st * 1024 + (ob ^ (((ob >> 9) & 1) << 5)); }
__device__ __forceinline__ void stage_rc(int b, int& R, int& C) { const int st = b / 1024, sb = b % 1024, swz = sb ^ (((sb >> 9) & 1) << 5); R = (st >> 1) * 16 + swz / 64; C = (st & 1) * 32 + (swz % 64) / 2; }
__device__ __forceinline__ int perm32(int rho) { const int n = rho >> 4, i = rho & 15; return 8 * (i >> 2) + 4 * n + (i & 3); }

struct Unit { int pm, pn, e0, e1; };
struct Gemm { const bf16* A; const bf16* Bt; int K, lda, ldb; };

template <int NM, int NN> struct StaticOrder {
    static constexpr int nM = NM, nN = NN, nwg = NM * NN;
    int G, c;
    __device__ void init(int G_, int c_) { G = G_; c = c_; }
    __device__ bool next(int i, Unit& u) const {
        const int L = i * G + c; if (L >= nwg) return false;
        int wgid = L; { constexpr int q = nwg / NXCD, r = nwg % NXCD; const int xcd = wgid % NXCD, off = wgid / NXCD; wgid = (xcd < r ? xcd * (q + 1) : r * (q + 1) + (xcd - r) * q) + off; }
        constexpr int nig = WGM * nN; static_assert(NM % WGM == 0, "row tiles in whole groups");
        const int gid = wgid / nig, fm = gid * WGM;
        u.pm = fm + ((wgid % nig) % WGM); u.pn = (wgid % nig) / WGM; u.e0 = 0; u.e1 = 0; return true;
    }
    __device__ __forceinline__ const char* a_base(const Gemm& g, const Unit& u) const { return (const char*)g.A + (size_t)u.pm * BM * g.lda * 2; }
    __device__ __forceinline__ const char* b_lo(const Gemm& g, const Unit& u) const { return (const char*)g.Bt + (size_t)u.pn * BM * g.ldb * 2; }
    __device__ __forceinline__ const char* b_hi(const Gemm& g, const Unit& u) const { return b_lo(g, u); }
};
template <int NPN, int WHICH  >
struct MoeOrder {
    const int* tinfo; int G, c;
    __device__ bool next(int i, Unit& u) const {
        const int nT = __builtin_amdgcn_readfirstlane(tinfo[0]);
        const int L = i * G + c; if (L >= nT * NPN) return false;
        const int gF = nT >> 3, full = gF * 8 * NPN;
        if (L < full) { u.pm = (L / (8 * NPN)) * 8 + (L & 7); u.pn = (L >> 3) % NPN; }
        else { const int rT = nT - 8 * gF; int Lr = L - full, pn = 0; while (Lr >= rT) { Lr -= rT; ++pn; } u.pm = gF * 8 + Lr; u.pn = pn; }
        const int code = __builtin_amdgcn_readfirstlane(tinfo[1 + u.pm]); u.e0 = code & 0xff; u.e1 = (code >> 8) & 0xff; return true;
    }
    __device__ __forceinline__ const char* a_base(const Gemm& g, const Unit& u) const { return (const char*)g.A + (size_t)u.pm * BM * g.lda * 2; }
    __device__ __forceinline__ const char* b_lo(const Gemm& g, const Unit& u) const {
        if (WHICH == 1) return (const char*)g.Bt + ((size_t)(u.pn < 4 ? u.e0 : u.e1) * 1024 + (size_t)(u.pn & 3) * BM) * g.ldb * 2;
        return (const char*)g.Bt + ((size_t)u.e0 * 1024 * 512 + (size_t)u.pn * BM * 512) * 2;
    }
    __device__ __forceinline__ const char* b_hi(const Gemm& g, const Unit& u) const {
        if (WHICH == 1) return b_lo(g, u);
        return (const char*)g.Bt + ((size_t)u.e1 * 1024 * 512 + (size_t)u.pn * BM * 512) * 2 - (size_t)8 * BK * 2;
    }
};

struct EpiStoreBf16 {
    static constexpr bool PERM = true;
    bf16* O; int ldc;
    __device__ __forceinline__ void operator()(const f32x4 (&acc)[2][2][4][2], const Unit& u, int wr, int wc, int fr, int fq) const {
        const int row0 = u.pm * BM + wr * 64 + fr, col0 = u.pn * BM + wc * 32 + 8 * fq;
#pragma unroll
        for (int ai = 0; ai < 2; ++ai)
#pragma unroll
            for (int m = 0; m < 4; ++m) { bf16* rowp = O + (size_t)(row0 + ai * HALF + m * 16) * ldc + col0;
#pragma unroll
                for (int bj = 0; bj < 2; ++bj) { const f32x4 v0 = acc[ai][bj][m][0], v1 = acc[ai][bj][m][1];
                    u32x4 w; w.x = pk2(v0[0], v0[1]); w.y = pk2(v0[2], v0[3]); w.z = pk2(v1[0], v1[1]); w.w = pk2(v1[2], v1[3]);
                    *(u32x4*)(rowp + bj * HALF) = w; } }
    }
};
struct EpiInproj {
    static constexpr bool PERM = true;
    bf16* O; int ldc; const float* sa; const float* sw;
    __device__ __forceinline__ void operator()(const i32x4 (&acc)[2][2][4][2], const Unit& u, int wr, int wc, int fr, int fq) const {
        const int row0 = u.pm * BM + wr * 64 + fr, col0 = u.pn * BM + wc * 32 + 8 * fq;
        f32x4 cs[2][2];
#pragma unroll
        for (int bj = 0; bj < 2; ++bj)
#pragma unroll
            for (int n = 0; n < 2; ++n) cs[bj][n] = *(const f32x4*)(sw + col0 + bj * HALF + 4 * n);
#pragma unroll
        for (int ai = 0; ai < 2; ++ai)
#pragma unroll
            for (int m = 0; m < 4; ++m) { const int row = row0 + ai * HALF + m * 16; const float rs = sa[row]; bf16* rowp = O + (size_t)row * ldc + col0;
#pragma unroll
                for (int bj = 0; bj < 2; ++bj) { const f32x4 v0 = __builtin_convertvector(acc[ai][bj][m][0], f32x4) * cs[bj][0] * rs, v1 = __builtin_convertvector(acc[ai][bj][m][1], f32x4) * cs[bj][1] * rs;
                    u32x4 w; w.x = pk2(v0[0], v0[1]); w.y = pk2(v0[2], v0[3]); w.z = pk2(v1[0], v1[1]); w.w = pk2(v1[2], v1[3]);
                    *(u32x4*)(rowp + bj * HALF) = w; } }
    }
};
struct EpiResid {
    static constexpr bool PERM = false;
    const float* xin; float* out; const float* gate;
    __device__ __forceinline__ void operator()(const f32x4 (&acc)[2][2][4][2], const Unit& u, int wr, int wc, int fr, int fq) const {
        const int col0 = u.pn * BM + wc * 32 + 4 * fq; const int b = (u.pm * BM) >> 13;
        f32x4 gv[2][2];
#pragma unroll
        for (int bj = 0; bj < 2; ++bj)
#pragma unroll
            for (int n = 0; n < 2; ++n) gv[bj][n] = *(const f32x4*)(gate + (size_t)b * 6144 + col0 + bj * HALF + n * 16);
#pragma unroll
        for (int ai = 0; ai < 2; ++ai)
#pragma unroll
            for (int m = 0; m < 4; ++m) { const size_t off = (size_t)(u.pm * BM + ai * HALF + wr * 64 + m * 16 + fr) * DM + col0;
#pragma unroll
                for (int bj = 0; bj < 2; ++bj)
#pragma unroll
                    for (int n = 0; n < 2; ++n) { const f32x4 xv = *(const f32x4*)(xin + off + bj * HALF + n * 16); *(f32x4*)(out + off + bj * HALF + n * 16) = xv + gv[bj][n] * acc[ai][bj][m][n]; } }
    }
};
struct EpiMoe1 {
    static constexpr bool PERM = true;
    bf16* U; const float* gaS; const float* gbS; const float* saS; const float* sw1;
    __device__ __forceinline__ void operator()(const i32x4 (&acc)[2][2][4][2], const Unit& u, int wr, int wc, int fr, int fq) const {
        const float* gs = (u.pn < 4) ? gaS : gbS; const int ucol = u.pn * 128 + wc * 32 + 8 * fq;
        const float* swp = sw1 + (size_t)(u.pn < 4 ? u.e0 : u.e1) * 1024 + (u.pn & 3) * BM + wc * 32 + 8 * fq;
        f32x4 cs[2][2];
#pragma unroll
        for (int bj = 0; bj < 2; ++bj)
#pragma unroll
            for (int n = 0; n < 2; ++n) cs[bj][n] = *(const f32x4*)(swp + bj * HALF + 4 * n);
#pragma unroll
        for (int ai = 0; ai < 2; ++ai)
#pragma unroll
            for (int m = 0; m < 4; ++m) { const int slot = u.pm * BM + ai * HALF + wr * 64 + m * 16 + fr; const float w = gs[slot], rs = saS[slot];
                float r[8];
#pragma unroll
                for (int n = 0; n < 2; ++n) { const f32x4 gv = __builtin_convertvector(acc[ai][0][m][n], f32x4) * cs[0][n] * rs, uv = __builtin_convertvector(acc[ai][1][m][n], f32x4) * cs[1][n] * (rs * w);
#pragma unroll
                    for (int i = 0; i < 4; ++i) r[n * 4 + i] = silu_f(gv[i]) * uv[i]; }
                u32x4 o; o.x = pk2(r[0], r[1]); o.y = pk2(r[2], r[3]); o.z = pk2(r[4], r[5]); o.w = pk2(r[6], r[7]);
                *(u32x4*)(U + (size_t)slot * 1024 + ucol) = o; }
    }
};
struct EpiMoe2 {
    static constexpr bool PERM = false;
    float* x; const int* tokS; const float* gate;
    __device__ __forceinline__ void operator()(const f32x4 (&acc)[2][2][4][2], const Unit& u, int wr, int wc, int fr, int fq) const {
        const int col0 = u.pn * BM + wc * 32 + 4 * fq;
#pragma unroll
        for (int ai = 0; ai < 2; ++ai)
#pragma unroll
            for (int m = 0; m < 4; ++m) { const int slot = u.pm * BM + ai * HALF + wr * 64 + m * 16 + fr; const int tok = tokS[slot];
                if (tok >= 0) { const int b = tok >> 13; float* xp = x + (size_t)tok * DM + col0; const float* gp = gate + (size_t)b * 6144 + col0;
#pragma unroll
                    for (int bj = 0; bj < 2; ++bj)
#pragma unroll
                        for (int n = 0; n < 2; ++n) { const f32x4 gv = *(const f32x4*)(gp + bj * HALF + n * 16); const f32x4 xv = *(const f32x4*)(xp + bj * HALF + n * 16);
                            *(f32x4*)(xp + bj * HALF + n * 16) = xv + (DBG_MOE ? 1.f : 0.f) * gv * acc[ai][bj][m][n]; } } }
    }
};

template <bool I8> struct AccT { typedef f32x4 type; }; template <> struct AccT<true> { typedef i32x4 type; };
template <bool I8> __device__ __forceinline__ typename AccT<I8>::type mma1(bf16x8 b, bf16x8 a, typename AccT<I8>::type c);
template <> __device__ __forceinline__ f32x4 mma1<false>(bf16x8 b, bf16x8 a, f32x4 c) { return __builtin_amdgcn_mfma_f32_16x16x32_bf16(b, a, c, 0, 0, 0); }
template <> __device__ __forceinline__ i32x4 mma1<true>(bf16x8 b, bf16x8 a, i32x4 c) { return __builtin_amdgcn_mfma_i32_16x16x64_i8(__builtin_bit_cast(i32x4, b), __builtin_bit_cast(i32x4, a), c, 0, 0, 0); }
template <class Epi, class Sched, int KSPLIT  , bool I8 = false>
__device__ __forceinline__ void gemm_phase(LAS unsigned char* lds, const Gemm g, const Sched& S, const Epi& E, const int g_wave) {
    const int tid = otid(), wid = __builtin_amdgcn_readfirstlane(tid >> 6), lane = tid & 63, wr = wid >> 2, wc = wid & 3, fr = lane & 15, fq = lane >> 4;
    const int K = g.K, nt = K / BK;
    unsigned voffA[2], voffB[2];
#pragma unroll
    for (int i = 0; i < 2; ++i) { int R, C; stage_rc(tid * 16 + i * 8192, R, C); const int Rb = Epi::PERM ? ((R & ~31) + perm32(R & 31)) : R;
        voffA[i] = (unsigned)(R * g.lda + C) * 2u; voffB[i] = (unsigned)(Rb * g.ldb + C) * 2u; }
    const size_t kstep = (size_t)(BK * 2);
    const size_t hstepA = (size_t)HALF * g.lda * 2, hstepB = (size_t)HALF * g.ldb * 2;
    const unsigned ldsw = (unsigned)wid * 1024u;
    const int aoff = lds_byte(wr * 64 + fr, fq * 8), boff = lds_byte(wc * 32 + fr, fq * 8);
#define PG8_SA(b, h) (((b) * 2 + (h)) * HTB)
#define PG8_SB(b, h) ((4 + (b) * 2 + (h)) * HTB)
#define PG8_STAGE(bufoff, gbase, voff) do { _Pragma("unroll") for (int _i = 0; _i < 2; ++_i) \
        __builtin_amdgcn_global_load_lds((const unsigned*)((const char*)(gbase) + (voff)[_i]), (LAS unsigned*)(lds + (bufoff) + ldsw + _i * 8192), 16, 0, 0); } while (0)
#define PG8_LDA(dst, b, h) do { _Pragma("unroll") for (int m = 0; m < 4; ++m) _Pragma("unroll") for (int k = 0; k < 2; ++k) dst[m][k] = *(const LAS bf16x8*)(lds + PG8_SA(b, h) + aoff + m * 2048 + k * 1024); } while (0)
#define PG8_LDB(dst, b, h) do { _Pragma("unroll") for (int n = 0; n < 2; ++n) _Pragma("unroll") for (int k = 0; k < 2; ++k) dst[n][k] = *(const LAS bf16x8*)(lds + PG8_SB(b, h) + boff + n * 2048 + k * 1024); } while (0)
#define PG8_MMA(ai, bj, At, Bt) do { __builtin_amdgcn_s_setprio(1); _Pragma("unroll") for (int m = 0; m < 4; ++m) _Pragma("unroll") for (int n = 0; n < 2; ++n) _Pragma("unroll") for (int k = 0; k < 2; ++k) \
        acc[ai][bj][m][n] = mma1<I8>(Bt[n][k], At[m][k], acc[ai][bj][m][n]); __builtin_amdgcn_s_setprio(0); } while (0)
#define PG8_WAIT_V(n) asm volatile("s_waitcnt vmcnt(" #n ")" ::: "memory")
#define PG8_WAIT_L(n) asm volatile("s_waitcnt lgkmcnt(" #n ")" ::: "memory")
#define PG8_BAR __builtin_amdgcn_s_barrier()
#define PG8_SCHED __builtin_amdgcn_sched_barrier(0)
    Unit cur, nxt; int ui = 0;
    if (!S.next(0, cur)) return;
    typedef typename AccT<I8>::type acc_t;
    acc_t acc[2][2][4][2];
#pragma unroll
    for (int a = 0; a < 2; ++a)
#pragma unroll
        for (int b = 0; b < 2; ++b)
#pragma unroll
            for (int m = 0; m < 4; ++m)
#pragma unroll
                for (int n = 0; n < 2; ++n) acc[a][b][m][n] = (acc_t){0, 0, 0, 0};
    bf16x8 At[4][2], B0[2][2], B1[2][2];
    const char* cA = S.a_base(g, cur); const char* cB = S.b_lo(g, cur); const char* cBh = S.b_hi(g, cur);
    PG8_STAGE(PG8_SB(0, 0), cB, voffB); PG8_STAGE(PG8_SB(0, 1), cB + hstepB, voffB); PG8_STAGE(PG8_SA(0, 0), cA, voffA); PG8_STAGE(PG8_SA(0, 1), cA + hstepA, voffA);
    if (wr == 1) PG8_BAR;
    PG8_WAIT_V(2); PG8_BAR;
    PG8_STAGE(PG8_SB(1, 0), cB + kstep, voffB); PG8_STAGE(PG8_SA(1, 0), cA + kstep, voffA); PG8_STAGE(PG8_SB(1, 1), cB + hstepB + kstep, voffB);
    PG8_WAIT_V(6); PG8_BAR;
    for (;;) {
        const bool has_next = S.next(ui + 1, nxt);
        const char* nA = has_next ? S.a_base(g, nxt) : cA; const char* nB = has_next ? S.b_lo(g, nxt) : cB; const char* nBh = has_next ? S.b_hi(g, nxt) : cBh;
        for (int t = 0; t < nt; t += 2) {
            const bool last = (t == nt - 2);
            const char* a1 = cA + (size_t)(t + 1) * kstep;
            const char* bsel = (KSPLIT != 0 && (t + 2) >= KSPLIT) ? cBh : cB;
            const char* a2 = last ? nA : cA + (size_t)(t + 2) * kstep; const char* b2 = last ? nB : bsel + (size_t)(t + 2) * kstep;
            const char* a3 = a2 + kstep; const char* b3 = b2 + kstep;
            PG8_LDB(B0, 0, 0); PG8_LDB(B1, 0, 1); PG8_SCHED; PG8_LDA(At, 0, 0); PG8_STAGE(PG8_SA(1, 1), a1 + hstepA, voffA);
            PG8_WAIT_V(8); PG8_WAIT_L(0); PG8_BAR; PG8_MMA(0, 0, At, B0); PG8_MMA(0, 1, At, B1); PG8_BAR; PG8_SCHED;
            PG8_LDA(At, 0, 1); PG8_STAGE(PG8_SB(0, 0), b2, voffB); PG8_STAGE(PG8_SB(0, 1), b2 + hstepB, voffB); PG8_STAGE(PG8_SA(0, 0), a2, voffA);
            PG8_WAIT_V(8); PG8_WAIT_L(0); PG8_BAR; PG8_MMA(1, 0, At, B0); PG8_MMA(1, 1, At, B1); PG8_BAR; PG8_SCHED;
            PG8_LDB(B0, 1, 0); PG8_LDB(B1, 1, 1); PG8_SCHED; PG8_LDA(At, 1, 0); PG8_STAGE(PG8_SA(0, 1), a2 + hstepA, voffA);
            PG8_WAIT_V(8); PG8_WAIT_L(0); PG8_BAR; PG8_MMA(0, 0, At, B0); PG8_MMA(0, 1, At, B1); PG8_BAR; PG8_SCHED;
            PG8_LDA(At, 1, 1); PG8_STAGE(PG8_SB(1, 0), b3, voffB); PG8_STAGE(PG8_SB(1, 1), b3 + hstepB, voffB); PG8_STAGE(PG8_SA(1, 0), a3, voffA);
            PG8_WAIT_V(8); PG8_WAIT_L(0); PG8_BAR; PG8_MMA(1, 0, At, B0); PG8_MMA(1, 1, At, B1); PG8_BAR; PG8_SCHED;
        }
        if (wr == 0) PG8_BAR;
        E(acc, cur, wr, wc, fr, fq);
        if (!has_next) break;
#pragma unroll
        for (int a = 0; a < 2; ++a)
#pragma unroll
            for (int b = 0; b < 2; ++b)
#pragma unroll
                for (int m = 0; m < 4; ++m)
#pragma unroll
                    for (int n = 0; n < 2; ++n) acc[a][b][m][n] = (acc_t){0, 0, 0, 0};
        cur = nxt; cA = nA; cB = nB; cBh = nBh; ++ui;
        if (wr == 1) PG8_BAR;
    }
    PG8_WAIT_V(0);
    PG8_BAR;
#undef PG8_SA
#undef PG8_SB
#undef PG8_STAGE
#undef PG8_LDA
#undef PG8_LDB
#undef PG8_MMA
#undef PG8_WAIT_V
#undef PG8_WAIT_L
#undef PG8_BAR
#undef PG8_SCHED
}
}

#define XB_TMO      128
#define XB_XCNT(j)  (256  + 64 * (j))
#define XB_XSUB(j)  (1280 + 64 * (j))
#define XB_XGEN(j)  (2304 + 64 * (j))
#define XB_TOP      3328
#define XB_TOPGEN   3392
#define XCD_BAR_WORDS 3456
#define XB_SPIN_CAP (1u << 21)
__device__ __forceinline__ unsigned xb_ld(unsigned* p)              { return __hip_atomic_load(p, __ATOMIC_RELAXED, __HIP_MEMORY_SCOPE_AGENT); }
__device__ __forceinline__ unsigned xb_add(unsigned* p, unsigned v) { return __hip_atomic_fetch_add(p, v, __ATOMIC_RELAXED, __HIP_MEMORY_SCOPE_AGENT); }
__device__ __forceinline__ unsigned xb_xcc_id() { return (unsigned)__builtin_amdgcn_s_getreg((3 << 11) | 20) & 0xFu; }
#define XB_SPIN(cond, bar) do { unsigned _sp = 0; while (cond) { __builtin_amdgcn_s_sleep(1); \
    if ((++_sp & 255u) == 0u) { if (xb_ld(&(bar)[XB_TMO])) break; if (_sp > XB_SPIN_CAP) { atomicAdd(&(bar)[XB_TMO], 1u); break; } } } } while (0)
struct XcdBarrier { unsigned* bar; unsigned x; volatile LAS unsigned* st; };
__device__ __forceinline__ XcdBarrier xcd_barrier_post(unsigned* bar, volatile LAS unsigned* st, bool leader) {
    XcdBarrier b; b.bar = bar; b.x = xb_xcc_id(); b.st = st;
    if (leader) (void)xb_add(&bar[XB_XCNT(b.x)], 1u);
    return b;
}
__device__ __forceinline__ void xcd_barrier_complete(unsigned* bar, unsigned x, unsigned& nloc, unsigned& nx) {
    const unsigned G = gridDim.x * gridDim.y * gridDim.z;
    unsigned sum, cnt, mine, sp = 0u;
    for (;;) {
        sum = 0u; cnt = 0u; mine = 0u;
#pragma unroll
        for (unsigned j = 0; j < 16; ++j) { const unsigned c = xb_ld(&bar[XB_XCNT(j)]); sum += c; cnt += (c > 0u) ? 1u : 0u; mine = (j == x) ? c : mine; }
        if (sum == G) break;
        __builtin_amdgcn_s_sleep(1);
        if ((++sp & 255u) == 0u) { if (xb_ld(&bar[XB_TMO])) break; if (sp > XB_SPIN_CAP) { atomicAdd(&bar[XB_TMO], 1u); break; } }
    }
    nloc = mine > 0u ? mine : 1u; nx = cnt > 0u ? cnt : 1u;
}
__device__ __forceinline__ void xcd_barrier(const XcdBarrier& b, bool leader) {
    asm volatile("s_waitcnt vmcnt(0)" ::: "memory");
    __syncthreads();
    if (leader) {
        unsigned* bar = b.bar;
        __builtin_amdgcn_s_waitcnt(0);
        unsigned nloc = b.st[0], nx = b.st[1];
        if (nloc == 0u) { xcd_barrier_complete(bar, b.x, nloc, nx); b.st[0] = nloc; b.st[1] = nx; }
        const unsigned old = xb_add(&bar[XB_XSUB(b.x)], 1u);
        const unsigned gen = old / nloc;
        if (old + 1u == (gen + 1u) * nloc) {
            __builtin_amdgcn_fence(__ATOMIC_RELEASE, "agent");
            asm volatile("s_waitcnt vmcnt(0)" ::: "memory");
            const unsigned og = xb_add(&bar[XB_TOP], 1u);
            const unsigned tg = og / nx;
            if (og + 1u == (tg + 1u) * nx) xb_add(&bar[XB_TOPGEN], 1u);
            else XB_SPIN(xb_ld(&bar[XB_TOPGEN]) == tg, bar);
            __builtin_amdgcn_fence(__ATOMIC_ACQUIRE, "agent");
            xb_add(&bar[XB_XGEN(b.x)], 1u);
            asm volatile("s_waitcnt vmcnt(0)" ::: "memory");
        } else {
            XB_SPIN(xb_ld(&bar[XB_XGEN(b.x)]) == gen, bar);
            __builtin_amdgcn_fence(__ATOMIC_ACQUIRE, "agent");
            asm volatile("s_waitcnt vmcnt(0)" ::: "memory");
        }
    }
    __syncthreads();
}

__device__ __forceinline__ int tr_row(int kind, int n) {
    if (kind == 0) return n;
    if (kind == 1) return n < 3072 ? n : (n < 3088 ? -1 : n + 112);
    return (n >> 7) * 256 + (n & 127) + (kind == 3 ? 128 : 0);
}
__device__ __forceinline__ void tr_item(const float* W, int K, int N, bf16* WT, int ldt, int kind, LAS unsigned char* scr, int item, int lane) {
    const int nblk = (N + 63) / 64, kb = item / nblk, nb = item % nblk, k0 = 64 * kb, n0 = 64 * nb;
    const int n4 = (lane & 15) * 4; const bool inr = (n0 + n4) < N;
    f32x4 v[16];
#pragma unroll
    for (int i = 0; i < 16; ++i) { const int kk = 4 * i + (lane >> 4); v[i] = inr ? *(const f32x4*)(W + (size_t)(k0 + kk) * N + n0 + n4) : (f32x4){0.f, 0.f, 0.f, 0.f}; }
#pragma unroll
    for (int i = 0; i < 16; ++i) { const int kk = 4 * i + (lane >> 4); const unsigned w0 = pk2(v[i][0], v[i][1]), w1 = pk2(v[i][2], v[i][3]);
        *(LAS unsigned short*)(scr + (n4 + 0) * 132 + kk * 2) = (unsigned short)(w0 & 0xffffu); *(LAS unsigned short*)(scr + (n4 + 1) * 132 + kk * 2) = (unsigned short)(w0 >> 16);
        *(LAS unsigned short*)(scr + (n4 + 2) * 132 + kk * 2) = (unsigned short)(w1 & 0xffffu); *(LAS unsigned short*)(scr + (n4 + 3) * 132 + kk * 2) = (unsigned short)(w1 >> 16); }
    LDS_WAIT(); asm volatile("" ::: "memory");
#pragma unroll
    for (int j = 0; j < 8; ++j) { const int idx = lane + 64 * j, n = idx >> 3, c = idx & 7; const LAS unsigned* sp = (const LAS unsigned*)(scr + n * 132 + c * 16);
        u32x4 o; o.x = sp[0]; o.y = sp[1]; o.z = sp[2]; o.w = sp[3];
        const int gn = n0 + n; const int r = (gn < N) ? tr_row(kind, gn) : -1;
        if (r >= 0) *(u32x4*)(WT + (size_t)r * ldt + k0 + 8 * c) = o; }
    LDS_WAIT(); asm volatile("" ::: "memory");
}

template <bool LA>
__device__ __forceinline__ void quant_strip(LAS unsigned char* lds, const float* W, int N, int n0, unsigned char* Q, float* SW, int kind, const float* a2, int wave, int lane) {
    lane = olane();
    const int a = lane & 15, kg = lane >> 4; const int ncl = (n0 + 4 * a) < N ? (n0 + 4 * a) : (N - 4);
    f32x4 v[2][16];
#pragma unroll
    for (int t = 0; t < 2; ++t)
#pragma unroll
        for (int i = 0; i < 16; ++i) { const int kk = 128 * wave + 64 * t + 16 * (i >> 2) + 4 * kg + (i & 3);
            if (!LA) v[t][i] = *(const f32x4*)(W + (size_t)kk * N + ncl);
            else { f32x4 acc = (f32x4){0.f, 0.f, 0.f, 0.f}; const float* wr = W + (size_t)kk * N + 3072;
#pragma unroll 4
                for (int r = 0; r < 16; ++r) acc += *(const f32x4*)(a2 + r * 128 + n0 + 4 * a) * wr[r];
                v[t][i] = acc; } }
    f32x4 cm = (f32x4){0.f, 0.f, 0.f, 0.f};
#pragma unroll
    for (int t = 0; t < 2; ++t)
#pragma unroll
        for (int i = 0; i < 16; ++i) cm = __builtin_elementwise_max(cm, __builtin_elementwise_abs(v[t][i]));
    LAS float* cmax = (LAS float*)(lds + 67584);
#pragma unroll
    for (int e = 0; e < 4; ++e) { float m = cm[e]; m = fmaxf(m, sx<16>(m)); m = max_halves(m); if (kg == 0) cmax[wave * 64 + 4 * a + e] = m; }
    __syncthreads();
    float inv[4], scl[4];
#pragma unroll
    for (int e = 0; e < 4; ++e) { float m = 0.f;
#pragma unroll
        for (int w = 0; w < 8; ++w) m = fmaxf(m, cmax[w * 64 + 4 * a + e]);
        scl[e] = m > 0.f ? m * (1.0f / 127.0f) : 1.0f; inv[e] = m > 0.f ? 127.0f / m : 0.f; }
    LAS unsigned char* tile = lds + wave * 8448;
#pragma unroll
    for (int t = 0; t < 2; ++t)
#pragma unroll
        for (int g = 0; g < 4; ++g)
#pragma unroll
            for (int e = 0; e < 4; ++e) { unsigned w = 0u;
#pragma unroll
                for (int j = 0; j < 4; ++j) { const int q = (int)__builtin_rintf(v[t][4 * g + j][e] * inv[e]); w |= ((unsigned)q & 0xffu) << (8 * j); }
                *(LAS unsigned*)(tile + (4 * a + e) * 132 + 64 * t + 16 * g + 4 * kg) = w; }
    LDS_WAIT(); asm volatile("" ::: "memory");
#pragma unroll
    for (int j = 0; j < 8; ++j) { const int idx = lane + 64 * j, n = idx >> 3, c = idx & 7; const LAS unsigned* sp = (const LAS unsigned*)(tile + n * 132 + c * 16);
        u32x4 o; o.x = sp[0]; o.y = sp[1]; o.z = sp[2]; o.w = sp[3];
        const int gn = n0 + n; const int r = LA ? (C_LA + gn) : ((gn < N) ? tr_row(kind, gn) : -1);
        if (r >= 0) *(u32x4*)(Q + (size_t)r * 1024 + 128 * wave + 16 * c) = o; }
    if (wave == 0 && kg == 0) {
#pragma unroll
        for (int e = 0; e < 4; ++e) { const int gn = n0 + 4 * a + e; const int r = LA ? (C_LA + gn) : ((gn < N) ? tr_row(kind, gn) : -1); if (r >= 0) SW[r] = scl[e]; } }
    __syncthreads();
}

namespace lin {
constexpr int L_QL = 0, L_QU = 9216, L_KL = 18432, L_KU = 27648, L_KLT = 36864, L_VT = 46080, L_AM = 55296, L_ST = 64512, L_OUT = 73728, L_G = 90368, L_GL = 98560, L_END = 98816;
constexpr int NSEG = 16, LSEG = 8;
#define MFMA16(a, b, c) __builtin_amdgcn_mfma_f32_16x16x32_bf16(a, b, c, 0, 0, 0)
__device__ __forceinline__ bf16x8 frag(const LAS unsigned char* base, int pitchB, int r0, int ks, int lane) {
    return *(const LAS bf16x8*)(base + (r0 + (lane & 15)) * pitchB + (32 * ks + 8 * (lane >> 4)) * 2);
}
typedef short v4i16_t __attribute__((ext_vector_type(4)));
__device__ __forceinline__ bf16x8 trfrag(const LAS unsigned char* base, int pitchB, int k0, int n0, int lane) {
    const LAS unsigned char* p = base + (k0 + 8 * (lane >> 4) + ((lane & 15) >> 2)) * pitchB + (n0 + 4 * (lane & 3)) * 2;
    const s16x4 lo = __builtin_bit_cast(s16x4, __builtin_amdgcn_ds_read_tr16_b64_v4i16((LAS v4i16_t*)p));
    const s16x4 hi = __builtin_bit_cast(s16x4, __builtin_amdgcn_ds_read_tr16_b64_v4i16((LAS v4i16_t*)(p + 4 * pitchB)));
    return (bf16x8){lo[0], lo[1], lo[2], lo[3], hi[0], hi[1], hi[2], hi[3]};
}
template <int DK, bool RET, bool PH2>
__device__ __forceinline__ void unit(LAS unsigned char* lds, const bf16* P, bf16* MIX, const f32x2* csr, int b, int h, int seg,
                                     const float* b_a, const float* gnorm, float* Est, float* Aseg, const int g_wave) {
    constexpr int PQ = (DK + 8) * 2;
    constexpr int PS = 144;
    constexpr int NT = DK / 32;
    const int tid = otid(), lane = tid & 63, wid = __builtin_amdgcn_readfirstlane(tid >> 6);
    const int row = tid >> 3, c8 = tid & 7;
    const int entry = (b * 4 + h) * NSEG + seg;
    const float lng = RET ? __logf(1.0f - exp2f(-5.0f - (float)h)) : 0.f;
    const int cq = RET ? C_RQ + h * 64 : C_GQ + h * 32, ck = RET ? C_RK + h * 64 : C_GK + h * 32, cv = RET ? C_RV + h * 64 : C_GV + h * 64, cg = RET ? C_RG + h * 64 : C_GR + h * 64;
    f32x4 st[NT]; float ac[NT];
    int eb[NT], db[NT];
#pragma unroll
    for (int j = 0; j < NT; ++j) { const int i = wid + 8 * j; if (DK == 64) { eb[j] = i >> 2; db[j] = i & 3; } else { eb[j] = i >> 1; db[j] = i & 1; } st[j] = (f32x4){0.f, 0.f, 0.f, 0.f}; ac[j] = 1.f; }
    if (PH2) {
#pragma unroll 4
        for (int sp = 0; sp < seg; ++sp) { const int en = (b * 4 + h) * NSEG + sp;
#pragma unroll
            for (int j = 0; j < NT; ++j) { const int d = db[j] * 16 + (lane & 15); const float a = Aseg[(size_t)en * DK + d];
#pragma unroll
                for (int r = 0; r < 4; ++r) { const int e = eb[j] * 16 + 4 * (lane >> 4) + r; st[j][r] = a * st[j][r] + Est[((size_t)en * 64 + e) * DK + d]; } } }
    }
    float gn8[8] = {0.f, 0.f, 0.f, 0.f, 0.f, 0.f, 0.f, 0.f}, ba4[4] = {0.f, 0.f, 0.f, 0.f};
    if (PH2) {
#pragma unroll
        for (int i = 0; i < 8; ++i) gn8[i] = gnorm[8 * c8 + i]; }
    if (!RET) {
#pragma unroll
        for (int i = 0; i < 4; ++i) ba4[i] = b_a[h * 32 + 4 * wid + i]; }
    u32x4 rq_ = (u32x4){0u, 0u, 0u, 0u}, rk_ = rq_, rq2_ = rq_, rk2_ = rq_, pv = rq_, pgt = rq_; f32x4 pcs[4]; u32x2 pla = (u32x2){0u, 0u};
#pragma unroll
    for (int i = 0; i < 4; ++i) pcs[i] = (f32x4){0.f, 0.f, 0.f, 0.f};
    const int d0 = 8 * c8; const bool qk_on = RET || c8 < 4;
#define LIN_LOAD(cc) do { const size_t mr_ = (size_t)b * SEQ + (size_t)(seg * LSEG + (cc)) * 64 + row; \
        if (!RET) pla = *(const u32x2*)(P + ((size_t)b * SEQ + (size_t)(seg * LSEG + (cc)) * 64 + lane) * NP + C_LA + h * 32 + 4 * wid); \
        if (qk_on) { rk_ = *(const u32x4*)(P + mr_ * NP + ck + d0); if (PH2) rq_ = *(const u32x4*)(P + mr_ * NP + cq + d0); \
            if (RET) { rk2_ = *(const u32x4*)(P + mr_ * NP + ck + (d0 ^ 32)); if (PH2) rq2_ = *(const u32x4*)(P + mr_ * NP + cq + (d0 ^ 32)); \
                const f32x4* cs4_ = (const f32x4*)(csr + mr_ * 32 + (d0 & 31)); pcs[0] = cs4_[0]; pcs[1] = cs4_[1]; pcs[2] = cs4_[2]; pcs[3] = cs4_[3]; } } \
        pv = *(const u32x4*)(P + mr_ * NP + cv + 8 * c8); if (PH2) pgt = *(const u32x4*)(P + mr_ * NP + cg + 8 * c8); } while (0)
    LIN_LOAD(0);
    for (int c = 0; c < LSEG; ++c) {
        const size_t m0 = (size_t)b * SEQ + (size_t)(seg * LSEG + c) * 64;
        if (!RET) {
            const u32x2 w = pla;
            float x[4] = {bflo(w.x), bfhi(w.x), bflo(w.y), bfhi(w.y)};
#pragma unroll
            for (int i = 0; i < 4; ++i) { const float z = x[i] + ba4[i]; float v = (fminf(z, 0.f) - log1pf(__expf(-fabsf(z)))) * (1.0f / 16.0f);
#pragma unroll
                for (int o = 1; o < 64; o <<= 1) { const float u = __int_as_float(__builtin_amdgcn_ds_bpermute((lane - o) << 2, __float_as_int(v))); if (lane >= o) v += u; }
                ((LAS float*)(lds + L_G))[lane * 32 + 4 * wid + i] = v; if (lane == 63) ((LAS float*)(lds + L_GL))[4 * wid + i] = v; }
            __syncthreads();
        }
        u32x4 gcur = pgt;
        {
            if (qk_on) {
                const u32x4 kw = rk_, qw = rq_;
                float qv[8], kv[8], eg[8], ieg[8];
                { const unsigned* qp = (const unsigned*)&qw; const unsigned* kp = (const unsigned*)&kw;
#pragma unroll
                  for (int i = 0; i < 4; ++i) { qv[2 * i] = bflo(qp[i]); qv[2 * i + 1] = bfhi(qp[i]); kv[2 * i] = bflo(kp[i]); kv[2 * i + 1] = bfhi(kp[i]); } }
                if (RET) {
                    const u32x4 kw2 = rk2_, qw2 = rq2_;
                    const unsigned* qp2 = (const unsigned*)&qw2; const unsigned* kp2 = (const unsigned*)&kw2;
                    const float g = (float)(row + 1) * lng; const float e1 = __expf(g), e2 = __expf(-g);
#pragma unroll
                    for (int i = 0; i < 4; ++i) { const f32x4 cc = pcs[i];
                        const float qa = bflo(qp2[i]), qb = bfhi(qp2[i]), ka = bflo(kp2[i]), kb = bfhi(kp2[i]);
                        if (c8 < 4) { const float q0 = qv[2 * i] * cc[0] - qa * cc[1], q1 = qv[2 * i + 1] * cc[2] - qb * cc[3]; const float k0 = kv[2 * i] * cc[0] - ka * cc[1], k1 = kv[2 * i + 1] * cc[2] - kb * cc[3];
                            qv[2 * i] = q0; qv[2 * i + 1] = q1; kv[2 * i] = k0; kv[2 * i + 1] = k1; }
                        else { const float q0 = qa * cc[1] + qv[2 * i] * cc[0], q1 = qb * cc[3] + qv[2 * i + 1] * cc[2]; const float k0 = ka * cc[1] + kv[2 * i] * cc[0], k1 = kb * cc[3] + kv[2 * i + 1] * cc[2];
                            qv[2 * i] = q0; qv[2 * i + 1] = q1; kv[2 * i] = k0; kv[2 * i + 1] = k1; } }
#pragma unroll
                    for (int i = 0; i < 8; ++i) { kv[i] *= 0.125f; eg[i] = e1; ieg[i] = e2; }
                } else {
#pragma unroll
                    for (int i = 0; i < 8; ++i) { const float g = ((const LAS float*)(lds + L_G))[row * 32 + d0 + i]; eg[i] = __expf(g); ieg[i] = __expf(-g); qv[i] *= 0.17677669529663687f; }
                }
                float kl[8];
#pragma unroll
                for (int i = 0; i < 8; ++i) kl[i] = kv[i] * ieg[i];
                if (PH2) {
                    u32x4 o;
                    o.x = pk2(qv[0] * eg[0], qv[1] * eg[1]); o.y = pk2(qv[2] * eg[2], qv[3] * eg[3]); o.z = pk2(qv[4] * eg[4], qv[5] * eg[5]); o.w = pk2(qv[6] * eg[6], qv[7] * eg[7]);
                    *(LAS u32x4*)(lds + L_QL + row * PQ + d0 * 2) = o;
                    o.x = pk2(qv[0] * ieg[0], qv[1] * ieg[1]); o.y = pk2(qv[2] * ieg[2], qv[3] * ieg[3]); o.z = pk2(qv[4] * ieg[4], qv[5] * ieg[5]); o.w = pk2(qv[6] * ieg[6], qv[7] * ieg[7]);
                    *(LAS u32x4*)(lds + L_QU + row * PQ + d0 * 2) = o;
                    o.x = pk2(kv[0] * eg[0], kv[1] * eg[1]); o.y = pk2(kv[2] * eg[2], kv[3] * eg[3]); o.z = pk2(kv[4] * eg[4], kv[5] * eg[5]); o.w = pk2(kv[6] * eg[6], kv[7] * eg[7]);
                    *(LAS u32x4*)(lds + L_KU + row * PQ + d0 * 2) = o;
                }
                { u32x4 o; o.x = pk2(kl[0], kl[1]); o.y = pk2(kl[2], kl[3]); o.z = pk2(kl[4], kl[5]); o.w = pk2(kl[6], kl[7]);
                  *(LAS u32x4*)(lds + L_KL + row * PQ + d0 * 2) = o; }
            }
            *(LAS u32x4*)(lds + L_VT + row * PS + c8 * 16) = pv;
        }
        if (c + 1 < LSEG) LIN_LOAD(c + 1);
        __syncthreads();
#pragma unroll
        for (int j = 0; j < NT; ++j) {
            const int d = db[j] * 16 + (lane & 15);
            if (PH2) {
#pragma unroll
                for (int r = 0; r < 4; ++r) { const int e = eb[j] * 16 + 4 * (lane >> 4) + r; *(LAS unsigned short*)(lds + L_ST + e * PQ + d * 2) = (unsigned short)(pk2(st[j][r], 0.f) & 0xffffu); }
            }
            f32x4 u = (f32x4){0.f, 0.f, 0.f, 0.f};
#pragma unroll
            for (int ks = 0; ks < 2; ++ks) u = MFMA16(trfrag(lds + L_VT, PS, 32 * ks, eb[j] * 16, lane), trfrag(lds + L_KL, PQ, 32 * ks, db[j] * 16, lane), u);
            const float egl = RET ? __expf(64.f * lng) : __expf(((const LAS float*)(lds + L_GL))[d]);
#pragma unroll
            for (int r = 0; r < 4; ++r) st[j][r] = egl * (st[j][r] + u[r]);
            ac[j] *= egl;
        }
        if (PH2) {
#pragma unroll
            for (int j = 0; j < 2; ++j) { const int i = wid + 8 * j, tb = i >> 2, sb = i & 3;
                f32x4 lo = (f32x4){0.f, 0.f, 0.f, 0.f}, up = (f32x4){0.f, 0.f, 0.f, 0.f};
                if (sb <= tb) {
#pragma unroll
                    for (int ks = 0; ks < DK / 32; ++ks) lo = MFMA16(frag(lds + L_QL, PQ, tb * 16, ks, lane), frag(lds + L_KL, PQ, sb * 16, ks, lane), lo); }
                if (sb >= tb) {
#pragma unroll
                    for (int ks = 0; ks < DK / 32; ++ks) up = MFMA16(frag(lds + L_QU, PQ, tb * 16, ks, lane), frag(lds + L_KU, PQ, sb * 16, ks, lane), up); }
                const int s = sb * 16 + (lane & 15);
#pragma unroll
                for (int r = 0; r < 4; ++r) { const int t = tb * 16 + 4 * (lane >> 4) + r; const float v = (s <= t) ? lo[r] : up[r];
                    *(LAS unsigned short*)(lds + L_AM + t * PS + s * 2) = (unsigned short)(pk2(v, 0.f) & 0xffffu); } }
        }
        __syncthreads();
        if (PH2) {
#pragma unroll
            for (int j = 0; j < 2; ++j) { const int i = wid + 8 * j, tb = i >> 2, ob = i & 3;
                f32x4 o = (f32x4){0.f, 0.f, 0.f, 0.f};
#pragma unroll
                for (int ks = 0; ks < 2; ++ks) o = MFMA16(frag(lds + L_AM, PS, tb * 16, ks, lane), trfrag(lds + L_VT, PS, 32 * ks, ob * 16, lane), o);
#pragma unroll
                for (int ks = 0; ks < DK / 32; ++ks) o = MFMA16(frag(lds + L_QL, PQ, tb * 16, ks, lane), frag(lds + L_ST, PQ, ob * 16, ks, lane), o);
#pragma unroll
                for (int r = 0; r < 4; ++r) ((LAS float*)(lds + L_OUT))[(tb * 16 + 4 * (lane >> 4) + r) * 65 + ob * 16 + (lane & 15)] = o[r]; }
            __syncthreads();
            { const size_t m = m0 + row; const int e0 = 8 * c8; float v[8]; float ss = 0.f;
#pragma unroll
              for (int i = 0; i < 8; ++i) { v[i] = ((const LAS float*)(lds + L_OUT))[row * 65 + e0 + i]; ss += v[i] * v[i]; }
              ss += sx<1>(ss); ss += sx<2>(ss); ss += sx<4>(ss);
              const float rstd = rsqrtf(ss * (1.0f / 64.0f) + EPS);
              const u32x4 gw = gcur; const unsigned* gp = (const unsigned*)&gw; float y[8];
#pragma unroll
              for (int i = 0; i < 4; ++i) { y[2 * i] = v[2 * i] * rstd * gn8[2 * i] * silu_f(bflo(gp[i])); y[2 * i + 1] = v[2 * i + 1] * rstd * gn8[2 * i + 1] * silu_f(bfhi(gp[i])); }
              const bool on = RET ? ((DBG_GROUPS & 1) != 0) : ((DBG_GROUPS & 4) != 0);
              u32x4 o; o.x = pk2(y[0], y[1]); o.y = pk2(y[2], y[3]); o.z = pk2(y[4], y[5]); o.w = pk2(y[6], y[7]); if (!on) o = (u32x4){0u, 0u, 0u, 0u};
              *(u32x4*)(MIX + m * DM + (RET ? 0 : 768) + h * 64 + e0) = o; }
        }
    }
#undef LIN_LOAD
    if (!PH2) {
#pragma unroll
        for (int j = 0; j < NT; ++j) { const int d = db[j] * 16 + (lane & 15);
#pragma unroll
            for (int r = 0; r < 4; ++r) { const int e = eb[j] * 16 + 4 * (lane >> 4) + r; Est[((size_t)entry * 64 + e) * DK + d] = st[j][r]; }
            if (eb[j] == 0 && (lane >> 4) == 0) Aseg[(size_t)entry * DK + d] = ac[j]; }
    }
    __syncthreads();
}
}

namespace att {
constexpr int A_K = 0, A_V = 16384, A_O0 = 49152, A_LS = 114688, A_END = 116736;
#define MFMA32(a, b, c) __builtin_amdgcn_mfma_f32_32x32x16_bf16(a, b, c, 0, 0, 0)
typedef short v4i16_t __attribute__((ext_vector_type(4)));
__device__ __forceinline__ s16x4 vtr(const LAS unsigned char* p) { return __builtin_bit_cast(s16x4, __builtin_amdgcn_ds_read_tr16_b64_v4i16((LAS v4i16_t*)p)); }
__device__ __forceinline__ int crow(int r, int hi) { return (r & 3) + 8 * (r >> 2) + 4 * hi; }
__device__ __forceinline__ void unit(LAS unsigned char* lds, const bf16* P, bf16* MIX, int b, int h, int jq, float lam, float negM, const float* subg, float oscale, const int g_wave) {
    const int tid = otid(), lane = tid & 63, r32 = lane & 31, hh = lane >> 5, wid = __builtin_amdgcn_readfirstlane(tid >> 6);
    const size_t rowbase = (size_t)b * SEQ;
    const int q0 = jq * 256 + wid * 32;
    const int ntile = 4 * jq + 4, my_nt = 4 * jq + (wid >> 1) + 1;
    const int krow = tid >> 3, kch = (tid & 7) ^ ((krow >> 1) & 7);
    const int vrow = (tid >> 2) & 63, vcol = (tid >> 8) * 32 + (tid & 3) * 8;
    const unsigned ldsw = (unsigned)wid * 1024u;
    const int q4 = (lane & 15) >> 2, p4 = lane & 3, gsel = (lane >> 4) & 1;
    const unsigned vrd = (unsigned)((4 * hh + q4) * 64 + gsel * 32 + p4 * 8);
#pragma unroll 1
    for (int comp = 0; comp < 2; ++comp) {
        bf16x8 qf[4];
        const char* Pb = (const char*)(P + rowbase * NP + h * 128);
        { const unsigned qo = (unsigned)(((q0 + r32) * NP + C_DQ + comp * 64 + hh * 8) * 2);
#pragma unroll
          for (int ks = 0; ks < 4; ++ks) qf[ks] = *(const bf16x8*)(Pb + qo + 32 * ks); }
        const unsigned kgo = (unsigned)((krow * NP + C_DK + comp * 64 + kch * 8) * 2), vgo = (unsigned)((vrow * NP + C_DV + vcol) * 2);
        f32x16 o[4];
#pragma unroll
        for (int e = 0; e < 4; ++e)
#pragma unroll
            for (int r = 0; r < 16; ++r) o[e][r] = 0.f;
        float l = 0.f;
#define ATT_STAGE(buf, tt) do { const char* Pt = Pb + (size_t)(tt) * 64 * NP * 2; \
            __builtin_amdgcn_global_load_lds((const unsigned*)(Pt + kgo), (LAS unsigned*)(lds + A_K + (buf) * 8192 + ldsw), 16, 0, 0); \
            __builtin_amdgcn_global_load_lds((const unsigned*)(Pt + vgo), (LAS unsigned*)(lds + A_V + (buf) * 16384 + ldsw), 16, 0, 0); \
            __builtin_amdgcn_global_load_lds((const unsigned*)(Pt + vgo + 128), (LAS unsigned*)(lds + A_V + (buf) * 16384 + 8192 + ldsw), 16, 0, 0); } while (0)
        ATT_STAGE(0, 0);
        VM_WAIT(); __syncthreads();
        for (int t = 0; t < ntile; ++t) {
            const int cur = t & 1;
            if (t + 1 < ntile) ATT_STAGE(cur ^ 1, t + 1);
            if (t < my_nt) {
                const LAS unsigned char* Kb = lds + A_K + cur * 8192; const LAS unsigned char* Vb = lds + A_V + cur * 16384;
                bf16x8 pa[4];
#pragma unroll
                for (int kb = 0; kb < 2; ++kb) {
                    f32x16 s0;
#pragma unroll
                    for (int r = 0; r < 16; ++r) s0[r] = negM;
#pragma unroll
                    for (int ks = 0; ks < 4; ++ks) { const int cc = 2 * ks + hh; const unsigned ko = (unsigned)(r32 * 128 + ((cc ^ ((r32 >> 1) & 7)) << 4));
                        const bf16x8 a0 = *(const LAS bf16x8*)(Kb + ko + kb * 4096);
                        s0 = MFMA32(a0, qf[ks], s0); }
#pragma unroll
                    for (int r = 0; r < 16; ++r) { s0[r] = __builtin_amdgcn_exp2f(s0[r]); l += s0[r]; }
                    u32x4 w;
                    w.x = pk2(s0[0], s0[1]); w.y = pk2(s0[2], s0[3]); w.z = pk2(s0[4], s0[5]); w.w = pk2(s0[6], s0[7]); pa[2 * kb] = __builtin_bit_cast(bf16x8, w);
                    w.x = pk2(s0[8], s0[9]); w.y = pk2(s0[10], s0[11]); w.z = pk2(s0[12], s0[13]); w.w = pk2(s0[14], s0[15]); pa[2 * kb + 1] = __builtin_bit_cast(bf16x8, w);
                    __builtin_amdgcn_sched_barrier(0);
                }
#pragma unroll
                for (int e = 0; e < 4; ++e) {
#pragma unroll
                    for (int kk = 0; kk < 4; ++kk) { const s16x4 lo = vtr(Vb + e * 4096 + kk * 1024 + vrd), hi = vtr(Vb + e * 4096 + kk * 1024 + 512 + vrd);
                        const bf16x8 vf = (bf16x8){lo[0], lo[1], lo[2], lo[3], hi[0], hi[1], hi[2], hi[3]};
                        o[e] = MFMA32(pa[kk], vf, o[e]); }
                    __builtin_amdgcn_sched_barrier(0); }
            }
            VM_WAIT(); __syncthreads();
        }
#undef ATT_STAGE
        l = sum_halves(l);
        LAS float* ls = (LAS float*)(lds + A_LS) + wid * 64 + comp * 32;
        if (hh == 0) ls[r32] = l;
        LDS_WAIT(); asm volatile("" ::: "memory");
        float inv[16];
#pragma unroll
        for (int r = 0; r < 16; ++r) inv[r] = 1.0f / ls[crow(r, hh)];
        LAS unsigned* o0 = (LAS unsigned*)(lds + A_O0) + wid * 2048 + lane;
        if (comp == 0) {
#pragma unroll
            for (int e = 0; e < 4; ++e)
#pragma unroll
                for (int i = 0; i < 8; ++i) o0[(e * 8 + i) * 64] = pk2(o[e][2 * i] * inv[2 * i], o[e][2 * i + 1] * inv[2 * i + 1]);
        } else {
            float ss[16];
#pragma unroll
            for (int r = 0; r < 16; ++r) ss[r] = 0.f;
#pragma unroll
            for (int e = 0; e < 4; ++e)
#pragma unroll
                for (int i = 0; i < 8; ++i) { const unsigned w = o0[(e * 8 + i) * 64];
                    const float v0 = bflo(w) - lam * o[e][2 * i] * inv[2 * i], v1 = bfhi(w) - lam * o[e][2 * i + 1] * inv[2 * i + 1];
                    o[e][2 * i] = v0; o[e][2 * i + 1] = v1; ss[2 * i] += v0 * v0; ss[2 * i + 1] += v1 * v1; }
#pragma unroll
            for (int r = 0; r < 16; ++r) { float s = ss[r]; s += sx<1>(s); s += sx<2>(s); s += sx<4>(s); s += sx<8>(s); s += sx<16>(s);
                ss[r] = rsqrtf(s * (1.0f / 128.0f) + EPS) * oscale; }
            LAS unsigned char* stg = lds + A_O0 + wid * 8192;
            const int lane_e = olane(), r32e = lane_e & 31;
            LDS_WAIT(); asm volatile("" ::: "memory");
#pragma unroll
            for (int e = 0; e < 4; ++e) { const float gsub = subg[32 * e + r32e];
#pragma unroll
                for (int r = 0; r < 16; ++r) { const float y = ((DBG_GROUPS & 2) != 0) ? o[e][r] * ss[r] * gsub : 0.f;
                    *(LAS unsigned short*)(stg + crow(r, hh) * 256 + (32 * e + r32) * 2) = (unsigned short)(pk2(y, 0.f) & 0xffffu); } }
            LDS_WAIT(); asm volatile("" ::: "memory");
            { unsigned ob = (unsigned)(((q0 + (lane_e >> 4)) * DM + 256 + (lane_e & 15) * 8) * 2); char* Mb = (char*)(MIX + rowbase * DM + h * 128);
#pragma unroll
              for (int i = 0; i < 8; ++i) { const u32x4 w = *(const LAS u32x4*)(stg + ((lane_e >> 4) + 4 * i) * 256 + (lane_e & 15) * 16); *(u32x4*)(Mb + ob + i * 4 * DM * 2) = w; } }
            LDS_WAIT(); asm volatile("" ::: "memory");
        }
    }
}
}

struct Args { const float* in[25]; float* out; unsigned char* ws; int ph_lo, ph_hi; };
static_assert(sizeof(Args) == 27 * 8 + 8, "Args has no padding");
constexpr int NPHASE = 1 + 9 * DEPTH;

__global__ void __launch_bounds__(NWAVES * 64, 2) fwd(Args args) {
    extern __shared__ __attribute__((aligned(16))) unsigned char lds_raw[];
    LAS unsigned char* lds = (LAS unsigned char*)lds_raw;
    const int wave = __builtin_amdgcn_readfirstlane((int)threadIdx.x >> 6); const int g_wave = wave; const int tid0 = otid();
    const int G = gridDim.x; const int bx = blockIdx.x; const int vcu = (G % 8 == 0) ? (bx % 8) * (G / 8) + bx / 8 : bx;
    const int gw = vcu * NWAVES + wave, NGW = G * NWAVES;
    __builtin_assume(gw >= 0 && gw < 4096 && vcu >= 0 && vcu < 512 && G > 0 && G <= 512);
    unsigned char* ws = args.ws;
    unsigned* ctl = (unsigned*)(ws + WS_CTL);
    for (int u = tid0; u < (LDS_BYTES - LDSCTL_OFF) / 4; u += NWAVES * 64) ((LAS unsigned*)(lds + LDSCTL_OFF))[u] = 0u;
    __syncthreads();
    XcdBarrier bar; bar.bar = ctl + CW_BAR; bar.x = 0; bar.st = nullptr;
    if (MK_N_LAUNCHES == 1) bar = xcd_barrier_post(ctl + CW_BAR, (volatile LAS unsigned*)(lds + MISC_OFF) + 8, tid0 == 0);
    const int lo = args.ph_lo, hi = args.ph_hi;
#ifndef PHMASK
#define PHMASK 0x3ff
#endif
#define IN(k) (lo <= (k) && (k) < hi)
#define PHON(j) ((PHMASK >> (j)) & 1)
#define SEAM(k) do { if (IN(k) && IN((k) + 1)) xcd_barrier(bar, otid() == 0); } while (0)
    if (tid0 == 0) {
#pragma unroll
        for (int k = 0; k < 25; ++k) ((LAS unsigned long long*)(lds + PTR_OFF))[k] = (unsigned long long)args.in[k];
    }
    __syncthreads();
    float* xout = args.out;
#define WSP(Tp, off) ((Tp*)(wsl + (off)))
#define WSL() unsigned char* wsl = ws; asm volatile("" : "+s"(wsl))

    if (PHON(0) && IN(0)) {
        const int tid = otid(), lane = tid & 63; WSL();
        const float* c_in = INF(1); const int* pos_in = (const int*)INF(2); const float* w_mod = INF(3); const float* b_mod = INF(4); const float* w_in = INF(7);
        const float* diff_q_g = INF(9); const float* diff_k_g = INF(10); const float* lam_q1 = INF(11); const float* lam_k1 = INF(12); const float* lam_q2 = INF(13); const float* lam_k2 = INF(14);
        const float* gla_w_a2 = INF(16); const float* w_out = INF(19); const float* w_gate = INF(22); const float* w_up = INF(23); const float* w_down = INF(24);
        float* mod = WSP(float, WS_MOD); float* scal = WSP(float, WS_SCAL); f32x2* csr = WSP(f32x2, WS_CSR); f32x2* csd = WSP(f32x2, WS_CSD);
        bf16* Wout_t = WSP(bf16, WS_WOUT); bf16* W2 = WSP(bf16, WS_W2);
        LAS unsigned char* scr = lds + wave * 8704;
        LAS float* sact = (LAS float*)(lds + 69632);
        for (int i = tid; i < 8 * 1024; i += NWAVES * 64) sact[i] = silu_f(c_in[i]);
        __syncthreads();
        { unsigned char* Winq = WSP(unsigned char, WS_WIN); float* swin = WSP(float, WS_SWIN);
          constexpr int U_WIN = 2 * 53, U_LA = 4, U_W1 = 2 * 32 * 16;
#pragma unroll 1
          for (int bu = vcu; bu < U_WIN; bu += G) { const int l = bu / 53, st = bu % 53; quant_strip<false>(lds, w_in + (size_t)l * 1024 * IN_W, IN_W, 64 * st, Winq + (size_t)l * NP * 1024, swin + l * NP, 1, nullptr, wave, lane); }
#pragma unroll 1
          for (int bu = vcu; bu < U_W1; bu += G) { const int le = bu >> 4, st = bu & 15;
              quant_strip<false>(lds, (st < 8 ? w_gate : w_up) + (size_t)le * 1024 * 512, 512, 64 * (st & 7), WSP(unsigned char, WS_W1) + (size_t)le * 1024 * 1024, WSP(float, WS_SW1) + (size_t)le * 1024, st < 8 ? 2 : 3, nullptr, wave, lane); }
#pragma unroll 1
          for (int bu = G - 1 - vcu; bu < U_LA; bu += G) { const int l = bu >> 1, st = bu & 1; quant_strip<true>(lds, w_in + (size_t)l * 1024 * IN_W, IN_W, 64 * st, Winq + (size_t)l * NP * 1024, swin + l * NP, 1, gla_w_a2 + (size_t)l * 16 * 128, wave, lane); }
        }
        constexpr int I_MOD = 2 * 384, I_TABR = 1024, I_TABD = 1024, I_ZERO = 256, I_SC = 2;
        constexpr int I_WOUT = 16 * 16, I_DN = 8 * 16, I_LAYER = I_WOUT + 32 * I_DN;
        constexpr int I_PRE = I_MOD + I_TABR + I_TABD + I_ZERO + I_SC, NITEMS = I_PRE + 2 * I_LAYER;
        _Pragma("unroll 1") for (int rep_ = 0; rep_ < 1 + (RPT_PHASE == 100 ? RPT_N : 0); ++rep_)
        for (int it = gw; it < NITEMS; it += NGW) {
            int r = it;
            if (r < I_MOD) {
                const int l = r / 384, col = (r % 384) * 16 + (lane & 15), ks = lane >> 4;
                float acc[8] = {0.f, 0.f, 0.f, 0.f, 0.f, 0.f, 0.f, 0.f};
                const float* wp = w_mod + (size_t)l * 1024 * 6144 + col;
#pragma unroll 16
                for (int k = ks; k < 1024; k += 4) { const float w = wp[(size_t)k * 6144];
#pragma unroll
                    for (int b = 0; b < 8; ++b) acc[b] += sact[b * 1024 + k] * w; }
#pragma unroll
                for (int b = 0; b < 8; ++b) { float a = acc[b]; a += sx<16>(a); a = sum_halves(a); if (ks == 0) mod[((size_t)l * 8 + b) * 6144 + col] = a + b_mod[l * 6144 + col]; }
                continue; }
            r -= I_MOD;
            if (r < I_TABR) {
                const int i = lane & 31; const float inv_freq = exp2f(-((float)i * (1.0f / 32.0f)) * 13.287712379549449f);
                for (int s = 0; s < 32; ++s) { const int t = r * 64 + 2 * s + (lane >> 5); const float ang = (float)pos_in[t] * inv_freq; float sn, cs; sincosf(ang, &sn, &cs); csr[(size_t)t * 32 + i] = (f32x2){cs, sn}; }
                continue; }
            r -= I_TABR;
            if (r < I_TABD) {
                const int i = lane & 7; const float inv_freq = exp2f(-((float)i * (1.0f / 8.0f)) * 18.931568569324174f);
                for (int s = 0; s < 8; ++s) { const int t = r * 64 + 8 * s + (lane >> 3); const float ang = (float)pos_in[t] * inv_freq; float sn, cs; sincosf(ang, &sn, &cs); csd[(size_t)t * 8 + i] = (f32x2){cs, sn}; }
                continue; }
            r -= I_TABD;
            if (r < I_ZERO) {
                const int l = r >> 7, j = r & 127; u32x4* p = (u32x4*)(WSP(unsigned char, WS_WIN) + ((size_t)l * NP + C_PAD + j) * 1024);
                p[lane] = (u32x4){0u, 0u, 0u, 0u}; if (lane == 0) WSP(float, WS_SWIN)[l * NP + C_PAD + j] = 1.0f;
                continue; }
            r -= I_ZERO;
            if (r < I_SC) {
                const int l = r; const float s1 = wave_sum(lam_q1[l * 64 + lane] * lam_k1[l * 64 + lane]), s2 = wave_sum(lam_q2[l * 64 + lane] * lam_k2[l * 64 + lane]);
                const float mq = wave_max(fabsf(diff_q_g[l * 64 + lane])), mk = wave_max(fabsf(diff_k_g[l * 64 + lane]));
                const float lam_init = 0.8f - 0.6f * expf(-0.3f * (float)l);
                if (lane == 0) { scal[l * 4 + 0] = expf(s1) - expf(s2) + lam_init; scal[l * 4 + 1] = -(8.0f * mq * mk * LOG2E + 0.5f); scal[l * 4 + 2] = 1.0f - lam_init; }
                continue; }
            r -= I_SC;
            const int l = r / I_LAYER; r -= l * I_LAYER;
            if (r < I_WOUT) { tr_item(w_out + (size_t)l * 1024 * 1024, 1024, 1024, Wout_t + (size_t)l * 1024 * 1024, 1024, 0, scr, r, lane); continue; } r -= I_WOUT;
            const int e = r / I_DN; r -= e * I_DN; const size_t le = (size_t)l * 32 + e;
            tr_item(w_down + le * 512 * 1024, 512, 1024, W2 + le * 1024 * 512, 512, 0, scr, r, lane);
        }
        __syncthreads();
    }
    SEAM(0);

    for (int l = 0; l < DEPTH; ++l) {
        const int pb = 1 + 9 * l;
#define XIN ((l == 0) ? INF(0) : (const float*)xout)
#define MODL (WSP(const float, WS_MOD) + (size_t)l * 8 * 6144)
        if (PHON(1) && IN(pb + 0)) {
            const int tid = otid(), lane = tid & 63; (void)tid; (void)lane; WSL();
            const float* xin = XIN; const float* modl = MODL; const float* norm1_g = INF(5); unsigned char* ACTq = WSP(unsigned char, WS_ACT); float* sa1 = WSP(float, WS_SA1);
            const float* g1 = norm1_g + l * 1024;
            _Pragma("unroll 1") for (int rep_ = 0; rep_ < 1 + (RPT_PHASE == 1 ? RPT_N : 0); ++rep_)
            for (int m0 = gw; m0 < T; m0 += 4 * NGW) {
                f32x4 v[4][4];
#pragma unroll
                for (int q = 0; q < 4; ++q) { const int mq = m0 + q * NGW, m = mq < T ? mq : T - 1; const f32x4* xr = (const f32x4*)(xin + (size_t)m * DM) + lane;
#pragma unroll
                    for (int j = 0; j < 4; ++j) v[q][j] = xr[64 * j]; }
#pragma unroll
                for (int q = 0; q < 4; ++q) { const int m = m0 + q * NGW; if (m < T) {
                    const int b = m >> 13; const float* mb = modl + (size_t)b * 6144; float s = 0.f;
#pragma unroll
                    for (int j = 0; j < 4; ++j) s += (v[q][j][0] * v[q][j][0] + v[q][j][1] * v[q][j][1]) + (v[q][j][2] * v[q][j][2] + v[q][j][3] * v[q][j][3]);
                    const float rstd = rsqrtf(wave_sum(s) * (1.0f / 1024.0f) + EPS);
                    f32x4 y[4]; float am = 0.f;
#pragma unroll
                    for (int j = 0; j < 4; ++j) { const int k = 4 * lane + 256 * j; const f32x4 gg = *(const f32x4*)(g1 + k), sh = *(const f32x4*)(mb + k), sc = *(const f32x4*)(mb + 1024 + k);
                        y[j] = v[q][j] * rstd * gg * (sc + 1.0f) + sh; am = fmaxf(am, fmaxf(fmaxf(fabsf(y[j][0]), fabsf(y[j][1])), fmaxf(fabsf(y[j][2]), fabsf(y[j][3])))); }
                    am = wave_max(am); const float inv = am > 0.f ? 127.0f / am : 0.f;
                    if (lane == 0) sa1[m] = am > 0.f ? am * (1.0f / 127.0f) : 1.0f;
                    unsigned* o4 = (unsigned*)(ACTq + (size_t)m * 1024) + lane;
#pragma unroll
                    for (int j = 0; j < 4; ++j) { unsigned w = 0u;
#pragma unroll
                        for (int e = 0; e < 4; ++e) w |= ((unsigned)(int)__builtin_rintf(y[j][e] * inv) & 0xffu) << (8 * e);
                        o4[64 * j] = w; } } }
            }
        }
        SEAM(pb + 0);
        if (PHON(2) && IN(pb + 1)) {
            const int tid = otid(), lane = tid & 63; (void)tid; (void)lane; WSL();
            bf16* ACT = WSP(bf16, WS_ACT); bf16* P = WSP(bf16, WS_P);
            pg8::Gemm g{ACT, (const bf16*)(WSP(unsigned char, WS_WIN) + (size_t)l * NP * 1024), 512, 512, 512}; pg8::StaticOrder<T / 256, NP / 256> S; S.init(G, bx);
            pg8::EpiInproj E{P, NP, WSP(const float, WS_SA1), WSP(const float, WS_SWIN) + l * NP};
            _Pragma("unroll 1") for (int rep_ = 0; rep_ < 1 + (RPT_PHASE == 2 ? RPT_N : 0); ++rep_)
            pg8::gemm_phase<pg8::EpiInproj, pg8::StaticOrder<T / 256, NP / 256>, 0, true>(lds, g, S, E, g_wave);
        }
        SEAM(pb + 1);
        if (PHON(3) && IN(pb + 2)) {
            const int tid = otid(), lane = tid & 63; (void)tid; (void)lane; WSL();
            const float* diff_q_g = INF(9); const float* diff_k_g = INF(10); const float* gla_b_a = INF(17); bf16* P = WSP(bf16, WS_P); bf16* ACT = WSP(bf16, WS_ACT); f32x2* csr = WSP(f32x2, WS_CSR); f32x2* csd = WSP(f32x2, WS_CSD);
            float* Eret = WSP(float, WS_EST); float* Egla = WSP(float, WS_EGL); float* Asr = WSP(float, WS_ASR); float* Asg = WSP(float, WS_ASG);
            const float* gq = diff_q_g + l * 64; const float* gk = diff_k_g + l * 64;
            for (int m = gw; m < T; m += NGW) {
                bf16* p = P + (size_t)m * NP + C_DQ + 16 * lane;
                const u32x4 w0 = *(const u32x4*)p, w1 = *(const u32x4*)(p + 8);
                float v[16];
                { const unsigned* a = (const unsigned*)&w0; const unsigned* c = (const unsigned*)&w1;
#pragma unroll
                  for (int i = 0; i < 4; ++i) { v[2 * i] = bflo(a[i]); v[2 * i + 1] = bfhi(a[i]); v[8 + 2 * i] = bflo(c[i]); v[8 + 2 * i + 1] = bfhi(c[i]); } }
                float ss = 0.f;
#pragma unroll
                for (int i = 0; i < 16; ++i) ss += v[i] * v[i];
                ss += sx<1>(ss); ss += sx<2>(ss);
                const float rstd = rsqrtf(ss * (1.0f / 64.0f) + EPS);
                const bool isq = lane < 32; const float* gg = (isq ? gq : gk) + (lane & 3) * 16;
#pragma unroll
                for (int i = 0; i < 16; ++i) v[i] = v[i] * rstd * gg[i];
                if ((lane & 3) == 0) { const f32x4* cs4 = (const f32x4*)(csd + (size_t)m * 8);
#pragma unroll
                    for (int i = 0; i < 4; ++i) { const f32x4 cc = cs4[i];
                        const float a0 = v[2 * i], b0 = v[2 * i + 8], a1 = v[2 * i + 1], b1 = v[2 * i + 9];
                        v[2 * i] = a0 * cc[0] - b0 * cc[1]; v[2 * i + 8] = a0 * cc[1] + b0 * cc[0]; v[2 * i + 1] = a1 * cc[2] - b1 * cc[3]; v[2 * i + 9] = a1 * cc[3] + b1 * cc[2]; } }
                const float qs = isq ? 0.125f * LOG2E : 1.0f;
                u32x4 o0, o1;
                o0.x = pk2(v[0] * qs, v[1] * qs); o0.y = pk2(v[2] * qs, v[3] * qs); o0.z = pk2(v[4] * qs, v[5] * qs); o0.w = pk2(v[6] * qs, v[7] * qs);
                o1.x = pk2(v[8] * qs, v[9] * qs); o1.y = pk2(v[10] * qs, v[11] * qs); o1.z = pk2(v[12] * qs, v[13] * qs); o1.w = pk2(v[14] * qs, v[15] * qs);
                *(u32x4*)p = o0; *(u32x4*)(p + 8) = o1;
            }
            _Pragma("unroll 1") for (int rep_ = 0; rep_ < 1 + (RPT_PHASE == 31 ? RPT_N : 0); ++rep_)
            for (int u = vcu; u < 1024; u += G) {
                const int r = u & 511, bh = r >> 4, seg = r & 15;
                if (u < 512) lin::unit<64, true, false>(lds, P, ACT, csr, bh >> 2, bh & 3, seg, nullptr, nullptr, Eret, Asr, g_wave);
                else lin::unit<32, false, false>(lds, P, ACT, csr, bh >> 2, bh & 3, seg, gla_b_a + l * 128, nullptr, Egla, Asg, g_wave);
            }
        }
        SEAM(pb + 2);
        if (PHON(4) && IN(pb + 3)) {
            const int tid = otid(), lane = tid & 63; (void)tid; (void)lane; WSL();
            const float* scal = WSP(const float, WS_SCAL); const float* diff_sub_g = INF(15); const float* ret_norm_g = INF(8); const float* gla_norm_g = INF(18); const float* gla_b_a = INF(17); bf16* P = WSP(bf16, WS_P); bf16* ACT = WSP(bf16, WS_ACT); f32x2* csr = WSP(f32x2, WS_CSR);
            float* Eret = WSP(float, WS_EST); float* Egla = WSP(float, WS_EGL); float* Asr = WSP(float, WS_ASR); float* Asg = WSP(float, WS_ASG);
            const float lam = scal[l * 4 + 0], negM = scal[l * 4 + 1], osc = scal[l * 4 + 2];
#ifndef NO_ATT
            _Pragma("unroll 1") for (int rep_ = 0; rep_ < 1 + (RPT_PHASE == 41 ? RPT_N : 0); ++rep_)
            for (int pu = vcu; pu < 512; pu += G) {
                const int bh = pu >> 4, jp = pu & 15;
                att::unit(lds, P, ACT, bh >> 2, bh & 3, jp, lam, negM, diff_sub_g + l * 128, osc, g_wave);
                att::unit(lds, P, ACT, bh >> 2, bh & 3, 31 - jp, lam, negM, diff_sub_g + l * 128, osc, g_wave);
            }
#endif
#ifndef NO_LIN2
            _Pragma("unroll 1") for (int rep_ = 0; rep_ < 1 + (RPT_PHASE == 42 ? RPT_N : 0); ++rep_)
            for (int u = vcu; u < 1024; u += G) {
                const int r = u & 511, bh = r >> 4, seg = r & 15;
                if (u < 512) lin::unit<64, true, true>(lds, P, ACT, csr, bh >> 2, bh & 3, seg, nullptr, ret_norm_g + l * 64, Eret, Asr, g_wave);
                else lin::unit<32, false, true>(lds, P, ACT, csr, bh >> 2, bh & 3, seg, gla_b_a + l * 128, gla_norm_g + l * 64, Egla, Asg, g_wave);
            }
#endif
        }
        SEAM(pb + 3);
        if (PHON(5) && IN(pb + 4)) {
            const int tid = otid(), lane = tid & 63; (void)tid; (void)lane; WSL();
            const float* xin = XIN; const float* modl = MODL; bf16* ACT = WSP(bf16, WS_ACT); bf16* Wout_t = WSP(bf16, WS_WOUT);
            pg8::Gemm g{ACT, Wout_t + (size_t)l * 1024 * 1024, 1024, 1024, 1024}; pg8::StaticOrder<T / 256, 4> S; S.init(G, bx);
            pg8::EpiResid E{xin, xout, modl + 2048};
            _Pragma("unroll 1") for (int rep_ = 0; rep_ < 1 + ((RPT_PHASE == 5 && l == 0) ? RPT_N : 0); ++rep_)
            pg8::gemm_phase<pg8::EpiResid, pg8::StaticOrder<T / 256, 4>, 0>(lds, g, S, E, g_wave);
        }
        SEAM(pb + 4);
        if (PHON(6) && IN(pb + 5)) {
            const int tid = otid(), lane = tid & 63; (void)tid; (void)lane; WSL();
            const float* modl = MODL; const float* router_w = INF(20); const float* router_b = INF(21); const float* norm2_g = INF(6); bf16* ACT = WSP(bf16, WS_ACT); int* tokinfo = WSP(int, WS_ROUTE); int* tokS = WSP(int, WS_TOKS); unsigned char* h2q = WSP(unsigned char, WS_H2Q); float* sa2 = WSP(float, WS_SA2);
            constexpr int WR_PITCH = 2064, LG_OFF = 32 * WR_PITCH;
#pragma unroll 4
            for (int i = tid; i < 32768; i += NWAVES * 64) { const int k = i >> 5, e = i & 31; *(LAS unsigned short*)(lds + e * WR_PITCH + k * 2) = (unsigned short)(pk2(router_w[i], 0.f) & 0xffffu); }
            { int Gl = G; asm volatile("" : "+s"(Gl));
#pragma unroll 1
              for (int i = bx * NWAVES * 64 + tid; i < TPAD; i += Gl * NWAVES * 64) tokS[i] = -1; }
            __syncthreads();
            const float* g2 = norm2_g + l * 1024;
            LAS float* lg = (LAS float*)(lds + LG_OFF + wave * 2112);
            unsigned* cnt = ctl + CW_CNT + l * 64;
            for (int gi = gw; gi < T / 16; gi += NGW) {
                for (int r4 = 0; r4 < 16; r4 += 4) {
                    f32x4 v[4][4];
#pragma unroll
                    for (int q = 0; q < 4; ++q) { const f32x4* xr = (const f32x4*)(xout + (size_t)(gi * 16 + r4 + q) * DM) + lane;
#pragma unroll
                        for (int j = 0; j < 4; ++j) v[q][j] = xr[64 * j]; }
#pragma unroll
                    for (int q = 0; q < 4; ++q) { const int m = gi * 16 + r4 + q; const int b = m >> 13; const float* mb = modl + (size_t)b * 6144 + 3072; float s = 0.f;
#pragma unroll
                        for (int j = 0; j < 4; ++j) s += (v[q][j][0] * v[q][j][0] + v[q][j][1] * v[q][j][1]) + (v[q][j][2] * v[q][j][2] + v[q][j][3] * v[q][j][3]);
                        const float rstd = rsqrtf(wave_sum(s) * (1.0f / 1024.0f) + EPS);
                        u32x2* o8 = (u32x2*)(ACT + (size_t)m * DM) + lane; f32x4 y[4]; float am = 0.f;
#pragma unroll
                        for (int j = 0; j < 4; ++j) { const int k = 4 * lane + 256 * j; const f32x4 gg = *(const f32x4*)(g2 + k), sh = *(const f32x4*)(mb + k), sc = *(const f32x4*)(mb + 1024 + k);
                            y[j] = v[q][j] * rstd * gg * (sc + 1.0f) + sh; u32x2 w; w.x = pk2(y[j][0], y[j][1]); w.y = pk2(y[j][2], y[j][3]); o8[64 * j] = w;
                            am = fmaxf(am, fmaxf(fmaxf(fabsf(y[j][0]), fabsf(y[j][1])), fmaxf(fabsf(y[j][2]), fabsf(y[j][3])))); }
                        am = wave_max(am); const float inv = am > 0.f ? 127.0f / am : 0.f;
                        if (lane == 0) sa2[m] = am > 0.f ? am * (1.0f / 127.0f) : 1.0f;
                        unsigned* o4 = (unsigned*)(h2q + (size_t)m * 1024) + lane;
#pragma unroll
                        for (int j = 0; j < 4; ++j) { unsigned w = 0u;
#pragma unroll
                            for (int e = 0; e < 4; ++e) w |= ((unsigned)(int)__builtin_rintf(y[j][e] * inv) & 0xffu) << (8 * e);
                            o4[64 * j] = w; } }
                }
                VM_WAIT();
                f32x4 a0 = (f32x4){0.f, 0.f, 0.f, 0.f}, a1 = a0;
                const bf16* ap = ACT + (size_t)(gi * 16 + (lane & 15)) * DM + 8 * (lane >> 4);
#pragma unroll 4
                for (int ks = 0; ks < 32; ++ks) { const bf16x8 a = *(const bf16x8*)(ap + 32 * ks);
                    const bf16x8 b0 = *(const LAS bf16x8*)(lds + (lane & 15) * WR_PITCH + (32 * ks + 8 * (lane >> 4)) * 2), b1 = *(const LAS bf16x8*)(lds + (16 + (lane & 15)) * WR_PITCH + (32 * ks + 8 * (lane >> 4)) * 2);
                    a0 = MFMA16(a, b0, a0); a1 = MFMA16(a, b1, a1); }
#pragma unroll
                for (int r = 0; r < 4; ++r) { lg[(4 * (lane >> 4) + r) * 33 + (lane & 15)] = a0[r]; lg[(4 * (lane >> 4) + r) * 33 + 16 + (lane & 15)] = a1[r]; }
                LDS_WAIT(); asm volatile("" ::: "memory");
                if (lane < 16) {
                    const int m = gi * 16 + lane; float best = -3.0e38f; int bcls = 0; float bwa = 0.f, bwb = 0.f;
#pragma unroll
                    for (int g = 0; g < 8; ++g) {
                        float s[4], a[4];
#pragma unroll
                        for (int i = 0; i < 4; ++i) { s[i] = 1.0f / (1.0f + __expf(-lg[lane * 33 + 4 * g + i])); a[i] = s[i] + router_b[4 * g + i]; }
                        int i1 = 0; float v1 = a[0];
                        if (a[1] > v1) { v1 = a[1]; i1 = 1; } if (a[2] > v1) { v1 = a[2]; i1 = 2; } if (a[3] > v1) { v1 = a[3]; i1 = 3; }
                        int i2 = -1; float v2 = -3.0e38f;
                        if (i1 != 0 && a[0] > v2) { v2 = a[0]; i2 = 0; } if (i1 != 1 && a[1] > v2) { v2 = a[1]; i2 = 1; } if (i1 != 2 && a[2] > v2) { v2 = a[2]; i2 = 2; } if (i1 != 3 && a[3] > v2) { v2 = a[3]; i2 = 3; }
                        const float gsum = v1 + v2;
                        const int ea = i1 < i2 ? i1 : i2, eb = i1 < i2 ? i2 : i1;
                        const float sa = ea == 0 ? s[0] : (ea == 1 ? s[1] : s[2]), sb = eb == 1 ? s[1] : (eb == 2 ? s[2] : s[3]);
                        const int pidx = (ea * (7 - ea)) / 2 + (eb - ea - 1);
                        if (gsum > best) { best = gsum; bcls = g * 6 + pidx; const float den = 1.0f / (sa + sb); bwa = sa * den; bwb = sb * den; }
                    }
                    const unsigned rank = atomicAdd(cnt + bcls, 1u);
                    *(u32x4*)(tokinfo + (size_t)m * 4) = (u32x4){(unsigned)bcls, rank, __float_as_uint(bwa), __float_as_uint(bwb)};
                }
                LDS_WAIT(); asm volatile("" ::: "memory");
            }
            __syncthreads();
        }
        SEAM(pb + 5);
        if (PHON(7) && IN(pb + 6)) {
            const int tid = otid(), lane = tid & 63; (void)tid; (void)lane; WSL();
            const unsigned char* h2q = WSP(const unsigned char, WS_H2Q); unsigned char* H2S = WSP(unsigned char, WS_H2S); const float* sa2 = WSP(const float, WS_SA2); float* saS = WSP(float, WS_SAS); int* tokinfo = WSP(int, WS_ROUTE); int* tokS = WSP(int, WS_TOKS); float* gaS = WSP(float, WS_GAS); float* gbS = WSP(float, WS_GBS); int* tinfo = WSP(int, WS_TINFO);
            LAS int* cst = (LAS int*)lds;
            if (tid == 0) { const unsigned* cnt = ctl + CW_CNT + l * 64; int s = 0, nt = 0;
                for (int c = 0; c < NCLS; ++c) { const int n = (int)__hip_atomic_load(cnt + c, __ATOMIC_RELAXED, __HIP_MEMORY_SCOPE_AGENT); cst[c] = s; const int tl = (n + 255) >> 8;
                    if (bx == 0) { const int g = c / 6, p = c % 6; const int a = p < 3 ? 0 : (p < 5 ? 1 : 2); const int bb = p < 3 ? p + 1 : (p < 5 ? p - 1 : 3); const int code = (g * 4 + a) | ((g * 4 + bb) << 8);
                        for (int i = 0; i < tl; ++i) tinfo[1 + nt + i] = code; }
                    nt += tl; s += tl * 256; }
                if (bx == 0) tinfo[0] = nt; }
            __syncthreads();
            _Pragma("unroll 1") for (int rep_ = 0; rep_ < 1 + (RPT_PHASE == 7 ? RPT_N : 0); ++rep_)
            for (int m = gw; m < T; m += NGW) {
                const u32x4 inf = *(const u32x4*)(tokinfo + (size_t)m * 4);
                const int slot = cst[inf.x] + (int)inf.y;
                const u32x4* src = (const u32x4*)(h2q + (size_t)m * 1024); u32x4* dst = (u32x4*)(H2S + (size_t)slot * 1024);
                dst[lane] = src[lane];
                if (lane == 0) { tokS[slot] = m; gaS[slot] = __uint_as_float(inf.z); gbS[slot] = __uint_as_float(inf.w); saS[slot] = sa2[m]; }
            }
            __syncthreads();
        }
        SEAM(pb + 6);
        if (PHON(8) && IN(pb + 7)) {
            const int tid = otid(), lane = tid & 63; (void)tid; (void)lane; WSL();
            bf16* H2S = WSP(bf16, WS_H2S); bf16* U = WSP(bf16, WS_U); float* gaS = WSP(float, WS_GAS); float* gbS = WSP(float, WS_GBS); int* tinfo = WSP(int, WS_TINFO);
            pg8::Gemm g{H2S, (const bf16*)(WSP(unsigned char, WS_W1) + (size_t)l * 32 * 1024 * 1024), 512, 512, 512}; pg8::MoeOrder<8, 1> S{tinfo, G, vcu};
            pg8::EpiMoe1 E{U, gaS, gbS, WSP(const float, WS_SAS), WSP(const float, WS_SW1) + (size_t)l * 32 * 1024};
            _Pragma("unroll 1") for (int rep_ = 0; rep_ < 1 + (RPT_PHASE == 8 ? RPT_N : 0); ++rep_)
            pg8::gemm_phase<pg8::EpiMoe1, pg8::MoeOrder<8, 1>, 0, true>(lds, g, S, E, g_wave);
        }
        SEAM(pb + 7);
        if (PHON(9) && IN(pb + 8)) {
            const int tid = otid(), lane = tid & 63; (void)tid; (void)lane; WSL();
            const float* modl = MODL; bf16* U = WSP(bf16, WS_U); bf16* W2 = WSP(bf16, WS_W2); int* tokS = WSP(int, WS_TOKS); int* tinfo = WSP(int, WS_TINFO);
            pg8::Gemm g{U, W2 + (size_t)l * 32 * 1024 * 512, 1024, 1024, 512}; pg8::MoeOrder<4, 2> S{tinfo, G, vcu};
            pg8::EpiMoe2 E{xout, tokS, modl + 5 * 1024};
            pg8::gemm_phase<pg8::EpiMoe2, pg8::MoeOrder<4, 2>, 8>(lds, g, S, E, g_wave);
        }
        SEAM(pb + 8);
    }
#undef IN
#undef SEAM
}

extern "C" void kernel_launch(void* const* d_in, const int* in_sizes, int n_in, void* d_out, int out_size, void* d_ws, size_t ws_size, hipStream_t stream) {
    static int grid = 0;
    if (grid == 0) {
        if (n_in != 25 || in_sizes[0] != T * DM || out_size != T * DM || ws_size < WS_END) { fprintf(stderr, "kernel_launch: unexpected shapes (n_in %d, in0 %d, out %d, ws %zu < %zu)\n", n_in, n_in > 0 ? in_sizes[0] : -1, out_size, ws_size, (size_t)WS_END); grid = -1; return; }
        int dev = 0, cus = 0, per_cu = 0;
        if (hipGetDevice(&dev) != hipSuccess || hipDeviceGetAttribute(&cus, hipDeviceAttributeMultiprocessorCount, dev) != hipSuccess) { grid = -1; return; }
        if (hipFuncSetAttribute((const void*)fwd, hipFuncAttributeMaxDynamicSharedMemorySize, LDS_BYTES) != hipSuccess) { fprintf(stderr, "kernel_launch: hipFuncSetAttribute failed\n"); grid = -1; return; }
        if (hipOccupancyMaxActiveBlocksPerMultiprocessor(&per_cu, (const void*)fwd, NWAVES * 64, LDS_BYTES) != hipSuccess || per_cu < 1) fprintf(stderr, "kernel_launch: occupancy query reports %d\n", per_cu);
        (void)hipGetLastError();
        grid = cus;
    }
    if (grid < 0) return;
    if (hipMemsetAsync((char*)d_ws + WS_CTL, 0, CTL_ZERO_BYTES, stream) != hipSuccess) return;
    Args a{};
    for (int i = 0; i < 25; ++i) a.in[i] = (const float*)d_in[i];
    a.out = (float*)d_out; a.ws = (unsigned char*)d_ws;
#if MK_N_LAUNCHES == 1
    a.ph_lo = 0; a.ph_hi = NPHASE;
    hipLaunchKernelGGL(fwd, dim3(grid), dim3(NWAVES * 64), LDS_BYTES, stream, a);
#else
    for (int p = 0; p < NPHASE; ++p) { a.ph_lo = p; a.ph_hi = p + 1; hipLaunchKernelGGL(fwd, dim3(grid), dim3(NWAVES * 64), LDS_BYTES, stream, a); }
#endif
}
```

```cpp
#include <hip/hip_runtime.h>
#include <cstdio>
#include <cstdint>

#ifndef MK_N_LAUNCHES
#define MK_N_LAUNCHES 1
#endif
#ifndef DBG_GROUPS
#define DBG_GROUPS 7
#endif
#ifndef DBG_MOE
#define DBG_MOE 1
#endif
#ifndef RPT_PHASE
#define RPT_PHASE 0
#endif
#ifndef RPT_N
#define RPT_N 1
#endif

#define LAS __attribute__((address_space(3)))
#define GAS __attribute__((address_space(1)))
typedef unsigned short bf16;
typedef short bf16x8 __attribute__((ext_vector_type(8)));
typedef short s16x4 __attribute__((ext_vector_type(4)));
typedef float f32x4 __attribute__((ext_vector_type(4)));
typedef float f32x16 __attribute__((ext_vector_type(16)));
typedef float f32x2 __attribute__((ext_vector_type(2)));
typedef unsigned u32x4 __attribute__((ext_vector_type(4)));
typedef unsigned u32x2 __attribute__((ext_vector_type(2)));
typedef __bf16 bf16x2_t __attribute__((ext_vector_type(2)));
typedef int i32x4 __attribute__((ext_vector_type(4)));

constexpr int BATCH = 8, SEQ = 8192, DM = 1024, T = BATCH * SEQ, DEPTH = 2;
constexpr int NP = 3584;
constexpr int C_RQ = 0, C_RK = 256, C_RV = 512, C_RG = 768, C_DQ = 1024, C_DK = 1536, C_DV = 2048, C_GQ = 2560, C_GK = 2688, C_GV = 2816, C_LA = 3072, C_GR = 3200, C_PAD = 3456;
constexpr int IN_W = 3344;
constexpr int NCLS = 48, TPAD = T + NCLS * 256, MAXTILES = TPAD / 256;
constexpr float EPS = 1e-6f, LOG2E = 1.4426950408889634f;

constexpr size_t MiB = 1u << 20;
constexpr size_t WS_CTL = 0, CTL_ZERO_BYTES = 1 * MiB;
constexpr size_t WS_MOD = 1 * MiB;
constexpr size_t WS_SCAL = WS_MOD + 400 * 1024;
constexpr size_t WS_CSR = 2 * MiB;
constexpr size_t WS_CSD = 19 * MiB;
constexpr size_t WS_WIN = 24 * MiB;
constexpr size_t WS_WOUT = 38 * MiB;
constexpr size_t WS_W1 = 42 * MiB;
constexpr size_t WS_W2 = 170 * MiB;
constexpr size_t WS_ACT = 234 * MiB;
constexpr size_t WS_P = 362 * MiB;
constexpr size_t WS_H2S = WS_P;
constexpr size_t WS_U = WS_P + 152 * MiB;
constexpr size_t WS_EST = 810 * MiB;
constexpr size_t WS_EGL = WS_EST + 8 * MiB, WS_ASR = WS_EST + 12 * MiB, WS_ASG = WS_ASR + 256 * 1024;
constexpr size_t WS_ROUTE = 824 * MiB;
constexpr size_t WS_TOKS = WS_ROUTE + 1 * MiB, WS_GAS = WS_TOKS + 512 * 1024, WS_GBS = WS_GAS + 512 * 1024, WS_TINFO = WS_GBS + 512 * 1024;
constexpr size_t WS_SA1 = 828 * MiB, WS_SA2 = WS_SA1 + 256 * 1024, WS_SAS = WS_SA2 + 256 * 1024, WS_SWIN = WS_SA1 + 1024 * 1024, WS_SW1 = WS_SWIN + 256 * 1024;
constexpr size_t WS_H2Q = 830 * MiB;
constexpr size_t WS_END = 894 * MiB;
static_assert((size_t)TPAD * 1024 * 2 <= 152 * MiB && WS_U + 152 * MiB <= WS_P + (size_t)T * NP * 2, "aliases fit inside P");
static_assert((size_t)T * NP * 2 == 448 * MiB && WS_P + 448 * MiB == WS_EST, "P size");
constexpr int CW_BAR = 4096;
constexpr int CW_CNT = 16384;

constexpr int RING_BYTES = 131072, LDSCTL_OFF = RING_BYTES, MISC_OFF = LDSCTL_OFF + 320, PTR_OFF = MISC_OFF + 128, LDS_BYTES = 147456;
constexpr int NWAVES = 8;

__device__ __forceinline__ unsigned pk2(float lo, float hi) { f32x2 v = {lo, hi}; bf16x2_t b = __builtin_convertvector(v, bf16x2_t); return __builtin_bit_cast(unsigned, b); }
__device__ __forceinline__ float bflo(unsigned w) { return __uint_as_float(w << 16); }
__device__ __forceinline__ float bfhi(unsigned w) { return __uint_as_float(w & 0xffff0000u); }
template <int K> __device__ __forceinline__ float sx(float v) { static_assert(K >= 1 && K < 32, "sx"); return __int_as_float(__builtin_amdgcn_ds_swizzle(__float_as_int(v), (K << 10) | 0x1f)); }
__device__ __forceinline__ float sum_halves(float v) { auto rr = __builtin_amdgcn_permlane32_swap(__float_as_uint(v), __float_as_uint(v), false, false); return __uint_as_float(rr[0]) + __uint_as_float(rr[1]); }
__device__ __forceinline__ float max_halves(float v) { auto rr = __builtin_amdgcn_permlane32_swap(__float_as_uint(v), __float_as_uint(v), false, false); return fmaxf(__uint_as_float(rr[0]), __uint_as_float(rr[1])); }
__device__ __forceinline__ float wave_sum(float v) { v += sx<1>(v); v += sx<2>(v); v += sx<4>(v); v += sx<8>(v); v += sx<16>(v); return sum_halves(v); }
__device__ __forceinline__ float wave_max(float v) { v = fmaxf(v, sx<1>(v)); v = fmaxf(v, sx<2>(v)); v = fmaxf(v, sx<4>(v)); v = fmaxf(v, sx<8>(v)); v = fmaxf(v, sx<16>(v)); return max_halves(v); }
__device__ __forceinline__ float silu_f(float x) { return x * __builtin_amdgcn_rcpf(1.0f + __expf(-x)); }
__device__ __forceinline__ int olane() { int l; asm volatile("v_mbcnt_lo_u32_b32 %0, -1, 0\n\tv_mbcnt_hi_u32_b32 %0, -1, %0" : "=v"(l)); return l; }
__device__ __forceinline__ int otid_w(int wave) { return wave * 64 + olane(); }
#define otid() otid_w(g_wave)
template <class Tp> __device__ __forceinline__ const Tp* inptr(const LAS unsigned char* lds, int k) {
    const LAS unsigned* q = (const LAS unsigned*)(lds + PTR_OFF) + 2 * k; const unsigned lo = __builtin_amdgcn_readfirstlane(q[0]), hi = __builtin_amdgcn_readfirstlane(q[1]);
    return (const Tp*)(((unsigned long long)hi << 32) | lo); }
#define INF(k) inptr<float>(lds, k)
#define LDS_WAIT() asm volatile("s_waitcnt lgkmcnt(0)" ::: "memory")
#define VM_WAIT() asm volatile("s_waitcnt vmcnt(0)" ::: "memory")

namespace pg8 {
constexpr int BM = 256, BK = 64, HALF = 128, HTB = HALF * BK * 2, STAGE_BYTES = 8 * HTB, NXCD = 8, WGM = 8;
__device__ __forceinline__ int lds_byte(int r, int c) { const int st = (r >> 4) * 2 + (c >> 5), rr = r & 15, cc = c & 31, ob = rr * 64 + cc * 2; return st * 1024 + (ob ^ (((ob >> 9) & 1) << 5)); }
__device__ __forceinline__ void stage_rc(int b, int& R, int& C) { const int st = b / 1024, sb = b % 1024, swz = sb ^ (((sb >> 9) & 1) << 5); R = (st >> 1) * 16 + swz / 64; C = (st & 1) * 32 + (swz % 64) / 2; }
__device__ __forceinline__ int perm32(int rho) { const int n = rho >> 4, i = rho & 15; return 8 * (i >> 2) + 4 * n + (i & 3); }

struct Unit { int pm, pn, e0, e1; };
struct Gemm { const bf16* A; const bf16* Bt; int K, lda, ldb; };

template <int NM, int NN> struct StaticOrder {
    static constexpr int nM = NM, nN = NN, nwg = NM * NN;
    int G, c;
    __device__ void init(int G_, int c_) { G = G_; c = c_; }
    __device__ bool next(int i, Unit& u) const {
        const int L = i * G + c; if (L >= nwg) return false;
        int wgid = L; { constexpr int q = nwg / NXCD, r = nwg % NXCD; const int xcd = wgid % NXCD, off = wgid / NXCD; wgid = (xcd < r ? xcd * (q + 1) : r * (q + 1) + (xcd - r) * q) + off; }
        constexpr int nig = WGM * nN; static_assert(NM % WGM == 0, "row tiles in whole groups");
        const int gid = wgid / nig, fm = gid * WGM;
        u.pm = fm + ((wgid % nig) % WGM); u.pn = (wgid % nig) / WGM; u.e0 = 0; u.e1 = 0; return true;
    }
    __device__ __forceinline__ const char* a_base(const Gemm& g, const Unit& u) const { return (const char*)g.A + (size_t)u.pm * BM * g.lda * 2; }
    __device__ __forceinline__ const char* b_lo(const Gemm& g, const Unit& u) const { return (const char*)g.Bt + (size_t)u.pn * BM * g.ldb * 2; }
    __device__ __forceinline__ const char* b_hi(const Gemm& g, const Unit& u) const { return b_lo(g, u); }
};
template <int NPN, int WHICH  >
struct MoeOrder {
    const int* tinfo; int G, c;
    __device__ bool next(int i, Unit& u) const {
        const int nT = __builtin_amdgcn_readfirstlane(tinfo[0]);
        const int L = i * G + c; if (L >= nT * NPN) return false;
        const int gF = nT >> 3, full = gF * 8 * NPN;
        if (L < full) { u.pm = (L / (8 * NPN)) * 8 + (L & 7); u.pn = (L >> 3) % NPN; }
        else { const int rT = nT - 8 * gF; int Lr = L - full, pn = 0; while (Lr >= rT) { Lr -= rT; ++pn; } u.pm = gF * 8 + Lr; u.pn = pn; }
        const int code = __builtin_amdgcn_readfirstlane(tinfo[1 + u.pm]); u.e0 = code & 0xff; u.e1 = (code >> 8) & 0xff; return true;
    }
    __device__ __forceinline__ const char* a_base(const Gemm& g, const Unit& u) const { return (const char*)g.A + (size_t)u.pm * BM * g.lda * 2; }
    __device__ __forceinline__ const char* b_lo(const Gemm& g, const Unit& u) const {
        if (WHICH == 1) return (const char*)g.Bt + ((size_t)(u.pn < 4 ? u.e0 : u.e1) * 1024 + (size_t)(u.pn & 3) * BM) * g.ldb * 2;
        return (const char*)g.Bt + ((size_t)u.e0 * 1024 * 512 + (size_t)u.pn * BM * 512) * 2;
    }
    __device__ __forceinline__ const char* b_hi(const Gemm& g, const Unit& u) const {
        if (WHICH == 1) return b_lo(g, u);
        return (const char*)g.Bt + ((size_t)u.e1 * 1024 * 512 + (size_t)u.pn * BM * 512) * 2 - (size_t)8 * BK * 2;
    }
};

struct EpiStoreBf16 {
    static constexpr bool PERM = true;
    bf16* O; int ldc;
    __device__ __forceinline__ void operator()(const f32x4 (&acc)[2][2][4][2], const Unit& u, int wr, int wc, int fr, int fq) const {
        const int row0 = u.pm * BM + wr * 64 + fr, col0 = u.pn * BM + wc * 32 + 8 * fq;
#pragma unroll
        for (int ai = 0; ai < 2; ++ai)
#pragma unroll
            for (int m = 0; m < 4; ++m) { bf16* rowp = O + (size_t)(row0 + ai * HALF + m * 16) * ldc + col0;
#pragma unroll
                for (int bj = 0; bj < 2; ++bj) { const f32x4 v0 = acc[ai][bj][m][0], v1 = acc[ai][bj][m][1];
                    u32x4 w; w.x = pk2(v0[0], v0[1]); w.y = pk2(v0[2], v0[3]); w.z = pk2(v1[0], v1[1]); w.w = pk2(v1[2], v1[3]);
                    *(u32x4*)(rowp + bj * HALF) = w; } }
    }
};
struct EpiInproj {
    static constexpr bool PERM = true;
    bf16* O; int ldc; const float* sa; const float* sw; const float* gq; const float* gk; const f32x2* csd;
    __device__ __forceinline__ void operator()(const i32x4 (&acc)[2][2][4][2], const Unit& u, int wr, int wc, int fr, int fq) const {
        const int row0 = u.pm * BM + wr * 64 + fr, col0 = u.pn * BM + wc * 32 + 8 * fq;
        f32x4 cs[2][2];
#pragma unroll
        for (int bj = 0; bj < 2; ++bj)
#pragma unroll
            for (int n = 0; n < 2; ++n) cs[bj][n] = *(const f32x4*)(sw + col0 + bj * HALF + 4 * n);
        if (u.pn < 4 || u.pn >= 8) {
#pragma unroll
            for (int ai = 0; ai < 2; ++ai)
#pragma unroll
                for (int m = 0; m < 4; ++m) { const int row = row0 + ai * HALF + m * 16; const float rs = sa[row]; bf16* rowp = O + (size_t)row * ldc + col0;
#pragma unroll
                    for (int bj = 0; bj < 2; ++bj) { const f32x4 v0 = __builtin_convertvector(acc[ai][bj][m][0], f32x4) * cs[bj][0] * rs, v1 = __builtin_convertvector(acc[ai][bj][m][1], f32x4) * cs[bj][1] * rs;
                        u32x4 w; w.x = pk2(v0[0], v0[1]); w.y = pk2(v0[2], v0[3]); w.z = pk2(v1[0], v1[1]); w.w = pk2(v1[2], v1[3]);
                        *(u32x4*)(rowp + bj * HALF) = w; } }
        } else {
            const bool isq = u.pn < 6; const float* gg = (isq ? gq : gk) + 8 * fq; const float qs = isq ? 0.125f * LOG2E : 1.0f;
            f32x4 gv[2][2];
#pragma unroll
            for (int bj = 0; bj < 2; ++bj)
#pragma unroll
                for (int n = 0; n < 2; ++n) gv[bj][n] = *(const f32x4*)(gg + 32 * bj + 4 * n) * qs;
            const int lcol = u.pn * BM + 64 * wc + 8 * fq;
#pragma unroll
            for (int ai = 0; ai < 2; ++ai)
#pragma unroll
                for (int m = 0; m < 4; ++m) { const int row = row0 + ai * HALF + m * 16; const float rs = sa[row];
                    f32x4 x[2][2]; float ss = 0.f;
#pragma unroll
                    for (int bj = 0; bj < 2; ++bj)
#pragma unroll
                        for (int n = 0; n < 2; ++n) { x[bj][n] = __builtin_convertvector(acc[ai][bj][m][n], f32x4) * cs[bj][n] * rs; ss += (x[bj][n][0] * x[bj][n][0] + x[bj][n][1] * x[bj][n][1]) + (x[bj][n][2] * x[bj][n][2] + x[bj][n][3] * x[bj][n][3]); }
                    ss += sx<16>(ss); ss = sum_halves(ss);
                    const float rstd = rsqrtf(ss * (1.0f / 64.0f) + EPS);
#pragma unroll
                    for (int bj = 0; bj < 2; ++bj)
#pragma unroll
                        for (int n = 0; n < 2; ++n) x[bj][n] = x[bj][n] * gv[bj][n] * rstd;
                    const f32x4* c4 = (const f32x4*)(csd + (size_t)row * 8);
#pragma unroll
                    for (int n = 0; n < 2; ++n) { const f32x4 ca = c4[2 * n], cb = c4[2 * n + 1];
                        f32x4 pr;
#pragma unroll
                        for (int i = 0; i < 4; ++i) pr[i] = sx<16>(x[0][n][i]);
                        const f32x4 co = (f32x4){ca[0], ca[2], cb[0], cb[2]}, sn = (f32x4){ca[1], ca[3], cb[1], cb[3]};
                        const f32x4 r0 = x[0][n] * co - pr * sn, r1 = pr * sn + x[0][n] * co;
                        if (fq == 0) x[0][n] = r0; else if (fq == 1) x[0][n] = r1; }
                    bf16* rowp = O + (size_t)row * ldc + lcol;
#pragma unroll
                    for (int bj = 0; bj < 2; ++bj) { u32x4 w; w.x = pk2(x[bj][0][0], x[bj][0][1]); w.y = pk2(x[bj][0][2], x[bj][0][3]); w.z = pk2(x[bj][1][0], x[bj][1][1]); w.w = pk2(x[bj][1][2], x[bj][1][3]);
                        *(u32x4*)(rowp + 32 * bj) = w; } }
        }
    }
};
struct EpiResid {
    static constexpr bool PERM = false;
    const float* xin; float* out; const float* gate;
    __device__ __forceinline__ void operator()(const f32x4 (&acc)[2][2][4][2], const Unit& u, int wr, int wc, int fr, int fq) const {
        const int col0 = u.pn * BM + wc * 32 + 4 * fq; const int b = (u.pm * BM) >> 13;
        f32x4 gv[2][2];
#pragma unroll
        for (int bj = 0; bj < 2; ++bj)
#pragma unroll
            for (int n = 0; n < 2; ++n) gv[bj][n] = *(const f32x4*)(gate + (size_t)b * 6144 + col0 + bj * HALF + n * 16);
#pragma unroll
        for (int ai = 0; ai < 2; ++ai)
#pragma unroll
            for (int m = 0; m < 4; ++m) { const size_t off = (size_t)(u.pm * BM + ai * HALF + wr * 64 + m * 16 + fr) * DM + col0;
#pragma unroll
                for (int bj = 0; bj < 2; ++bj)
#pragma unroll
                    for (int n = 0; n < 2; ++n) { const f32x4 xv = *(const f32x4*)(xin + off + bj * HALF + n * 16); *(f32x4*)(out + off + bj * HALF + n * 16) = xv + gv[bj][n] * acc[ai][bj][m][n]; } }
    }
};
struct EpiMoe1 {
    static constexpr bool PERM = true;
    bf16* U; const float* gaS; const float* gbS; const float* saS; const float* sw1;
    __device__ __forceinline__ void operator()(const i32x4 (&acc)[2][2][4][2], const Unit& u, int wr, int wc, int fr, int fq) const {
        const float* gs = (u.pn < 4) ? gaS : gbS; const int ucol = u.pn * 128 + wc * 32 + 8 * fq;
        const float* swp = sw1 + (size_t)(u.pn < 4 ? u.e0 : u.e1) * 1024 + (u.pn & 3) * BM + wc * 32 + 8 * fq;
        f32x4 cs[2][2];
#pragma unroll
        for (int bj = 0; bj < 2; ++bj)
#pragma unroll
            for (int n = 0; n < 2; ++n) cs[bj][n] = *(const f32x4*)(swp + bj * HALF + 4 * n);
#pragma unroll
        for (int ai = 0; ai < 2; ++ai)
#pragma unroll
            for (int m = 0; m < 4; ++m) { const int slot = u.pm * BM + ai * HALF + wr * 64 + m * 16 + fr; const float w = gs[slot], rs = saS[slot];
                float r[8];
#pragma unroll
                for (int n = 0; n < 2; ++n) { const f32x4 gv = __builtin_convertvector(acc[ai][0][m][n], f32x4) * cs[0][n] * rs, uv = __builtin_convertvector(acc[ai][1][m][n], f32x4) * cs[1][n] * (rs * w);
#pragma unroll
                    for (int i = 0; i < 4; ++i) r[n * 4 + i] = silu_f(gv[i]) * uv[i]; }
                u32x4 o; o.x = pk2(r[0], r[1]); o.y = pk2(r[2], r[3]); o.z = pk2(r[4], r[5]); o.w = pk2(r[6], r[7]);
                *(u32x4*)(U + (size_t)slot * 1024 + ucol) = o; }
    }
};
struct EpiMoe2 {
    static constexpr bool PERM = false;
    float* x; const int* tokS; const float* gate;
    __device__ __forceinline__ void operator()(const f32x4 (&acc)[2][2][4][2], const Unit& u, int wr, int wc, int fr, int fq) const {
        const int col0 = u.pn * BM + wc * 32 + 4 * fq;
#pragma unroll
        for (int ai = 0; ai < 2; ++ai)
#pragma unroll
            for (int m = 0; m < 4; ++m) { const int slot = u.pm * BM + ai * HALF + wr * 64 + m * 16 + fr; const int tok = tokS[slot];
                if (tok >= 0) { const int b = tok >> 13; float* xp = x + (size_t)tok * DM + col0; const float* gp = gate + (size_t)b * 6144 + col0;
#pragma unroll
                    for (int bj = 0; bj < 2; ++bj)
#pragma unroll
                        for (int n = 0; n < 2; ++n) { const f32x4 gv = *(const f32x4*)(gp + bj * HALF + n * 16); const f32x4 xv = *(const f32x4*)(xp + bj * HALF + n * 16);
                            *(f32x4*)(xp + bj * HALF + n * 16) = xv + (DBG_MOE ? 1.f : 0.f) * gv * acc[ai][bj][m][n]; } } }
    }
};

template <bool I8> struct AccT { typedef f32x4 type; }; template <> struct AccT<true> { typedef i32x4 type; };
template <bool I8> __device__ __forceinline__ typename AccT<I8>::type mma1(bf16x8 b, bf16x8 a, typename AccT<I8>::type c);
template <> __device__ __forceinline__ f32x4 mma1<false>(bf16x8 b, bf16x8 a, f32x4 c) { return __builtin_amdgcn_mfma_f32_16x16x32_bf16(b, a, c, 0, 0, 0); }
template <> __device__ __forceinline__ i32x4 mma1<true>(bf16x8 b, bf16x8 a, i32x4 c) { return __builtin_amdgcn_mfma_i32_16x16x64_i8(__builtin_bit_cast(i32x4, b), __builtin_bit_cast(i32x4, a), c, 0, 0, 0); }
template <class Epi, class Sched, int KSPLIT  , bool I8 = false>
__device__ __forceinline__ void gemm_phase(LAS unsigned char* lds, const Gemm g, const Sched& S, const Epi& E, const int g_wave) {
    const int tid = otid(), wid = __builtin_amdgcn_readfirstlane(tid >> 6), lane = tid & 63, wr = wid >> 2, wc = wid & 3, fr = lane & 15, fq = lane >> 4;
    const int K = g.K, nt = K / BK;
    unsigned voffA[2], voffB[2];
#pragma unroll
    for (int i = 0; i < 2; ++i) { int R, C; stage_rc(tid * 16 + i * 8192, R, C); const int Rb = Epi::PERM ? ((R & ~31) + perm32(R & 31)) : R;
        voffA[i] = (unsigned)(R * g.lda + C) * 2u; voffB[i] = (unsigned)(Rb * g.ldb + C) * 2u; }
    const size_t kstep = (size_t)(BK * 2);
    const size_t hstepA = (size_t)HALF * g.lda * 2, hstepB = (size_t)HALF * g.ldb * 2;
    const unsigned ldsw = (unsigned)wid * 1024u;
    const int aoff = lds_byte(wr * 64 + fr, fq * 8), boff = lds_byte(wc * 32 + fr, fq * 8);
#define PG8_SA(b, h) (((b) * 2 + (h)) * HTB)
#define PG8_SB(b, h) ((4 + (b) * 2 + (h)) * HTB)
#define PG8_STAGE(bufoff, gbase, voff) do { _Pragma("unroll") for (int _i = 0; _i < 2; ++_i) \
        __builtin_amdgcn_global_load_lds((const unsigned*)((const char*)(gbase) + (voff)[_i]), (LAS unsigned*)(lds + (bufoff) + ldsw + _i * 8192), 16, 0, 0); } while (0)
#define PG8_LDA(dst, b, h) do { _Pragma("unroll") for (int m = 0; m < 4; ++m) _Pragma("unroll") for (int k = 0; k < 2; ++k) dst[m][k] = *(const LAS bf16x8*)(lds + PG8_SA(b, h) + aoff + m * 2048 + k * 1024); } while (0)
#define PG8_LDB(dst, b, h) do { _Pragma("unroll") for (int n = 0; n < 2; ++n) _Pragma("unroll") for (int k = 0; k < 2; ++k) dst[n][k] = *(const LAS bf16x8*)(lds + PG8_SB(b, h) + boff + n * 2048 + k * 1024); } while (0)
#define PG8_MMA(ai, bj, At, Bt) do { __builtin_amdgcn_s_setprio(1); _Pragma("unroll") for (int m = 0; m < 4; ++m) _Pragma("unroll") for (int n = 0; n < 2; ++n) _Pragma("unroll") for (int k = 0; k < 2; ++k) \
        acc[ai][bj][m][n] = mma1<I8>(Bt[n][k], At[m][k], acc[ai][bj][m][n]); __builtin_amdgcn_s_setprio(0); } while (0)
#define PG8_WAIT_V(n) asm volatile("s_waitcnt vmcnt(" #n ")" ::: "memory")
#define PG8_WAIT_L(n) asm volatile("s_waitcnt lgkmcnt(" #n ")" ::: "memory")
#define PG8_BAR __builtin_amdgcn_s_barrier()
#define PG8_SCHED __builtin_amdgcn_sched_barrier(0)
    Unit cur, nxt; int ui = 0;
    if (!S.next(0, cur)) return;
    typedef typename AccT<I8>::type acc_t;
    acc_t acc[2][2][4][2];
#pragma unroll
    for (int a = 0; a < 2; ++a)
#pragma unroll
        for (int b = 0; b < 2; ++b)
#pragma unroll
            for (int m = 0; m < 4; ++m)
#pragma unroll
                for (int n = 0; n < 2; ++n) acc[a][b][m][n] = (acc_t){0, 0, 0, 0};
    bf16x8 At[4][2], B0[2][2], B1[2][2];
    const char* cA = S.a_base(g, cur); const char* cB = S.b_lo(g, cur); const char* cBh = S.b_hi(g, cur);
    PG8_STAGE(PG8_SB(0, 0), cB, voffB); PG8_STAGE(PG8_SB(0, 1), cB + hstepB, voffB); PG8_STAGE(PG8_SA(0, 0), cA, voffA); PG8_STAGE(PG8_SA(0, 1), cA + hstepA, voffA);
    if (wr == 1) PG8_BAR;
    PG8_WAIT_V(2); PG8_BAR;
    PG8_STAGE(PG8_SB(1, 0), cB + kstep, voffB); PG8_STAGE(PG8_SA(1, 0), cA + kstep, voffA); PG8_STAGE(PG8_SB(1, 1), cB + hstepB + kstep, voffB);
    PG8_WAIT_V(6); PG8_BAR;
    for (;;) {
        const bool has_next = S.next(ui + 1, nxt);
        const char* nA = has_next ? S.a_base(g, nxt) : cA; const char* nB = has_next ? S.b_lo(g, nxt) : cB; const char* nBh = has_next ? S.b_hi(g, nxt) : cBh;
        for (int t = 0; t < nt; t += 2) {
            const bool last = (t == nt - 2);
            const char* a1 = cA + (size_t)(t + 1) * kstep;
            const char* bsel = (KSPLIT != 0 && (t + 2) >= KSPLIT) ? cBh : cB;
            const char* a2 = last ? nA : cA + (size_t)(t + 2) * kstep; const char* b2 = last ? nB : bsel + (size_t)(t + 2) * kstep;
            const char* a3 = a2 + kstep; const char* b3 = b2 + kstep;
            PG8_LDB(B0, 0, 0); PG8_LDB(B1, 0, 1); PG8_SCHED; PG8_LDA(At, 0, 0); PG8_STAGE(PG8_SA(1, 1), a1 + hstepA, voffA);
            PG8_WAIT_V(8); PG8_WAIT_L(0); PG8_BAR; PG8_MMA(0, 0, At, B0); PG8_MMA(0, 1, At, B1); PG8_BAR; PG8_SCHED;
            PG8_LDA(At, 0, 1); PG8_STAGE(PG8_SB(0, 0), b2, voffB); PG8_STAGE(PG8_SB(0, 1), b2 + hstepB, voffB); PG8_STAGE(PG8_SA(0, 0), a2, voffA);
            PG8_WAIT_V(8); PG8_WAIT_L(0); PG8_BAR; PG8_MMA(1, 0, At, B0); PG8_MMA(1, 1, At, B1); PG8_BAR; PG8_SCHED;
            PG8_LDB(B0, 1, 0); PG8_LDB(B1, 1, 1); PG8_SCHED; PG8_LDA(At, 1, 0); PG8_STAGE(PG8_SA(0, 1), a2 + hstepA, voffA);
            PG8_WAIT_V(8); PG8_WAIT_L(0); PG8_BAR; PG8_MMA(0, 0, At, B0); PG8_MMA(0, 1, At, B1); PG8_BAR; PG8_SCHED;
            PG8_LDA(At, 1, 1); PG8_STAGE(PG8_SB(1, 0), b3, voffB); PG8_STAGE(PG8_SB(1, 1), b3 + hstepB, voffB); PG8_STAGE(PG8_SA(1, 0), a3, voffA);
            PG8_WAIT_V(8); PG8_WAIT_L(0); PG8_BAR; PG8_MMA(1, 0, At, B0); PG8_MMA(1, 1, At, B1); PG8_BAR; PG8_SCHED;
        }
        if (wr == 0) PG8_BAR;
        E(acc, cur, wr, wc, fr, fq);
        if (!has_next) break;
#pragma unroll
        for (int a = 0; a < 2; ++a)
#pragma unroll
            for (int b = 0; b < 2; ++b)
#pragma unroll
                for (int m = 0; m < 4; ++m)
#pragma unroll
                    for (int n = 0; n < 2; ++n) acc[a][b][m][n] = (acc_t){0, 0, 0, 0};
        cur = nxt; cA = nA; cB = nB; cBh = nBh; ++ui;
        if (wr == 1) PG8_BAR;
    }
    PG8_WAIT_V(0);
    PG8_BAR;
#undef PG8_SA
#undef PG8_SB
#undef PG8_STAGE
#undef PG8_LDA
#undef PG8_LDB
#undef PG8_MMA
#undef PG8_WAIT_V
#undef PG8_WAIT_L
#undef PG8_BAR
#undef PG8_SCHED
}
}

#define XB_TMO      128
#define XB_XCNT(j)  (256  + 64 * (j))
#define XB_XSUB(j)  (1280 + 64 * (j))
#define XB_XGEN(j)  (2304 + 64 * (j))
#define XB_TOP      3328
#define XB_TOPGEN   3392
#define XCD_BAR_WORDS 3456
#define XB_SPIN_CAP (1u << 21)
__device__ __forceinline__ unsigned xb_ld(unsigned* p)              { return __hip_atomic_load(p, __ATOMIC_RELAXED, __HIP_MEMORY_SCOPE_AGENT); }
__device__ __forceinline__ unsigned xb_add(unsigned* p, unsigned v) { return __hip_atomic_fetch_add(p, v, __ATOMIC_RELAXED, __HIP_MEMORY_SCOPE_AGENT); }
__device__ __forceinline__ unsigned xb_xcc_id() { return (unsigned)__builtin_amdgcn_s_getreg((3 << 11) | 20) & 0xFu; }
#define XB_SPIN(cond, bar) do { unsigned _sp = 0; while (cond) { __builtin_amdgcn_s_sleep(1); \
    if ((++_sp & 255u) == 0u) { if (xb_ld(&(bar)[XB_TMO])) break; if (_sp > XB_SPIN_CAP) { atomicAdd(&(bar)[XB_TMO], 1u); break; } } } } while (0)
struct XcdBarrier { unsigned* bar; unsigned x; volatile LAS unsigned* st; };
__device__ __forceinline__ XcdBarrier xcd_barrier_post(unsigned* bar, volatile LAS unsigned* st, bool leader) {
    XcdBarrier b; b.bar = bar; b.x = xb_xcc_id(); b.st = st;
    if (leader) (void)xb_add(&bar[XB_XCNT(b.x)], 1u);
    return b;
}
__device__ __forceinline__ void xcd_barrier_complete(unsigned* bar, unsigned x, unsigned& nloc, unsigned& nx) {
    const unsigned G = gridDim.x * gridDim.y * gridDim.z;
    unsigned sum, cnt, mine, sp = 0u;
    for (;;) {
        sum = 0u; cnt = 0u; mine = 0u;
#pragma unroll
        for (unsigned j = 0; j < 16; ++j) { const unsigned c = xb_ld(&bar[XB_XCNT(j)]); sum += c; cnt += (c > 0u) ? 1u : 0u; mine = (j == x) ? c : mine; }
        if (sum == G) break;
        __builtin_amdgcn_s_sleep(1);
        if ((++sp & 255u) == 0u) { if (xb_ld(&bar[XB_TMO])) break; if (sp > XB_SPIN_CAP) { atomicAdd(&bar[XB_TMO], 1u); break; } }
    }
    nloc = mine > 0u ? mine : 1u; nx = cnt > 0u ? cnt : 1u;
}
__device__ __forceinline__ void xcd_barrier(const XcdBarrier& b, bool leader) {
    asm volatile("s_waitcnt vmcnt(0)" ::: "memory");
    __syncthreads();
    if (leader) {
        unsigned* bar = b.bar;
        __builtin_amdgcn_s_waitcnt(0);
        unsigned nloc = b.st[0], nx = b.st[1];
        if (nloc == 0u) { xcd_barrier_complete(bar, b.x, nloc, nx); b.st[0] = nloc; b.st[1] = nx; }
        const unsigned old = xb_add(&bar[XB_XSUB(b.x)], 1u);
        const unsigned gen = old / nloc;
        if (old + 1u == (gen + 1u) * nloc) {
            __builtin_amdgcn_fence(__ATOMIC_RELEASE, "agent");
            asm volatile("s_waitcnt vmcnt(0)" ::: "memory");
            const unsigned og = xb_add(&bar[XB_TOP], 1u);
            const unsigned tg = og / nx;
            if (og + 1u == (tg + 1u) * nx) xb_add(&bar[XB_TOPGEN], 1u);
            else XB_SPIN(xb_ld(&bar[XB_TOPGEN]) == tg, bar);
            __builtin_amdgcn_fence(__ATOMIC_ACQUIRE, "agent");
            xb_add(&bar[XB_XGEN(b.x)], 1u);
            asm volatile("s_waitcnt vmcnt(0)" ::: "memory");
        } else {
            XB_SPIN(xb_ld(&bar[XB_XGEN(b.x)]) == gen, bar);
            __builtin_amdgcn_fence(__ATOMIC_ACQUIRE, "agent");
            asm volatile("s_waitcnt vmcnt(0)" ::: "memory");
        }
    }
    __syncthreads();
}

__device__ __forceinline__ int tr_row(int kind, int n) {
    if (kind == 0) return n;
    if (kind == 1) { if (n >= 1024 && n < 2048) { const int lc = (n - 1024) & 255, sh = lc >> 6, d = lc & 63; return (n & ~255) + 128 * (d >> 5) + 32 * sh + (d & 31); }
                     return n < 3072 ? n : (n < 3088 ? -1 : n + 112); }
    return (n >> 7) * 256 + (n & 127) + (kind == 3 ? 128 : 0);
}
__device__ __forceinline__ void tr_item(const float* W, int K, int N, bf16* WT, int ldt, int kind, LAS unsigned char* scr, int item, int lane) {
    const int nblk = (N + 63) / 64, kb = item / nblk, nb = item % nblk, k0 = 64 * kb, n0 = 64 * nb;
    const int n4 = (lane & 15) * 4; const bool inr = (n0 + n4) < N;
    f32x4 v[16];
#pragma unroll
    for (int i = 0; i < 16; ++i) { const int kk = 4 * i + (lane >> 4); v[i] = inr ? *(const f32x4*)(W + (size_t)(k0 + kk) * N + n0 + n4) : (f32x4){0.f, 0.f, 0.f, 0.f}; }
#pragma unroll
    for (int i = 0; i < 16; ++i) { const int kk = 4 * i + (lane >> 4); const unsigned w0 = pk2(v[i][0], v[i][1]), w1 = pk2(v[i][2], v[i][3]);
        *(LAS unsigned short*)(scr + (n4 + 0) * 132 + kk * 2) = (unsigned short)(w0 & 0xffffu); *(LAS unsigned short*)(scr + (n4 + 1) * 132 + kk * 2) = (unsigned short)(w0 >> 16);
        *(LAS unsigned short*)(scr + (n4 + 2) * 132 + kk * 2) = (unsigned short)(w1 & 0xffffu); *(LAS unsigned short*)(scr + (n4 + 3) * 132 + kk * 2) = (unsigned short)(w1 >> 16); }
    LDS_WAIT(); asm volatile("" ::: "memory");
#pragma unroll
    for (int j = 0; j < 8; ++j) { const int idx = lane + 64 * j, n = idx >> 3, c = idx & 7; const LAS unsigned* sp = (const LAS unsigned*)(scr + n * 132 + c * 16);
        u32x4 o; o.x = sp[0]; o.y = sp[1]; o.z = sp[2]; o.w = sp[3];
        const int gn = n0 + n; const int r = (gn < N) ? tr_row(kind, gn) : -1;
        if (r >= 0) *(u32x4*)(WT + (size_t)r * ldt + k0 + 8 * c) = o; }
    LDS_WAIT(); asm volatile("" ::: "memory");
}

template <bool LA>
__device__ __forceinline__ void quant_strip(LAS unsigned char* lds, const float* W, int N, int n0, unsigned char* Q, float* SW, int kind, const float* a2, int wave, int lane) {
    lane = olane();
    const int a = lane & 15, kg = lane >> 4; const int ncl = (n0 + 4 * a) < N ? (n0 + 4 * a) : (N - 4);
    f32x4 v[2][16];
#pragma unroll
    for (int t = 0; t < 2; ++t)
#pragma unroll
        for (int i = 0; i < 16; ++i) { const int kk = 128 * wave + 64 * t + 16 * (i >> 2) + 4 * kg + (i & 3);
            if (!LA) v[t][i] = *(const f32x4*)(W + (size_t)kk * N + ncl);
            else { f32x4 acc = (f32x4){0.f, 0.f, 0.f, 0.f}; const float* wr = W + (size_t)kk * N + 3072;
#pragma unroll 4
                for (int r = 0; r < 16; ++r) acc += *(const f32x4*)(a2 + r * 128 + n0 + 4 * a) * wr[r];
                v[t][i] = acc; } }
    f32x4 cm = (f32x4){0.f, 0.f, 0.f, 0.f};
#pragma unroll
    for (int t = 0; t < 2; ++t)
#pragma unroll
        for (int i = 0; i < 16; ++i) cm = __builtin_elementwise_max(cm, __builtin_elementwise_abs(v[t][i]));
    LAS float* cmax = (LAS float*)(lds + 67584);
#pragma unroll
    for (int e = 0; e < 4; ++e) { float m = cm[e]; m = fmaxf(m, sx<16>(m)); m = max_halves(m); if (kg == 0) cmax[wave * 64 + 4 * a + e] = m; }
    __syncthreads();
    float inv[4], scl[4];
#pragma unroll
    for (int e = 0; e < 4; ++e) { float m = 0.f;
#pragma unroll
        for (int w = 0; w < 8; ++w) m = fmaxf(m, cmax[w * 64 + 4 * a + e]);
        scl[e] = m > 0.f ? m * (1.0f / 127.0f) : 1.0f; inv[e] = m > 0.f ? 127.0f / m : 0.f; }
    LAS unsigned char* tile = lds + wave * 8448;
#pragma unroll
    for (int t = 0; t < 2; ++t)
#pragma unroll
        for (int g = 0; g < 4; ++g)
#pragma unroll
            for (int e = 0; e < 4; ++e) { unsigned w = 0u;
#pragma unroll
                for (int j = 0; j < 4; ++j) { const int q = (int)__builtin_rintf(v[t][4 * g + j][e] * inv[e]); w |= ((unsigned)q & 0xffu) << (8 * j); }
                *(LAS unsigned*)(tile + (4 * a + e) * 132 + 64 * t + 16 * g + 4 * kg) = w; }
    LDS_WAIT(); asm volatile("" ::: "memory");
#pragma unroll
    for (int j = 0; j < 8; ++j) { const int idx = lane + 64 * j, n = idx >> 3, c = idx & 7; const LAS unsigned* sp = (const LAS unsigned*)(tile + n * 132 + c * 16);
        u32x4 o; o.x = sp[0]; o.y = sp[1]; o.z = sp[2]; o.w = sp[3];
        const int gn = n0 + n; const int r = LA ? (C_LA + gn) : ((gn < N) ? tr_row(kind, gn) : -1);
        if (r >= 0) *(u32x4*)(Q + (size_t)r * 1024 + 128 * wave + 16 * c) = o; }
    if (wave == 0 && kg == 0) {
#pragma unroll
        for (int e = 0; e < 4; ++e) { const int gn = n0 + 4 * a + e; const int r = LA ? (C_LA + gn) : ((gn < N) ? tr_row(kind, gn) : -1); if (r >= 0) SW[r] = scl[e]; } }
    __syncthreads();
}

namespace lin {
constexpr int L_QL = 0, L_QU = 9216, L_KL = 18432, L_KU = 27648, L_KLT = 36864, L_VT = 46080, L_AM = 55296, L_ST = 64512, L_OUT = 73728, L_G = 90368, L_GL = 98560, L_END = 98816;
constexpr int NSEG = 16, LSEG = 8;
#define MFMA16(a, b, c) __builtin_amdgcn_mfma_f32_16x16x32_bf16(a, b, c, 0, 0, 0)
__device__ __forceinline__ bf16x8 frag(const LAS unsigned char* base, int pitchB, int r0, int ks, int lane) {
    return *(const LAS bf16x8*)(base + (r0 + (lane & 15)) * pitchB + (32 * ks + 8 * (lane >> 4)) * 2);
}
typedef short v4i16_t __attribute__((ext_vector_type(4)));
__device__ __forceinline__ bf16x8 trfrag(const LAS unsigned char* base, int pitchB, int k0, int n0, int lane) {
    const LAS unsigned char* p = base + (k0 + 8 * (lane >> 4) + ((lane & 15) >> 2)) * pitchB + (n0 + 4 * (lane & 3)) * 2;
    const s16x4 lo = __builtin_bit_cast(s16x4, __builtin_amdgcn_ds_read_tr16_b64_v4i16((LAS v4i16_t*)p));
    const s16x4 hi = __builtin_bit_cast(s16x4, __builtin_amdgcn_ds_read_tr16_b64_v4i16((LAS v4i16_t*)(p + 4 * pitchB)));
    return (bf16x8){lo[0], lo[1], lo[2], lo[3], hi[0], hi[1], hi[2], hi[3]};
}
template <int DK, bool RET, bool PH2>
__device__ __forceinline__ void unit(LAS unsigned char* lds, const bf16* P, bf16* MIX, const f32x2* csr, int b, int h, int seg,
                                     const float* b_a, const float* gnorm, float* Est, float* Aseg, const int g_wave) {
    constexpr int PQ = (DK + 8) * 2;
    constexpr int PS = 144;
    constexpr int NT = DK / 32;
    const int tid = otid(), lane = tid & 63, wid = __builtin_amdgcn_readfirstlane(tid >> 6);
    const int row = tid >> 3, c8 = tid & 7;
    const int entry = (b * 4 + h) * NSEG + seg;
    const float lng = RET ? __logf(1.0f - exp2f(-5.0f - (float)h)) : 0.f;
    const int cq = RET ? C_RQ + h * 64 : C_GQ + h * 32, ck = RET ? C_RK + h * 64 : C_GK + h * 32, cv = RET ? C_RV + h * 64 : C_GV + h * 64, cg = RET ? C_RG + h * 64 : C_GR + h * 64;
    f32x4 st[NT]; float ac[NT];
    int eb[NT], db[NT];
#pragma unroll
    for (int j = 0; j < NT; ++j) { const int i = wid + 8 * j; if (DK == 64) { eb[j] = i >> 2; db[j] = i & 3; } else { eb[j] = i >> 1; db[j] = i & 1; } st[j] = (f32x4){0.f, 0.f, 0.f, 0.f}; ac[j] = 1.f; }
    if (PH2) {
#pragma unroll 4
        for (int sp = 0; sp < seg; ++sp) { const int en = (b * 4 + h) * NSEG + sp;
#pragma unroll
            for (int j = 0; j < NT; ++j) { const int d = db[j] * 16 + (lane & 15); const float a = Aseg[(size_t)en * DK + d];
#pragma unroll
                for (int r = 0; r < 4; ++r) { const int e = eb[j] * 16 + 4 * (lane >> 4) + r; st[j][r] = a * st[j][r] + Est[((size_t)en * 64 + e) * DK + d]; } } }
    }
    float gn8[8] = {0.f, 0.f, 0.f, 0.f, 0.f, 0.f, 0.f, 0.f}, ba4[4] = {0.f, 0.f, 0.f, 0.f};
    if (PH2) {
#pragma unroll
        for (int i = 0; i < 8; ++i) gn8[i] = gnorm[8 * c8 + i]; }
    if (!RET) {
#pragma unroll
        for (int i = 0; i < 4; ++i) ba4[i] = b_a[h * 32 + 4 * wid + i]; }
    u32x4 rq_ = (u32x4){0u, 0u, 0u, 0u}, rk_ = rq_, rq2_ = rq_, rk2_ = rq_, pv = rq_, pgt = rq_; f32x4 pcs[4]; u32x2 pla = (u32x2){0u, 0u};
#pragma unroll
    for (int i = 0; i < 4; ++i) pcs[i] = (f32x4){0.f, 0.f, 0.f, 0.f};
    const int d0 = 8 * c8; const bool qk_on = RET || c8 < 4;
#define LIN_LOAD(cc) do { const size_t mr_ = (size_t)b * SEQ + (size_t)(seg * LSEG + (cc)) * 64 + row; \
        if (!RET) pla = *(const u32x2*)(P + ((size_t)b * SEQ + (size_t)(seg * LSEG + (cc)) * 64 + lane) * NP + C_LA + h * 32 + 4 * wid); \
        if (qk_on) { rk_ = *(const u32x4*)(P + mr_ * NP + ck + d0); if (PH2) rq_ = *(const u32x4*)(P + mr_ * NP + cq + d0); \
            if (RET) { rk2_ = *(const u32x4*)(P + mr_ * NP + ck + (d0 ^ 32)); if (PH2) rq2_ = *(const u32x4*)(P + mr_ * NP + cq + (d0 ^ 32)); \
                const f32x4* cs4_ = (const f32x4*)(csr + mr_ * 32 + (d0 & 31)); pcs[0] = cs4_[0]; pcs[1] = cs4_[1]; pcs[2] = cs4_[2]; pcs[3] = cs4_[3]; } } \
        pv = *(const u32x4*)(P + mr_ * NP + cv + 8 * c8); if (PH2) pgt = *(const u32x4*)(P + mr_ * NP + cg + 8 * c8); } while (0)
    LIN_LOAD(0);
    for (int c = 0; c < LSEG; ++c) {
        const size_t m0 = (size_t)b * SEQ + (size_t)(seg * LSEG + c) * 64;
        if (!RET) {
            const u32x2 w = pla;
            float x[4] = {bflo(w.x), bfhi(w.x), bflo(w.y), bfhi(w.y)};
#pragma unroll
            for (int i = 0; i < 4; ++i) { const float z = x[i] + ba4[i]; float v = (fminf(z, 0.f) - log1pf(__expf(-fabsf(z)))) * (1.0f / 16.0f);
#pragma unroll
                for (int o = 1; o < 64; o <<= 1) { const float u = __int_as_float(__builtin_amdgcn_ds_bpermute((lane - o) << 2, __float_as_int(v))); if (lane >= o) v += u; }
                ((LAS float*)(lds + L_G))[lane * 32 + 4 * wid + i] = v; if (lane == 63) ((LAS float*)(lds + L_GL))[4 * wid + i] = v; }
            __syncthreads();
        }
        u32x4 gcur = pgt;
        {
            if (qk_on) {
                const u32x4 kw = rk_, qw = rq_;
                float qv[8], kv[8], eg[8], ieg[8];
                { const unsigned* qp = (const unsigned*)&qw; const unsigned* kp = (const unsigned*)&kw;
#pragma unroll
                  for (int i = 0; i < 4; ++i) { qv[2 * i] = bflo(qp[i]); qv[2 * i + 1] = bfhi(qp[i]); kv[2 * i] = bflo(kp[i]); kv[2 * i + 1] = bfhi(kp[i]); } }
                if (RET) {
                    const u32x4 kw2 = rk2_, qw2 = rq2_;
                    const unsigned* qp2 = (const unsigned*)&qw2; const unsigned* kp2 = (const unsigned*)&kw2;
                    const float g = (float)(row + 1) * lng; const float e1 = __expf(g), e2 = __expf(-g);
#pragma unroll
                    for (int i = 0; i < 4; ++i) { const f32x4 cc = pcs[i];
                        const float qa = bflo(qp2[i]), qb = bfhi(qp2[i]), ka = bflo(kp2[i]), kb = bfhi(kp2[i]);
                        if (c8 < 4) { const float q0 = qv[2 * i] * cc[0] - qa * cc[1], q1 = qv[2 * i + 1] * cc[2] - qb * cc[3]; const float k0 = kv[2 * i] * cc[0] - ka * cc[1], k1 = kv[2 * i + 1] * cc[2] - kb * cc[3];
                            qv[2 * i] = q0; qv[2 * i + 1] = q1; kv[2 * i] = k0; kv[2 * i + 1] = k1; }
                        else { const float q0 = qa * cc[1] + qv[2 * i] * cc[0], q1 = qb * cc[3] + qv[2 * i + 1] * cc[2]; const float k0 = ka * cc[1] + kv[2 * i] * cc[0], k1 = kb * cc[3] + kv[2 * i + 1] * cc[2];
                            qv[2 * i] = q0; qv[2 * i + 1] = q1; kv[2 * i] = k0; kv[2 * i + 1] = k1; } }
#pragma unroll
                    for (int i = 0; i < 8; ++i) { kv[i] *= 0.125f; eg[i] = e1; ieg[i] = e2; }
                } else {
#pragma unroll
                    for (int i = 0; i < 8; ++i) { const float g = ((const LAS float*)(lds + L_G))[row * 32 + d0 + i]; eg[i] = __expf(g); ieg[i] = __expf(-g); qv[i] *= 0.17677669529663687f; }
                }
                float kl[8];
#pragma unroll
                for (int i = 0; i < 8; ++i) kl[i] = kv[i] * ieg[i];
                if (PH2) {
                    u32x4 o;
                    o.x = pk2(qv[0] * eg[0], qv[1] * eg[1]); o.y = pk2(qv[2] * eg[2], qv[3] * eg[3]); o.z = pk2(qv[4] * eg[4], qv[5] * eg[5]); o.w = pk2(qv[6] * eg[6], qv[7] * eg[7]);
                    *(LAS u32x4*)(lds + L_QL + row * PQ + d0 * 2) = o;
                    o.x = pk2(qv[0] * ieg[0], qv[1] * ieg[1]); o.y = pk2(qv[2] * ieg[2], qv[3] * ieg[3]); o.z = pk2(qv[4] * ieg[4], qv[5] * ieg[5]); o.w = pk2(qv[6] * ieg[6], qv[7] * ieg[7]);
                    *(LAS u32x4*)(lds + L_QU + row * PQ + d0 * 2) = o;
                    o.x = pk2(kv[0] * eg[0], kv[1] * eg[1]); o.y = pk2(kv[2] * eg[2], kv[3] * eg[3]); o.z = pk2(kv[4] * eg[4], kv[5] * eg[5]); o.w = pk2(kv[6] * eg[6], kv[7] * eg[7]);
                    *(LAS u32x4*)(lds + L_KU + row * PQ + d0 * 2) = o;
                }
                { u32x4 o; o.x = pk2(kl[0], kl[1]); o.y = pk2(kl[2], kl[3]); o.z = pk2(kl[4], kl[5]); o.w = pk2(kl[6], kl[7]);
                  *(LAS u32x4*)(lds + L_KL + row * PQ + d0 * 2) = o; }
            }
            *(LAS u32x4*)(lds + L_VT + row * PS + c8 * 16) = pv;
        }
        if (c + 1 < LSEG) LIN_LOAD(c + 1);
        __syncthreads();
#pragma unroll
        for (int j = 0; j < NT; ++j) {
            const int d = db[j] * 16 + (lane & 15);
            if (PH2) {
#pragma unroll
                for (int r = 0; r < 4; ++r) { const int e = eb[j] * 16 + 4 * (lane >> 4) + r; *(LAS unsigned short*)(lds + L_ST + e * PQ + d * 2) = (unsigned short)(pk2(st[j][r], 0.f) & 0xffffu); }
            }
            f32x4 u = (f32x4){0.f, 0.f, 0.f, 0.f};
#pragma unroll
            for (int ks = 0; ks < 2; ++ks) u = MFMA16(trfrag(lds + L_VT, PS, 32 * ks, eb[j] * 16, lane), trfrag(lds + L_KL, PQ, 32 * ks, db[j] * 16, lane), u);
            const float egl = RET ? __expf(64.f * lng) : __expf(((const LAS float*)(lds + L_GL))[d]);
#pragma unroll
            for (int r = 0; r < 4; ++r) st[j][r] = egl * (st[j][r] + u[r]);
            ac[j] *= egl;
        }
        if (PH2) {
#pragma unroll
            for (int j = 0; j < 2; ++j) { const int i = wid + 8 * j, tb = i >> 2, sb = i & 3;
                f32x4 lo = (f32x4){0.f, 0.f, 0.f, 0.f}, up = (f32x4){0.f, 0.f, 0.f, 0.f};
                if (sb <= tb) {
#pragma unroll
                    for (int ks = 0; ks < DK / 32; ++ks) lo = MFMA16(frag(lds + L_QL, PQ, tb * 16, ks, lane), frag(lds + L_KL, PQ, sb * 16, ks, lane), lo); }
                if (sb >= tb) {
#pragma unroll
                    for (int ks = 0; ks < DK / 32; ++ks) up = MFMA16(frag(lds + L_QU, PQ, tb * 16, ks, lane), frag(lds + L_KU, PQ, sb * 16, ks, lane), up); }
                const int s = sb * 16 + (lane & 15);
#pragma unroll
                for (int r = 0; r < 4; ++r) { const int t = tb * 16 + 4 * (lane >> 4) + r; const float v = (s <= t) ? lo[r] : up[r];
                    *(LAS unsigned short*)(lds + L_AM + t * PS + s * 2) = (unsigned short)(pk2(v, 0.f) & 0xffffu); } }
        }
        __syncthreads();
        if (PH2) {
#pragma unroll
            for (int j = 0; j < 2; ++j) { const int i = wid + 8 * j, tb = i >> 2, ob = i & 3;
                f32x4 o = (f32x4){0.f, 0.f, 0.f, 0.f};
#pragma unroll
                for (int ks = 0; ks < 2; ++ks) o = MFMA16(frag(lds + L_AM, PS, tb * 16, ks, lane), trfrag(lds + L_VT, PS, 32 * ks, ob * 16, lane), o);
#pragma unroll
                for (int ks = 0; ks < DK / 32; ++ks) o = MFMA16(frag(lds + L_QL, PQ, tb * 16, ks, lane), frag(lds + L_ST, PQ, ob * 16, ks, lane), o);
#pragma unroll
                for (int r = 0; r < 4; ++r) ((LAS float*)(lds + L_OUT))[(tb * 16 + 4 * (lane >> 4) + r) * 65 + ob * 16 + (lane & 15)] = o[r]; }
            __syncthreads();
            { const size_t m = m0 + row; const int e0 = 8 * c8; float v[8]; float ss = 0.f;
#pragma unroll
              for (int i = 0; i < 8; ++i) { v[i] = ((const LAS float*)(lds + L_OUT))[row * 65 + e0 + i]; ss += v[i] * v[i]; }
              ss += sx<1>(ss); ss += sx<2>(ss); ss += sx<4>(ss);
              const float rstd = rsqrtf(ss * (1.0f / 64.0f) + EPS);
              const u32x4 gw = gcur; const unsigned* gp = (const unsigned*)&gw; float y[8];
#pragma unroll
              for (int i = 0; i < 4; ++i) { y[2 * i] = v[2 * i] * rstd * gn8[2 * i] * silu_f(bflo(gp[i])); y[2 * i + 1] = v[2 * i + 1] * rstd * gn8[2 * i + 1] * silu_f(bfhi(gp[i])); }
              const bool on = RET ? ((DBG_GROUPS & 1) != 0) : ((DBG_GROUPS & 4) != 0);
              u32x4 o; o.x = pk2(y[0], y[1]); o.y = pk2(y[2], y[3]); o.z = pk2(y[4], y[5]); o.w = pk2(y[6], y[7]); if (!on) o = (u32x4){0u, 0u, 0u, 0u};
              *(u32x4*)(MIX + m * DM + (RET ? 0 : 768) + h * 64 + e0) = o; }
        }
    }
#undef LIN_LOAD
    if (!PH2) {
#pragma unroll
        for (int j = 0; j < NT; ++j) { const int d = db[j] * 16 + (lane & 15);
#pragma unroll
            for (int r = 0; r < 4; ++r) { const int e = eb[j] * 16 + 4 * (lane >> 4) + r; Est[((size_t)entry * 64 + e) * DK + d] = st[j][r]; }
            if (eb[j] == 0 && (lane >> 4) == 0) Aseg[(size_t)entry * DK + d] = ac[j]; }
    }
    __syncthreads();
}
}

namespace att {
constexpr int A_K = 0, A_V = 24576, A_O0 = 0, A_LS = 73728, A_END = 75776;
#define MFMA32(a, b, c) __builtin_amdgcn_mfma_f32_32x32x16_bf16(a, b, c, 0, 0, 0)
typedef short v4i16_t __attribute__((ext_vector_type(4)));
__device__ __forceinline__ s16x4 vtr(const LAS unsigned char* p) { return __builtin_bit_cast(s16x4, __builtin_amdgcn_ds_read_tr16_b64_v4i16((LAS v4i16_t*)p)); }
__device__ __forceinline__ int crow(int r, int hi) { return (r & 3) + 8 * (r >> 2) + 4 * hi; }
__device__ __forceinline__ void unit(LAS unsigned char* lds, const bf16* P, bf16* MIX, int b, int h, int jq, float lam, float negM, const float* subg, float oscale, const int g_wave) {
    const int tid = otid(), lane = tid & 63, r32 = lane & 31, hh = lane >> 5, wid = __builtin_amdgcn_readfirstlane(tid >> 6);
    const size_t rowbase = (size_t)b * SEQ;
    const int q0 = jq * 256 + wid * 32;
    const int ntile = 4 * jq + 4, my_nt = 4 * jq + (wid >> 1) + 1;
    const int krow = tid >> 3, kch = (tid & 7) ^ ((krow >> 1) & 7);
    const int vrow = (tid >> 2) & 63, vcol = (tid >> 8) * 32 + (tid & 3) * 8;
    const unsigned ldsw = (unsigned)wid * 1024u;
    const int q4 = (lane & 15) >> 2, p4 = lane & 3, gsel = (lane >> 4) & 1;
    const unsigned vrd = (unsigned)((4 * hh + q4) * 64 + gsel * 32 + p4 * 8);
    unsigned o0r[32];
#pragma unroll
    for (int i = 0; i < 32; ++i) o0r[i] = 0u;
#pragma unroll 1
    for (int comp = 0; comp < 2; ++comp) {
        bf16x8 qf[4];
        const char* Pb = (const char*)(P + rowbase * NP + h * 128);
        { const unsigned qo = (unsigned)(((q0 + r32) * NP + C_DQ + comp * 64 + hh * 8) * 2);
#pragma unroll
          for (int ks = 0; ks < 4; ++ks) qf[ks] = *(const bf16x8*)(Pb + qo + 32 * ks); }
        const unsigned kgo = (unsigned)((krow * NP + C_DK + comp * 64 + kch * 8) * 2), vgo = (unsigned)((vrow * NP + C_DV + vcol) * 2);
        f32x16 o[4];
#pragma unroll
        for (int e = 0; e < 4; ++e)
#pragma unroll
            for (int r = 0; r < 16; ++r) o[e][r] = 0.f;
        float l = 0.f;
#define ATT_GLDS(sb, vo, dst) do { unsigned keep_; asm volatile("s_mov_b32 %0, m0\n\ts_mov_b32 m0, %3\n\ts_nop 0\n\tglobal_load_lds_dwordx4 %1, %2\n\ts_mov_b32 m0, %0" \
            : "=&s"(keep_) : "v"(vo), "s"(sb), "s"(dst) : "memory"); } while (0)
#define ATT_STAGE(buf, tt) do { const char* Pt = Pb + (size_t)(tt) * 64 * NP * 2; \
            ATT_GLDS(Pt, kgo, (unsigned)__builtin_amdgcn_readfirstlane((int)(ldsb + A_K + (buf) * 8192 + ldsw))); \
            ATT_GLDS(Pt, vgo, (unsigned)__builtin_amdgcn_readfirstlane((int)(ldsb + A_V + (buf) * 16384 + ldsw))); \
            ATT_GLDS(Pt, vgo + 128u, (unsigned)__builtin_amdgcn_readfirstlane((int)(ldsb + A_V + (buf) * 16384 + 8192 + ldsw))); } while (0)
        const unsigned ldsb = (unsigned)(size_t)lds;
        unsigned kro[4];
#pragma unroll
        for (int ks = 0; ks < 4; ++ks) kro[ks] = (unsigned)(r32 * 128 + (((2 * ks + hh) ^ ((r32 >> 1) & 7)) << 4));
        ATT_STAGE(0, 0);
        if (ntile > 1) ATT_STAGE(1, 1);
        __builtin_amdgcn_s_waitcnt(0x0F70);
        VM_WAIT(); __syncthreads();
        int cur = 0, nx2 = 2;
        for (int t = 0; t < ntile; ++t) {
            const bool more = (t + 2 < ntile);
            if (more) ATT_STAGE(nx2, t + 2);
            if (t < my_nt) {
                const LAS unsigned char* Kb = lds + A_K + cur * 8192; const LAS unsigned char* Vb = lds + A_V + cur * 16384 + vrd;
#define ATT_KF(j) (*(const LAS bf16x8*)(Kb + kro[(j) & 3] + ((j) >> 2) * 4096))
#define ATT_VOFF(j) ((((j) >> 1) & 3) * 4096 + (2 * ((j) >> 3) + ((j) & 1)) * 1024)
                bf16x8 kr[3]; kr[0] = ATT_KF(0); kr[1] = ATT_KF(1);
                const f32x16 z16 = {0.f, 0.f, 0.f, 0.f, 0.f, 0.f, 0.f, 0.f, 0.f, 0.f, 0.f, 0.f, 0.f, 0.f, 0.f, 0.f};
                f32x16 s0, s1;
#pragma unroll
                for (int j = 0; j < 8; ++j) { if (j + 2 < 8) kr[(j + 2) % 3] = ATT_KF(j + 2);
                    if (j < 4) s0 = MFMA32(kr[j % 3], qf[j & 3], j == 0 ? z16 : s0); else s1 = MFMA32(kr[j % 3], qf[j & 3], j == 4 ? z16 : s1); }
                s16x4 vl[3], vh[3];
                vl[0] = vtr(Vb + ATT_VOFF(0)); vh[0] = vtr(Vb + ATT_VOFF(0) + 512); vl[1] = vtr(Vb + ATT_VOFF(1)); vh[1] = vtr(Vb + ATT_VOFF(1) + 512);
                bf16x8 pa[4];
                { u32x4 w;
#pragma unroll
                  for (int r = 0; r < 16; ++r) { s0[r] = __builtin_amdgcn_exp2f(s0[r]); l += s0[r]; }
                  w.x = pk2(s0[0], s0[1]); w.y = pk2(s0[2], s0[3]); w.z = pk2(s0[4], s0[5]); w.w = pk2(s0[6], s0[7]); pa[0] = __builtin_bit_cast(bf16x8, w);
                  w.x = pk2(s0[8], s0[9]); w.y = pk2(s0[10], s0[11]); w.z = pk2(s0[12], s0[13]); w.w = pk2(s0[14], s0[15]); pa[1] = __builtin_bit_cast(bf16x8, w);
#pragma unroll
                  for (int r = 0; r < 16; ++r) { s1[r] = __builtin_amdgcn_exp2f(s1[r]); l += s1[r]; }
                  w.x = pk2(s1[0], s1[1]); w.y = pk2(s1[2], s1[3]); w.z = pk2(s1[4], s1[5]); w.w = pk2(s1[6], s1[7]); pa[2] = __builtin_bit_cast(bf16x8, w);
                  w.x = pk2(s1[8], s1[9]); w.y = pk2(s1[10], s1[11]); w.z = pk2(s1[12], s1[13]); w.w = pk2(s1[14], s1[15]); pa[3] = __builtin_bit_cast(bf16x8, w); }
#pragma unroll
                for (int j = 0; j < 16; ++j) { if (j + 2 < 16) { vl[(j + 2) % 3] = vtr(Vb + ATT_VOFF(j + 2)); vh[(j + 2) % 3] = vtr(Vb + ATT_VOFF(j + 2) + 512); }
                    const s16x4 lo = vl[j % 3], hi = vh[j % 3]; const bf16x8 vf = (bf16x8){lo[0], lo[1], lo[2], lo[3], hi[0], hi[1], hi[2], hi[3]};
                    o[(j >> 1) & 3] = MFMA32(pa[2 * (j >> 3) + (j & 1)], vf, o[(j >> 1) & 3]); }
#undef ATT_KF
#undef ATT_VOFF
            }
            if (more) asm volatile("s_waitcnt vmcnt(3)" ::: "memory"); else VM_WAIT();
            __syncthreads();
            cur = (cur == 2) ? 0 : cur + 1; nx2 = (nx2 == 2) ? 0 : nx2 + 1;
        }
#undef ATT_GLDS
#undef ATT_STAGE
        l = sum_halves(l);
        LAS float* ls = (LAS float*)(lds + A_LS) + wid * 64 + comp * 32;
        if (hh == 0) ls[r32] = l;
        LDS_WAIT(); asm volatile("" ::: "memory");
        float inv[16];
#pragma unroll
        for (int r = 0; r < 16; ++r) inv[r] = 1.0f / ls[crow(r, hh)];
        if (comp == 0) {
#pragma unroll
            for (int e = 0; e < 4; ++e)
#pragma unroll
                for (int i = 0; i < 8; ++i) o0r[e * 8 + i] = pk2(o[e][2 * i] * inv[2 * i], o[e][2 * i + 1] * inv[2 * i + 1]);
        } else {
            float ss[16];
#pragma unroll
            for (int r = 0; r < 16; ++r) ss[r] = 0.f;
#pragma unroll
            for (int e = 0; e < 4; ++e)
#pragma unroll
                for (int i = 0; i < 8; ++i) { const unsigned w = o0r[e * 8 + i];
                    const float v0 = bflo(w) - lam * o[e][2 * i] * inv[2 * i], v1 = bfhi(w) - lam * o[e][2 * i + 1] * inv[2 * i + 1];
                    o[e][2 * i] = v0; o[e][2 * i + 1] = v1; ss[2 * i] += v0 * v0; ss[2 * i + 1] += v1 * v1; }
#pragma unroll
            for (int r = 0; r < 16; ++r) { float s = ss[r]; s += sx<1>(s); s += sx<2>(s); s += sx<4>(s); s += sx<8>(s); s += sx<16>(s);
                ss[r] = rsqrtf(s * (1.0f / 128.0f) + EPS) * oscale; }
            LAS unsigned char* stg = lds + A_O0 + wid * 8192;
            const int lane_e = olane(), r32e = lane_e & 31;
            LDS_WAIT(); asm volatile("" ::: "memory");
#pragma unroll
            for (int e = 0; e < 4; ++e) { const float gsub = subg[32 * e + r32e];
#pragma unroll
                for (int r = 0; r < 16; ++r) { const float y = ((DBG_GROUPS & 2) != 0) ? o[e][r] * ss[r] * gsub : 0.f;
                    *(LAS unsigned short*)(stg + crow(r, hh) * 256 + (32 * e + r32) * 2) = (unsigned short)(pk2(y, 0.f) & 0xffffu); } }
            LDS_WAIT(); asm volatile("" ::: "memory");
            { unsigned ob = (unsigned)(((q0 + (lane_e >> 4)) * DM + 256 + (lane_e & 15) * 8) * 2); char* Mb = (char*)(MIX + rowbase * DM + h * 128);
#pragma unroll
              for (int i = 0; i < 8; ++i) { const u32x4 w = *(const LAS u32x4*)(stg + ((lane_e >> 4) + 4 * i) * 256 + (lane_e & 15) * 16); *(u32x4*)(Mb + ob + i * 4 * DM * 2) = w; } }
            LDS_WAIT(); asm volatile("" ::: "memory");
        }
    }
    __syncthreads();
}
}

struct Args { const float* in[25]; float* out; unsigned char* ws; int ph_lo, ph_hi; };
static_assert(sizeof(Args) == 27 * 8 + 8, "Args has no padding");
constexpr int NPHASE = 1 + 9 * DEPTH;

__global__ void __launch_bounds__(NWAVES * 64, 2) fwd(Args args) {
    extern __shared__ __attribute__((aligned(16))) unsigned char lds_raw[];
    LAS unsigned char* lds = (LAS unsigned char*)lds_raw;
    const int wave = __builtin_amdgcn_readfirstlane((int)threadIdx.x >> 6); const int g_wave = wave; const int tid0 = otid();
    const int G = gridDim.x; const int bx = blockIdx.x; const int vcu = (G % 8 == 0) ? (bx % 8) * (G / 8) + bx / 8 : bx;
    const int gw = vcu * NWAVES + wave, NGW = G * NWAVES;
    __builtin_assume(gw >= 0 && gw < 4096 && vcu >= 0 && vcu < 512 && G > 0 && G <= 512);
    unsigned char* ws = args.ws;
    unsigned* ctl = (unsigned*)(ws + WS_CTL);
    for (int u = tid0; u < (LDS_BYTES - LDSCTL_OFF) / 4; u += NWAVES * 64) ((LAS unsigned*)(lds + LDSCTL_OFF))[u] = 0u;
    __syncthreads();
    XcdBarrier bar; bar.bar = ctl + CW_BAR; bar.x = 0; bar.st = nullptr;
    if (MK_N_LAUNCHES == 1) bar = xcd_barrier_post(ctl + CW_BAR, (volatile LAS unsigned*)(lds + MISC_OFF) + 8, tid0 == 0);
    const int lo = args.ph_lo, hi = args.ph_hi;
#ifndef PHMASK
#define PHMASK 0x3ff
#endif
#define IN(k) (lo <= (k) && (k) < hi)
#define PHON(j) ((PHMASK >> (j)) & 1)
#define SEAM(k) do { if (IN(k) && IN((k) + 1)) xcd_barrier(bar, otid() == 0); } while (0)
    if (tid0 == 0) {
#pragma unroll
        for (int k = 0; k < 25; ++k) ((LAS unsigned long long*)(lds + PTR_OFF))[k] = (unsigned long long)args.in[k];
    }
    __syncthreads();
    float* xout = args.out;
#define WSP(Tp, off) ((Tp*)(wsl + (off)))
#define WSL() unsigned char* wsl = ws; asm volatile("" : "+s"(wsl))

    if (PHON(0) && IN(0)) {
        const int tid = otid(), lane = tid & 63; WSL();
        const float* c_in = INF(1); const int* pos_in = (const int*)INF(2); const float* w_mod = INF(3); const float* b_mod = INF(4); const float* w_in = INF(7);
        const float* diff_q_g = INF(9); const float* diff_k_g = INF(10); const float* lam_q1 = INF(11); const float* lam_k1 = INF(12); const float* lam_q2 = INF(13); const float* lam_k2 = INF(14);
        const float* gla_w_a2 = INF(16); const float* w_out = INF(19); const float* w_gate = INF(22); const float* w_up = INF(23); const float* w_down = INF(24);
        float* mod = WSP(float, WS_MOD); float* scal = WSP(float, WS_SCAL); f32x2* csr = WSP(f32x2, WS_CSR); f32x2* csd = WSP(f32x2, WS_CSD);
        bf16* Wout_t = WSP(bf16, WS_WOUT); bf16* W2 = WSP(bf16, WS_W2);
        LAS unsigned char* scr = lds + wave * 8704;
        LAS float* sact = (LAS float*)(lds + 69632);
        for (int i = tid; i < 8 * 1024; i += NWAVES * 64) sact[i] = silu_f(c_in[i]);
        __syncthreads();
        { unsigned char* Winq = WSP(unsigned char, WS_WIN); float* swin = WSP(float, WS_SWIN);
          constexpr int U_WIN = 2 * 53, U_LA = 4, U_W1 = 2 * 32 * 16;
#pragma unroll 1
          for (int bu = vcu; bu < U_WIN; bu += G) { const int l = bu / 53, st = bu % 53; quant_strip<false>(lds, w_in + (size_t)l * 1024 * IN_W, IN_W, 64 * st, Winq + (size_t)l * NP * 1024, swin + l * NP, 1, nullptr, wave, lane); }
#pragma unroll 1
          for (int bu = vcu; bu < U_W1; bu += G) { const int le = bu >> 4, st = bu & 15;
              quant_strip<false>(lds, (st < 8 ? w_gate : w_up) + (size_t)le * 1024 * 512, 512, 64 * (st & 7), WSP(unsigned char, WS_W1) + (size_t)le * 1024 * 1024, WSP(float, WS_SW1) + (size_t)le * 1024, st < 8 ? 2 : 3, nullptr, wave, lane); }
#pragma unroll 1
          for (int bu = G - 1 - vcu; bu < U_LA; bu += G) { const int l = bu >> 1, st = bu & 1; quant_strip<true>(lds, w_in + (size_t)l * 1024 * IN_W, IN_W, 64 * st, Winq + (size_t)l * NP * 1024, swin + l * NP, 1, gla_w_a2 + (size_t)l * 16 * 128, wave, lane); }
        }
        constexpr int I_MOD = 2 * 384, I_TABR = 1024, I_TABD = 1024, I_ZERO = 256, I_SC = 2;
        constexpr int I_WOUT = 16 * 16, I_DN = 8 * 16, I_LAYER = I_WOUT + 32 * I_DN;
        constexpr int I_PRE = I_MOD + I_TABR + I_TABD + I_ZERO + I_SC, NITEMS = I_PRE + 2 * I_LAYER;
        _Pragma("unroll 1") for (int rep_ = 0; rep_ < 1 + (RPT_PHASE == 100 ? RPT_N : 0); ++rep_)
        for (int it = gw; it < NITEMS; it += NGW) {
            int r = it;
            if (r < I_MOD) {
                const int l = r / 384, col = (r % 384) * 16 + (lane & 15), ks = lane >> 4;
                float acc[8] = {0.f, 0.f, 0.f, 0.f, 0.f, 0.f, 0.f, 0.f};
                const float* wp = w_mod + (size_t)l * 1024 * 6144 + col;
#pragma unroll 16
                for (int k = ks; k < 1024; k += 4) { const float w = wp[(size_t)k * 6144];
#pragma unroll
                    for (int b = 0; b < 8; ++b) acc[b] += sact[b * 1024 + k] * w; }
#pragma unroll
                for (int b = 0; b < 8; ++b) { float a = acc[b]; a += sx<16>(a); a = sum_halves(a); if (ks == 0) mod[((size_t)l * 8 + b) * 6144 + col] = a + b_mod[l * 6144 + col]; }
                continue; }
            r -= I_MOD;
            if (r < I_TABR) {
                const int i = lane & 31; const float inv_freq = exp2f(-((float)i * (1.0f / 32.0f)) * 13.287712379549449f);
                for (int s = 0; s < 32; ++s) { const int t = r * 64 + 2 * s + (lane >> 5); const float ang = (float)pos_in[t] * inv_freq; float sn, cs; sincosf(ang, &sn, &cs); csr[(size_t)t * 32 + i] = (f32x2){cs, sn}; }
                continue; }
            r -= I_TABR;
            if (r < I_TABD) {
                const int i = lane & 7; const float inv_freq = exp2f(-((float)i * (1.0f / 8.0f)) * 18.931568569324174f);
                for (int s = 0; s < 8; ++s) { const int t = r * 64 + 8 * s + (lane >> 3); const float ang = (float)pos_in[t] * inv_freq; float sn, cs; sincosf(ang, &sn, &cs); csd[(size_t)t * 8 + i] = (f32x2){cs, sn}; }
                continue; }
            r -= I_TABD;
            if (r < I_ZERO) {
                const int l = r >> 7, j = r & 127; u32x4* p = (u32x4*)(WSP(unsigned char, WS_WIN) + ((size_t)l * NP + C_PAD + j) * 1024);
                p[lane] = (u32x4){0u, 0u, 0u, 0u}; if (lane == 0) WSP(float, WS_SWIN)[l * NP + C_PAD + j] = 1.0f;
                continue; }
            r -= I_ZERO;
            if (r < I_SC) {
                const int l = r; const float s1 = wave_sum(lam_q1[l * 64 + lane] * lam_k1[l * 64 + lane]), s2 = wave_sum(lam_q2[l * 64 + lane] * lam_k2[l * 64 + lane]);
                const float mq = wave_max(fabsf(diff_q_g[l * 64 + lane])), mk = wave_max(fabsf(diff_k_g[l * 64 + lane]));
                const float lam_init = 0.8f - 0.6f * expf(-0.3f * (float)l);
                if (lane == 0) { scal[l * 4 + 0] = expf(s1) - expf(s2) + lam_init; scal[l * 4 + 1] = -(8.0f * mq * mk * LOG2E + 0.5f); scal[l * 4 + 2] = 1.0f - lam_init; }
                continue; }
            r -= I_SC;
            const int l = r / I_LAYER; r -= l * I_LAYER;
            if (r < I_WOUT) { tr_item(w_out + (size_t)l * 1024 * 1024, 1024, 1024, Wout_t + (size_t)l * 1024 * 1024, 1024, 0, scr, r, lane); continue; } r -= I_WOUT;
            const int e = r / I_DN; r -= e * I_DN; const size_t le = (size_t)l * 32 + e;
            tr_item(w_down + le * 512 * 1024, 512, 1024, W2 + le * 1024 * 512, 512, 0, scr, r, lane);
        }
        __syncthreads();
    }
    SEAM(0);

    for (int l = 0; l < DEPTH; ++l) {
        const int pb = 1 + 9 * l;
#define XIN ((l == 0) ? INF(0) : (const float*)xout)
#define MODL (WSP(const float, WS_MOD) + (size_t)l * 8 * 6144)
        if (PHON(1) && IN(pb + 0)) {
            const int tid = otid(), lane = tid & 63; (void)tid; (void)lane; WSL();
            const float* xin = XIN; const float* modl = MODL; const float* norm1_g = INF(5); unsigned char* ACTq = WSP(unsigned char, WS_ACT); float* sa1 = WSP(float, WS_SA1);
            const float* g1 = norm1_g + l * 1024;
            _Pragma("unroll 1") for (int rep_ = 0; rep_ < 1 + (RPT_PHASE == 1 ? RPT_N : 0); ++rep_)
            for (int m0 = gw; m0 < T; m0 += 4 * NGW) {
                f32x4 v[4][4];
#pragma unroll
                for (int q = 0; q < 4; ++q) { const int mq = m0 + q * NGW, m = mq < T ? mq : T - 1; const f32x4* xr = (const f32x4*)(xin + (size_t)m * DM) + lane;
#pragma unroll
                    for (int j = 0; j < 4; ++j) v[q][j] = xr[64 * j]; }
#pragma unroll
                for (int q = 0; q < 4; ++q) { const int m = m0 + q * NGW; if (m < T) {
                    const int b = m >> 13; const float* mb = modl + (size_t)b * 6144; float s = 0.f;
#pragma unroll
                    for (int j = 0; j < 4; ++j) s += (v[q][j][0] * v[q][j][0] + v[q][j][1] * v[q][j][1]) + (v[q][j][2] * v[q][j][2] + v[q][j][3] * v[q][j][3]);
                    const float rstd = rsqrtf(wave_sum(s) * (1.0f / 1024.0f) + EPS);
                    f32x4 y[4]; float am = 0.f;
#pragma unroll
                    for (int j = 0; j < 4; ++j) { const int k = 4 * lane + 256 * j; const f32x4 gg = *(const f32x4*)(g1 + k), sh = *(const f32x4*)(mb + k), sc = *(const f32x4*)(mb + 1024 + k);
                        y[j] = v[q][j] * rstd * gg * (sc + 1.0f) + sh; am = fmaxf(am, fmaxf(fmaxf(fabsf(y[j][0]), fabsf(y[j][1])), fmaxf(fabsf(y[j][2]), fabsf(y[j][3])))); }
                    am = wave_max(am); const float inv = am > 0.f ? 127.0f / am : 0.f;
                    if (lane == 0) sa1[m] = am > 0.f ? am * (1.0f / 127.0f) : 1.0f;
                    unsigned* o4 = (unsigned*)(ACTq + (size_t)m * 1024) + lane;
#pragma unroll
                    for (int j = 0; j < 4; ++j) { unsigned w = 0u;
#pragma unroll
                        for (int e = 0; e < 4; ++e) w |= ((unsigned)(int)__builtin_rintf(y[j][e] * inv) & 0xffu) << (8 * e);
                        o4[64 * j] = w; } } }
            }
        }
        SEAM(pb + 0);
        if (PHON(2) && IN(pb + 1)) {
            const int tid = otid(), lane = tid & 63; (void)tid; (void)lane; WSL();
            bf16* ACT = WSP(bf16, WS_ACT); bf16* P = WSP(bf16, WS_P);
            pg8::Gemm g{ACT, (const bf16*)(WSP(unsigned char, WS_WIN) + (size_t)l * NP * 1024), 512, 512, 512}; pg8::StaticOrder<T / 256, NP / 256> S; S.init(G, bx);
            pg8::EpiInproj E{P, NP, WSP(const float, WS_SA1), WSP(const float, WS_SWIN) + l * NP, INF(9) + l * 64, INF(10) + l * 64, WSP(const f32x2, WS_CSD)};
            _Pragma("unroll 1") for (int rep_ = 0; rep_ < 1 + (RPT_PHASE == 2 ? RPT_N : 0); ++rep_)
            pg8::gemm_phase<pg8::EpiInproj, pg8::StaticOrder<T / 256, NP / 256>, 0, true>(lds, g, S, E, g_wave);
        }
        SEAM(pb + 1);
        if (PHON(3) && IN(pb + 2)) {
            const int tid = otid(), lane = tid & 63; (void)tid; (void)lane; WSL();
            const float* diff_q_g = INF(9); const float* diff_k_g = INF(10); const float* gla_b_a = INF(17); bf16* P = WSP(bf16, WS_P); bf16* ACT = WSP(bf16, WS_ACT); f32x2* csr = WSP(f32x2, WS_CSR); f32x2* csd = WSP(f32x2, WS_CSD);
            float* Eret = WSP(float, WS_EST); float* Egla = WSP(float, WS_EGL); float* Asr = WSP(float, WS_ASR); float* Asg = WSP(float, WS_ASG);
            _Pragma("unroll 1") for (int rep_ = 0; rep_ < 1 + (RPT_PHASE == 31 ? RPT_N : 0); ++rep_)
            for (int u = vcu; u < 1024; u += G) {
                const int r = u & 511, bh = r >> 4, seg = r & 15;
                if (u < 512) lin::unit<64, true, false>(lds, P, ACT, csr, bh >> 2, bh & 3, seg, nullptr, nullptr, Eret, Asr, g_wave);
                else lin::unit<32, false, false>(lds, P, ACT, csr, bh >> 2, bh & 3, seg, gla_b_a + l * 128, nullptr, Egla, Asg, g_wave);
            }
        }
        SEAM(pb + 2);
        if (PHON(4) && IN(pb + 3)) {
            const int tid = otid(), lane = tid & 63; (void)tid; (void)lane; WSL();
            const float* scal = WSP(const float, WS_SCAL); const float* diff_sub_g = INF(15); const float* ret_norm_g = INF(8); const float* gla_norm_g = INF(18); const float* gla_b_a = INF(17); bf16* P = WSP(bf16, WS_P); bf16* ACT = WSP(bf16, WS_ACT); f32x2* csr = WSP(f32x2, WS_CSR);
            float* Eret = WSP(float, WS_EST); float* Egla = WSP(float, WS_EGL); float* Asr = WSP(float, WS_ASR); float* Asg = WSP(float, WS_ASG);
            const float lam = scal[l * 4 + 0], negM = scal[l * 4 + 1], osc = scal[l * 4 + 2];
#ifndef NO_ATT
            _Pragma("unroll 1") for (int rep_ = 0; rep_ < 1 + (RPT_PHASE == 41 ? RPT_N : 0); ++rep_)
            for (int pu = vcu; pu < 512; pu += G) {
                const int bh = pu >> 4, jp = pu & 15;
                att::unit(lds, P, ACT, bh >> 2, bh & 3, jp, lam, negM, diff_sub_g + l * 128, osc, g_wave);
                att::unit(lds, P, ACT, bh >> 2, bh & 3, 31 - jp, lam, negM, diff_sub_g + l * 128, osc, g_wave);
            }
#endif
#ifndef NO_LIN2
            _Pragma("unroll 1") for (int rep_ = 0; rep_ < 1 + (RPT_PHASE == 42 ? RPT_N : 0); ++rep_)
            for (int u = vcu; u < 1024; u += G) {
                const int r = u & 511, bh = r >> 4, seg = r & 15;
                if (u < 512) lin::unit<64, true, true>(lds, P, ACT, csr, bh >> 2, bh & 3, seg, nullptr, ret_norm_g + l * 64, Eret, Asr, g_wave);
                else lin::unit<32, false, true>(lds, P, ACT, csr, bh >> 2, bh & 3, seg, gla_b_a + l * 128, gla_norm_g + l * 64, Egla, Asg, g_wave);
            }
#endif
        }
        SEAM(pb + 3);
        if (PHON(5) && IN(pb + 4)) {
            const int tid = otid(), lane = tid & 63; (void)tid; (void)lane; WSL();
            const float* xin = XIN; const float* modl = MODL; bf16* ACT = WSP(bf16, WS_ACT); bf16* Wout_t = WSP(bf16, WS_WOUT);
            pg8::Gemm g{ACT, Wout_t + (size_t)l * 1024 * 1024, 1024, 1024, 1024}; pg8::StaticOrder<T / 256, 4> S; S.init(G, bx);
            pg8::EpiResid E{xin, xout, modl + 2048};
            _Pragma("unroll 1") for (int rep_ = 0; rep_ < 1 + ((RPT_PHASE == 5 && l == 0) ? RPT_N : 0); ++rep_)
            pg8::gemm_phase<pg8::EpiResid, pg8::StaticOrder<T / 256, 4>, 0>(lds, g, S, E, g_wave);
        }
        SEAM(pb + 4);
        if (PHON(6) && IN(pb + 5)) {
            const int tid = otid(), lane = tid & 63; (void)tid; (void)lane; WSL();
            const float* modl = MODL; const float* router_w = INF(20); const float* router_b = INF(21); const float* norm2_g = INF(6); bf16* ACT = WSP(bf16, WS_ACT); int* tokinfo = WSP(int, WS_ROUTE); int* tokS = WSP(int, WS_TOKS); unsigned char* h2q = WSP(unsigned char, WS_H2Q); float* sa2 = WSP(float, WS_SA2);
            constexpr int WR_PITCH = 2064, LG_OFF = 32 * WR_PITCH;
#pragma unroll 4
            for (int i = tid; i < 32768; i += NWAVES * 64) { const int k = i >> 5, e = i & 31; *(LAS unsigned short*)(lds + e * WR_PITCH + k * 2) = (unsigned short)(pk2(router_w[i], 0.f) & 0xffffu); }
            { int Gl = G; asm volatile("" : "+s"(Gl));
#pragma unroll 1
              for (int i = bx * NWAVES * 64 + tid; i < TPAD; i += Gl * NWAVES * 64) tokS[i] = -1; }
            __syncthreads();
            const float* g2 = norm2_g + l * 1024;
            LAS float* lg = (LAS float*)(lds + LG_OFF + wave * 2112);
            unsigned* cnt = ctl + CW_CNT + l * 64;
            for (int gi = gw; gi < T / 16; gi += NGW) {
                for (int r4 = 0; r4 < 16; r4 += 4) {
                    f32x4 v[4][4];
#pragma unroll
                    for (int q = 0; q < 4; ++q) { const f32x4* xr = (const f32x4*)(xout + (size_t)(gi * 16 + r4 + q) * DM) + lane;
#pragma unroll
                        for (int j = 0; j < 4; ++j) v[q][j] = xr[64 * j]; }
#pragma unroll
                    for (int q = 0; q < 4; ++q) { const int m = gi * 16 + r4 + q; const int b = m >> 13; const float* mb = modl + (size_t)b * 6144 + 3072; float s = 0.f;
#pragma unroll
                        for (int j = 0; j < 4; ++j) s += (v[q][j][0] * v[q][j][0] + v[q][j][1] * v[q][j][1]) + (v[q][j][2] * v[q][j][2] + v[q][j][3] * v[q][j][3]);
                        const float rstd = rsqrtf(wave_sum(s) * (1.0f / 1024.0f) + EPS);
                        u32x2* o8 = (u32x2*)(ACT + (size_t)m * DM) + lane; f32x4 y[4]; float am = 0.f;
#pragma unroll
                        for (int j = 0; j < 4; ++j) { const int k = 4 * lane + 256 * j; const f32x4 gg = *(const f32x4*)(g2 + k), sh = *(const f32x4*)(mb + k), sc = *(const f32x4*)(mb + 1024 + k);
                            y[j] = v[q][j] * rstd * gg * (sc + 1.0f) + sh; u32x2 w; w.x = pk2(y[j][0], y[j][1]); w.y = pk2(y[j][2], y[j][3]); o8[64 * j] = w;
                            am = fmaxf(am, fmaxf(fmaxf(fabsf(y[j][0]), fabsf(y[j][1])), fmaxf(fabsf(y[j][2]), fabsf(y[j][3])))); }
                        am = wave_max(am); const float inv = am > 0.f ? 127.0f / am : 0.f;
                        if (lane == 0) sa2[m] = am > 0.f ? am * (1.0f / 127.0f) : 1.0f;
                        unsigned* o4 = (unsigned*)(h2q + (size_t)m * 1024) + lane;
#pragma unroll
                        for (int j = 0; j < 4; ++j) { unsigned w = 0u;
#pragma unroll
                            for (int e = 0; e < 4; ++e) w |= ((unsigned)(int)__builtin_rintf(y[j][e] * inv) & 0xffu) << (8 * e);
                            o4[64 * j] = w; } }
                }
                VM_WAIT();
                f32x4 a0 = (f32x4){0.f, 0.f, 0.f, 0.f}, a1 = a0;
                const bf16* ap = ACT + (size_t)(gi * 16 + (lane & 15)) * DM + 8 * (lane >> 4);
#pragma unroll 4
                for (int ks = 0; ks < 32; ++ks) { const bf16x8 a = *(const bf16x8*)(ap + 32 * ks);
                    const bf16x8 b0 = *(const LAS bf16x8*)(lds + (lane & 15) * WR_PITCH + (32 * ks + 8 * (lane >> 4)) * 2), b1 = *(const LAS bf16x8*)(lds + (16 + (lane & 15)) * WR_PITCH + (32 * ks + 8 * (lane >> 4)) * 2);
                    a0 = MFMA16(a, b0, a0); a1 = MFMA16(a, b1, a1); }
#pragma unroll
                for (int r = 0; r < 4; ++r) { lg[(4 * (lane >> 4) + r) * 33 + (lane & 15)] = a0[r]; lg[(4 * (lane >> 4) + r) * 33 + 16 + (lane & 15)] = a1[r]; }
                LDS_WAIT(); asm volatile("" ::: "memory");
                if (lane < 16) {
                    const int m = gi * 16 + lane; float best = -3.0e38f; int bcls = 0; float bwa = 0.f, bwb = 0.f;
#pragma unroll
                    for (int g = 0; g < 8; ++g) {
                        float s[4], a[4];
#pragma unroll
                        for (int i = 0; i < 4; ++i) { s[i] = 1.0f / (1.0f + __expf(-lg[lane * 33 + 4 * g + i])); a[i] = s[i] + router_b[4 * g + i]; }
                        int i1 = 0; float v1 = a[0];
                        if (a[1] > v1) { v1 = a[1]; i1 = 1; } if (a[2] > v1) { v1 = a[2]; i1 = 2; } if (a[3] > v1) { v1 = a[3]; i1 = 3; }
                        int i2 = -1; float v2 = -3.0e38f;
                        if (i1 != 0 && a[0] > v2) { v2 = a[0]; i2 = 0; } if (i1 != 1 && a[1] > v2) { v2 = a[1]; i2 = 1; } if (i1 != 2 && a[2] > v2) { v2 = a[2]; i2 = 2; } if (i1 != 3 && a[3] > v2) { v2 = a[3]; i2 = 3; }
                        const float gsum = v1 + v2;
                        const int ea = i1 < i2 ? i1 : i2, eb = i1 < i2 ? i2 : i1;
                        const float sa = ea == 0 ? s[0] : (ea == 1 ? s[1] : s[2]), sb = eb == 1 ? s[1] : (eb == 2 ? s[2] : s[3]);
                        const int pidx = (ea * (7 - ea)) / 2 + (eb - ea - 1);
                        if (gsum > best) { best = gsum; bcls = g * 6 + pidx; const float den = 1.0f / (sa + sb); bwa = sa * den; bwb = sb * den; }
                    }
                    const unsigned rank = atomicAdd(cnt + bcls, 1u);
                    *(u32x4*)(tokinfo + (size_t)m * 4) = (u32x4){(unsigned)bcls, rank, __float_as_uint(bwa), __float_as_uint(bwb)};
                }
                LDS_WAIT(); asm volatile("" ::: "memory");
            }
            __syncthreads();
        }
        SEAM(pb + 5);
        if (PHON(7) && IN(pb + 6)) {
            const int tid = otid(), lane = tid & 63; (void)tid; (void)lane; WSL();
            const unsigned char* h2q = WSP(const unsigned char, WS_H2Q); unsigned char* H2S = WSP(unsigned char, WS_H2S); const float* sa2 = WSP(const float, WS_SA2); float* saS = WSP(float, WS_SAS); int* tokinfo = WSP(int, WS_ROUTE); int* tokS = WSP(int, WS_TOKS); float* gaS = WSP(float, WS_GAS); float* gbS = WSP(float, WS_GBS); int* tinfo = WSP(int, WS_TINFO);
            LAS int* cst = (LAS int*)lds;
            if (tid == 0) { const unsigned* cnt = ctl + CW_CNT + l * 64; int s = 0, nt = 0;
                for (int c = 0; c < NCLS; ++c) { const int n = (int)__hip_atomic_load(cnt + c, __ATOMIC_RELAXED, __HIP_MEMORY_SCOPE_AGENT); cst[c] = s; const int tl = (n + 255) >> 8;
                    if (bx == 0) { const int g = c / 6, p = c % 6; const int a = p < 3 ? 0 : (p < 5 ? 1 : 2); const int bb = p < 3 ? p + 1 : (p < 5 ? p - 1 : 3); const int code = (g * 4 + a) | ((g * 4 + bb) << 8);
                        for (int i = 0; i < tl; ++i) tinfo[1 + nt + i] = code; }
                    nt += tl; s += tl * 256; }
                if (bx == 0) tinfo[0] = nt; }
            __syncthreads();
            _Pragma("unroll 1") for (int rep_ = 0; rep_ < 1 + (RPT_PHASE == 7 ? RPT_N : 0); ++rep_)
            for (int m = gw; m < T; m += NGW) {
                const u32x4 inf = *(const u32x4*)(tokinfo + (size_t)m * 4);
                const int slot = cst[inf.x] + (int)inf.y;
                const u32x4* src = (const u32x4*)(h2q + (size_t)m * 1024); u32x4* dst = (u32x4*)(H2S + (size_t)slot * 1024);
                dst[lane] = src[lane];
                if (lane == 0) { tokS[slot] = m; gaS[slot] = __uint_as_float(inf.z); gbS[slot] = __uint_as_float(inf.w); saS[slot] = sa2[m]; }
            }
            __syncthreads();
        }
        SEAM(pb + 6);
        if (PHON(8) && IN(pb + 7)) {
            const int tid = otid(), lane = tid & 63; (void)tid; (void)lane; WSL();
            bf16* H2S = WSP(bf16, WS_H2S); bf16* U = WSP(bf16, WS_U); float* gaS = WSP(float, WS_GAS); float* gbS = WSP(float, WS_GBS); int* tinfo = WSP(int, WS_TINFO);
            pg8::Gemm g{H2S, (const bf16*)(WSP(unsigned char, WS_W1) + (size_t)l * 32 * 1024 * 1024), 512, 512, 512}; pg8::MoeOrder<8, 1> S{tinfo, G, vcu};
            pg8::EpiMoe1 E{U, gaS, gbS, WSP(const float, WS_SAS), WSP(const float, WS_SW1) + (size_t)l * 32 * 1024};
            _Pragma("unroll 1") for (int rep_ = 0; rep_ < 1 + (RPT_PHASE == 8 ? RPT_N : 0); ++rep_)
            pg8::gemm_phase<pg8::EpiMoe1, pg8::MoeOrder<8, 1>, 0, true>(lds, g, S, E, g_wave);
        }
        SEAM(pb + 7);
        if (PHON(9) && IN(pb + 8)) {
            const int tid = otid(), lane = tid & 63; (void)tid; (void)lane; WSL();
            const float* modl = MODL; bf16* U = WSP(bf16, WS_U); bf16* W2 = WSP(bf16, WS_W2); int* tokS = WSP(int, WS_TOKS); int* tinfo = WSP(int, WS_TINFO);
            pg8::Gemm g{U, W2 + (size_t)l * 32 * 1024 * 512, 1024, 1024, 512}; pg8::MoeOrder<4, 2> S{tinfo, G, vcu};
            pg8::EpiMoe2 E{xout, tokS, modl + 5 * 1024};
            pg8::gemm_phase<pg8::EpiMoe2, pg8::MoeOrder<4, 2>, 8>(lds, g, S, E, g_wave);
        }
        SEAM(pb + 8);
    }
#undef IN
#undef SEAM
}

extern "C" void kernel_launch(void* const* d_in, const int* in_sizes, int n_in, void* d_out, int out_size, void* d_ws, size_t ws_size, hipStream_t stream) {
    static int grid = 0;
    if (grid == 0) {
        if (n_in != 25 || in_sizes[0] != T * DM || out_size != T * DM || ws_size < WS_END) { fprintf(stderr, "kernel_launch: unexpected shapes (n_in %d, in0 %d, out %d, ws %zu < %zu)\n", n_in, n_in > 0 ? in_sizes[0] : -1, out_size, ws_size, (size_t)WS_END); grid = -1; return; }
        int dev = 0, cus = 0, per_cu = 0;
        if (hipGetDevice(&dev) != hipSuccess || hipDeviceGetAttribute(&cus, hipDeviceAttributeMultiprocessorCount, dev) != hipSuccess) { grid = -1; return; }
        if (hipFuncSetAttribute((const void*)fwd, hipFuncAttributeMaxDynamicSharedMemorySize, LDS_BYTES) != hipSuccess) { fprintf(stderr, "kernel_launch: hipFuncSetAttribute failed\n"); grid = -1; return; }
        if (hipOccupancyMaxActiveBlocksPerMultiprocessor(&per_cu, (const void*)fwd, NWAVES * 64, LDS_BYTES) != hipSuccess || per_cu < 1) fprintf(stderr, "kernel_launch: occupancy query reports %d\n", per_cu);
        (void)hipGetLastError();
        grid = cus;
    }
    if (grid < 0) return;
    if (hipMemsetAsync((char*)d_ws + WS_CTL, 0, CTL_ZERO_BYTES, stream) != hipSuccess) return;
    Args a{};
    for (int i = 0; i < 25; ++i) a.in[i] = (const float*)d_in[i];
    a.out = (float*)d_out; a.ws = (unsigned char*)d_ws;
#if MK_N_LAUNCHES == 1
    a.ph_lo = 0; a.ph_hi = NPHASE;
    hipLaunchKernelGGL(fwd, dim3(grid), dim3(NWAVES * 64), LDS_BYTES, stream, a);
#else
    for (int p = 0; p < NPHASE; ++p) { a.ph_lo = p; a.ph_hi = p + 1; hipLaunchKernelGGL(fwd, dim3(grid), dim3(NWAVES * 64), LDS_BYTES, stream, a); }
#endif
}
```

```cpp
#include <hip/hip_runtime.h>
#include <cstdio>
#include <cstdint>

#ifndef MK_N_LAUNCHES
#define MK_N_LAUNCHES 1
#endif
#ifndef DBG_GROUPS
#define DBG_GROUPS 7
#endif
#ifndef DBG_MOE
#define DBG_MOE 1
#endif
#ifndef RPT_PHASE
#define RPT_PHASE 0
#endif
#ifndef RPT_N
#define RPT_N 1
#endif

#define LAS __attribute__((address_space(3)))
#define GAS __attribute__((address_space(1)))
typedef unsigned short bf16;
typedef short bf16x8 __attribute__((ext_vector_type(8)));
typedef short s16x4 __attribute__((ext_vector_type(4)));
typedef float f32x4 __attribute__((ext_vector_type(4)));
typedef float f32x16 __attribute__((ext_vector_type(16)));
typedef float f32x2 __attribute__((ext_vector_type(2)));
typedef unsigned u32x4 __attribute__((ext_vector_type(4)));
typedef unsigned u32x2 __attribute__((ext_vector_type(2)));
typedef __bf16 bf16x2_t __attribute__((ext_vector_type(2)));
typedef int i32x4 __attribute__((ext_vector_type(4)));

constexpr int BATCH = 8, SEQ = 8192, DM = 1024, T = BATCH * SEQ, DEPTH = 2;
constexpr int NP = 3584;
constexpr int C_RQ = 0, C_RK = 256, C_RV = 512, C_RG = 768, C_DQ = 1024, C_DK = 1536, C_DV = 2048, C_GQ = 2560, C_GK = 2688, C_GV = 2816, C_LA = 3072, C_GR = 3200, C_PAD = 3456;
constexpr int IN_W = 3344;
constexpr int NCLS = 48, TPAD = T + NCLS * 256, MAXTILES = TPAD / 256;
constexpr float EPS = 1e-6f, LOG2E = 1.4426950408889634f;

constexpr size_t MiB = 1u << 20;
constexpr size_t WS_CTL = 0, CTL_ZERO_BYTES = 1 * MiB;
constexpr size_t WS_MOD = 1 * MiB;
constexpr size_t WS_SCAL = WS_MOD + 400 * 1024;
constexpr size_t WS_CSR = 2 * MiB;
constexpr size_t WS_CSD = 19 * MiB;
constexpr size_t WS_WIN = 24 * MiB;
constexpr size_t WS_WOUT = 38 * MiB;
constexpr size_t WS_W1 = 42 * MiB;
constexpr size_t WS_W2 = 170 * MiB;
constexpr size_t WS_ACT = 234 * MiB;
constexpr size_t WS_P = 362 * MiB;
constexpr size_t WS_H2S = WS_P;
constexpr size_t WS_U = WS_P + 152 * MiB;
constexpr size_t WS_EST = 810 * MiB;
constexpr size_t WS_EGL = WS_EST + 8 * MiB, WS_ASR = WS_EST + 12 * MiB, WS_ASG = WS_ASR + 256 * 1024;
constexpr size_t WS_ROUTE = 824 * MiB;
constexpr size_t WS_TOKS = WS_ROUTE + 1 * MiB, WS_GAS = WS_TOKS + 512 * 1024, WS_GBS = WS_GAS + 512 * 1024, WS_TINFO = WS_GBS + 512 * 1024;
constexpr size_t WS_SA1 = 828 * MiB, WS_SA2 = WS_SA1 + 256 * 1024, WS_SAS = WS_SA2 + 256 * 1024, WS_SWIN = WS_SA1 + 1024 * 1024, WS_SW1 = WS_SWIN + 256 * 1024;
constexpr size_t WS_H2Q = 830 * MiB;
constexpr size_t WS_XB = 894 * MiB;
constexpr size_t WS_END = 1022 * MiB;
static_assert((size_t)TPAD * 1024 * 2 <= 152 * MiB && WS_U + 152 * MiB <= WS_P + (size_t)T * NP * 2, "aliases fit inside P");
static_assert((size_t)T * NP * 2 == 448 * MiB && WS_P + 448 * MiB == WS_EST, "P size");
constexpr int CW_BAR = 4096;
constexpr int CW_CNT = 16384;

constexpr int RING_BYTES = 131072, LDSCTL_OFF = RING_BYTES, MISC_OFF = LDSCTL_OFF + 320, PTR_OFF = MISC_OFF + 128, LDS_BYTES = 147456;
constexpr int NWAVES = 8;

__device__ __forceinline__ unsigned pk2(float lo, float hi) { f32x2 v = {lo, hi}; bf16x2_t b = __builtin_convertvector(v, bf16x2_t); return __builtin_bit_cast(unsigned, b); }
__device__ __forceinline__ float bflo(unsigned w) { return __uint_as_float(w << 16); }
__device__ __forceinline__ float bfhi(unsigned w) { return __uint_as_float(w & 0xffff0000u); }
template <int K> __device__ __forceinline__ float sx(float v) { static_assert(K >= 1 && K < 32, "sx"); return __int_as_float(__builtin_amdgcn_ds_swizzle(__float_as_int(v), (K << 10) | 0x1f)); }
__device__ __forceinline__ float sum_halves(float v) { auto rr = __builtin_amdgcn_permlane32_swap(__float_as_uint(v), __float_as_uint(v), false, false); return __uint_as_float(rr[0]) + __uint_as_float(rr[1]); }
__device__ __forceinline__ float max_halves(float v) { auto rr = __builtin_amdgcn_permlane32_swap(__float_as_uint(v), __float_as_uint(v), false, false); return fmaxf(__uint_as_float(rr[0]), __uint_as_float(rr[1])); }
__device__ __forceinline__ float wave_sum(float v) { v += sx<1>(v); v += sx<2>(v); v += sx<4>(v); v += sx<8>(v); v += sx<16>(v); return sum_halves(v); }
__device__ __forceinline__ float wave_max(float v) { v = fmaxf(v, sx<1>(v)); v = fmaxf(v, sx<2>(v)); v = fmaxf(v, sx<4>(v)); v = fmaxf(v, sx<8>(v)); v = fmaxf(v, sx<16>(v)); return max_halves(v); }
__device__ __forceinline__ float silu_f(float x) { return x * __builtin_amdgcn_rcpf(1.0f + __expf(-x)); }
__device__ __forceinline__ int olane() { int l; asm volatile("v_mbcnt_lo_u32_b32 %0, -1, 0\n\tv_mbcnt_hi_u32_b32 %0, -1, %0" : "=v"(l)); return l; }
__device__ __forceinline__ int otid_w(int wave) { return wave * 64 + olane(); }
#define otid() otid_w(g_wave)
__device__ __forceinline__ unsigned pk4_fp8(float a, float b, float c, float d) { int w = __builtin_amdgcn_cvt_pk_fp8_f32(a, b, 0, false); w = __builtin_amdgcn_cvt_pk_fp8_f32(c, d, w, true); return (unsigned)w; }
constexpr float FP8_ACT_SCALE = 16.0f, FP8_W_SCALE = 32.0f;   static_assert(FP8_ACT_SCALE == 16.0f, "EpiMoe1 applies it as ldexp(., 4)");
constexpr int FP8_ACT_E8 = 127 - 4, FP8_W_E8 = 127 - 5;
template <class Tp> __device__ __forceinline__ const Tp* inptr(const LAS unsigned char* lds, int k) {
    const LAS unsigned* q = (const LAS unsigned*)(lds + PTR_OFF) + 2 * k; const unsigned lo = __builtin_amdgcn_readfirstlane(q[0]), hi = __builtin_amdgcn_readfirstlane(q[1]);
    return (const Tp*)(((unsigned long long)hi << 32) | lo); }
#define INF(k) inptr<float>(lds, k)
__device__ __forceinline__ f32x4 ldx4(const float* xf, const bf16* xb, size_t idx) {
    if (xf) return *(const f32x4*)(xf + idx);
    const u32x2 w = *(const u32x2*)(xb + idx); return (f32x4){bflo(w.x), bfhi(w.x), bflo(w.y), bfhi(w.y)}; }
#define LDS_WAIT() asm volatile("s_waitcnt lgkmcnt(0)" ::: "memory")
#define VM_WAIT() asm volatile("s_waitcnt vmcnt(0)" ::: "memory")

namespace pg8 {
constexpr int BM = 256, BK = 64, HALF = 128, HTB = HALF * BK * 2, STAGE_BYTES = 8 * HTB, NXCD = 8, WGM = 8;
__device__ __forceinline__ int lds_byte(int r, int c) { const int st = (r >> 4) * 2 + (c >> 5), rr = r & 15, cc = c & 31, ob = rr * 64 + cc * 2; return st * 1024 + (ob ^ (((ob >> 9) & 1) << 5)); }
__device__ __forceinline__ void stage_rc(int b, int& R, int& C) { const int st = b / 1024, sb = b % 1024, swz = sb ^ (((sb >> 9) & 1) << 5); R = (st >> 1) * 16 + swz / 64; C = (st & 1) * 32 + (swz % 64) / 2; }
__device__ __forceinline__ int perm32(int rho) { const int n = rho >> 4, i = rho & 15; return 8 * (i >> 2) + 4 * n + (i & 3); }

struct Unit { int pm, pn, e0, e1; };
struct Gemm { const bf16* A; const bf16* Bt; int K, lda, ldb; };

template <int NM, int NN> struct StaticOrder {
    static constexpr int nM = NM, nN = NN, nwg = NM * NN;
    int G, c;
    __device__ void init(int G_, int c_) { G = G_; c = c_; }
    __device__ bool next(int i, Unit& u) const {
        const int L = i * G + c; if (L >= nwg) return false;
        int wgid = L; { constexpr int q = nwg / NXCD, r = nwg % NXCD; const int xcd = wgid % NXCD, off = wgid / NXCD; wgid = (xcd < r ? xcd * (q + 1) : r * (q + 1) + (xcd - r) * q) + off; }
        constexpr int nig = WGM * nN; static_assert(NM % WGM == 0, "row tiles in whole groups");
        const int gid = wgid / nig, fm = gid * WGM;
        u.pm = fm + ((wgid % nig) % WGM); u.pn = (wgid % nig) / WGM; u.e0 = 0; u.e1 = 0; return true;
    }
    __device__ __forceinline__ const char* a_base(const Gemm& g, const Unit& u) const { return (const char*)g.A + (size_t)u.pm * BM * g.lda * 2; }
    __device__ __forceinline__ const char* b_lo(const Gemm& g, const Unit& u) const { return (const char*)g.Bt + (size_t)u.pn * BM * g.ldb * 2; }
    __device__ __forceinline__ const char* b_hi(const Gemm& g, const Unit& u) const { return b_lo(g, u); }
};
template <int NPN, int WHICH  >
struct MoeOrder {
    const int* tinfo; int G, c;
    __device__ bool next(int i, Unit& u) const {
        const int nT = __builtin_amdgcn_readfirstlane(tinfo[0]);
        const int L = i * G + c; if (L >= nT * NPN) return false;
        const int gF = nT >> 3, full = gF * 8 * NPN;
        if (L < full) { u.pm = (L / (8 * NPN)) * 8 + (L & 7); u.pn = (L >> 3) % NPN; }
        else { const int rT = nT - 8 * gF; int Lr = L - full, pn = 0; while (Lr >= rT) { Lr -= rT; ++pn; } u.pm = gF * 8 + Lr; u.pn = pn; }
        const int code = __builtin_amdgcn_readfirstlane(tinfo[1 + u.pm]); u.e0 = code & 0xff; u.e1 = (code >> 8) & 0xff; return true;
    }
    __device__ __forceinline__ const char* a_base(const Gemm& g, const Unit& u) const { return (const char*)g.A + (size_t)u.pm * BM * g.lda * 2; }
    __device__ __forceinline__ const char* b_lo(const Gemm& g, const Unit& u) const {
        if (WHICH == 1) return (const char*)g.Bt + ((size_t)(u.pn < 4 ? u.e0 : u.e1) * 1024 + (size_t)(u.pn & 3) * BM) * g.ldb * 2;
        return (const char*)g.Bt + ((size_t)u.e0 * 1024 + (size_t)u.pn * BM) * g.ldb * 2;
    }
    __device__ __forceinline__ const char* b_hi(const Gemm& g, const Unit& u) const {
        if (WHICH == 1) return b_lo(g, u);
        return (const char*)g.Bt + ((size_t)u.e1 * 1024 + (size_t)u.pn * BM) * g.ldb * 2 - (size_t)g.K;
    }
};

struct EpiStoreBf16 {
    static constexpr bool PERM = true;
    bf16* O; int ldc;
    __device__ __forceinline__ void operator()(const f32x4 (&acc)[2][2][4][2], const Unit& u, int wr, int wc, int fr, int fq) const {
        { const int l_ = olane(); fr = l_ & 15; fq = l_ >> 4; }
        const int row0 = u.pm * BM + wr * 64 + fr, col0 = u.pn * BM + wc * 32 + 8 * fq;
#pragma unroll
        for (int ai = 0; ai < 2; ++ai)
#pragma unroll
            for (int m = 0; m < 4; ++m) { bf16* rowp = O + (size_t)(row0 + ai * HALF + m * 16) * ldc + col0;
#pragma unroll
                for (int bj = 0; bj < 2; ++bj) { const f32x4 v0 = acc[ai][bj][m][0], v1 = acc[ai][bj][m][1];
                    u32x4 w; w.x = pk2(v0[0], v0[1]); w.y = pk2(v0[2], v0[3]); w.z = pk2(v1[0], v1[1]); w.w = pk2(v1[2], v1[3]);
                    *(u32x4*)(rowp + bj * HALF) = w; } }
    }
};
struct EpiInproj {
    static constexpr bool PERM = true;
    bf16* O; int ldc; const float* sa; const float* sw; const float* gq; const float* gk; const f32x2* csd;
    __device__ __forceinline__ void operator()(const i32x4 (&acc)[2][2][4][2], const Unit& u, int wr, int wc, int fr, int fq) const {
        { const int l_ = olane(); fr = l_ & 15; fq = l_ >> 4; }
        const int row0 = u.pm * BM + wr * 64 + fr, col0 = u.pn * BM + wc * 32 + 8 * fq;
        f32x4 cs[2][2];
#pragma unroll
        for (int bj = 0; bj < 2; ++bj)
#pragma unroll
            for (int n = 0; n < 2; ++n) cs[bj][n] = *(const f32x4*)(sw + col0 + bj * HALF + 4 * n);
        if (u.pn < 4 || u.pn >= 8) {
#pragma unroll
            for (int ai = 0; ai < 2; ++ai)
#pragma unroll
                for (int m = 0; m < 4; ++m) { const int row = row0 + ai * HALF + m * 16; const float rs = sa[row]; bf16* rowp = O + (size_t)row * ldc + col0;
#pragma unroll
                    for (int bj = 0; bj < 2; ++bj) { const f32x4 v0 = __builtin_convertvector(acc[ai][bj][m][0], f32x4) * cs[bj][0] * rs, v1 = __builtin_convertvector(acc[ai][bj][m][1], f32x4) * cs[bj][1] * rs;
                        u32x4 w; w.x = pk2(v0[0], v0[1]); w.y = pk2(v0[2], v0[3]); w.z = pk2(v1[0], v1[1]); w.w = pk2(v1[2], v1[3]);
                        *(u32x4*)(rowp + bj * HALF) = w; } }
        } else {
            const bool isq = u.pn < 6; const float* gg = (isq ? gq : gk) + 8 * fq; const float qs = isq ? 0.125f * LOG2E : 1.0f;
            f32x4 gv[2][2];
#pragma unroll
            for (int bj = 0; bj < 2; ++bj)
#pragma unroll
                for (int n = 0; n < 2; ++n) gv[bj][n] = *(const f32x4*)(gg + 32 * bj + 4 * n) * qs;
            const int lcol = u.pn * BM + 64 * wc + 8 * fq;
#pragma unroll
            for (int ai = 0; ai < 2; ++ai)
#pragma unroll
                for (int m = 0; m < 4; ++m) { const int row = row0 + ai * HALF + m * 16; const float rs = sa[row];
                    f32x4 x[2][2]; float ss = 0.f;
#pragma unroll
                    for (int bj = 0; bj < 2; ++bj)
#pragma unroll
                        for (int n = 0; n < 2; ++n) { x[bj][n] = __builtin_convertvector(acc[ai][bj][m][n], f32x4) * cs[bj][n] * rs; ss += (x[bj][n][0] * x[bj][n][0] + x[bj][n][1] * x[bj][n][1]) + (x[bj][n][2] * x[bj][n][2] + x[bj][n][3] * x[bj][n][3]); }
                    ss += sx<16>(ss); ss = sum_halves(ss);
                    const float rstd = rsqrtf(ss * (1.0f / 64.0f) + EPS);
#pragma unroll
                    for (int bj = 0; bj < 2; ++bj)
#pragma unroll
                        for (int n = 0; n < 2; ++n) x[bj][n] = x[bj][n] * gv[bj][n] * rstd;
                    const f32x4* c4 = (const f32x4*)(csd + (size_t)row * 8);
#pragma unroll
                    for (int n = 0; n < 2; ++n) { const f32x4 ca = c4[2 * n], cb = c4[2 * n + 1];
                        f32x4 pr;
#pragma unroll
                        for (int i = 0; i < 4; ++i) pr[i] = sx<16>(x[0][n][i]);
                        const f32x4 co = (f32x4){ca[0], ca[2], cb[0], cb[2]}, sn = (f32x4){ca[1], ca[3], cb[1], cb[3]};
                        const f32x4 r0 = x[0][n] * co - pr * sn, r1 = pr * sn + x[0][n] * co;
                        if (fq == 0) x[0][n] = r0; else if (fq == 1) x[0][n] = r1; }
                    bf16* rowp = O + (size_t)row * ldc + lcol;
#pragma unroll
                    for (int bj = 0; bj < 2; ++bj) { u32x4 w; w.x = pk2(x[bj][0][0], x[bj][0][1]); w.y = pk2(x[bj][0][2], x[bj][0][3]); w.z = pk2(x[bj][1][0], x[bj][1][1]); w.w = pk2(x[bj][1][2], x[bj][1][3]);
                        *(u32x4*)(rowp + 32 * bj) = w; } }
        }
    }
};
struct EpiResid {
    static constexpr bool PERM = true;
    const float* xf; bf16* xb; const float* gate;
    __device__ __forceinline__ void operator()(const f32x4 (&acc)[2][2][4][2], const Unit& u, int wr, int wc, int fr, int fq) const {
        { const int l_ = olane(); fr = l_ & 15; fq = l_ >> 4; }
        const int col0 = u.pn * BM + wc * 32 + 8 * fq; const int b = (u.pm * BM) >> 13;
        f32x4 gv[2][2];
#pragma unroll
        for (int bj = 0; bj < 2; ++bj)
#pragma unroll
            for (int n = 0; n < 2; ++n) gv[bj][n] = *(const f32x4*)(gate + (size_t)b * 6144 + col0 + bj * HALF + 4 * n);
#pragma unroll
        for (int ai = 0; ai < 2; ++ai)
#pragma unroll
            for (int m = 0; m < 4; ++m) { const size_t off = (size_t)(u.pm * BM + ai * HALF + wr * 64 + m * 16 + fr) * DM + col0;
#pragma unroll
                for (int bj = 0; bj < 2; ++bj) { f32x4 x0, x1;
                    if (xf) { x0 = *(const f32x4*)(xf + off + bj * HALF); x1 = *(const f32x4*)(xf + off + bj * HALF + 4); }
                    else { const u32x4 w = *(const u32x4*)(xb + off + bj * HALF); x0 = (f32x4){bflo(w.x), bfhi(w.x), bflo(w.y), bfhi(w.y)}; x1 = (f32x4){bflo(w.z), bfhi(w.z), bflo(w.w), bfhi(w.w)}; }
                    x0 += gv[bj][0] * acc[ai][bj][m][0]; x1 += gv[bj][1] * acc[ai][bj][m][1];
                    u32x4 o; o.x = pk2(x0[0], x0[1]); o.y = pk2(x0[2], x0[3]); o.z = pk2(x1[0], x1[1]); o.w = pk2(x1[2], x1[3]);
                    *(u32x4*)(xb + off + bj * HALF) = o; }
                if (m & 1) asm volatile("" ::: "memory"); }
    }
};
struct EpiMoe1 {
    static constexpr bool PERM = true;
    unsigned char* U; const float* gaS; const float* gbS; const float* saS; const float* sw1;
    __device__ __forceinline__ void operator()(const i32x4 (&acc)[2][2][4][2], const Unit& u, int wr, int wc, int fr, int fq) const {
        { const int l_ = olane(); fr = l_ & 15; fq = l_ >> 4; }
        const float* gs = (u.pn < 4) ? gaS : gbS; const int ucol = u.pn * 128 + wc * 32 + 8 * fq;
        const float* swp = sw1 + (size_t)(u.pn < 4 ? u.e0 : u.e1) * 1024 + (u.pn & 3) * BM + wc * 32 + 8 * fq;
        f32x4 cs[2][2];
#pragma unroll
        for (int bj = 0; bj < 2; ++bj)
#pragma unroll
            for (int n = 0; n < 2; ++n) cs[bj][n] = *(const f32x4*)(swp + bj * HALF + 4 * n);
#pragma unroll
        for (int ai = 0; ai < 2; ++ai)
#pragma unroll
            for (int m = 0; m < 4; ++m) { const int slot = u.pm * BM + ai * HALF + wr * 64 + m * 16 + fr; const float w = __builtin_ldexpf(gs[slot], 4)  , rs = saS[slot];
                float r[8];
#pragma unroll
                for (int n = 0; n < 2; ++n) { const f32x4 gv = __builtin_convertvector(acc[ai][0][m][n], f32x4) * cs[0][n] * rs, uv = __builtin_convertvector(acc[ai][1][m][n], f32x4) * cs[1][n] * (rs * w);
#pragma unroll
                    for (int i = 0; i < 4; ++i) r[n * 4 + i] = silu_f(gv[i]) * uv[i]; }
                u32x2 o; o.x = pk4_fp8(r[0], r[1], r[2], r[3]); o.y = pk4_fp8(r[4], r[5], r[6], r[7]);
                *(u32x2*)(U + (size_t)slot * 1024 + ucol) = o; asm volatile("" ::: "memory"); }
    }
};
struct EpiMoe2 {
    static constexpr bool PERM = true;
    bf16* xb; float* outf; const int* tokS; const float* gate;
    __device__ __forceinline__ void operator()(const f32x4 (&acc)[2][2][4][2], const Unit& u, int wr, int wc, int fr, int fq) const {
        { const int l_ = olane(); fr = l_ & 15; fq = l_ >> 4; }
        const int col0 = u.pn * BM + wc * 32 + 8 * fq;
#pragma unroll
        for (int ai = 0; ai < 2; ++ai)
#pragma unroll
            for (int m = 0; m < 4; ++m) { const int slot = u.pm * BM + ai * HALF + wr * 64 + m * 16 + fr; const int tok = tokS[slot];
                if (tok >= 0) { const int b = tok >> 13; const size_t off = (size_t)tok * DM + col0; const float* gp = gate + (size_t)b * 6144 + col0;
#pragma unroll
                    for (int bj = 0; bj < 2; ++bj) { const f32x4 g0 = *(const f32x4*)(gp + bj * HALF), g1 = *(const f32x4*)(gp + bj * HALF + 4); const u32x4 w = *(const u32x4*)(xb + off + bj * HALF);
                        const f32x4 x0 = (f32x4){bflo(w.x), bfhi(w.x), bflo(w.y), bfhi(w.y)} + (DBG_MOE ? 1.f : 0.f) * g0 * acc[ai][bj][m][0], x1 = (f32x4){bflo(w.z), bfhi(w.z), bflo(w.w), bfhi(w.w)} + (DBG_MOE ? 1.f : 0.f) * g1 * acc[ai][bj][m][1];
                        if (outf) { *(f32x4*)(outf + off + bj * HALF) = x0; *(f32x4*)(outf + off + bj * HALF + 4) = x1; }
                        else { u32x4 o; o.x = pk2(x0[0], x0[1]); o.y = pk2(x0[2], x0[3]); o.z = pk2(x1[0], x1[1]); o.w = pk2(x1[2], x1[3]); *(u32x4*)(xb + off + bj * HALF) = o; } } }
                if (m & 1) asm volatile("" ::: "memory"); }
    }
};

typedef int i32x8 __attribute__((ext_vector_type(8)));
template <int MODE> struct AccT { typedef f32x4 type; }; template <> struct AccT<1> { typedef i32x4 type; };
template <int MODE> struct Frag { bf16x8 lo, hi; __device__ __forceinline__ void ld(const LAS unsigned char* p) { lo = *(const LAS bf16x8*)p; hi = *(const LAS bf16x8*)(p + 1024); } };
template <> struct Frag<2> { i32x8 v; __device__ __forceinline__ void ld(const LAS unsigned char* p) { const i32x4 l_ = *(const LAS i32x4*)p, h_ = *(const LAS i32x4*)(p + 1024); v = __builtin_shufflevector(l_, h_, 0, 1, 2, 3, 4, 5, 6, 7); } };
__device__ __forceinline__ f32x4 mma2(const Frag<0>& b, const Frag<0>& a, f32x4 c) { c = __builtin_amdgcn_mfma_f32_16x16x32_bf16(b.lo, a.lo, c, 0, 0, 0); return __builtin_amdgcn_mfma_f32_16x16x32_bf16(b.hi, a.hi, c, 0, 0, 0); }
__device__ __forceinline__ i32x4 mma2(const Frag<1>& b, const Frag<1>& a, i32x4 c) {
    c = __builtin_amdgcn_mfma_i32_16x16x64_i8(__builtin_bit_cast(i32x4, b.lo), __builtin_bit_cast(i32x4, a.lo), c, 0, 0, 0); return __builtin_amdgcn_mfma_i32_16x16x64_i8(__builtin_bit_cast(i32x4, b.hi), __builtin_bit_cast(i32x4, a.hi), c, 0, 0, 0); }
__device__ __forceinline__ f32x4 mma2(const Frag<2>& b, const Frag<2>& a, f32x4 c) {
    return __builtin_amdgcn_mfma_scale_f32_16x16x128_f8f6f4(b.v, a.v, c, 0, 0, 0, FP8_W_E8, 0, FP8_ACT_E8); }
template <class Epi, class Sched, int KSPLIT  , int MODE = 0>
__device__ __forceinline__ void gemm_phase(LAS unsigned char* lds, const Gemm g, const Sched& S, const Epi& E, const int g_wave) {
    const int tid = otid(), wid = __builtin_amdgcn_readfirstlane(tid >> 6), lane = tid & 63, wr = wid >> 2, wc = wid & 3, fr = lane & 15, fq = lane >> 4;
    const int K = g.K, nt = K / BK;
    unsigned voffA[2], voffB[2];
#pragma unroll
    for (int i = 0; i < 2; ++i) { int R, C; stage_rc(tid * 16 + i * 8192, R, C); const int Rb = Epi::PERM ? ((R & ~31) + perm32(R & 31)) : R;
        voffA[i] = (unsigned)(R * g.lda + C) * 2u; voffB[i] = (unsigned)(Rb * g.ldb + C) * 2u; }
    const size_t kstep = (size_t)(BK * 2);
    const size_t hstepA = (size_t)HALF * g.lda * 2, hstepB = (size_t)HALF * g.ldb * 2;
    const unsigned ldsw = (unsigned)wid * 1024u;
    const int aoff = lds_byte(wr * 64 + fr, fq * 8), boff = lds_byte(wc * 32 + fr, fq * 8);
#define PG8_SA(b, h) (((b) * 2 + (h)) * HTB)
#define PG8_SB(b, h) ((4 + (b) * 2 + (h)) * HTB)
#define PG8_STAGE(bufoff, gbase, voff) do { _Pragma("unroll") for (int _i = 0; _i < 2; ++_i) \
        __builtin_amdgcn_global_load_lds((const unsigned*)((const char*)(gbase) + (voff)[_i]), (LAS unsigned*)(lds + (bufoff) + ldsw + _i * 8192), 16, 0, 0); } while (0)
#define PG8_LDA(dst, b, h) do { _Pragma("unroll") for (int m = 0; m < 4; ++m) dst[m].ld(lds + PG8_SA(b, h) + aoff + m * 2048); } while (0)
#define PG8_LDB(dst, b, h) do { _Pragma("unroll") for (int n = 0; n < 2; ++n) dst[n].ld(lds + PG8_SB(b, h) + boff + n * 2048); } while (0)
#define PG8_MMA(ai, bj, At, Bt) do { __builtin_amdgcn_s_setprio(1); _Pragma("unroll") for (int m = 0; m < 4; ++m) _Pragma("unroll") for (int n = 0; n < 2; ++n) \
        acc[ai][bj][m][n] = mma2(Bt[n], At[m], acc[ai][bj][m][n]); \
        if (MODE == 2) { _Pragma("unroll") for (int m = 0; m < 4; ++m) _Pragma("unroll") for (int n = 0; n < 2; ++n) asm volatile("" : "+v"(acc[ai][bj][m][n])); }     \
        __builtin_amdgcn_s_setprio(0); } while (0)
#define PG8_WAIT_V(n) asm volatile("s_waitcnt vmcnt(" #n ")" ::: "memory")
#define PG8_WAIT_L(n) asm volatile("s_waitcnt lgkmcnt(" #n ")" ::: "memory")
#define PG8_BAR __builtin_amdgcn_s_barrier()
#define PG8_SCHED __builtin_amdgcn_sched_barrier(0)
    Unit cur, nxt; int ui = 0;
    if (!S.next(0, cur)) return;
    typedef typename AccT<MODE>::type acc_t;
    acc_t acc[2][2][4][2];
#pragma unroll
    for (int a = 0; a < 2; ++a)
#pragma unroll
        for (int b = 0; b < 2; ++b)
#pragma unroll
            for (int m = 0; m < 4; ++m)
#pragma unroll
                for (int n = 0; n < 2; ++n) acc[a][b][m][n] = (acc_t){0, 0, 0, 0};
    Frag<MODE> At[4], B0[2], B1[2];
    const char* cA = S.a_base(g, cur); const char* cB = S.b_lo(g, cur); const char* cBh = S.b_hi(g, cur);
    PG8_STAGE(PG8_SB(0, 0), cB, voffB); PG8_STAGE(PG8_SB(0, 1), cB + hstepB, voffB); PG8_STAGE(PG8_SA(0, 0), cA, voffA); PG8_STAGE(PG8_SA(0, 1), cA + hstepA, voffA);
    if (wr == 1) PG8_BAR;
    PG8_WAIT_V(2); PG8_BAR;
    PG8_STAGE(PG8_SB(1, 0), cB + kstep, voffB); PG8_STAGE(PG8_SA(1, 0), cA + kstep, voffA); PG8_STAGE(PG8_SB(1, 1), cB + hstepB + kstep, voffB);
    PG8_WAIT_V(6); PG8_BAR;
    for (;;) {
        const bool has_next = S.next(ui + 1, nxt);
        const char* nA = has_next ? S.a_base(g, nxt) : cA; const char* nB = has_next ? S.b_lo(g, nxt) : cB; const char* nBh = has_next ? S.b_hi(g, nxt) : cBh;
        for (int t = 0; t < nt; t += 2) {
            const bool last = (t == nt - 2);
            const char* a1 = cA + (size_t)(t + 1) * kstep;
            const char* bsel = (KSPLIT != 0 && (t + 2) >= KSPLIT) ? cBh : cB;
            const char* a2 = last ? nA : cA + (size_t)(t + 2) * kstep; const char* b2 = last ? nB : bsel + (size_t)(t + 2) * kstep;
            const char* a3 = a2 + kstep; const char* b3 = b2 + kstep;
            PG8_LDB(B0, 0, 0); PG8_LDB(B1, 0, 1); PG8_SCHED; PG8_LDA(At, 0, 0); PG8_STAGE(PG8_SA(1, 1), a1 + hstepA, voffA);
            PG8_WAIT_V(8); PG8_WAIT_L(0); PG8_BAR; PG8_MMA(0, 0, At, B0); PG8_MMA(0, 1, At, B1); PG8_BAR; PG8_SCHED;
            PG8_LDA(At, 0, 1); PG8_STAGE(PG8_SB(0, 0), b2, voffB); PG8_STAGE(PG8_SB(0, 1), b2 + hstepB, voffB); PG8_STAGE(PG8_SA(0, 0), a2, voffA);
            PG8_WAIT_V(8); PG8_WAIT_L(0); PG8_BAR; PG8_MMA(1, 0, At, B0); PG8_MMA(1, 1, At, B1); PG8_BAR; PG8_SCHED;
            PG8_LDB(B0, 1, 0); PG8_LDB(B1, 1, 1); PG8_SCHED; PG8_LDA(At, 1, 0); PG8_STAGE(PG8_SA(0, 1), a2 + hstepA, voffA);
            PG8_WAIT_V(8); PG8_WAIT_L(0); PG8_BAR; PG8_MMA(0, 0, At, B0); PG8_MMA(0, 1, At, B1); PG8_BAR; PG8_SCHED;
            PG8_LDA(At, 1, 1); PG8_STAGE(PG8_SB(1, 0), b3, voffB); PG8_STAGE(PG8_SB(1, 1), b3 + hstepB, voffB); PG8_STAGE(PG8_SA(1, 0), a3, voffA);
            PG8_WAIT_V(8); PG8_WAIT_L(0); PG8_BAR; PG8_MMA(1, 0, At, B0); PG8_MMA(1, 1, At, B1); PG8_BAR; PG8_SCHED;
        }
        if (wr == 0) PG8_BAR;
        E(acc, cur, wr, wc, fr, fq);
        if (!has_next) break;
#pragma unroll
        for (int a = 0; a < 2; ++a)
#pragma unroll
            for (int b = 0; b < 2; ++b)
#pragma unroll
                for (int m = 0; m < 4; ++m)
#pragma unroll
                    for (int n = 0; n < 2; ++n) acc[a][b][m][n] = (acc_t){0, 0, 0, 0};
        cur = nxt; cA = nA; cB = nB; cBh = nBh; ++ui;
        if (wr == 1) PG8_BAR;
    }
    PG8_WAIT_V(0);
    PG8_BAR;
#undef PG8_SA
#undef PG8_SB
#undef PG8_STAGE
#undef PG8_LDA
#undef PG8_LDB
#undef PG8_MMA
#undef PG8_WAIT_V
#undef PG8_WAIT_L
#undef PG8_BAR
#undef PG8_SCHED
}
}

#define XB_TMO      128
#define XB_XCNT(j)  (256  + 64 * (j))
#define XB_XSUB(j)  (1280 + 64 * (j))
#define XB_XGEN(j)  (2304 + 64 * (j))
#define XB_TOP      3328
#define XB_TOPGEN   3392
#define XCD_BAR_WORDS 3456
#define XB_SPIN_CAP (1u << 21)
__device__ __forceinline__ unsigned xb_ld(unsigned* p)              { return __hip_atomic_load(p, __ATOMIC_RELAXED, __HIP_MEMORY_SCOPE_AGENT); }
__device__ __forceinline__ unsigned xb_add(unsigned* p, unsigned v) { return __hip_atomic_fetch_add(p, v, __ATOMIC_RELAXED, __HIP_MEMORY_SCOPE_AGENT); }
__device__ __forceinline__ unsigned xb_xcc_id() { return (unsigned)__builtin_amdgcn_s_getreg((3 << 11) | 20) & 0xFu; }
#define XB_SPIN(cond, bar) do { unsigned _sp = 0; while (cond) { __builtin_amdgcn_s_sleep(1); \
    if ((++_sp & 255u) == 0u) { if (xb_ld(&(bar)[XB_TMO])) break; if (_sp > XB_SPIN_CAP) { atomicAdd(&(bar)[XB_TMO], 1u); break; } } } } while (0)
struct XcdBarrier { unsigned* bar; unsigned x; volatile LAS unsigned* st; };
__device__ __forceinline__ XcdBarrier xcd_barrier_post(unsigned* bar, volatile LAS unsigned* st, bool leader) {
    XcdBarrier b; b.bar = bar; b.x = xb_xcc_id(); b.st = st;
    if (leader) (void)xb_add(&bar[XB_XCNT(b.x)], 1u);
    return b;
}
__device__ __forceinline__ void xcd_barrier_complete(unsigned* bar, unsigned x, unsigned& nloc, unsigned& nx) {
    const unsigned G = gridDim.x * gridDim.y * gridDim.z;
    unsigned sum, cnt, mine, sp = 0u;
    for (;;) {
        sum = 0u; cnt = 0u; mine = 0u;
#pragma unroll
        for (unsigned j = 0; j < 16; ++j) { const unsigned c = xb_ld(&bar[XB_XCNT(j)]); sum += c; cnt += (c > 0u) ? 1u : 0u; }
        mine = xb_ld(&bar[XB_XCNT(x)]);
        if (sum == G) break;
        __builtin_amdgcn_s_sleep(1);
        if ((++sp & 255u) == 0u) { if (xb_ld(&bar[XB_TMO])) break; if (sp > XB_SPIN_CAP) { atomicAdd(&bar[XB_TMO], 1u); break; } }
    }
    nloc = mine > 0u ? mine : 1u; nx = cnt > 0u ? cnt : 1u;
}
__device__ __forceinline__ void xcd_barrier(const XcdBarrier& b, bool leader) {
    asm volatile("s_waitcnt vmcnt(0)" ::: "memory");
    __syncthreads();
    if (leader) {
        unsigned* bar = b.bar;
        __builtin_amdgcn_s_waitcnt(0);
        unsigned nloc = b.st[0], nx = b.st[1];
        if (nloc == 0u) { xcd_barrier_complete(bar, b.x, nloc, nx); b.st[0] = nloc; b.st[1] = nx; }
        const unsigned old = xb_add(&bar[XB_XSUB(b.x)], 1u);
        const unsigned gen = old / nloc;
        if (old + 1u == (gen + 1u) * nloc) {
            __builtin_amdgcn_fence(__ATOMIC_RELEASE, "agent");
            asm volatile("s_waitcnt vmcnt(0)" ::: "memory");
            const unsigned og = xb_add(&bar[XB_TOP], 1u);
            const unsigned tg = og / nx;
            if (og + 1u == (tg + 1u) * nx) xb_add(&bar[XB_TOPGEN], 1u);
            else XB_SPIN(xb_ld(&bar[XB_TOPGEN]) == tg, bar);
            __builtin_amdgcn_fence(__ATOMIC_ACQUIRE, "agent");
            xb_add(&bar[XB_XGEN(b.x)], 1u);
            asm volatile("s_waitcnt vmcnt(0)" ::: "memory");
        } else {
            XB_SPIN(xb_ld(&bar[XB_XGEN(b.x)]) == gen, bar);
            __builtin_amdgcn_fence(__ATOMIC_ACQUIRE, "agent");
            asm volatile("s_waitcnt vmcnt(0)" ::: "memory");
        }
    }
    __syncthreads();
}

__device__ __forceinline__ int tr_row(int kind, int n) {
    if (kind == 0) return n;
    if (kind == 1) { if (n >= 1024 && n < 2048) { const int lc = (n - 1024) & 255, sh = lc >> 6, d = lc & 63; return (n & ~255) + 128 * (d >> 5) + 32 * sh + (d & 31); }
                     return n < 3072 ? n : (n < 3088 ? -1 : n + 112); }
    return (n >> 7) * 256 + (n & 127) + (kind == 3 ? 128 : 0);
}
__device__ __forceinline__ void tr_item(const float* W, int K, int N, bf16* WT, int ldt, int kind, LAS unsigned char* scr, int item, int lane) {
    const int nblk = (N + 63) / 64, kb = item / nblk, nb = item % nblk, k0 = 64 * kb, n0 = 64 * nb;
    const int n4 = (lane & 15) * 4; const bool inr = (n0 + n4) < N;
    f32x4 v[16];
#pragma unroll
    for (int i = 0; i < 16; ++i) { const int kk = 4 * i + (lane >> 4); v[i] = inr ? *(const f32x4*)(W + (size_t)(k0 + kk) * N + n0 + n4) : (f32x4){0.f, 0.f, 0.f, 0.f}; }
#pragma unroll
    for (int i = 0; i < 16; ++i) { const int kk = 4 * i + (lane >> 4); const unsigned w0 = pk2(v[i][0], v[i][1]), w1 = pk2(v[i][2], v[i][3]);
        *(LAS unsigned short*)(scr + (n4 + 0) * 132 + kk * 2) = (unsigned short)(w0 & 0xffffu); *(LAS unsigned short*)(scr + (n4 + 1) * 132 + kk * 2) = (unsigned short)(w0 >> 16);
        *(LAS unsigned short*)(scr + (n4 + 2) * 132 + kk * 2) = (unsigned short)(w1 & 0xffffu); *(LAS unsigned short*)(scr + (n4 + 3) * 132 + kk * 2) = (unsigned short)(w1 >> 16); }
    LDS_WAIT(); asm volatile("" ::: "memory");
#pragma unroll
    for (int j = 0; j < 8; ++j) { const int idx = lane + 64 * j, n = idx >> 3, c = idx & 7; const LAS unsigned* sp = (const LAS unsigned*)(scr + n * 132 + c * 16);
        u32x4 o; o.x = sp[0]; o.y = sp[1]; o.z = sp[2]; o.w = sp[3];
        const int gn = n0 + n; const int r = (gn < N) ? tr_row(kind, gn) : -1;
        if (r >= 0) *(u32x4*)(WT + (size_t)r * ldt + k0 + 8 * c) = o; }
    LDS_WAIT(); asm volatile("" ::: "memory");
}

__device__ __forceinline__ void tr_item8(const float* W, int K, int N, unsigned char* WT8, int ldt, LAS unsigned char* scr, int item, int lane) {
    const int nblk = N / 64, kb = item / nblk, nb = item % nblk, k0 = 64 * kb, n0 = 64 * nb;
    const int a = lane & 15, kg = lane >> 4;
    f32x4 v[16];
#pragma unroll
    for (int i = 0; i < 16; ++i) { const int kk = 16 * (i >> 2) + 4 * kg + (i & 3); v[i] = *(const f32x4*)(W + (size_t)(k0 + kk) * N + n0 + 4 * a); }
#pragma unroll
    for (int g = 0; g < 4; ++g)
#pragma unroll
        for (int e = 0; e < 4; ++e) *(LAS unsigned*)(scr + (4 * a + e) * 68 + 16 * g + 4 * kg) = pk4_fp8(v[4 * g][e] * FP8_W_SCALE, v[4 * g + 1][e] * FP8_W_SCALE, v[4 * g + 2][e] * FP8_W_SCALE, v[4 * g + 3][e] * FP8_W_SCALE);
    LDS_WAIT(); asm volatile("" ::: "memory");
#pragma unroll
    for (int j = 0; j < 4; ++j) { const int idx = lane + 64 * j, n = idx >> 2, c = idx & 3; const LAS unsigned* sp = (const LAS unsigned*)(scr + n * 68 + c * 16);
        u32x4 o; o.x = sp[0]; o.y = sp[1]; o.z = sp[2]; o.w = sp[3];
        *(u32x4*)(WT8 + (size_t)(n0 + n) * ldt + k0 + 16 * c) = o; }
    LDS_WAIT(); asm volatile("" ::: "memory");
}

template <bool LA>
__device__ __forceinline__ void quant_strip(LAS unsigned char* lds, const float* W, int N, int n0, unsigned char* Q, float* SW, int kind, const float* a2, int wave, int lane) {
    lane = olane();
    const int a = lane & 15, kg = lane >> 4; const int ncl = (n0 + 4 * a) < N ? (n0 + 4 * a) : (N - 4);
    f32x4 v[2][16];
#pragma unroll
    for (int t = 0; t < 2; ++t)
#pragma unroll
        for (int i = 0; i < 16; ++i) { const int kk = 128 * wave + 64 * t + 16 * (i >> 2) + 4 * kg + (i & 3);
            if (!LA) v[t][i] = *(const f32x4*)(W + (size_t)kk * N + ncl);
            else { f32x4 acc = (f32x4){0.f, 0.f, 0.f, 0.f}; const float* wr = W + (size_t)kk * N + 3072;
#pragma unroll 4
                for (int r = 0; r < 16; ++r) acc += *(const f32x4*)(a2 + r * 128 + n0 + 4 * a) * wr[r];
                v[t][i] = acc; } }
    f32x4 cm = (f32x4){0.f, 0.f, 0.f, 0.f};
#pragma unroll
    for (int t = 0; t < 2; ++t)
#pragma unroll
        for (int i = 0; i < 16; ++i) cm = __builtin_elementwise_max(cm, __builtin_elementwise_abs(v[t][i]));
    LAS float* cmax = (LAS float*)(lds + 67584);
#pragma unroll
    for (int e = 0; e < 4; ++e) { float m = cm[e]; m = fmaxf(m, sx<16>(m)); m = max_halves(m); if (kg == 0) cmax[wave * 64 + 4 * a + e] = m; }
    __syncthreads();
    float inv[4], scl[4];
#pragma unroll
    for (int e = 0; e < 4; ++e) { float m = 0.f;
#pragma unroll
        for (int w = 0; w < 8; ++w) m = fmaxf(m, cmax[w * 64 + 4 * a + e]);
        scl[e] = m > 0.f ? m * (1.0f / 127.0f) : 1.0f; inv[e] = m > 0.f ? 127.0f / m : 0.f; }
    LAS unsigned char* tile = lds + wave * 8448;
#pragma unroll
    for (int t = 0; t < 2; ++t)
#pragma unroll
        for (int g = 0; g < 4; ++g)
#pragma unroll
            for (int e = 0; e < 4; ++e) { unsigned w = 0u;
#pragma unroll
                for (int j = 0; j < 4; ++j) { const int q = (int)__builtin_rintf(v[t][4 * g + j][e] * inv[e]); w |= ((unsigned)q & 0xffu) << (8 * j); }
                *(LAS unsigned*)(tile + (4 * a + e) * 132 + 64 * t + 16 * g + 4 * kg) = w; }
    LDS_WAIT(); asm volatile("" ::: "memory");
#pragma unroll
    for (int j = 0; j < 8; ++j) { const int idx = lane + 64 * j, n = idx >> 3, c = idx & 7; const LAS unsigned* sp = (const LAS unsigned*)(tile + n * 132 + c * 16);
        u32x4 o; o.x = sp[0]; o.y = sp[1]; o.z = sp[2]; o.w = sp[3];
        const int gn = n0 + n; const int r = LA ? (C_LA + gn) : ((gn < N) ? tr_row(kind, gn) : -1);
        if (r >= 0) *(u32x4*)(Q + (size_t)r * 1024 + 128 * wave + 16 * c) = o; }
    if (wave == 0 && kg == 0) {
#pragma unroll
        for (int e = 0; e < 4; ++e) { const int gn = n0 + 4 * a + e; const int r = LA ? (C_LA + gn) : ((gn < N) ? tr_row(kind, gn) : -1); if (r >= 0) SW[r] = scl[e]; } }
    __syncthreads();
}

namespace lin {
constexpr int L_QL = 0, L_QU = 9216, L_KL = 18432, L_KU = 27648, L_KLT = 36864, L_VT = 46080, L_AM = 55296, L_ST = 64512, L_OUT = 73728, L_G = 90368, L_GL = 98560, L_END = 98816;
constexpr int NSEG = 16, LSEG = 8;
#define MFMA16(a, b, c) __builtin_amdgcn_mfma_f32_16x16x32_bf16(a, b, c, 0, 0, 0)
__device__ __forceinline__ bf16x8 frag(const LAS unsigned char* base, int pitchB, int r0, int ks, int lane) {
    return *(const LAS bf16x8*)(base + (r0 + (lane & 15)) * pitchB + (32 * ks + 8 * (lane >> 4)) * 2);
}
typedef short v4i16_t __attribute__((ext_vector_type(4)));
__device__ __forceinline__ bf16x8 trfrag(const LAS unsigned char* base, int pitchB, int k0, int n0, int lane) {
    const LAS unsigned char* p = base + (k0 + 8 * (lane >> 4) + ((lane & 15) >> 2)) * pitchB + (n0 + 4 * (lane & 3)) * 2;
    const s16x4 lo = __builtin_bit_cast(s16x4, __builtin_amdgcn_ds_read_tr16_b64_v4i16((LAS v4i16_t*)p));
    const s16x4 hi = __builtin_bit_cast(s16x4, __builtin_amdgcn_ds_read_tr16_b64_v4i16((LAS v4i16_t*)(p + 4 * pitchB)));
    return (bf16x8){lo[0], lo[1], lo[2], lo[3], hi[0], hi[1], hi[2], hi[3]};
}
template <int DK, bool RET, bool PH2>
__device__ __forceinline__ void unit(LAS unsigned char* lds, const bf16* P, unsigned char* MIX, const f32x2* csr, int b, int h, int seg,
                                     const float* b_a, const float* gnorm, float* Est, float* Aseg, const int g_wave) {
    constexpr int PQ = (DK + 8) * 2;
    constexpr int PS = 144;
    constexpr int NT = DK / 32;
    const int tid = otid(), lane = tid & 63, wid = __builtin_amdgcn_readfirstlane(tid >> 6);
    const int row = tid >> 3, c8 = tid & 7;
    const int entry = (b * 4 + h) * NSEG + seg;
    const float lng = RET ? __logf(1.0f - exp2f(-5.0f - (float)h)) : 0.f;
    const int cq = RET ? C_RQ + h * 64 : C_GQ + h * 32, ck = RET ? C_RK + h * 64 : C_GK + h * 32, cv = RET ? C_RV + h * 64 : C_GV + h * 64, cg = RET ? C_RG + h * 64 : C_GR + h * 64;
    f32x4 st[NT]; float ac[NT];
    int eb[NT], db[NT];
#pragma unroll
    for (int j = 0; j < NT; ++j) { const int i = wid + 8 * j; if (DK == 64) { eb[j] = i >> 2; db[j] = i & 3; } else { eb[j] = i >> 1; db[j] = i & 1; } st[j] = (f32x4){0.f, 0.f, 0.f, 0.f}; ac[j] = 1.f; }
    if (PH2) {
#pragma unroll 4
        for (int sp = 0; sp < seg; ++sp) { const int en = (b * 4 + h) * NSEG + sp;
#pragma unroll
            for (int j = 0; j < NT; ++j) { const int d = db[j] * 16 + (lane & 15); const float a = Aseg[(size_t)en * DK + d];
#pragma unroll
                for (int r = 0; r < 4; ++r) { const int e = eb[j] * 16 + 4 * (lane >> 4) + r; st[j][r] = a * st[j][r] + Est[((size_t)en * 64 + e) * DK + d]; } } }
    }
    float gn8[8] = {0.f, 0.f, 0.f, 0.f, 0.f, 0.f, 0.f, 0.f}, ba4[4] = {0.f, 0.f, 0.f, 0.f};
    if (PH2) {
#pragma unroll
        for (int i = 0; i < 8; ++i) gn8[i] = gnorm[8 * c8 + i]; }
    if (!RET) {
#pragma unroll
        for (int i = 0; i < 4; ++i) ba4[i] = b_a[h * 32 + 4 * wid + i]; }
    u32x4 rq_ = (u32x4){0u, 0u, 0u, 0u}, rk_ = rq_, rq2_ = rq_, rk2_ = rq_, pv = rq_, pgt = rq_; f32x4 pcs[4]; u32x2 pla = (u32x2){0u, 0u};
#pragma unroll
    for (int i = 0; i < 4; ++i) pcs[i] = (f32x4){0.f, 0.f, 0.f, 0.f};
    const int d0 = 8 * c8; const bool qk_on = RET || c8 < 4;
#define LIN_LOAD(cc) do { const size_t mr_ = (size_t)b * SEQ + (size_t)(seg * LSEG + (cc)) * 64 + row; \
        if (!RET) pla = *(const u32x2*)(P + ((size_t)b * SEQ + (size_t)(seg * LSEG + (cc)) * 64 + lane) * NP + C_LA + h * 32 + 4 * wid); \
        if (qk_on) { rk_ = *(const u32x4*)(P + mr_ * NP + ck + d0); if (PH2) rq_ = *(const u32x4*)(P + mr_ * NP + cq + d0); \
            if (RET) { rk2_ = *(const u32x4*)(P + mr_ * NP + ck + (d0 ^ 32)); if (PH2) rq2_ = *(const u32x4*)(P + mr_ * NP + cq + (d0 ^ 32)); \
                const f32x4* cs4_ = (const f32x4*)(csr + mr_ * 32 + (d0 & 31)); pcs[0] = cs4_[0]; pcs[1] = cs4_[1]; pcs[2] = cs4_[2]; pcs[3] = cs4_[3]; } } \
        pv = *(const u32x4*)(P + mr_ * NP + cv + 8 * c8); if (PH2) pgt = *(const u32x4*)(P + mr_ * NP + cg + 8 * c8); } while (0)
    LIN_LOAD(0);
    for (int c = 0; c < LSEG; ++c) {
        const size_t m0 = (size_t)b * SEQ + (size_t)(seg * LSEG + c) * 64;
        if (!RET) {
            const u32x2 w = pla;
            float x[4] = {bflo(w.x), bfhi(w.x), bflo(w.y), bfhi(w.y)};
#pragma unroll
            for (int i = 0; i < 4; ++i) { const float z = x[i] + ba4[i]; float v = (fminf(z, 0.f) - log1pf(__expf(-fabsf(z)))) * (1.0f / 16.0f);
#pragma unroll
                for (int o = 1; o < 64; o <<= 1) { const float u = __int_as_float(__builtin_amdgcn_ds_bpermute((lane - o) << 2, __float_as_int(v))); if (lane >= o) v += u; }
                ((LAS float*)(lds + L_G))[lane * 32 + 4 * wid + i] = v; if (lane == 63) ((LAS float*)(lds + L_GL))[4 * wid + i] = v; }
            __syncthreads();
        }
        u32x4 gcur = pgt;
        {
            if (qk_on) {
                const u32x4 kw = rk_, qw = rq_;
                float qv[8], kv[8], eg[8], ieg[8];
                { const unsigned* qp = (const unsigned*)&qw; const unsigned* kp = (const unsigned*)&kw;
#pragma unroll
                  for (int i = 0; i < 4; ++i) { qv[2 * i] = bflo(qp[i]); qv[2 * i + 1] = bfhi(qp[i]); kv[2 * i] = bflo(kp[i]); kv[2 * i + 1] = bfhi(kp[i]); } }
                if (RET) {
                    const u32x4 kw2 = rk2_, qw2 = rq2_;
                    const unsigned* qp2 = (const unsigned*)&qw2; const unsigned* kp2 = (const unsigned*)&kw2;
                    const float g = (float)(row + 1) * lng; const float e1 = __expf(g), e2 = __expf(-g);
#pragma unroll
                    for (int i = 0; i < 4; ++i) { const f32x4 cc = pcs[i];
                        const float qa = bflo(qp2[i]), qb = bfhi(qp2[i]), ka = bflo(kp2[i]), kb = bfhi(kp2[i]);
                        if (c8 < 4) { const float q0 = qv[2 * i] * cc[0] - qa * cc[1], q1 = qv[2 * i + 1] * cc[2] - qb * cc[3]; const float k0 = kv[2 * i] * cc[0] - ka * cc[1], k1 = kv[2 * i + 1] * cc[2] - kb * cc[3];
                            qv[2 * i] = q0; qv[2 * i + 1] = q1; kv[2 * i] = k0; kv[2 * i + 1] = k1; }
                        else { const float q0 = qa * cc[1] + qv[2 * i] * cc[0], q1 = qb * cc[3] + qv[2 * i + 1] * cc[2]; const float k0 = ka * cc[1] + kv[2 * i] * cc[0], k1 = kb * cc[3] + kv[2 * i + 1] * cc[2];
                            qv[2 * i] = q0; qv[2 * i + 1] = q1; kv[2 * i] = k0; kv[2 * i + 1] = k1; } }
#pragma unroll
                    for (int i = 0; i < 8; ++i) { kv[i] *= 0.125f; eg[i] = e1; ieg[i] = e2; }
                } else {
#pragma unroll
                    for (int i = 0; i < 8; ++i) { const float g = ((const LAS float*)(lds + L_G))[row * 32 + d0 + i]; eg[i] = __expf(g); ieg[i] = __expf(-g); qv[i] *= 0.17677669529663687f; }
                }
                float kl[8];
#pragma unroll
                for (int i = 0; i < 8; ++i) kl[i] = kv[i] * ieg[i];
                if (PH2) {
                    u32x4 o;
                    o.x = pk2(qv[0] * eg[0], qv[1] * eg[1]); o.y = pk2(qv[2] * eg[2], qv[3] * eg[3]); o.z = pk2(qv[4] * eg[4], qv[5] * eg[5]); o.w = pk2(qv[6] * eg[6], qv[7] * eg[7]);
                    *(LAS u32x4*)(lds + L_QL + row * PQ + d0 * 2) = o;
                    o.x = pk2(qv[0] * ieg[0], qv[1] * ieg[1]); o.y = pk2(qv[2] * ieg[2], qv[3] * ieg[3]); o.z = pk2(qv[4] * ieg[4], qv[5] * ieg[5]); o.w = pk2(qv[6] * ieg[6], qv[7] * ieg[7]);
                    *(LAS u32x4*)(lds + L_QU + row * PQ + d0 * 2) = o;
                    o.x = pk2(kv[0] * eg[0], kv[1] * eg[1]); o.y = pk2(kv[2] * eg[2], kv[3] * eg[3]); o.z = pk2(kv[4] * eg[4], kv[5] * eg[5]); o.w = pk2(kv[6] * eg[6], kv[7] * eg[7]);
                    *(LAS u32x4*)(lds + L_KU + row * PQ + d0 * 2) = o;
                }
                { u32x4 o; o.x = pk2(kl[0], kl[1]); o.y = pk2(kl[2], kl[3]); o.z = pk2(kl[4], kl[5]); o.w = pk2(kl[6], kl[7]);
                  *(LAS u32x4*)(lds + L_KL + row * PQ + d0 * 2) = o; }
            }
            *(LAS u32x4*)(lds + L_VT + row * PS + c8 * 16) = pv;
        }
        if (c + 1 < LSEG) LIN_LOAD(c + 1);
        __syncthreads();
#pragma unroll
        for (int j = 0; j < NT; ++j) {
            const int d = db[j] * 16 + (lane & 15);
            if (PH2) {
#pragma unroll
                for (int r = 0; r < 4; ++r) { const int e = eb[j] * 16 + 4 * (lane >> 4) + r; *(LAS unsigned short*)(lds + L_ST + e * PQ + d * 2) = (unsigned short)(pk2(st[j][r], 0.f) & 0xffffu); }
            }
            f32x4 u = (f32x4){0.f, 0.f, 0.f, 0.f};
#pragma unroll
            for (int ks = 0; ks < 2; ++ks) u = MFMA16(trfrag(lds + L_VT, PS, 32 * ks, eb[j] * 16, lane), trfrag(lds + L_KL, PQ, 32 * ks, db[j] * 16, lane), u);
            const float egl = RET ? __expf(64.f * lng) : __expf(((const LAS float*)(lds + L_GL))[d]);
#pragma unroll
            for (int r = 0; r < 4; ++r) st[j][r] = egl * (st[j][r] + u[r]);
            ac[j] *= egl;
        }
        if (PH2) {
#pragma unroll
            for (int j = 0; j < 2; ++j) { const int i = wid + 8 * j, tb = i >> 2, sb = i & 3;
                f32x4 lo = (f32x4){0.f, 0.f, 0.f, 0.f}, up = (f32x4){0.f, 0.f, 0.f, 0.f};
                if (sb <= tb) {
#pragma unroll
                    for (int ks = 0; ks < DK / 32; ++ks) lo = MFMA16(frag(lds + L_QL, PQ, tb * 16, ks, lane), frag(lds + L_KL, PQ, sb * 16, ks, lane), lo); }
                if (sb >= tb) {
#pragma unroll
                    for (int ks = 0; ks < DK / 32; ++ks) up = MFMA16(frag(lds + L_QU, PQ, tb * 16, ks, lane), frag(lds + L_KU, PQ, sb * 16, ks, lane), up); }
                const int s = sb * 16 + (lane & 15);
#pragma unroll
                for (int r = 0; r < 4; ++r) { const int t = tb * 16 + 4 * (lane >> 4) + r; const float v = (s <= t) ? lo[r] : up[r];
                    *(LAS unsigned short*)(lds + L_AM + t * PS + s * 2) = (unsigned short)(pk2(v, 0.f) & 0xffffu); } }
        }
        __syncthreads();
        if (PH2) {
#pragma unroll
            for (int j = 0; j < 2; ++j) { const int i = wid + 8 * j, tb = i >> 2, ob = i & 3;
                f32x4 o = (f32x4){0.f, 0.f, 0.f, 0.f};
#pragma unroll
                for (int ks = 0; ks < 2; ++ks) o = MFMA16(frag(lds + L_AM, PS, tb * 16, ks, lane), trfrag(lds + L_VT, PS, 32 * ks, ob * 16, lane), o);
#pragma unroll
                for (int ks = 0; ks < DK / 32; ++ks) o = MFMA16(frag(lds + L_QL, PQ, tb * 16, ks, lane), frag(lds + L_ST, PQ, ob * 16, ks, lane), o);
#pragma unroll
                for (int r = 0; r < 4; ++r) ((LAS float*)(lds + L_OUT))[(tb * 16 + 4 * (lane >> 4) + r) * 65 + ob * 16 + (lane & 15)] = o[r]; }
            __syncthreads();
            { const size_t m = m0 + row; const int e0 = 8 * c8; float v[8]; float ss = 0.f;
#pragma unroll
              for (int i = 0; i < 8; ++i) { v[i] = ((const LAS float*)(lds + L_OUT))[row * 65 + e0 + i]; ss += v[i] * v[i]; }
              ss += sx<1>(ss); ss += sx<2>(ss); ss += sx<4>(ss);
              const float rstd = rsqrtf(ss * (1.0f / 64.0f) + EPS);
              const u32x4 gw = gcur; const unsigned* gp = (const unsigned*)&gw; float y[8];
#pragma unroll
              for (int i = 0; i < 4; ++i) { y[2 * i] = v[2 * i] * rstd * gn8[2 * i] * silu_f(bflo(gp[i])); y[2 * i + 1] = v[2 * i + 1] * rstd * gn8[2 * i + 1] * silu_f(bfhi(gp[i])); }
              const bool on = RET ? ((DBG_GROUPS & 1) != 0) : ((DBG_GROUPS & 4) != 0);
              u32x2 o; o.x = pk4_fp8(y[0] * FP8_ACT_SCALE, y[1] * FP8_ACT_SCALE, y[2] * FP8_ACT_SCALE, y[3] * FP8_ACT_SCALE); o.y = pk4_fp8(y[4] * FP8_ACT_SCALE, y[5] * FP8_ACT_SCALE, y[6] * FP8_ACT_SCALE, y[7] * FP8_ACT_SCALE);
              if (!on) o = (u32x2){0u, 0u};
              *(u32x2*)(MIX + m * DM + (RET ? 0 : 768) + h * 64 + e0) = o; }
        }
    }
#undef LIN_LOAD
    if (!PH2) {
#pragma unroll
        for (int j = 0; j < NT; ++j) { const int d = db[j] * 16 + (lane & 15);
#pragma unroll
            for (int r = 0; r < 4; ++r) { const int e = eb[j] * 16 + 4 * (lane >> 4) + r; Est[((size_t)entry * 64 + e) * DK + d] = st[j][r]; }
            if (eb[j] == 0 && (lane >> 4) == 0) Aseg[(size_t)entry * DK + d] = ac[j]; }
    }
    __syncthreads();
}
}

namespace att {
constexpr int A_K = 0, A_V = 24576, A_O0 = 0, A_LS = 73728, A_END = 75776;
#define MFMA32(a, b, c) __builtin_amdgcn_mfma_f32_32x32x16_bf16(a, b, c, 0, 0, 0)
typedef short v4i16_t __attribute__((ext_vector_type(4)));
__device__ __forceinline__ s16x4 vtr(const LAS unsigned char* p) { return __builtin_bit_cast(s16x4, __builtin_amdgcn_ds_read_tr16_b64_v4i16((LAS v4i16_t*)p)); }
__device__ __forceinline__ int crow(int r, int hi) { return (r & 3) + 8 * (r >> 2) + 4 * hi; }
__device__ __forceinline__ void unit(LAS unsigned char* lds, const bf16* P, unsigned char* MIX, int b, int h, int jq, float lam, float negM, const float* subg, float oscale, const int g_wave) {
    const int tid = otid(), lane = tid & 63, r32 = lane & 31, hh = lane >> 5, wid = __builtin_amdgcn_readfirstlane(tid >> 6);
    const size_t rowbase = (size_t)b * SEQ;
    const int q0 = jq * 256 + wid * 32;
    const int ntile = 4 * jq + 4, my_nt = 4 * jq + (wid >> 1) + 1;
    const int krow = tid >> 3, kch = (tid & 7) ^ ((krow >> 1) & 7);
    const int vrow = (tid >> 2) & 63, vcol = (tid >> 8) * 32 + (tid & 3) * 8;
    const unsigned ldsw = (unsigned)wid * 1024u;
    const int q4 = (lane & 15) >> 2, p4 = lane & 3, gsel = (lane >> 4) & 1;
    const unsigned vrd = (unsigned)((4 * hh + q4) * 64 + gsel * 32 + p4 * 8);
    unsigned o0r[32];
#pragma unroll
    for (int i = 0; i < 32; ++i) o0r[i] = 0u;
#pragma unroll 1
    for (int comp = 0; comp < 2; ++comp) {
        bf16x8 qf[4];
        const char* Pb = (const char*)(P + rowbase * NP + h * 128);
        { const unsigned qo = (unsigned)(((q0 + r32) * NP + C_DQ + comp * 64 + hh * 8) * 2);
#pragma unroll
          for (int ks = 0; ks < 4; ++ks) qf[ks] = *(const bf16x8*)(Pb + qo + 32 * ks); }
        const unsigned kgo = (unsigned)((krow * NP + C_DK + comp * 64 + kch * 8) * 2), vgo = (unsigned)((vrow * NP + C_DV + vcol) * 2);
        f32x16 o[4];
#pragma unroll
        for (int e = 0; e < 4; ++e)
#pragma unroll
            for (int r = 0; r < 16; ++r) o[e][r] = 0.f;
        float l = 0.f;
#define ATT_GLDS(sb, vo, dst) do { unsigned keep_; asm volatile("s_mov_b32 %0, m0\n\ts_mov_b32 m0, %3\n\ts_nop 0\n\tglobal_load_lds_dwordx4 %1, %2\n\ts_mov_b32 m0, %0" \
            : "=&s"(keep_) : "v"(vo), "s"(sb), "s"(dst) : "memory"); } while (0)
#define ATT_STAGE(buf, tt) do { const char* Pt = Pb + (size_t)(tt) * 64 * NP * 2; \
            ATT_GLDS(Pt, kgo, (unsigned)__builtin_amdgcn_readfirstlane((int)(ldsb + A_K + (buf) * 8192 + ldsw))); \
            ATT_GLDS(Pt, vgo, (unsigned)__builtin_amdgcn_readfirstlane((int)(ldsb + A_V + (buf) * 16384 + ldsw))); \
            ATT_GLDS(Pt, vgo + 128u, (unsigned)__builtin_amdgcn_readfirstlane((int)(ldsb + A_V + (buf) * 16384 + 8192 + ldsw))); } while (0)
        const unsigned ldsb = (unsigned)(size_t)lds;
        unsigned kro[4];
#pragma unroll
        for (int ks = 0; ks < 4; ++ks) kro[ks] = (unsigned)(r32 * 128 + (((2 * ks + hh) ^ ((r32 >> 1) & 7)) << 4));
        ATT_STAGE(0, 0);
        if (ntile > 1) ATT_STAGE(1, 1);
        __builtin_amdgcn_s_waitcnt(0x0F70);
        VM_WAIT(); __syncthreads();
        int cur = 0, nx2 = 2;
        for (int t = 0; t < ntile; ++t) {
            const bool more = (t + 2 < ntile);
            if (more) ATT_STAGE(nx2, t + 2);
            if (t < my_nt) {
                const LAS unsigned char* Kb = lds + A_K + cur * 8192; const LAS unsigned char* Vb = lds + A_V + cur * 16384 + vrd;
#define ATT_KF(j) (*(const LAS bf16x8*)(Kb + kro[(j) & 3] + ((j) >> 2) * 4096))
#define ATT_VOFF(j) ((((j) >> 1) & 3) * 4096 + (2 * ((j) >> 3) + ((j) & 1)) * 1024)
                bf16x8 kr[3]; kr[0] = ATT_KF(0); kr[1] = ATT_KF(1);
                const f32x16 z16 = {0.f, 0.f, 0.f, 0.f, 0.f, 0.f, 0.f, 0.f, 0.f, 0.f, 0.f, 0.f, 0.f, 0.f, 0.f, 0.f};
                f32x16 s0, s1;
#pragma unroll
                for (int j = 0; j < 8; ++j) { if (j + 2 < 8) kr[(j + 2) % 3] = ATT_KF(j + 2);
                    if (j < 4) s0 = MFMA32(kr[j % 3], qf[j & 3], j == 0 ? z16 : s0); else s1 = MFMA32(kr[j % 3], qf[j & 3], j == 4 ? z16 : s1); }
                s16x4 vl[3], vh[3];
                vl[0] = vtr(Vb + ATT_VOFF(0)); vh[0] = vtr(Vb + ATT_VOFF(0) + 512); vl[1] = vtr(Vb + ATT_VOFF(1)); vh[1] = vtr(Vb + ATT_VOFF(1) + 512);
                bf16x8 pa[4];
                { u32x4 w;
#pragma unroll
                  for (int r = 0; r < 16; ++r) { s0[r] = __builtin_amdgcn_exp2f(s0[r]); l += s0[r]; }
                  w.x = pk2(s0[0], s0[1]); w.y = pk2(s0[2], s0[3]); w.z = pk2(s0[4], s0[5]); w.w = pk2(s0[6], s0[7]); pa[0] = __builtin_bit_cast(bf16x8, w);
                  w.x = pk2(s0[8], s0[9]); w.y = pk2(s0[10], s0[11]); w.z = pk2(s0[12], s0[13]); w.w = pk2(s0[14], s0[15]); pa[1] = __builtin_bit_cast(bf16x8, w);
#pragma unroll
                  for (int r = 0; r < 16; ++r) { s1[r] = __builtin_amdgcn_exp2f(s1[r]); l += s1[r]; }
                  w.x = pk2(s1[0], s1[1]); w.y = pk2(s1[2], s1[3]); w.z = pk2(s1[4], s1[5]); w.w = pk2(s1[6], s1[7]); pa[2] = __builtin_bit_cast(bf16x8, w);
                  w.x = pk2(s1[8], s1[9]); w.y = pk2(s1[10], s1[11]); w.z = pk2(s1[12], s1[13]); w.w = pk2(s1[14], s1[15]); pa[3] = __builtin_bit_cast(bf16x8, w); }
#pragma unroll
                for (int j = 0; j < 16; ++j) { if (j + 2 < 16) { vl[(j + 2) % 3] = vtr(Vb + ATT_VOFF(j + 2)); vh[(j + 2) % 3] = vtr(Vb + ATT_VOFF(j + 2) + 512); }
                    const s16x4 lo = vl[j % 3], hi = vh[j % 3]; const bf16x8 vf = (bf16x8){lo[0], lo[1], lo[2], lo[3], hi[0], hi[1], hi[2], hi[3]};
                    o[(j >> 1) & 3] = MFMA32(pa[2 * (j >> 3) + (j & 1)], vf, o[(j >> 1) & 3]); }
#undef ATT_KF
#undef ATT_VOFF
            }
            if (more) asm volatile("s_waitcnt vmcnt(3)" ::: "memory"); else VM_WAIT();
            __syncthreads();
            cur = (cur == 2) ? 0 : cur + 1; nx2 = (nx2 == 2) ? 0 : nx2 + 1;
        }
#undef ATT_GLDS
#undef ATT_STAGE
        l = sum_halves(l);
        LAS float* ls = (LAS float*)(lds + A_LS) + wid * 64 + comp * 32;
        if (hh == 0) ls[r32] = l;
        LDS_WAIT(); asm volatile("" ::: "memory");
        float inv[16];
#pragma unroll
        for (int r = 0; r < 16; ++r) inv[r] = 1.0f / ls[crow(r, hh)];
        if (comp == 0) {
#pragma unroll
            for (int e = 0; e < 4; ++e)
#pragma unroll
                for (int i = 0; i < 8; ++i) o0r[e * 8 + i] = pk2(o[e][2 * i] * inv[2 * i], o[e][2 * i + 1] * inv[2 * i + 1]);
        } else {
            float ss[16];
#pragma unroll
            for (int r = 0; r < 16; ++r) ss[r] = 0.f;
#pragma unroll
            for (int e = 0; e < 4; ++e)
#pragma unroll
                for (int i = 0; i < 8; ++i) { const unsigned w = o0r[e * 8 + i];
                    const float v0 = bflo(w) - lam * o[e][2 * i] * inv[2 * i], v1 = bfhi(w) - lam * o[e][2 * i + 1] * inv[2 * i + 1];
                    o[e][2 * i] = v0; o[e][2 * i + 1] = v1; ss[2 * i] += v0 * v0; ss[2 * i + 1] += v1 * v1; }
#pragma unroll
            for (int r = 0; r < 16; ++r) { float s = ss[r]; s += sx<1>(s); s += sx<2>(s); s += sx<4>(s); s += sx<8>(s); s += sx<16>(s);
                ss[r] = rsqrtf(s * (1.0f / 128.0f) + EPS) * oscale; }
            LAS unsigned char* stg = lds + A_O0 + wid * 8192;
            const int lane_e = olane(), r32e = lane_e & 31;
            LDS_WAIT(); asm volatile("" ::: "memory");
#pragma unroll
            for (int e = 0; e < 4; ++e) { const float gsub = subg[32 * e + r32e] * FP8_ACT_SCALE;
#pragma unroll
                for (int r = 0; r < 16; r += 2) { const float y0 = ((DBG_GROUPS & 2) != 0) ? o[e][r] * ss[r] * gsub : 0.f, y1 = ((DBG_GROUPS & 2) != 0) ? o[e][r + 1] * ss[r + 1] * gsub : 0.f;
                    const int w = __builtin_amdgcn_cvt_pk_fp8_f32(y0, y1, 0, false);
                    *(LAS unsigned char*)(stg + crow(r, hh) * 128 + 32 * e + r32) = (unsigned char)(w & 0xff); *(LAS unsigned char*)(stg + crow(r + 1, hh) * 128 + 32 * e + r32) = (unsigned char)((w >> 8) & 0xff); } }
            LDS_WAIT(); asm volatile("" ::: "memory");
            { unsigned ob = (unsigned)((q0 + (lane_e >> 3)) * DM + 256 + (lane_e & 7) * 16); unsigned char* Mb = MIX + rowbase * DM + h * 128;
#pragma unroll
              for (int i = 0; i < 4; ++i) { const u32x4 w = *(const LAS u32x4*)(stg + ((lane_e >> 3) + 8 * i) * 128 + (lane_e & 7) * 16); *(u32x4*)(Mb + ob + i * 8 * DM) = w; } }
            LDS_WAIT(); asm volatile("" ::: "memory");
        }
    }
    __syncthreads();
}
}

struct Args { const float* in[25]; float* out; unsigned char* ws; int ph_lo, ph_hi; };
static_assert(sizeof(Args) == 27 * 8 + 8, "Args has no padding");
constexpr int NPHASE = 1 + 9 * DEPTH;

__global__ void __launch_bounds__(NWAVES * 64, 2) fwd(Args args) {
    extern __shared__ __attribute__((aligned(16))) unsigned char lds_raw[];
    LAS unsigned char* lds = (LAS unsigned char*)lds_raw;
    const int wave = __builtin_amdgcn_readfirstlane((int)threadIdx.x >> 6); const int g_wave = wave; const int tid0 = otid();
    const int G = gridDim.x; const int bx = blockIdx.x; const int vcu = (G % 8 == 0) ? (bx % 8) * (G / 8) + bx / 8 : bx;
    const int gw = vcu * NWAVES + wave, NGW = G * NWAVES;
    __builtin_assume(gw >= 0 && gw < 4096 && vcu >= 0 && vcu < 512 && G > 0 && G <= 512);
    unsigned char* ws = args.ws;
    unsigned* ctl = (unsigned*)(ws + WS_CTL);
    for (int u = tid0; u < (LDS_BYTES - LDSCTL_OFF) / 4; u += NWAVES * 64) ((LAS unsigned*)(lds + LDSCTL_OFF))[u] = 0u;
    __syncthreads();
    XcdBarrier bar; bar.bar = ctl + CW_BAR; bar.x = 0; bar.st = nullptr;
    if (MK_N_LAUNCHES == 1) bar = xcd_barrier_post(ctl + CW_BAR, (volatile LAS unsigned*)(lds + MISC_OFF) + 8, tid0 == 0);
    const int lo = args.ph_lo, hi = args.ph_hi;
#ifndef PHMASK
#define PHMASK 0x3ff
#endif
#define IN(k) (lo <= (k) && (k) < hi)
#define PHON(j) ((PHMASK >> (j)) & 1)
#define SEAM(k) do { if (IN(k) && IN((k) + 1)) xcd_barrier(bar, otid() == 0); } while (0)
    if (tid0 == 0) {
#pragma unroll
        for (int k = 0; k < 25; ++k) ((LAS unsigned long long*)(lds + PTR_OFF))[k] = (unsigned long long)args.in[k];
        ((LAS unsigned long long*)(lds + PTR_OFF))[25] = (unsigned long long)args.out;
    }
    __syncthreads();
#define WSP(Tp, off) ((Tp*)(wsl + (off)))
#define WSL() unsigned char* wsl = ws; asm volatile("" : "+s"(wsl))

    if (PHON(0) && IN(0)) {
        const int tid = otid(), lane = tid & 63; WSL();
        const float* c_in = INF(1); const int* pos_in = (const int*)INF(2); const float* w_mod = INF(3); const float* b_mod = INF(4); const float* w_in = INF(7);
        const float* diff_q_g = INF(9); const float* diff_k_g = INF(10); const float* lam_q1 = INF(11); const float* lam_k1 = INF(12); const float* lam_q2 = INF(13); const float* lam_k2 = INF(14);
        const float* gla_w_a2 = INF(16); const float* w_out = INF(19); const float* w_gate = INF(22); const float* w_up = INF(23); const float* w_down = INF(24);
        float* mod = WSP(float, WS_MOD); float* scal = WSP(float, WS_SCAL); f32x2* csr = WSP(f32x2, WS_CSR); f32x2* csd = WSP(f32x2, WS_CSD);
        LAS unsigned char* scr = lds + wave * 8704;
        LAS float* sact = (LAS float*)(lds + 69632);
        for (int i = tid; i < 8 * 1024; i += NWAVES * 64) sact[i] = silu_f(c_in[i]);
        __syncthreads();
        { unsigned char* Winq = WSP(unsigned char, WS_WIN); float* swin = WSP(float, WS_SWIN);
          constexpr int U_WIN = 2 * 53, U_LA = 4, U_W1 = 2 * 32 * 16;
#pragma unroll 1
          for (int bu = vcu; bu < U_WIN; bu += G) { const int l = bu / 53, st = bu % 53; quant_strip<false>(lds, w_in + (size_t)l * 1024 * IN_W, IN_W, 64 * st, Winq + (size_t)l * NP * 1024, swin + l * NP, 1, nullptr, wave, lane); }
#pragma unroll 1
          for (int bu = vcu; bu < U_W1; bu += G) { const int le = bu >> 4, st = bu & 15;
              quant_strip<false>(lds, (st < 8 ? w_gate : w_up) + (size_t)le * 1024 * 512, 512, 64 * (st & 7), WSP(unsigned char, WS_W1) + (size_t)le * 1024 * 1024, WSP(float, WS_SW1) + (size_t)le * 1024, st < 8 ? 2 : 3, nullptr, wave, lane); }
#pragma unroll 1
          for (int bu = G - 1 - vcu; bu < U_LA; bu += G) { const int l = bu >> 1, st = bu & 1; quant_strip<true>(lds, w_in + (size_t)l * 1024 * IN_W, IN_W, 64 * st, Winq + (size_t)l * NP * 1024, swin + l * NP, 1, gla_w_a2 + (size_t)l * 16 * 128, wave, lane); }
        }
        constexpr int I_MOD = 2 * 384, I_TABR = 1024, I_TABD = 1024, I_ZERO = 256, I_SC = 2;
        constexpr int I_WOUT = 16 * 16, I_DN = 8 * 16, I_LAYER = I_WOUT + 32 * I_DN;
        constexpr int I_PRE = I_MOD + I_TABR + I_TABD + I_ZERO + I_SC, NITEMS = I_PRE + 2 * I_LAYER;
        _Pragma("unroll 1") for (int rep_ = 0; rep_ < 1 + (RPT_PHASE == 100 ? RPT_N : 0); ++rep_)
        for (int it = gw; it < NITEMS; it += NGW) {
            int r = it;
            if (r < I_MOD) {
                const int l = r / 384, col = (r % 384) * 16 + (lane & 15), ks = lane >> 4;
                float acc[8] = {0.f, 0.f, 0.f, 0.f, 0.f, 0.f, 0.f, 0.f};
                const float* wp = w_mod + (size_t)l * 1024 * 6144 + col;
#pragma unroll 16
                for (int k = ks; k < 1024; k += 4) { const float w = wp[(size_t)k * 6144];
#pragma unroll
                    for (int b = 0; b < 8; ++b) acc[b] += sact[b * 1024 + k] * w; }
#pragma unroll
                for (int b = 0; b < 8; ++b) { float a = acc[b]; a += sx<16>(a); a = sum_halves(a); if (ks == 0) mod[((size_t)l * 8 + b) * 6144 + col] = a + b_mod[l * 6144 + col]; }
                continue; }
            r -= I_MOD;
            if (r < I_TABR) {
                const int i = lane & 31; const float inv_freq = exp2f(-((float)i * (1.0f / 32.0f)) * 13.287712379549449f);
                for (int s = 0; s < 32; ++s) { const int t = r * 64 + 2 * s + (lane >> 5); const float ang = (float)pos_in[t] * inv_freq; float sn, cs; sincosf(ang, &sn, &cs); csr[(size_t)t * 32 + i] = (f32x2){cs, sn}; }
                continue; }
            r -= I_TABR;
            if (r < I_TABD) {
                const int i = lane & 7; const float inv_freq = exp2f(-((float)i * (1.0f / 8.0f)) * 18.931568569324174f);
                for (int s = 0; s < 8; ++s) { const int t = r * 64 + 8 * s + (lane >> 3); const float ang = (float)pos_in[t] * inv_freq; float sn, cs; sincosf(ang, &sn, &cs); csd[(size_t)t * 8 + i] = (f32x2){cs, sn}; }
                continue; }
            r -= I_TABD;
            if (r < I_ZERO) {
                const int l = r >> 7, j = r & 127; u32x4* p = (u32x4*)(WSP(unsigned char, WS_WIN) + ((size_t)l * NP + C_PAD + j) * 1024);
                p[lane] = (u32x4){0u, 0u, 0u, 0u}; if (lane == 0) WSP(float, WS_SWIN)[l * NP + C_PAD + j] = 1.0f;
                continue; }
            r -= I_ZERO;
            if (r < I_SC) {
                const int l = r; const float s1 = wave_sum(lam_q1[l * 64 + lane] * lam_k1[l * 64 + lane]), s2 = wave_sum(lam_q2[l * 64 + lane] * lam_k2[l * 64 + lane]);
                const float mq = wave_max(fabsf(diff_q_g[l * 64 + lane])), mk = wave_max(fabsf(diff_k_g[l * 64 + lane]));
                const float lam_init = 0.8f - 0.6f * expf(-0.3f * (float)l);
                if (lane == 0) { scal[l * 4 + 0] = expf(s1) - expf(s2) + lam_init; scal[l * 4 + 1] = -(8.0f * mq * mk * LOG2E + 0.5f); scal[l * 4 + 2] = 1.0f - lam_init; }
                continue; }
            r -= I_SC;
            const int l = r / I_LAYER; r -= l * I_LAYER;
            if (r < I_WOUT) { tr_item8(w_out + (size_t)l * 1024 * 1024, 1024, 1024, WSP(unsigned char, WS_WOUT) + (size_t)l * 1024 * 1024, 1024, scr, r, lane); continue; } r -= I_WOUT;
            const int e = r / I_DN; r -= e * I_DN; const size_t le = (size_t)l * 32 + e;
            tr_item8(w_down + le * 512 * 1024, 512, 1024, WSP(unsigned char, WS_W2) + le * 1024 * 512, 512, scr, r, lane);
        }
        __syncthreads();
    }
    SEAM(0);

    for (int l = 0; l < DEPTH; ++l) {
        const int pb = 1 + 9 * l;
#define MODL (WSP(const float, WS_MOD) + (size_t)l * 8 * 6144)
        if (PHON(1) && IN(pb + 0)) {
            const int tid = otid(), lane = tid & 63; (void)tid; (void)lane; WSL();
            const float* xf = (l == 0) ? INF(0) : nullptr; const bf16* XB = WSP(const bf16, WS_XB); const float* modl = MODL; const float* norm1_g = INF(5); unsigned char* ACTq = WSP(unsigned char, WS_ACT); float* sa1 = WSP(float, WS_SA1);
            const float* g1 = norm1_g + l * 1024;
            _Pragma("unroll 1") for (int rep_ = 0; rep_ < 1 + (RPT_PHASE == 1 ? RPT_N : 0); ++rep_)
            for (int m0 = gw; m0 < T; m0 += 4 * NGW) {
                f32x4 v[4][4];
#pragma unroll
                for (int q = 0; q < 4; ++q) { const int mq = m0 + q * NGW, m = mq < T ? mq : T - 1;
#pragma unroll
                    for (int j = 0; j < 4; ++j) v[q][j] = ldx4(xf, XB, (size_t)m * DM + 4 * lane + 256 * j); }
#pragma unroll
                for (int q = 0; q < 4; ++q) { const int m = m0 + q * NGW; if (m < T) {
                    const int b = m >> 13; const float* mb = modl + (size_t)b * 6144; float s = 0.f;
#pragma unroll
                    for (int j = 0; j < 4; ++j) s += (v[q][j][0] * v[q][j][0] + v[q][j][1] * v[q][j][1]) + (v[q][j][2] * v[q][j][2] + v[q][j][3] * v[q][j][3]);
                    const float rstd = rsqrtf(wave_sum(s) * (1.0f / 1024.0f) + EPS);
                    f32x4 y[4]; float am = 0.f;
#pragma unroll
                    for (int j = 0; j < 4; ++j) { const int k = 4 * lane + 256 * j; const f32x4 gg = *(const f32x4*)(g1 + k), sh = *(const f32x4*)(mb + k), sc = *(const f32x4*)(mb + 1024 + k);
                        y[j] = v[q][j] * rstd * gg * (sc + 1.0f) + sh; am = fmaxf(am, fmaxf(fmaxf(fabsf(y[j][0]), fabsf(y[j][1])), fmaxf(fabsf(y[j][2]), fabsf(y[j][3])))); }
                    am = wave_max(am); const float inv = am > 0.f ? 127.0f / am : 0.f;
                    if (lane == 0) sa1[m] = am > 0.f ? am * (1.0f / 127.0f) : 1.0f;
                    unsigned* o4 = (unsigned*)(ACTq + (size_t)m * 1024) + lane;
#pragma unroll
                    for (int j = 0; j < 4; ++j) { unsigned w = 0u;
#pragma unroll
                        for (int e = 0; e < 4; ++e) w |= ((unsigned)(int)__builtin_rintf(y[j][e] * inv) & 0xffu) << (8 * e);
                        o4[64 * j] = w; } } }
            }
        }
        SEAM(pb + 0);
        if (PHON(2) && IN(pb + 1)) {
            const int tid = otid(), lane = tid & 63; (void)tid; (void)lane; WSL();
            bf16* ACT = WSP(bf16, WS_ACT); bf16* P = WSP(bf16, WS_P);
            pg8::Gemm g{ACT, (const bf16*)(WSP(unsigned char, WS_WIN) + (size_t)l * NP * 1024), 512, 512, 512}; pg8::StaticOrder<T / 256, NP / 256> S; S.init(G, bx);
            pg8::EpiInproj E{P, NP, WSP(const float, WS_SA1), WSP(const float, WS_SWIN) + l * NP, INF(9) + l * 64, INF(10) + l * 64, WSP(const f32x2, WS_CSD)};
            _Pragma("unroll 1") for (int rep_ = 0; rep_ < 1 + (RPT_PHASE == 2 ? RPT_N : 0); ++rep_)
            pg8::gemm_phase<pg8::EpiInproj, pg8::StaticOrder<T / 256, NP / 256>, 0, 1>(lds, g, S, E, g_wave);
        }
        SEAM(pb + 1);
        if (PHON(3) && IN(pb + 2)) {
            const int tid = otid(), lane = tid & 63; (void)tid; (void)lane; WSL();
            const float* diff_q_g = INF(9); const float* diff_k_g = INF(10); const float* gla_b_a = INF(17); bf16* P = WSP(bf16, WS_P); unsigned char* ACT = WSP(unsigned char, WS_ACT); f32x2* csr = WSP(f32x2, WS_CSR);
            float* Eret = WSP(float, WS_EST); float* Egla = WSP(float, WS_EGL); float* Asr = WSP(float, WS_ASR); float* Asg = WSP(float, WS_ASG);
            _Pragma("unroll 1") for (int rep_ = 0; rep_ < 1 + (RPT_PHASE == 31 ? RPT_N : 0); ++rep_)
            for (int u = vcu; u < 1024; u += G) {
                const int r = u & 511, bh = r >> 4, seg = r & 15;
                if (u < 512) lin::unit<64, true, false>(lds, P, ACT, csr, bh >> 2, bh & 3, seg, nullptr, nullptr, Eret, Asr, g_wave);
                else lin::unit<32, false, false>(lds, P, ACT, csr, bh >> 2, bh & 3, seg, gla_b_a + l * 128, nullptr, Egla, Asg, g_wave);
            }
        }
        SEAM(pb + 2);
        if (PHON(4) && IN(pb + 3)) {
            const int tid = otid(), lane = tid & 63; (void)tid; (void)lane; WSL();
            const float* scal = WSP(const float, WS_SCAL); const float* diff_sub_g = INF(15); const float* ret_norm_g = INF(8); const float* gla_norm_g = INF(18); const float* gla_b_a = INF(17); bf16* P = WSP(bf16, WS_P); unsigned char* ACT = WSP(unsigned char, WS_ACT); f32x2* csr = WSP(f32x2, WS_CSR);
            float* Eret = WSP(float, WS_EST); float* Egla = WSP(float, WS_EGL); float* Asr = WSP(float, WS_ASR); float* Asg = WSP(float, WS_ASG);
            const float lam = scal[l * 4 + 0], negM = scal[l * 4 + 1], osc = scal[l * 4 + 2];
#ifndef NO_ATT
            _Pragma("unroll 1") for (int rep_ = 0; rep_ < 1 + (RPT_PHASE == 41 ? RPT_N : 0); ++rep_)
            for (int pu = vcu; pu < 512; pu += G) {
                const int bh = pu >> 4, jp = pu & 15;
                att::unit(lds, P, ACT, bh >> 2, bh & 3, jp, lam, negM, diff_sub_g + l * 128, osc, g_wave);
                att::unit(lds, P, ACT, bh >> 2, bh & 3, 31 - jp, lam, negM, diff_sub_g + l * 128, osc, g_wave);
            }
#endif
#ifndef NO_LIN2
            _Pragma("unroll 1") for (int rep_ = 0; rep_ < 1 + (RPT_PHASE == 42 ? RPT_N : 0); ++rep_)
            for (int u = vcu; u < 1024; u += G) {
                const int r = u & 511, bh = r >> 4, seg = r & 15;
                if (u < 512) lin::unit<64, true, true>(lds, P, ACT, csr, bh >> 2, bh & 3, seg, nullptr, ret_norm_g + l * 64, Eret, Asr, g_wave);
                else lin::unit<32, false, true>(lds, P, ACT, csr, bh >> 2, bh & 3, seg, gla_b_a + l * 128, gla_norm_g + l * 64, Egla, Asg, g_wave);
            }
#endif
        }
        SEAM(pb + 3);
        if (PHON(5) && IN(pb + 4)) {
            const int tid = otid(), lane = tid & 63; (void)tid; (void)lane; WSL();
            const float* modl = MODL;
            pg8::Gemm g{WSP(const bf16, WS_ACT), (const bf16*)(WSP(unsigned char, WS_WOUT) + (size_t)l * 1024 * 1024), 512, 512, 512}; pg8::StaticOrder<T / 256, 4> S; S.init(G, bx);
            pg8::EpiResid E{(l == 0) ? INF(0) : nullptr, WSP(bf16, WS_XB), modl + 2048};
            _Pragma("unroll 1") for (int rep_ = 0; rep_ < 1 + ((RPT_PHASE == 5 && l == 0) ? RPT_N : 0); ++rep_)
            pg8::gemm_phase<pg8::EpiResid, pg8::StaticOrder<T / 256, 4>, 0, 2>(lds, g, S, E, g_wave);
        }
        SEAM(pb + 4);
        if (PHON(6) && IN(pb + 5)) {
            const int tid = otid(), lane = tid & 63; (void)tid; (void)lane; WSL();
            const float* modl = MODL; const float* router_w = INF(20); const float* router_b = INF(21); const float* norm2_g = INF(6); const bf16* XB = WSP(const bf16, WS_XB); bf16* ACT = WSP(bf16, WS_ACT); int* tokinfo = WSP(int, WS_ROUTE); int* tokS = WSP(int, WS_TOKS); unsigned char* h2q = WSP(unsigned char, WS_H2Q); float* sa2 = WSP(float, WS_SA2);
            constexpr int WR_PITCH = 2064, LG_OFF = 32 * WR_PITCH;
#pragma unroll 4
            for (int i = tid; i < 32768; i += NWAVES * 64) { const int k = i >> 5, e = i & 31; *(LAS unsigned short*)(lds + e * WR_PITCH + k * 2) = (unsigned short)(pk2(router_w[i], 0.f) & 0xffffu); }
            { int Gl = G; asm volatile("" : "+s"(Gl));
#pragma unroll 1
              for (int i = bx * NWAVES * 64 + tid; i < TPAD; i += Gl * NWAVES * 64) tokS[i] = -1; }
            __syncthreads();
            const float* g2 = norm2_g + l * 1024;
            LAS float* lg = (LAS float*)(lds + LG_OFF + wave * 2112);
            unsigned* cnt = ctl + CW_CNT + l * 64;
            for (int gi = gw; gi < T / 16; gi += NGW) {
                for (int r4 = 0; r4 < 16; r4 += 4) {
                    f32x4 v[4][4];
#pragma unroll
                    for (int q = 0; q < 4; ++q) {
#pragma unroll
                        for (int j = 0; j < 4; ++j) v[q][j] = ldx4(nullptr, XB, (size_t)(gi * 16 + r4 + q) * DM + 4 * lane + 256 * j); }
#pragma unroll
                    for (int q = 0; q < 4; ++q) { const int m = gi * 16 + r4 + q; const int b = m >> 13; const float* mb = modl + (size_t)b * 6144 + 3072; float s = 0.f;
#pragma unroll
                        for (int j = 0; j < 4; ++j) s += (v[q][j][0] * v[q][j][0] + v[q][j][1] * v[q][j][1]) + (v[q][j][2] * v[q][j][2] + v[q][j][3] * v[q][j][3]);
                        const float rstd = rsqrtf(wave_sum(s) * (1.0f / 1024.0f) + EPS);
                        u32x2* o8 = (u32x2*)(ACT + (size_t)m * DM) + lane; f32x4 y[4]; float am = 0.f;
#pragma unroll
                        for (int j = 0; j < 4; ++j) { const int k = 4 * lane + 256 * j; const f32x4 gg = *(const f32x4*)(g2 + k), sh = *(const f32x4*)(mb + k), sc = *(const f32x4*)(mb + 1024 + k);
                            y[j] = v[q][j] * rstd * gg * (sc + 1.0f) + sh; u32x2 w; w.x = pk2(y[j][0], y[j][1]); w.y = pk2(y[j][2], y[j][3]); o8[64 * j] = w;
                            am = fmaxf(am, fmaxf(fmaxf(fabsf(y[j][0]), fabsf(y[j][1])), fmaxf(fabsf(y[j][2]), fabsf(y[j][3])))); }
                        am = wave_max(am); const float inv = am > 0.f ? 127.0f / am : 0.f;
                        if (lane == 0) sa2[m] = am > 0.f ? am * (1.0f / 127.0f) : 1.0f;
                        unsigned* o4 = (unsigned*)(h2q + (size_t)m * 1024) + lane;
#pragma unroll
                        for (int j = 0; j < 4; ++j) { unsigned w = 0u;
#pragma unroll
                            for (int e = 0; e < 4; ++e) w |= ((unsigned)(int)__builtin_rintf(y[j][e] * inv) & 0xffu) << (8 * e);
                            o4[64 * j] = w; } }
                }
                VM_WAIT();
                f32x4 a0 = (f32x4){0.f, 0.f, 0.f, 0.f}, a1 = a0;
                const bf16* ap = ACT + (size_t)(gi * 16 + (lane & 15)) * DM + 8 * (lane >> 4);
#pragma unroll 4
                for (int ks = 0; ks < 32; ++ks) { const bf16x8 a = *(const bf16x8*)(ap + 32 * ks);
                    const bf16x8 b0 = *(const LAS bf16x8*)(lds + (lane & 15) * WR_PITCH + (32 * ks + 8 * (lane >> 4)) * 2), b1 = *(const LAS bf16x8*)(lds + (16 + (lane & 15)) * WR_PITCH + (32 * ks + 8 * (lane >> 4)) * 2);
                    a0 = MFMA16(a, b0, a0); a1 = MFMA16(a, b1, a1); }
#pragma unroll
                for (int r = 0; r < 4; ++r) { lg[(4 * (lane >> 4) + r) * 33 + (lane & 15)] = a0[r]; lg[(4 * (lane >> 4) + r) * 33 + 16 + (lane & 15)] = a1[r]; }
                LDS_WAIT(); asm volatile("" ::: "memory");
                if (lane < 16) {
                    const int m = gi * 16 + lane; float best = -3.0e38f; int bcls = 0; float bwa = 0.f, bwb = 0.f;
#pragma unroll
                    for (int g = 0; g < 8; ++g) {
                        float s[4], a[4];
#pragma unroll
                        for (int i = 0; i < 4; ++i) { s[i] = 1.0f / (1.0f + __expf(-lg[lane * 33 + 4 * g + i])); a[i] = s[i] + router_b[4 * g + i]; }
                        int i1 = 0; float v1 = a[0];
                        if (a[1] > v1) { v1 = a[1]; i1 = 1; } if (a[2] > v1) { v1 = a[2]; i1 = 2; } if (a[3] > v1) { v1 = a[3]; i1 = 3; }
                        int i2 = -1; float v2 = -3.0e38f;
                        if (i1 != 0 && a[0] > v2) { v2 = a[0]; i2 = 0; } if (i1 != 1 && a[1] > v2) { v2 = a[1]; i2 = 1; } if (i1 != 2 && a[2] > v2) { v2 = a[2]; i2 = 2; } if (i1 != 3 && a[3] > v2) { v2 = a[3]; i2 = 3; }
                        const float gsum = v1 + v2;
                        const int ea = i1 < i2 ? i1 : i2, eb = i1 < i2 ? i2 : i1;
                        const float sa = ea == 0 ? s[0] : (ea == 1 ? s[1] : s[2]), sb = eb == 1 ? s[1] : (eb == 2 ? s[2] : s[3]);
                        const int pidx = (ea * (7 - ea)) / 2 + (eb - ea - 1);
                        if (gsum > best) { best = gsum; bcls = g * 6 + pidx; const float den = 1.0f / (sa + sb); bwa = sa * den; bwb = sb * den; }
                    }
                    const unsigned rank = atomicAdd(cnt + bcls, 1u);
                    *(u32x4*)(tokinfo + (size_t)m * 4) = (u32x4){(unsigned)bcls, rank, __float_as_uint(bwa), __float_as_uint(bwb)};
                }
                LDS_WAIT(); asm volatile("" ::: "memory");
            }
            __syncthreads();
        }
        SEAM(pb + 5);
        if (PHON(7) && IN(pb + 6)) {
            const int tid = otid(), lane = tid & 63; (void)tid; (void)lane; WSL();
            const unsigned char* h2q = WSP(const unsigned char, WS_H2Q); unsigned char* H2S = WSP(unsigned char, WS_H2S); const float* sa2 = WSP(const float, WS_SA2); float* saS = WSP(float, WS_SAS); int* tokinfo = WSP(int, WS_ROUTE); int* tokS = WSP(int, WS_TOKS); float* gaS = WSP(float, WS_GAS); float* gbS = WSP(float, WS_GBS); int* tinfo = WSP(int, WS_TINFO);
            LAS int* cst = (LAS int*)lds;
            if (tid == 0) { const unsigned* cnt = ctl + CW_CNT + l * 64; int s = 0, nt = 0;
                for (int c = 0; c < NCLS; ++c) { const int n = (int)__hip_atomic_load(cnt + c, __ATOMIC_RELAXED, __HIP_MEMORY_SCOPE_AGENT); cst[c] = s; const int tl = (n + 255) >> 8;
                    if (bx == 0) { const int g = c / 6, p = c % 6; const int a = p < 3 ? 0 : (p < 5 ? 1 : 2); const int bb = p < 3 ? p + 1 : (p < 5 ? p - 1 : 3); const int code = (g * 4 + a) | ((g * 4 + bb) << 8);
                        for (int i = 0; i < tl; ++i) tinfo[1 + nt + i] = code; }
                    nt += tl; s += tl * 256; }
                if (bx == 0) tinfo[0] = nt; }
            __syncthreads();
            _Pragma("unroll 1") for (int rep_ = 0; rep_ < 1 + (RPT_PHASE == 7 ? RPT_N : 0); ++rep_)
            for (int m = gw; m < T; m += NGW) {
                const u32x4 inf = *(const u32x4*)(tokinfo + (size_t)m * 4);
                const int slot = cst[inf.x] + (int)inf.y;
                const u32x4* src = (const u32x4*)(h2q + (size_t)m * 1024); u32x4* dst = (u32x4*)(H2S + (size_t)slot * 1024);
                dst[lane] = src[lane];
                if (lane == 0) { tokS[slot] = m; gaS[slot] = __uint_as_float(inf.z); gbS[slot] = __uint_as_float(inf.w); saS[slot] = sa2[m]; }
            }
            __syncthreads();
        }
        SEAM(pb + 6);
        if (PHON(8) && IN(pb + 7)) {
            const int tid = otid(), lane = tid & 63; (void)tid; (void)lane; WSL();
            bf16* H2S = WSP(bf16, WS_H2S); unsigned char* U = WSP(unsigned char, WS_U); float* gaS = WSP(float, WS_GAS); float* gbS = WSP(float, WS_GBS); int* tinfo = WSP(int, WS_TINFO);
            pg8::Gemm g{H2S, (const bf16*)(WSP(unsigned char, WS_W1) + (size_t)l * 32 * 1024 * 1024), 512, 512, 512}; pg8::MoeOrder<8, 1> S{tinfo, G, vcu};
            pg8::EpiMoe1 E{U, gaS, gbS, WSP(const float, WS_SAS), WSP(const float, WS_SW1) + (size_t)l * 32 * 1024};
            _Pragma("unroll 1") for (int rep_ = 0; rep_ < 1 + (RPT_PHASE == 8 ? RPT_N : 0); ++rep_)
            pg8::gemm_phase<pg8::EpiMoe1, pg8::MoeOrder<8, 1>, 0, 1>(lds, g, S, E, g_wave);
        }
        SEAM(pb + 7);
        if (PHON(9) && IN(pb + 8)) {
            const int tid = otid(), lane = tid & 63; (void)tid; (void)lane; WSL();
            const float* modl = MODL; int* tokS = WSP(int, WS_TOKS); int* tinfo = WSP(int, WS_TINFO);
            pg8::Gemm g{WSP(const bf16, WS_U), (const bf16*)(WSP(unsigned char, WS_W2) + (size_t)l * 32 * 1024 * 512), 512, 512, 256}; pg8::MoeOrder<4, 2> S{tinfo, G, vcu};
            pg8::EpiMoe2 E{WSP(bf16, WS_XB), (l == DEPTH - 1) ? (float*)INF(25) : nullptr, tokS, modl + 5 * 1024};
            pg8::gemm_phase<pg8::EpiMoe2, pg8::MoeOrder<4, 2>, 4, 2>(lds, g, S, E, g_wave);
        }
        SEAM(pb + 8);
    }
#undef IN
#undef SEAM
}

extern "C" void kernel_launch(void* const* d_in, const int* in_sizes, int n_in, void* d_out, int out_size, void* d_ws, size_t ws_size, hipStream_t stream) {
    static int grid = 0;
    if (grid == 0) {
        if (n_in != 25 || in_sizes[0] != T * DM || out_size != T * DM || ws_size < WS_END) { fprintf(stderr, "kernel_launch: unexpected shapes (n_in %d, in0 %d, out %d, ws %zu < %zu)\n", n_in, n_in > 0 ? in_sizes[0] : -1, out_size, ws_size, (size_t)WS_END); grid = -1; return; }
        int dev = 0, cus = 0, per_cu = 0;
        if (hipGetDevice(&dev) != hipSuccess || hipDeviceGetAttribute(&cus, hipDeviceAttributeMultiprocessorCount, dev) != hipSuccess) { grid = -1; return; }
        if (hipFuncSetAttribute((const void*)fwd, hipFuncAttributeMaxDynamicSharedMemorySize, LDS_BYTES) != hipSuccess) { fprintf(stderr, "kernel_launch: hipFuncSetAttribute failed\n"); grid = -1; return; }
        if (hipOccupancyMaxActiveBlocksPerMultiprocessor(&per_cu, (const void*)fwd, NWAVES * 64, LDS_BYTES) != hipSuccess || per_cu < 1) fprintf(stderr, "kernel_launch: occupancy query reports %d\n", per_cu);
        (void)hipGetLastError();
        grid = cus;
    }
    if (grid < 0) return;
    if (hipMemsetAsync((char*)d_ws + WS_CTL, 0, CTL_ZERO_BYTES, stream) != hipSuccess) return;
    Args a{};
    for (int i = 0; i < 25; ++i) a.in[i] = (const float*)d_in[i];
    a.out = (float*)d_out; a.ws = (unsigned char*)d_ws;
#if MK_N_LAUNCHES == 1
    a.ph_lo = 0; a.ph_hi = NPHASE;
    hipLaunchKernelGGL(fwd, dim3(grid), dim3(NWAVES * 64), LDS_BYTES, stream, a);
#else
    for (int p = 0; p < NPHASE; ++p) { a.ph_lo = p; a.ph_hi = p + 1; hipLaunchKernelGGL(fwd, dim3(grid), dim3(NWAVES * 64), LDS_BYTES, stream, a); }
#endif
}
```

```cpp
#include <hip/hip_runtime.h>
#include <cstdio>
#include <cstdint>

#ifndef MK_N_LAUNCHES
#define MK_N_LAUNCHES 1
#endif
#ifndef DBG_GROUPS
#define DBG_GROUPS 7
#endif
#ifndef DBG_MOE
#define DBG_MOE 1
#endif
#ifndef RPT_PHASE
#define RPT_PHASE 0
#endif
#ifndef RPT_N
#define RPT_N 1
#endif

#define LAS __attribute__((address_space(3)))
#define GAS __attribute__((address_space(1)))
typedef unsigned short bf16;
typedef short bf16x8 __attribute__((ext_vector_type(8)));
typedef short s16x4 __attribute__((ext_vector_type(4)));
typedef float f32x4 __attribute__((ext_vector_type(4)));
typedef float f32x16 __attribute__((ext_vector_type(16)));
typedef float f32x2 __attribute__((ext_vector_type(2)));
typedef unsigned u32x4 __attribute__((ext_vector_type(4)));
typedef unsigned u32x2 __attribute__((ext_vector_type(2)));
typedef __bf16 bf16x2_t __attribute__((ext_vector_type(2)));
typedef int i32x4 __attribute__((ext_vector_type(4)));

constexpr int BATCH = 8, SEQ = 8192, DM = 1024, T = BATCH * SEQ, DEPTH = 2;
constexpr int NP = 3584;
constexpr int C_RQ = 0, C_RK = 256, C_RV = 512, C_RG = 768, C_DQ = 1024, C_DK = 1536, C_DV = 2048, C_GQ = 2560, C_GK = 2688, C_GV = 2816, C_LA = 3072, C_GR = 3200, C_PAD = 3456;
constexpr int IN_W = 3344;
constexpr int NCLS = 48, TPAD = T + NCLS * 256, MAXTILES = TPAD / 256;
constexpr float EPS = 1e-6f, LOG2E = 1.4426950408889634f;

constexpr size_t MiB = 1u << 20;
constexpr size_t WS_CTL = 0, CTL_ZERO_BYTES = 1 * MiB;
constexpr size_t WS_MOD = 1 * MiB;
constexpr size_t WS_SCAL = WS_MOD + 400 * 1024;
constexpr size_t WS_CSR = 2 * MiB;
constexpr size_t WS_CSD = 19 * MiB;
constexpr size_t WS_WIN = 24 * MiB;
constexpr size_t WS_WOUT = 38 * MiB;
constexpr size_t WS_W1 = 42 * MiB;
constexpr size_t WS_W2 = 170 * MiB;
constexpr size_t WS_ACT = 234 * MiB;
constexpr size_t WS_P = 362 * MiB;
constexpr size_t WS_H2S = WS_P;
constexpr size_t WS_U = WS_P + 152 * MiB;
constexpr size_t WS_EST = 810 * MiB;
constexpr size_t WS_EGL = WS_EST + 8 * MiB, WS_ASR = WS_EST + 12 * MiB, WS_ASG = WS_ASR + 256 * 1024;
constexpr size_t WS_ROUTE = 824 * MiB;
constexpr size_t WS_TOKS = WS_ROUTE + 1 * MiB, WS_GAS = WS_TOKS + 512 * 1024, WS_GBS = WS_GAS + 512 * 1024, WS_TINFO = WS_GBS + 512 * 1024;
constexpr size_t WS_SA1 = 828 * MiB, WS_SA2 = WS_SA1 + 256 * 1024, WS_SAS = WS_SA2 + 256 * 1024, WS_SWIN = WS_SA1 + 1024 * 1024, WS_SW1 = WS_SWIN + 256 * 1024;
constexpr size_t WS_H2Q = 830 * MiB;
constexpr size_t WS_XB = 894 * MiB;
constexpr size_t WS_CNTB = WS_TINFO + 64 * 1024;
constexpr size_t WS_END = 1022 * MiB;
static_assert((size_t)TPAD * 1024 * 2 <= 152 * MiB && WS_U + 152 * MiB <= WS_P + (size_t)T * NP * 2, "aliases fit inside P");
static_assert((size_t)T * NP * 2 == 448 * MiB && WS_P + 448 * MiB == WS_EST, "P size");
constexpr int CW_BAR = 4096;
constexpr int CW_CNT = 16384;

constexpr int RING_BYTES = 131072, LDSCTL_OFF = RING_BYTES, MISC_OFF = LDSCTL_OFF + 320, PTR_OFF = MISC_OFF + 128, LDS_BYTES = 147456;
constexpr int NWAVES = 8;

__device__ __forceinline__ unsigned pk2(float lo, float hi) { f32x2 v = {lo, hi}; bf16x2_t b = __builtin_convertvector(v, bf16x2_t); return __builtin_bit_cast(unsigned, b); }
__device__ __forceinline__ float bflo(unsigned w) { return __uint_as_float(w << 16); }
__device__ __forceinline__ float bfhi(unsigned w) { return __uint_as_float(w & 0xffff0000u); }
template <int K> __device__ __forceinline__ float sx(float v) { static_assert(K >= 1 && K < 32, "sx"); return __int_as_float(__builtin_amdgcn_ds_swizzle(__float_as_int(v), (K << 10) | 0x1f)); }
__device__ __forceinline__ float sum_halves(float v) { auto rr = __builtin_amdgcn_permlane32_swap(__float_as_uint(v), __float_as_uint(v), false, false); return __uint_as_float(rr[0]) + __uint_as_float(rr[1]); }
__device__ __forceinline__ float max_halves(float v) { auto rr = __builtin_amdgcn_permlane32_swap(__float_as_uint(v), __float_as_uint(v), false, false); return fmaxf(__uint_as_float(rr[0]), __uint_as_float(rr[1])); }
__device__ __forceinline__ float wave_sum(float v) { v += sx<1>(v); v += sx<2>(v); v += sx<4>(v); v += sx<8>(v); v += sx<16>(v); return sum_halves(v); }
__device__ __forceinline__ float wave_max(float v) { v = fmaxf(v, sx<1>(v)); v = fmaxf(v, sx<2>(v)); v = fmaxf(v, sx<4>(v)); v = fmaxf(v, sx<8>(v)); v = fmaxf(v, sx<16>(v)); return max_halves(v); }
__device__ __forceinline__ float silu_f(float x) { return x * __builtin_amdgcn_rcpf(1.0f + __expf(-x)); }
__device__ __forceinline__ int olane() { int l; asm volatile("v_mbcnt_lo_u32_b32 %0, -1, 0\n\tv_mbcnt_hi_u32_b32 %0, -1, %0" : "=v"(l)); return l; }
__device__ __forceinline__ int otid_w(int wave) { return wave * 64 + olane(); }
#define otid() otid_w(g_wave)
__device__ __forceinline__ unsigned pk4_fp8(float a, float b, float c, float d) { int w = __builtin_amdgcn_cvt_pk_fp8_f32(a, b, 0, false); w = __builtin_amdgcn_cvt_pk_fp8_f32(c, d, w, true); return (unsigned)w; }
constexpr float FP8_ACT_SCALE = 16.0f, FP8_W_SCALE = 32.0f;   static_assert(FP8_ACT_SCALE == 16.0f, "EpiMoe1 applies it as ldexp(., 4)");
constexpr int FP8_ACT_E8 = 127 - 4, FP8_W_E8 = 127 - 5;
template <class Tp> __device__ __forceinline__ const Tp* inptr(const LAS unsigned char* lds, int k) {
    const LAS unsigned* q = (const LAS unsigned*)(lds + PTR_OFF) + 2 * k; const unsigned lo = __builtin_amdgcn_readfirstlane(q[0]), hi = __builtin_amdgcn_readfirstlane(q[1]);
    return (const Tp*)(((unsigned long long)hi << 32) | lo); }
#define INF(k) inptr<float>(lds, k)
__device__ __forceinline__ f32x4 ldx4(const float* xf, const bf16* xb, size_t idx) {
    if (xf) return *(const f32x4*)(xf + idx);
    const u32x2 w = *(const u32x2*)(xb + idx); return (f32x4){bflo(w.x), bfhi(w.x), bflo(w.y), bfhi(w.y)}; }
#define LDS_WAIT() asm volatile("s_waitcnt lgkmcnt(0)" ::: "memory")
#define VM_WAIT() asm volatile("s_waitcnt vmcnt(0)" ::: "memory")

namespace pg8 {
constexpr int BM = 256, BK = 64, HALF = 128, HTB = HALF * BK * 2, STAGE_BYTES = 8 * HTB, NXCD = 8, WGM = 8;
__device__ __forceinline__ int lds_byte(int r, int c) { const int st = (r >> 4) * 2 + (c >> 5), rr = r & 15, cc = c & 31, ob = rr * 64 + cc * 2; return st * 1024 + (ob ^ (((ob >> 9) & 1) << 5)); }
__device__ __forceinline__ void stage_rc(int b, int& R, int& C) { const int st = b / 1024, sb = b % 1024, swz = sb ^ (((sb >> 9) & 1) << 5); R = (st >> 1) * 16 + swz / 64; C = (st & 1) * 32 + (swz % 64) / 2; }
__device__ __forceinline__ int perm32(int rho) { const int n = rho >> 4, i = rho & 15; return 8 * (i >> 2) + 4 * n + (i & 3); }

struct Unit { int pm, pn, e0, e1; };
struct Gemm { const bf16* A; const bf16* Bt; int K, lda, ldb; };

template <int NM, int NN> struct StaticOrder {
    static constexpr int nM = NM, nN = NN, nwg = NM * NN;
    int G, c;
    __device__ void init(int G_, int c_) { G = G_; c = c_; }
    __device__ bool next(int i, Unit& u) const {
        const int L = i * G + c; if (L >= nwg) return false;
        int wgid = L; { constexpr int q = nwg / NXCD, r = nwg % NXCD; const int xcd = wgid % NXCD, off = wgid / NXCD; wgid = (xcd < r ? xcd * (q + 1) : r * (q + 1) + (xcd - r) * q) + off; }
        constexpr int nig = WGM * nN; static_assert(NM % WGM == 0, "row tiles in whole groups");
        const int gid = wgid / nig, fm = gid * WGM;
        u.pm = fm + ((wgid % nig) % WGM); u.pn = (wgid % nig) / WGM; u.e0 = 0; u.e1 = 0; return true;
    }
    __device__ __forceinline__ const char* a_base(const Gemm& g, const Unit& u) const { return (const char*)g.A + (size_t)u.pm * BM * g.lda * 2; }
    __device__ __forceinline__ const char* b_lo(const Gemm& g, const Unit& u) const { return (const char*)g.Bt + (size_t)u.pn * BM * g.ldb * 2; }
    __device__ __forceinline__ const char* b_hi(const Gemm& g, const Unit& u) const { return b_lo(g, u); }
};
template <int NPN, int WHICH  >
struct MoeOrder {
    const int* tinfo; int G, c;
    __device__ bool next(int i, Unit& u) const {
        const int nT = __builtin_amdgcn_readfirstlane(tinfo[0]);
        const int L = i * G + c; if (L >= nT * NPN) return false;
        const int gF = nT >> 3, full = gF * 8 * NPN;
        if (L < full) { u.pm = (L / (8 * NPN)) * 8 + (L & 7); u.pn = (L >> 3) % NPN; }
        else { const int rT = nT - 8 * gF; int Lr = L - full, pn = 0; while (Lr >= rT) { Lr -= rT; ++pn; } u.pm = gF * 8 + Lr; u.pn = pn; }
        const int code = __builtin_amdgcn_readfirstlane(tinfo[1 + u.pm]); u.e0 = code & 0xff; u.e1 = (code >> 8) & 0xff; return true;
    }
    __device__ __forceinline__ const char* a_base(const Gemm& g, const Unit& u) const { return (const char*)g.A + (size_t)u.pm * BM * g.lda * 2; }
    __device__ __forceinline__ const char* b_lo(const Gemm& g, const Unit& u) const {
        if (WHICH == 1) return (const char*)g.Bt + ((size_t)(u.pn < 4 ? u.e0 : u.e1) * 1024 + (size_t)(u.pn & 3) * BM) * g.ldb * 2;
        return (const char*)g.Bt + ((size_t)u.e0 * 1024 + (size_t)u.pn * BM) * g.ldb * 2;
    }
    __device__ __forceinline__ const char* b_hi(const Gemm& g, const Unit& u) const {
        if (WHICH == 1) return b_lo(g, u);
        return (const char*)g.Bt + ((size_t)u.e1 * 1024 + (size_t)u.pn * BM) * g.ldb * 2 - (size_t)g.K;
    }
};

struct EpiStoreBf16 {
    static constexpr bool PERM = true;
    bf16* O; int ldc;
    __device__ __forceinline__ void operator()(const f32x4 (&acc)[2][2][4][2], const Unit& u, int wr, int wc, int fr, int fq) const {
        { const int l_ = olane(); fr = l_ & 15; fq = l_ >> 4; }
        const int row0 = u.pm * BM + wr * 64 + fr, col0 = u.pn * BM + wc * 32 + 8 * fq;
#pragma unroll
        for (int ai = 0; ai < 2; ++ai)
#pragma unroll
            for (int m = 0; m < 4; ++m) { bf16* rowp = O + (size_t)(row0 + ai * HALF + m * 16) * ldc + col0;
#pragma unroll
                for (int bj = 0; bj < 2; ++bj) { const f32x4 v0 = acc[ai][bj][m][0], v1 = acc[ai][bj][m][1];
                    u32x4 w; w.x = pk2(v0[0], v0[1]); w.y = pk2(v0[2], v0[3]); w.z = pk2(v1[0], v1[1]); w.w = pk2(v1[2], v1[3]);
                    *(u32x4*)(rowp + bj * HALF) = w; } }
    }
};
struct EpiInproj {
    static constexpr bool PERM = true;
    bf16* O; int ldc; const float* sa; const float* sw; const float* gq; const float* gk; const f32x2* csd;
    __device__ __forceinline__ void operator()(const i32x4 (&acc)[2][2][4][2], const Unit& u, int wr, int wc, int fr, int fq) const {
        { const int l_ = olane(); fr = l_ & 15; fq = l_ >> 4; }
        const int row0 = u.pm * BM + wr * 64 + fr, col0 = u.pn * BM + wc * 32 + 8 * fq;
        f32x4 cs[2][2];
#pragma unroll
        for (int bj = 0; bj < 2; ++bj)
#pragma unroll
            for (int n = 0; n < 2; ++n) cs[bj][n] = *(const f32x4*)(sw + col0 + bj * HALF + 4 * n);
        if (u.pn < 4 || u.pn >= 8) {
#pragma unroll
            for (int ai = 0; ai < 2; ++ai)
#pragma unroll
                for (int m = 0; m < 4; ++m) { const int row = row0 + ai * HALF + m * 16; const float rs = sa[row]; bf16* rowp = O + (size_t)row * ldc + col0;
#pragma unroll
                    for (int bj = 0; bj < 2; ++bj) { const f32x4 v0 = __builtin_convertvector(acc[ai][bj][m][0], f32x4) * cs[bj][0] * rs, v1 = __builtin_convertvector(acc[ai][bj][m][1], f32x4) * cs[bj][1] * rs;
                        u32x4 w; w.x = pk2(v0[0], v0[1]); w.y = pk2(v0[2], v0[3]); w.z = pk2(v1[0], v1[1]); w.w = pk2(v1[2], v1[3]);
                        *(u32x4*)(rowp + bj * HALF) = w; } }
        } else {
            const bool isq = u.pn < 6; const float* gg = (isq ? gq : gk) + 8 * fq; const float qs = isq ? 0.125f * LOG2E : 1.0f;
            f32x4 gv[2][2];
#pragma unroll
            for (int bj = 0; bj < 2; ++bj)
#pragma unroll
                for (int n = 0; n < 2; ++n) gv[bj][n] = *(const f32x4*)(gg + 32 * bj + 4 * n) * qs;
            const int lcol = u.pn * BM + 64 * wc + 8 * fq;
#pragma unroll
            for (int ai = 0; ai < 2; ++ai)
#pragma unroll
                for (int m = 0; m < 4; ++m) { const int row = row0 + ai * HALF + m * 16; const float rs = sa[row];
                    f32x4 x[2][2]; float ss = 0.f;
#pragma unroll
                    for (int bj = 0; bj < 2; ++bj)
#pragma unroll
                        for (int n = 0; n < 2; ++n) { x[bj][n] = __builtin_convertvector(acc[ai][bj][m][n], f32x4) * cs[bj][n] * rs; ss += (x[bj][n][0] * x[bj][n][0] + x[bj][n][1] * x[bj][n][1]) + (x[bj][n][2] * x[bj][n][2] + x[bj][n][3] * x[bj][n][3]); }
                    ss += sx<16>(ss); ss = sum_halves(ss);
                    const float rstd = rsqrtf(ss * (1.0f / 64.0f) + EPS);
#pragma unroll
                    for (int bj = 0; bj < 2; ++bj)
#pragma unroll
                        for (int n = 0; n < 2; ++n) x[bj][n] = x[bj][n] * gv[bj][n] * rstd;
                    const f32x4* c4 = (const f32x4*)(csd + (size_t)row * 8);
#pragma unroll
                    for (int n = 0; n < 2; ++n) { const f32x4 ca = c4[2 * n], cb = c4[2 * n + 1];
                        f32x4 pr;
#pragma unroll
                        for (int i = 0; i < 4; ++i) pr[i] = sx<16>(x[0][n][i]);
                        const f32x4 co = (f32x4){ca[0], ca[2], cb[0], cb[2]}, sn = (f32x4){ca[1], ca[3], cb[1], cb[3]};
                        const f32x4 r0 = x[0][n] * co - pr * sn, r1 = pr * sn + x[0][n] * co;
                        if (fq == 0) x[0][n] = r0; else if (fq == 1) x[0][n] = r1; }
                    bf16* rowp = O + (size_t)row * ldc + lcol;
#pragma unroll
                    for (int bj = 0; bj < 2; ++bj) { u32x4 w; w.x = pk2(x[bj][0][0], x[bj][0][1]); w.y = pk2(x[bj][0][2], x[bj][0][3]); w.z = pk2(x[bj][1][0], x[bj][1][1]); w.w = pk2(x[bj][1][2], x[bj][1][3]);
                        *(u32x4*)(rowp + 32 * bj) = w; } }
        }
    }
};
struct EpiResid {
    static constexpr bool PERM = true;
    const float* xf; bf16* xb; const float* gate;
    __device__ __forceinline__ void operator()(const f32x4 (&acc)[2][2][4][2], const Unit& u, int wr, int wc, int fr, int fq) const {
        { const int l_ = olane(); fr = l_ & 15; fq = l_ >> 4; }
        const int col0 = u.pn * BM + wc * 32 + 8 * fq; const int b = (u.pm * BM) >> 13;
        f32x4 gv[2][2];
#pragma unroll
        for (int bj = 0; bj < 2; ++bj)
#pragma unroll
            for (int n = 0; n < 2; ++n) gv[bj][n] = *(const f32x4*)(gate + (size_t)b * 6144 + col0 + bj * HALF + 4 * n);
#pragma unroll
        for (int ai = 0; ai < 2; ++ai)
#pragma unroll
            for (int m = 0; m < 4; ++m) { const size_t off = (size_t)(u.pm * BM + ai * HALF + wr * 64 + m * 16 + fr) * DM + col0;
#pragma unroll
                for (int bj = 0; bj < 2; ++bj) { f32x4 x0, x1;
                    if (xf) { x0 = *(const f32x4*)(xf + off + bj * HALF); x1 = *(const f32x4*)(xf + off + bj * HALF + 4); }
                    else { const u32x4 w = *(const u32x4*)(xb + off + bj * HALF); x0 = (f32x4){bflo(w.x), bfhi(w.x), bflo(w.y), bfhi(w.y)}; x1 = (f32x4){bflo(w.z), bfhi(w.z), bflo(w.w), bfhi(w.w)}; }
                    x0 += gv[bj][0] * acc[ai][bj][m][0]; x1 += gv[bj][1] * acc[ai][bj][m][1];
                    u32x4 o; o.x = pk2(x0[0], x0[1]); o.y = pk2(x0[2], x0[3]); o.z = pk2(x1[0], x1[1]); o.w = pk2(x1[2], x1[3]);
                    *(u32x4*)(xb + off + bj * HALF) = o; }
                if (m == 3) asm volatile("" ::: "memory"); }
    }
};
struct EpiMoe1 {
    static constexpr bool PERM = true;
    unsigned char* U; const float* gaS; const float* gbS; const float* saS; const float* sw1;
    __device__ __forceinline__ void operator()(const i32x4 (&acc)[2][2][4][2], const Unit& u, int wr, int wc, int fr, int fq) const {
        { const int l_ = olane(); fr = l_ & 15; fq = l_ >> 4; }
        const float* gs = (u.pn < 4) ? gaS : gbS; const int ucol = u.pn * 128 + wc * 32 + 8 * fq;
        const float* swp = sw1 + (size_t)(u.pn < 4 ? u.e0 : u.e1) * 1024 + (u.pn & 3) * BM + wc * 32 + 8 * fq;
        f32x4 cs[2][2];
#pragma unroll
        for (int bj = 0; bj < 2; ++bj)
#pragma unroll
            for (int n = 0; n < 2; ++n) cs[bj][n] = *(const f32x4*)(swp + bj * HALF + 4 * n);
#pragma unroll
        for (int ai = 0; ai < 2; ++ai)
#pragma unroll
            for (int m = 0; m < 4; ++m) { const int slot = u.pm * BM + ai * HALF + wr * 64 + m * 16 + fr; const float w = __builtin_ldexpf(gs[slot], 4)  , rs = saS[slot];
                float r[8];
#pragma unroll
                for (int n = 0; n < 2; ++n) { const f32x4 gv = __builtin_convertvector(acc[ai][0][m][n], f32x4) * cs[0][n] * rs, uv = __builtin_convertvector(acc[ai][1][m][n], f32x4) * cs[1][n] * (rs * w);
#pragma unroll
                    for (int i = 0; i < 4; ++i) r[n * 4 + i] = silu_f(gv[i]) * uv[i]; }
                u32x2 o; o.x = pk4_fp8(r[0], r[1], r[2], r[3]); o.y = pk4_fp8(r[4], r[5], r[6], r[7]);
                *(u32x2*)(U + (size_t)slot * 1024 + ucol) = o; asm volatile("" ::: "memory"); }
    }
};
struct EpiMoe2 {
    static constexpr bool PERM = true;
    bf16* xb; float* outf; const int* tokS; const float* gate; int dry;
    __device__ __forceinline__ void operator()(const f32x4 (&acc)[2][2][4][2], const Unit& u, int wr, int wc, int fr, int fq) const {
        if (dry) { asm volatile("" :: "v"(acc[0][0][0][0]), "v"(acc[1][1][3][1])); return; }
        { const int l_ = olane(); fr = l_ & 15; fq = l_ >> 4; }
        const int col0 = u.pn * BM + wc * 32 + 8 * fq;
        int tok[2][4];
#pragma unroll
        for (int ai = 0; ai < 2; ++ai)
#pragma unroll
            for (int m = 0; m < 4; ++m) tok[ai][m] = tokS[u.pm * BM + ai * HALF + wr * 64 + m * 16 + fr];
#pragma unroll
        for (int ai = 0; ai < 2; ++ai) {
            u32x4 xw[4][2];
#pragma unroll
            for (int m = 0; m < 4; ++m) { const int tk = tok[ai][m] < 0 ? 0 : tok[ai][m]; const size_t off = (size_t)tk * DM + col0;
#pragma unroll
                for (int bj = 0; bj < 2; ++bj) xw[m][bj] = *(const u32x4*)(xb + off + bj * HALF); }
#pragma unroll
            for (int m = 0; m < 4; ++m) { if (tok[ai][m] >= 0) { const size_t off = (size_t)tok[ai][m] * DM + col0; const float* gp = gate + (size_t)(tok[ai][m] >> 13) * 6144 + col0;
#pragma unroll
                for (int bj = 0; bj < 2; ++bj) { const u32x4 w = xw[m][bj]; const f32x4 g0 = *(const f32x4*)(gp + bj * HALF), g1 = *(const f32x4*)(gp + bj * HALF + 4);
                    const f32x4 x0 = (f32x4){bflo(w.x), bfhi(w.x), bflo(w.y), bfhi(w.y)} + (DBG_MOE ? 1.f : 0.f) * g0 * acc[ai][bj][m][0], x1 = (f32x4){bflo(w.z), bfhi(w.z), bflo(w.w), bfhi(w.w)} + (DBG_MOE ? 1.f : 0.f) * g1 * acc[ai][bj][m][1];
                    if (outf) { *(f32x4*)(outf + off + bj * HALF) = x0; *(f32x4*)(outf + off + bj * HALF + 4) = x1; }
                    else { u32x4 o; o.x = pk2(x0[0], x0[1]); o.y = pk2(x0[2], x0[3]); o.z = pk2(x1[0], x1[1]); o.w = pk2(x1[2], x1[3]); *(u32x4*)(xb + off + bj * HALF) = o; } } } }
            asm volatile("" ::: "memory"); }
    }
};

typedef int i32x8 __attribute__((ext_vector_type(8)));
template <int MODE> struct AccT { typedef f32x4 type; }; template <> struct AccT<1> { typedef i32x4 type; };
template <int MODE> struct Frag { bf16x8 lo, hi; __device__ __forceinline__ void ld(const LAS unsigned char* p) { lo = *(const LAS bf16x8*)p; hi = *(const LAS bf16x8*)(p + 1024); } };
template <> struct Frag<2> { i32x8 v; __device__ __forceinline__ void ld(const LAS unsigned char* p) { const i32x4 l_ = *(const LAS i32x4*)p, h_ = *(const LAS i32x4*)(p + 1024); v = __builtin_shufflevector(l_, h_, 0, 1, 2, 3, 4, 5, 6, 7); } };
__device__ __forceinline__ f32x4 mma2(const Frag<0>& b, const Frag<0>& a, f32x4 c) { c = __builtin_amdgcn_mfma_f32_16x16x32_bf16(b.lo, a.lo, c, 0, 0, 0); return __builtin_amdgcn_mfma_f32_16x16x32_bf16(b.hi, a.hi, c, 0, 0, 0); }
__device__ __forceinline__ i32x4 mma2(const Frag<1>& b, const Frag<1>& a, i32x4 c) {
    c = __builtin_amdgcn_mfma_i32_16x16x64_i8(__builtin_bit_cast(i32x4, b.lo), __builtin_bit_cast(i32x4, a.lo), c, 0, 0, 0); return __builtin_amdgcn_mfma_i32_16x16x64_i8(__builtin_bit_cast(i32x4, b.hi), __builtin_bit_cast(i32x4, a.hi), c, 0, 0, 0); }
__device__ __forceinline__ f32x4 mma2(const Frag<2>& b, const Frag<2>& a, f32x4 c) {
    return __builtin_amdgcn_mfma_scale_f32_16x16x128_f8f6f4(b.v, a.v, c, 0, 0, 0, FP8_W_E8, 0, FP8_ACT_E8); }
template <class Epi, class Sched, int KSPLIT  , int MODE = 0>
__device__ __forceinline__ void gemm_phase(LAS unsigned char* lds, const Gemm g, const Sched& S, const Epi& E, const int g_wave) {
    const int tid = otid(), wid = __builtin_amdgcn_readfirstlane(tid >> 6), lane = tid & 63, wr = wid >> 2, wc = wid & 3, fr = lane & 15, fq = lane >> 4;
    const int K = g.K, nt = K / BK;
    unsigned voffA[2], voffB[2];
#pragma unroll
    for (int i = 0; i < 2; ++i) { int R, C; stage_rc(tid * 16 + i * 8192, R, C); const int Rb = Epi::PERM ? ((R & ~31) + perm32(R & 31)) : R;
        voffA[i] = (unsigned)(R * g.lda + C) * 2u; voffB[i] = (unsigned)(Rb * g.ldb + C) * 2u; }
    const size_t kstep = (size_t)(BK * 2);
    const size_t hstepA = (size_t)HALF * g.lda * 2, hstepB = (size_t)HALF * g.ldb * 2;
    const unsigned ldsw = (unsigned)wid * 1024u;
    const int aoff = lds_byte(wr * 64 + fr, fq * 8), boff = lds_byte(wc * 32 + fr, fq * 8);
#define PG8_SA(b, h) (((b) * 2 + (h)) * HTB)
#define PG8_SB(b, h) ((4 + (b) * 2 + (h)) * HTB)
#define PG8_STAGE(bufoff, gbase, voff) do { _Pragma("unroll") for (int _i = 0; _i < 2; ++_i) \
        __builtin_amdgcn_global_load_lds((const unsigned*)((const char*)(gbase) + (voff)[_i]), (LAS unsigned*)(lds + (bufoff) + ldsw + _i * 8192), 16, 0, 0); } while (0)
#define PG8_LDA(dst, b, h) do { _Pragma("unroll") for (int m = 0; m < 4; ++m) dst[m].ld(lds + PG8_SA(b, h) + aoff + m * 2048); } while (0)
#define PG8_LDB(dst, b, h) do { _Pragma("unroll") for (int n = 0; n < 2; ++n) dst[n].ld(lds + PG8_SB(b, h) + boff + n * 2048); } while (0)
#define PG8_MMA(ai, bj, At, Bt) do { __builtin_amdgcn_s_setprio(1); _Pragma("unroll") for (int m = 0; m < 4; ++m) _Pragma("unroll") for (int n = 0; n < 2; ++n) \
        acc[ai][bj][m][n] = mma2(Bt[n], At[m], acc[ai][bj][m][n]); \
        if (MODE == 2) { _Pragma("unroll") for (int m = 0; m < 4; ++m) _Pragma("unroll") for (int n = 0; n < 2; ++n) asm volatile("" : "+v"(acc[ai][bj][m][n])); }     \
        __builtin_amdgcn_s_setprio(0); } while (0)
#define PG8_WAIT_V(n) asm volatile("s_waitcnt vmcnt(" #n ")" ::: "memory")
#define PG8_WAIT_L(n) asm volatile("s_waitcnt lgkmcnt(" #n ")" ::: "memory")
#define PG8_BAR __builtin_amdgcn_s_barrier()
#define PG8_SCHED __builtin_amdgcn_sched_barrier(0)
    Unit cur, nxt; int ui = 0;
    if (!S.next(0, cur)) return;
    typedef typename AccT<MODE>::type acc_t;
    acc_t acc[2][2][4][2];
#pragma unroll
    for (int a = 0; a < 2; ++a)
#pragma unroll
        for (int b = 0; b < 2; ++b)
#pragma unroll
            for (int m = 0; m < 4; ++m)
#pragma unroll
                for (int n = 0; n < 2; ++n) acc[a][b][m][n] = (acc_t){0, 0, 0, 0};
    Frag<MODE> At[4], B0[2], B1[2];
    const char* cA = S.a_base(g, cur); const char* cB = S.b_lo(g, cur); const char* cBh = S.b_hi(g, cur);
    PG8_STAGE(PG8_SB(0, 0), cB, voffB); PG8_STAGE(PG8_SB(0, 1), cB + hstepB, voffB); PG8_STAGE(PG8_SA(0, 0), cA, voffA); PG8_STAGE(PG8_SA(0, 1), cA + hstepA, voffA);
    if (wr == 1) PG8_BAR;
    PG8_WAIT_V(2); PG8_BAR;
    PG8_STAGE(PG8_SB(1, 0), cB + kstep, voffB); PG8_STAGE(PG8_SA(1, 0), cA + kstep, voffA); PG8_STAGE(PG8_SB(1, 1), cB + hstepB + kstep, voffB);
    PG8_WAIT_V(6); PG8_BAR;
    for (;;) {
        const bool has_next = S.next(ui + 1, nxt);
        const char* nA = has_next ? S.a_base(g, nxt) : cA; const char* nB = has_next ? S.b_lo(g, nxt) : cB; const char* nBh = has_next ? S.b_hi(g, nxt) : cBh;
        for (int t = 0; t < nt; t += 2) {
            const bool last = (t == nt - 2);
            const char* a1 = cA + (size_t)(t + 1) * kstep;
            const char* bsel = (KSPLIT != 0 && (t + 2) >= KSPLIT) ? cBh : cB;
            const char* a2 = last ? nA : cA + (size_t)(t + 2) * kstep; const char* b2 = last ? nB : bsel + (size_t)(t + 2) * kstep;
            const char* a3 = a2 + kstep; const char* b3 = b2 + kstep;
            PG8_LDB(B0, 0, 0); PG8_LDB(B1, 0, 1); PG8_SCHED; PG8_LDA(At, 0, 0); PG8_STAGE(PG8_SA(1, 1), a1 + hstepA, voffA);
            PG8_WAIT_V(8); PG8_WAIT_L(0); PG8_BAR; PG8_MMA(0, 0, At, B0); PG8_MMA(0, 1, At, B1); PG8_BAR; PG8_SCHED;
            PG8_LDA(At, 0, 1); PG8_STAGE(PG8_SB(0, 0), b2, voffB); PG8_STAGE(PG8_SB(0, 1), b2 + hstepB, voffB); PG8_STAGE(PG8_SA(0, 0), a2, voffA);
            PG8_WAIT_V(8); PG8_WAIT_L(0); PG8_BAR; PG8_MMA(1, 0, At, B0); PG8_MMA(1, 1, At, B1); PG8_BAR; PG8_SCHED;
            PG8_LDB(B0, 1, 0); PG8_LDB(B1, 1, 1); PG8_SCHED; PG8_LDA(At, 1, 0); PG8_STAGE(PG8_SA(0, 1), a2 + hstepA, voffA);
            PG8_WAIT_V(8); PG8_WAIT_L(0); PG8_BAR; PG8_MMA(0, 0, At, B0); PG8_MMA(0, 1, At, B1); PG8_BAR; PG8_SCHED;
            PG8_LDA(At, 1, 1); PG8_STAGE(PG8_SB(1, 0), b3, voffB); PG8_STAGE(PG8_SB(1, 1), b3 + hstepB, voffB); PG8_STAGE(PG8_SA(1, 0), a3, voffA);
            PG8_WAIT_V(8); PG8_WAIT_L(0); PG8_BAR; PG8_MMA(1, 0, At, B0); PG8_MMA(1, 1, At, B1); PG8_BAR; PG8_SCHED;
        }
        if (wr == 0) PG8_BAR;
        E(acc, cur, wr, wc, fr, fq);
        if (!has_next) break;
#pragma unroll
        for (int a = 0; a < 2; ++a)
#pragma unroll
            for (int b = 0; b < 2; ++b)
#pragma unroll
                for (int m = 0; m < 4; ++m)
#pragma unroll
                    for (int n = 0; n < 2; ++n) acc[a][b][m][n] = (acc_t){0, 0, 0, 0};
        cur = nxt; cA = nA; cB = nB; cBh = nBh; ++ui;
        if (wr == 1) PG8_BAR;
    }
    PG8_WAIT_V(0);
    PG8_BAR;
#undef PG8_SA
#undef PG8_SB
#undef PG8_STAGE
#undef PG8_LDA
#undef PG8_LDB
#undef PG8_MMA
#undef PG8_WAIT_V
#undef PG8_WAIT_L
#undef PG8_BAR
#undef PG8_SCHED
}
}

#define XB_TMO      128
#define XB_XCNT(j)  (256  + 64 * (j))
#define XB_XSUB(j)  (1280 + 64 * (j))
#define XB_XGEN(j)  (2304 + 64 * (j))
#define XB_TOP      3328
#define XB_TOPGEN   3392
#define XCD_BAR_WORDS 3456
#define XB_SPIN_CAP (1u << 21)
__device__ __forceinline__ unsigned xb_ld(unsigned* p)              { return __hip_atomic_load(p, __ATOMIC_RELAXED, __HIP_MEMORY_SCOPE_AGENT); }
__device__ __forceinline__ unsigned xb_add(unsigned* p, unsigned v) { return __hip_atomic_fetch_add(p, v, __ATOMIC_RELAXED, __HIP_MEMORY_SCOPE_AGENT); }
__device__ __forceinline__ unsigned xb_xcc_id() { return (unsigned)__builtin_amdgcn_s_getreg((3 << 11) | 20) & 0xFu; }
#define XB_SPIN(cond, bar) do { unsigned _sp = 0; while (cond) { __builtin_amdgcn_s_sleep(1); \
    if ((++_sp & 255u) == 0u) { if (xb_ld(&(bar)[XB_TMO])) break; if (_sp > XB_SPIN_CAP) { atomicAdd(&(bar)[XB_TMO], 1u); break; } } } } while (0)
struct XcdBarrier { unsigned* bar; unsigned x; volatile LAS unsigned* st; };
__device__ __forceinline__ XcdBarrier xcd_barrier_post(unsigned* bar, volatile LAS unsigned* st, bool leader) {
    XcdBarrier b; b.bar = bar; b.x = xb_xcc_id(); b.st = st;
    if (leader) (void)xb_add(&bar[XB_XCNT(b.x)], 1u);
    return b;
}
__device__ __forceinline__ void xcd_barrier_complete(unsigned* bar, unsigned x, unsigned& nloc, unsigned& nx) {
    const unsigned G = gridDim.x * gridDim.y * gridDim.z;
    unsigned sum, cnt, mine, sp = 0u;
    for (;;) {
        sum = 0u; cnt = 0u; mine = 0u;
#pragma unroll
        for (unsigned j = 0; j < 16; ++j) { const unsigned c = xb_ld(&bar[XB_XCNT(j)]); sum += c; cnt += (c > 0u) ? 1u : 0u; }
        mine = xb_ld(&bar[XB_XCNT(x)]);
        if (sum == G) break;
        __builtin_amdgcn_s_sleep(1);
        if ((++sp & 255u) == 0u) { if (xb_ld(&bar[XB_TMO])) break; if (sp > XB_SPIN_CAP) { atomicAdd(&bar[XB_TMO], 1u); break; } }
    }
    nloc = mine > 0u ? mine : 1u; nx = cnt > 0u ? cnt : 1u;
}
__device__ __forceinline__ void xcd_barrier(const XcdBarrier& b, bool leader) {
    asm volatile("s_waitcnt vmcnt(0)" ::: "memory");
    __syncthreads();
    if (leader) {
        unsigned* bar = b.bar;
        __builtin_amdgcn_s_waitcnt(0);
        unsigned nloc = b.st[0], nx = b.st[1];
        if (nloc == 0u) { xcd_barrier_complete(bar, b.x, nloc, nx); b.st[0] = nloc; b.st[1] = nx; }
        const unsigned old = xb_add(&bar[XB_XSUB(b.x)], 1u);
        const unsigned gen = old / nloc;
        if (old + 1u == (gen + 1u) * nloc) {
            __builtin_amdgcn_fence(__ATOMIC_RELEASE, "agent");
            asm volatile("s_waitcnt vmcnt(0)" ::: "memory");
            const unsigned og = xb_add(&bar[XB_TOP], 1u);
            const unsigned tg = og / nx;
            if (og + 1u == (tg + 1u) * nx) xb_add(&bar[XB_TOPGEN], 1u);
            else XB_SPIN(xb_ld(&bar[XB_TOPGEN]) == tg, bar);
            __builtin_amdgcn_fence(__ATOMIC_ACQUIRE, "agent");
            xb_add(&bar[XB_XGEN(b.x)], 1u);
            asm volatile("s_waitcnt vmcnt(0)" ::: "memory");
        } else {
            XB_SPIN(xb_ld(&bar[XB_XGEN(b.x)]) == gen, bar);
            __builtin_amdgcn_fence(__ATOMIC_ACQUIRE, "agent");
            asm volatile("s_waitcnt vmcnt(0)" ::: "memory");
        }
    }
    __syncthreads();
}

__device__ __forceinline__ int tr_row(int kind, int n) {
    if (kind == 0) return n;
    if (kind == 1) { if (n >= 1024 && n < 2048) { const int lc = (n - 1024) & 255, sh = lc >> 6, d = lc & 63; return (n & ~255) + 128 * (d >> 5) + 32 * sh + (d & 31); }
                     return n < 3072 ? n : (n < 3088 ? -1 : n + 112); }
    return (n >> 7) * 256 + (n & 127) + (kind == 3 ? 128 : 0);
}
__device__ __forceinline__ void tr_item(const float* W, int K, int N, bf16* WT, int ldt, int kind, LAS unsigned char* scr, int item, int lane) {
    const int nblk = (N + 63) / 64, kb = item / nblk, nb = item % nblk, k0 = 64 * kb, n0 = 64 * nb;
    const int n4 = (lane & 15) * 4; const bool inr = (n0 + n4) < N;
    f32x4 v[16];
#pragma unroll
    for (int i = 0; i < 16; ++i) { const int kk = 4 * i + (lane >> 4); v[i] = inr ? *(const f32x4*)(W + (size_t)(k0 + kk) * N + n0 + n4) : (f32x4){0.f, 0.f, 0.f, 0.f}; }
#pragma unroll
    for (int i = 0; i < 16; ++i) { const int kk = 4 * i + (lane >> 4); const unsigned w0 = pk2(v[i][0], v[i][1]), w1 = pk2(v[i][2], v[i][3]);
        *(LAS unsigned short*)(scr + (n4 + 0) * 132 + kk * 2) = (unsigned short)(w0 & 0xffffu); *(LAS unsigned short*)(scr + (n4 + 1) * 132 + kk * 2) = (unsigned short)(w0 >> 16);
        *(LAS unsigned short*)(scr + (n4 + 2) * 132 + kk * 2) = (unsigned short)(w1 & 0xffffu); *(LAS unsigned short*)(scr + (n4 + 3) * 132 + kk * 2) = (unsigned short)(w1 >> 16); }
    LDS_WAIT(); asm volatile("" ::: "memory");
#pragma unroll
    for (int j = 0; j < 8; ++j) { const int idx = lane + 64 * j, n = idx >> 3, c = idx & 7; const LAS unsigned* sp = (const LAS unsigned*)(scr + n * 132 + c * 16);
        u32x4 o; o.x = sp[0]; o.y = sp[1]; o.z = sp[2]; o.w = sp[3];
        const int gn = n0 + n; const int r = (gn < N) ? tr_row(kind, gn) : -1;
        if (r >= 0) *(u32x4*)(WT + (size_t)r * ldt + k0 + 8 * c) = o; }
    LDS_WAIT(); asm volatile("" ::: "memory");
}

__device__ __forceinline__ void tr_item8(const float* W, int K, int N, unsigned char* WT8, int ldt, LAS unsigned char* scr, int item, int lane) {
    const int nblk = N / 64, kb = item / nblk, nb = item % nblk, k0 = 64 * kb, n0 = 64 * nb;
    const int a = lane & 15, kg = lane >> 4;
    f32x4 v[16];
#pragma unroll
    for (int i = 0; i < 16; ++i) { const int kk = 16 * (i >> 2) + 4 * kg + (i & 3); v[i] = *(const f32x4*)(W + (size_t)(k0 + kk) * N + n0 + 4 * a); }
#pragma unroll
    for (int g = 0; g < 4; ++g)
#pragma unroll
        for (int e = 0; e < 4; ++e) *(LAS unsigned*)(scr + (4 * a + e) * 68 + 16 * g + 4 * kg) = pk4_fp8(v[4 * g][e] * FP8_W_SCALE, v[4 * g + 1][e] * FP8_W_SCALE, v[4 * g + 2][e] * FP8_W_SCALE, v[4 * g + 3][e] * FP8_W_SCALE);
    LDS_WAIT(); asm volatile("" ::: "memory");
#pragma unroll
    for (int j = 0; j < 4; ++j) { const int idx = lane + 64 * j, n = idx >> 2, c = idx & 3; const LAS unsigned* sp = (const LAS unsigned*)(scr + n * 68 + c * 16);
        u32x4 o; o.x = sp[0]; o.y = sp[1]; o.z = sp[2]; o.w = sp[3];
        *(u32x4*)(WT8 + (size_t)(n0 + n) * ldt + k0 + 16 * c) = o; }
    LDS_WAIT(); asm volatile("" ::: "memory");
}

template <bool LA>
__device__ __forceinline__ void quant_strip(LAS unsigned char* lds, const float* W, int N, int n0, unsigned char* Q, float* SW, int kind, const float* a2, int wave, int lane) {
    lane = olane();
    const int a = lane & 15, kg = lane >> 4; const int ncl = (n0 + 4 * a) < N ? (n0 + 4 * a) : (N - 4);
    f32x4 v[2][16];
#pragma unroll
    for (int t = 0; t < 2; ++t)
#pragma unroll
        for (int i = 0; i < 16; ++i) { const int kk = 128 * wave + 64 * t + 16 * (i >> 2) + 4 * kg + (i & 3);
            if (!LA) v[t][i] = *(const f32x4*)(W + (size_t)kk * N + ncl);
            else { f32x4 acc = (f32x4){0.f, 0.f, 0.f, 0.f}; const float* wr = W + (size_t)kk * N + 3072;
#pragma unroll 4
                for (int r = 0; r < 16; ++r) acc += *(const f32x4*)(a2 + r * 128 + n0 + 4 * a) * wr[r];
                v[t][i] = acc; } }
    f32x4 cm = (f32x4){0.f, 0.f, 0.f, 0.f};
#pragma unroll
    for (int t = 0; t < 2; ++t)
#pragma unroll
        for (int i = 0; i < 16; ++i) cm = __builtin_elementwise_max(cm, __builtin_elementwise_abs(v[t][i]));
    LAS float* cmax = (LAS float*)(lds + 67584);
#pragma unroll
    for (int e = 0; e < 4; ++e) { float m = cm[e]; m = fmaxf(m, sx<16>(m)); m = max_halves(m); if (kg == 0) cmax[wave * 64 + 4 * a + e] = m; }
    __syncthreads();
    float inv[4], scl[4];
#pragma unroll
    for (int e = 0; e < 4; ++e) { float m = 0.f;
#pragma unroll
        for (int w = 0; w < 8; ++w) m = fmaxf(m, cmax[w * 64 + 4 * a + e]);
        scl[e] = m > 0.f ? m * (1.0f / 127.0f) : 1.0f; inv[e] = m > 0.f ? 127.0f / m : 0.f; }
    LAS unsigned char* tile = lds + wave * 8448;
#pragma unroll
    for (int t = 0; t < 2; ++t)
#pragma unroll
        for (int g = 0; g < 4; ++g)
#pragma unroll
            for (int e = 0; e < 4; ++e) { unsigned w = 0u;
#pragma unroll
                for (int j = 0; j < 4; ++j) { const int q = (int)__builtin_rintf(v[t][4 * g + j][e] * inv[e]); w |= ((unsigned)q & 0xffu) << (8 * j); }
                *(LAS unsigned*)(tile + (4 * a + e) * 132 + 64 * t + 16 * g + 4 * kg) = w; }
    LDS_WAIT(); asm volatile("" ::: "memory");
#pragma unroll
    for (int j = 0; j < 8; ++j) { const int idx = lane + 64 * j, n = idx >> 3, c = idx & 7; const LAS unsigned* sp = (const LAS unsigned*)(tile + n * 132 + c * 16);
        u32x4 o; o.x = sp[0]; o.y = sp[1]; o.z = sp[2]; o.w = sp[3];
        const int gn = n0 + n; const int r = LA ? (C_LA + gn) : ((gn < N) ? tr_row(kind, gn) : -1);
        if (r >= 0) *(u32x4*)(Q + (size_t)r * 1024 + 128 * wave + 16 * c) = o; }
    if (wave == 0 && kg == 0) {
#pragma unroll
        for (int e = 0; e < 4; ++e) { const int gn = n0 + 4 * a + e; const int r = LA ? (C_LA + gn) : ((gn < N) ? tr_row(kind, gn) : -1); if (r >= 0) SW[r] = scl[e]; } }
    __syncthreads();
}

namespace lin {
constexpr int L_QL = 0, L_QU = 9216, L_KL = 18432, L_KU = 27648, L_KLT = 36864, L_VT = 46080, L_AM = 55296, L_ST = 64512, L_OUT = 73728, L_G = 90368, L_GL = 98560, L_END = 98816;
constexpr int NSEG = 16, LSEG = 8;
#define MFMA16(a, b, c) __builtin_amdgcn_mfma_f32_16x16x32_bf16(a, b, c, 0, 0, 0)
__device__ __forceinline__ bf16x8 frag(const LAS unsigned char* base, int pitchB, int r0, int ks, int lane) {
    return *(const LAS bf16x8*)(base + (r0 + (lane & 15)) * pitchB + (32 * ks + 8 * (lane >> 4)) * 2);
}
typedef short v4i16_t __attribute__((ext_vector_type(4)));
__device__ __forceinline__ bf16x8 trfrag(const LAS unsigned char* base, int pitchB, int k0, int n0, int lane) {
    const LAS unsigned char* p = base + (k0 + 8 * (lane >> 4) + ((lane & 15) >> 2)) * pitchB + (n0 + 4 * (lane & 3)) * 2;
    const s16x4 lo = __builtin_bit_cast(s16x4, __builtin_amdgcn_ds_read_tr16_b64_v4i16((LAS v4i16_t*)p));
    const s16x4 hi = __builtin_bit_cast(s16x4, __builtin_amdgcn_ds_read_tr16_b64_v4i16((LAS v4i16_t*)(p + 4 * pitchB)));
    return (bf16x8){lo[0], lo[1], lo[2], lo[3], hi[0], hi[1], hi[2], hi[3]};
}
template <int DK, bool RET, bool PH2>
__device__ __forceinline__ void unit(LAS unsigned char* lds, const bf16* P, unsigned char* MIX, const f32x2* csr, int b, int h, int seg,
                                     const float* b_a, const float* gnorm, float* Est, float* Aseg, const int g_wave) {
    constexpr int PQ = (DK + 8) * 2;
    constexpr int PS = 144;
    constexpr int NT = DK / 32;
    const int tid = otid(), lane = tid & 63, wid = __builtin_amdgcn_readfirstlane(tid >> 6);
    const int row = tid >> 3, c8 = tid & 7;
    const int entry = (b * 4 + h) * NSEG + seg;
    const float lng = RET ? __logf(1.0f - exp2f(-5.0f - (float)h)) : 0.f;
    const int cq = RET ? C_RQ + h * 64 : C_GQ + h * 32, ck = RET ? C_RK + h * 64 : C_GK + h * 32, cv = RET ? C_RV + h * 64 : C_GV + h * 64, cg = RET ? C_RG + h * 64 : C_GR + h * 64;
    f32x4 st[NT]; float ac[NT];
    int eb[NT], db[NT];
#pragma unroll
    for (int j = 0; j < NT; ++j) { const int i = wid + 8 * j; if (DK == 64) { eb[j] = i >> 2; db[j] = i & 3; } else { eb[j] = i >> 1; db[j] = i & 1; } st[j] = (f32x4){0.f, 0.f, 0.f, 0.f}; ac[j] = 1.f; }
    if (PH2) {
#pragma unroll 4
        for (int sp = 0; sp < seg; ++sp) { const int en = (b * 4 + h) * NSEG + sp;
#pragma unroll
            for (int j = 0; j < NT; ++j) { const int d = db[j] * 16 + (lane & 15); const float a = Aseg[(size_t)en * DK + d];
                { const f32x4 ev = *(const f32x4*)(Est + ((size_t)en * DK + d) * 64 + eb[j] * 16 + 4 * (lane >> 4)); st[j] = st[j] * a + ev; } } }
    }
    float gn8[8] = {0.f, 0.f, 0.f, 0.f, 0.f, 0.f, 0.f, 0.f}, ba4[4] = {0.f, 0.f, 0.f, 0.f};
    if (PH2) {
#pragma unroll
        for (int i = 0; i < 8; ++i) gn8[i] = gnorm[8 * c8 + i]; }
    if (!RET) {
#pragma unroll
        for (int i = 0; i < 4; ++i) ba4[i] = b_a[h * 32 + 4 * wid + i]; }
    u32x4 rq_ = (u32x4){0u, 0u, 0u, 0u}, rk_ = rq_, rq2_ = rq_, rk2_ = rq_, pv = rq_, pgt = rq_; f32x4 pcs[4]; u32x2 pla = (u32x2){0u, 0u};
#pragma unroll
    for (int i = 0; i < 4; ++i) pcs[i] = (f32x4){0.f, 0.f, 0.f, 0.f};
    const int d0 = 8 * c8; const bool qk_on = RET || c8 < 4;
#define LIN_LOAD(cc) do { const size_t mr_ = (size_t)b * SEQ + (size_t)(seg * LSEG + (cc)) * 64 + row; \
        if (!RET) pla = *(const u32x2*)(P + ((size_t)b * SEQ + (size_t)(seg * LSEG + (cc)) * 64 + lane) * NP + C_LA + h * 32 + 4 * wid); \
        if (qk_on) { rk_ = *(const u32x4*)(P + mr_ * NP + ck + d0); if (PH2) rq_ = *(const u32x4*)(P + mr_ * NP + cq + d0); \
            if (RET) { rk2_ = *(const u32x4*)(P + mr_ * NP + ck + (d0 ^ 32)); if (PH2) rq2_ = *(const u32x4*)(P + mr_ * NP + cq + (d0 ^ 32)); \
                const f32x4* cs4_ = (const f32x4*)(csr + mr_ * 32 + (d0 & 31)); pcs[0] = cs4_[0]; pcs[1] = cs4_[1]; pcs[2] = cs4_[2]; pcs[3] = cs4_[3]; } } \
        pv = *(const u32x4*)(P + mr_ * NP + cv + 8 * c8); if (PH2) pgt = *(const u32x4*)(P + mr_ * NP + cg + 8 * c8); } while (0)
    LIN_LOAD(0);
    for (int c = 0; c < LSEG; ++c) {
        const size_t m0 = (size_t)b * SEQ + (size_t)(seg * LSEG + c) * 64;
        if (!RET) {
            const u32x2 w = pla;
            float x[4] = {bflo(w.x), bfhi(w.x), bflo(w.y), bfhi(w.y)};
#pragma unroll
            for (int i = 0; i < 4; ++i) { const float z = x[i] + ba4[i]; float v = (fminf(z, 0.f) - log1pf(__expf(-fabsf(z)))) * (1.0f / 16.0f);
#pragma unroll
                for (int o = 1; o < 64; o <<= 1) { const float u = __int_as_float(__builtin_amdgcn_ds_bpermute((lane - o) << 2, __float_as_int(v))); if (lane >= o) v += u; }
                ((LAS float*)(lds + L_G))[lane * 32 + 4 * wid + i] = v; if (lane == 63) ((LAS float*)(lds + L_GL))[4 * wid + i] = v; }
            __syncthreads();
        }
        u32x4 gcur = pgt;
        {
            if (qk_on) {
                const u32x4 kw = rk_, qw = rq_;
                float qv[8], kv[8], eg[8], ieg[8];
                { const unsigned* qp = (const unsigned*)&qw; const unsigned* kp = (const unsigned*)&kw;
#pragma unroll
                  for (int i = 0; i < 4; ++i) { qv[2 * i] = bflo(qp[i]); qv[2 * i + 1] = bfhi(qp[i]); kv[2 * i] = bflo(kp[i]); kv[2 * i + 1] = bfhi(kp[i]); } }
                if (RET) {
                    const u32x4 kw2 = rk2_, qw2 = rq2_;
                    const unsigned* qp2 = (const unsigned*)&qw2; const unsigned* kp2 = (const unsigned*)&kw2;
                    const float g = (float)(row + 1) * lng; const float e1 = __expf(g), e2 = __expf(-g);
#pragma unroll
                    for (int i = 0; i < 4; ++i) { const f32x4 cc = pcs[i];
                        const float qa = bflo(qp2[i]), qb = bfhi(qp2[i]), ka = bflo(kp2[i]), kb = bfhi(kp2[i]);
                        if (c8 < 4) { const float q0 = qv[2 * i] * cc[0] - qa * cc[1], q1 = qv[2 * i + 1] * cc[2] - qb * cc[3]; const float k0 = kv[2 * i] * cc[0] - ka * cc[1], k1 = kv[2 * i + 1] * cc[2] - kb * cc[3];
                            qv[2 * i] = q0; qv[2 * i + 1] = q1; kv[2 * i] = k0; kv[2 * i + 1] = k1; }
                        else { const float q0 = qa * cc[1] + qv[2 * i] * cc[0], q1 = qb * cc[3] + qv[2 * i + 1] * cc[2]; const float k0 = ka * cc[1] + kv[2 * i] * cc[0], k1 = kb * cc[3] + kv[2 * i + 1] * cc[2];
                            qv[2 * i] = q0; qv[2 * i + 1] = q1; kv[2 * i] = k0; kv[2 * i + 1] = k1; } }
#pragma unroll
                    for (int i = 0; i < 8; ++i) { kv[i] *= 0.125f; eg[i] = e1; ieg[i] = e2; }
                } else {
#pragma unroll
                    for (int i = 0; i < 8; ++i) { const float g = ((const LAS float*)(lds + L_G))[row * 32 + d0 + i]; eg[i] = __expf(g); ieg[i] = __expf(-g); qv[i] *= 0.17677669529663687f; }
                }
                float kl[8];
#pragma unroll
                for (int i = 0; i < 8; ++i) kl[i] = kv[i] * ieg[i];
                if (PH2) {
                    u32x4 o;
                    o.x = pk2(qv[0] * eg[0], qv[1] * eg[1]); o.y = pk2(qv[2] * eg[2], qv[3] * eg[3]); o.z = pk2(qv[4] * eg[4], qv[5] * eg[5]); o.w = pk2(qv[6] * eg[6], qv[7] * eg[7]);
                    *(LAS u32x4*)(lds + L_QL + row * PQ + d0 * 2) = o;
                    o.x = pk2(qv[0] * ieg[0], qv[1] * ieg[1]); o.y = pk2(qv[2] * ieg[2], qv[3] * ieg[3]); o.z = pk2(qv[4] * ieg[4], qv[5] * ieg[5]); o.w = pk2(qv[6] * ieg[6], qv[7] * ieg[7]);
                    *(LAS u32x4*)(lds + L_QU + row * PQ + d0 * 2) = o;
                    o.x = pk2(kv[0] * eg[0], kv[1] * eg[1]); o.y = pk2(kv[2] * eg[2], kv[3] * eg[3]); o.z = pk2(kv[4] * eg[4], kv[5] * eg[5]); o.w = pk2(kv[6] * eg[6], kv[7] * eg[7]);
                    *(LAS u32x4*)(lds + L_KU + row * PQ + d0 * 2) = o;
                }
                { u32x4 o; o.x = pk2(kl[0], kl[1]); o.y = pk2(kl[2], kl[3]); o.z = pk2(kl[4], kl[5]); o.w = pk2(kl[6], kl[7]);
                  *(LAS u32x4*)(lds + L_KL + row * PQ + d0 * 2) = o; }
            }
            *(LAS u32x4*)(lds + L_VT + row * PS + c8 * 16) = pv;
        }
        if (c + 1 < LSEG) LIN_LOAD(c + 1);
        __syncthreads();
#pragma unroll
        for (int j = 0; j < NT; ++j) {
            const int d = db[j] * 16 + (lane & 15);
            if (PH2) {
#pragma unroll
                for (int r = 0; r < 4; ++r) { const int e = eb[j] * 16 + 4 * (lane >> 4) + r; *(LAS unsigned short*)(lds + L_ST + e * PQ + d * 2) = (unsigned short)(pk2(st[j][r], 0.f) & 0xffffu); }
            }
            f32x4 u = (f32x4){0.f, 0.f, 0.f, 0.f};
#pragma unroll
            for (int ks = 0; ks < 2; ++ks) u = MFMA16(trfrag(lds + L_VT, PS, 32 * ks, eb[j] * 16, lane), trfrag(lds + L_KL, PQ, 32 * ks, db[j] * 16, lane), u);
            const float egl = RET ? __expf(64.f * lng) : __expf(((const LAS float*)(lds + L_GL))[d]);
#pragma unroll
            for (int r = 0; r < 4; ++r) st[j][r] = egl * (st[j][r] + u[r]);
            ac[j] *= egl;
        }
        if (PH2) {
#pragma unroll
            for (int j = 0; j < 2; ++j) { const int i = wid + 8 * j, tb = i >> 2, sb = i & 3;
                f32x4 lo = (f32x4){0.f, 0.f, 0.f, 0.f}, up = (f32x4){0.f, 0.f, 0.f, 0.f};
                if (sb <= tb) {
#pragma unroll
                    for (int ks = 0; ks < DK / 32; ++ks) lo = MFMA16(frag(lds + L_QL, PQ, tb * 16, ks, lane), frag(lds + L_KL, PQ, sb * 16, ks, lane), lo); }
                if (sb >= tb) {
#pragma unroll
                    for (int ks = 0; ks < DK / 32; ++ks) up = MFMA16(frag(lds + L_QU, PQ, tb * 16, ks, lane), frag(lds + L_KU, PQ, sb * 16, ks, lane), up); }
                const int s = sb * 16 + (lane & 15);
#pragma unroll
                for (int r = 0; r < 4; ++r) { const int t = tb * 16 + 4 * (lane >> 4) + r; const float v = (s <= t) ? lo[r] : up[r];
                    *(LAS unsigned short*)(lds + L_AM + t * PS + s * 2) = (unsigned short)(pk2(v, 0.f) & 0xffffu); } }
        }
        __syncthreads();
        if (PH2) {
#pragma unroll
            for (int j = 0; j < 2; ++j) { const int i = wid + 8 * j, tb = i >> 2, ob = i & 3;
                f32x4 o = (f32x4){0.f, 0.f, 0.f, 0.f};
#pragma unroll
                for (int ks = 0; ks < 2; ++ks) o = MFMA16(frag(lds + L_AM, PS, tb * 16, ks, lane), trfrag(lds + L_VT, PS, 32 * ks, ob * 16, lane), o);
#pragma unroll
                for (int ks = 0; ks < DK / 32; ++ks) o = MFMA16(frag(lds + L_QL, PQ, tb * 16, ks, lane), frag(lds + L_ST, PQ, ob * 16, ks, lane), o);
#pragma unroll
                for (int r = 0; r < 4; ++r) ((LAS float*)(lds + L_OUT))[(tb * 16 + 4 * (lane >> 4) + r) * 65 + ob * 16 + (lane & 15)] = o[r]; }
            __syncthreads();
            { const size_t m = m0 + row; const int e0 = 8 * c8; float v[8]; float ss = 0.f;
#pragma unroll
              for (int i = 0; i < 8; ++i) { v[i] = ((const LAS float*)(lds + L_OUT))[row * 65 + e0 + i]; ss += v[i] * v[i]; }
              ss += sx<1>(ss); ss += sx<2>(ss); ss += sx<4>(ss);
              const float rstd = rsqrtf(ss * (1.0f / 64.0f) + EPS);
              const u32x4 gw = gcur; const unsigned* gp = (const unsigned*)&gw; float y[8];
#pragma unroll
              for (int i = 0; i < 4; ++i) { y[2 * i] = v[2 * i] * rstd * gn8[2 * i] * silu_f(bflo(gp[i])); y[2 * i + 1] = v[2 * i + 1] * rstd * gn8[2 * i + 1] * silu_f(bfhi(gp[i])); }
              const bool on = RET ? ((DBG_GROUPS & 1) != 0) : ((DBG_GROUPS & 4) != 0);
              u32x2 o; o.x = pk4_fp8(y[0] * FP8_ACT_SCALE, y[1] * FP8_ACT_SCALE, y[2] * FP8_ACT_SCALE, y[3] * FP8_ACT_SCALE); o.y = pk4_fp8(y[4] * FP8_ACT_SCALE, y[5] * FP8_ACT_SCALE, y[6] * FP8_ACT_SCALE, y[7] * FP8_ACT_SCALE);
              if (!on) o = (u32x2){0u, 0u};
              *(u32x2*)(MIX + m * DM + (RET ? 0 : 768) + h * 64 + e0) = o; }
        }
    }
#undef LIN_LOAD
    if (!PH2) {
#pragma unroll
        for (int j = 0; j < NT; ++j) { const int d = db[j] * 16 + (lane & 15);
            *(f32x4*)(Est + ((size_t)entry * DK + d) * 64 + eb[j] * 16 + 4 * (lane >> 4)) = st[j];
            if (eb[j] == 0 && (lane >> 4) == 0) Aseg[(size_t)entry * DK + d] = ac[j]; }
    }
    __syncthreads();
}
}

namespace att {
constexpr int A_K = 0, A_V = 24576, A_O0 = 0, A_LS = 73728, A_END = 75776;
#define MFMA32(a, b, c) __builtin_amdgcn_mfma_f32_32x32x16_bf16(a, b, c, 0, 0, 0)
typedef short v4i16_t __attribute__((ext_vector_type(4)));
__device__ __forceinline__ s16x4 vtr(const LAS unsigned char* p) { return __builtin_bit_cast(s16x4, __builtin_amdgcn_ds_read_tr16_b64_v4i16((LAS v4i16_t*)p)); }
__device__ __forceinline__ int crow(int r, int hi) { return (r & 3) + 8 * (r >> 2) + 4 * hi; }
__device__ __forceinline__ void unit(LAS unsigned char* lds, const bf16* P, unsigned char* MIX, int b, int h, int jq, float lam, float negM, const float* subg, float oscale, const int g_wave) {
    const int tid = otid(), lane = tid & 63, r32 = lane & 31, hh = lane >> 5, wid = __builtin_amdgcn_readfirstlane(tid >> 6);
    const size_t rowbase = (size_t)b * SEQ;
    const int q0 = jq * 256 + wid * 32;
    const int ntile = 4 * jq + 4, my_nt = 4 * jq + (wid >> 1) + 1;
    const int krow = tid >> 3, kch = (tid & 7) ^ ((krow >> 1) & 7);
    const int vrow = (tid >> 2) & 63, vcol = (tid >> 8) * 32 + (tid & 3) * 8;
    const unsigned ldsw = (unsigned)wid * 1024u;
    const int q4 = (lane & 15) >> 2, p4 = lane & 3, gsel = (lane >> 4) & 1;
    const unsigned vrd = (unsigned)((4 * hh + q4) * 64 + gsel * 32 + p4 * 8);
    unsigned o0r[32];
#pragma unroll
    for (int i = 0; i < 32; ++i) o0r[i] = 0u;
#pragma unroll 1
    for (int comp = 0; comp < 2; ++comp) {
        bf16x8 qf[4];
        const char* Pb = (const char*)(P + rowbase * NP + h * 128);
        { const unsigned qo = (unsigned)(((q0 + r32) * NP + C_DQ + comp * 64 + hh * 8) * 2);
#pragma unroll
          for (int ks = 0; ks < 4; ++ks) qf[ks] = *(const bf16x8*)(Pb + qo + 32 * ks); }
        const unsigned kgo = (unsigned)((krow * NP + C_DK + comp * 64 + kch * 8) * 2), vgo = (unsigned)((vrow * NP + C_DV + vcol) * 2);
        f32x16 o[4];
#pragma unroll
        for (int e = 0; e < 4; ++e)
#pragma unroll
            for (int r = 0; r < 16; ++r) o[e][r] = 0.f;
        float l = 0.f;
#define ATT_GLDS(sb, vo, dst) do { unsigned keep_; asm volatile("s_mov_b32 %0, m0\n\ts_mov_b32 m0, %3\n\ts_nop 0\n\tglobal_load_lds_dwordx4 %1, %2\n\ts_mov_b32 m0, %0" \
            : "=&s"(keep_) : "v"(vo), "s"(sb), "s"(dst) : "memory"); } while (0)
#define ATT_STAGE(buf, tt) do { const char* Pt = Pb + (size_t)(tt) * 64 * NP * 2; \
            ATT_GLDS(Pt, kgo, (unsigned)__builtin_amdgcn_readfirstlane((int)(ldsb + A_K + (buf) * 8192 + ldsw))); \
            ATT_GLDS(Pt, vgo, (unsigned)__builtin_amdgcn_readfirstlane((int)(ldsb + A_V + (buf) * 16384 + ldsw))); \
            ATT_GLDS(Pt, vgo + 128u, (unsigned)__builtin_amdgcn_readfirstlane((int)(ldsb + A_V + (buf) * 16384 + 8192 + ldsw))); } while (0)
        const unsigned ldsb = (unsigned)(size_t)lds;
        unsigned kro[4];
#pragma unroll
        for (int ks = 0; ks < 4; ++ks) kro[ks] = (unsigned)(r32 * 128 + (((2 * ks + hh) ^ ((r32 >> 1) & 7)) << 4));
        ATT_STAGE(0, 0);
        if (ntile > 1) ATT_STAGE(1, 1);
        __builtin_amdgcn_s_waitcnt(0x0F70);
        VM_WAIT(); __syncthreads();
        int cur = 0, nx2 = 2;
        for (int t = 0; t < ntile; ++t) {
            const bool more = (t + 2 < ntile);
            if (more) ATT_STAGE(nx2, t + 2);
            if (t < my_nt) {
                const LAS unsigned char* Kb = lds + A_K + cur * 8192; const LAS unsigned char* Vb = lds + A_V + cur * 16384 + vrd;
#define ATT_KF(j) (*(const LAS bf16x8*)(Kb + kro[(j) & 3] + ((j) >> 2) * 4096))
#define ATT_VOFF(j) ((((j) >> 1) & 3) * 4096 + (2 * ((j) >> 3) + ((j) & 1)) * 1024)
                bf16x8 kr[3]; kr[0] = ATT_KF(0); kr[1] = ATT_KF(1);
                const f32x16 z16 = {0.f, 0.f, 0.f, 0.f, 0.f, 0.f, 0.f, 0.f, 0.f, 0.f, 0.f, 0.f, 0.f, 0.f, 0.f, 0.f};
                f32x16 s0, s1;
#pragma unroll
                for (int j = 0; j < 8; ++j) { if (j + 2 < 8) kr[(j + 2) % 3] = ATT_KF(j + 2);
                    if (j < 4) s0 = MFMA32(kr[j % 3], qf[j & 3], j == 0 ? z16 : s0); else s1 = MFMA32(kr[j % 3], qf[j & 3], j == 4 ? z16 : s1); }
                s16x4 vl[3], vh[3];
                vl[0] = vtr(Vb + ATT_VOFF(0)); vh[0] = vtr(Vb + ATT_VOFF(0) + 512); vl[1] = vtr(Vb + ATT_VOFF(1)); vh[1] = vtr(Vb + ATT_VOFF(1) + 512);
                bf16x8 pa[4];
                { u32x4 w;
#pragma unroll
                  for (int r = 0; r < 16; ++r) { s0[r] = __builtin_amdgcn_exp2f(s0[r]); l += s0[r]; }
                  w.x = pk2(s0[0], s0[1]); w.y = pk2(s0[2], s0[3]); w.z = pk2(s0[4], s0[5]); w.w = pk2(s0[6], s0[7]); pa[0] = __builtin_bit_cast(bf16x8, w);
                  w.x = pk2(s0[8], s0[9]); w.y = pk2(s0[10], s0[11]); w.z = pk2(s0[12], s0[13]); w.w = pk2(s0[14], s0[15]); pa[1] = __builtin_bit_cast(bf16x8, w);
#pragma unroll
                  for (int r = 0; r < 16; ++r) { s1[r] = __builtin_amdgcn_exp2f(s1[r]); l += s1[r]; }
                  w.x = pk2(s1[0], s1[1]); w.y = pk2(s1[2], s1[3]); w.z = pk2(s1[4], s1[5]); w.w = pk2(s1[6], s1[7]); pa[2] = __builtin_bit_cast(bf16x8, w);
                  w.x = pk2(s1[8], s1[9]); w.y = pk2(s1[10], s1[11]); w.z = pk2(s1[12], s1[13]); w.w = pk2(s1[14], s1[15]); pa[3] = __builtin_bit_cast(bf16x8, w); }
#pragma unroll
                for (int j = 0; j < 16; ++j) { if (j + 2 < 16) { vl[(j + 2) % 3] = vtr(Vb + ATT_VOFF(j + 2)); vh[(j + 2) % 3] = vtr(Vb + ATT_VOFF(j + 2) + 512); }
                    const s16x4 lo = vl[j % 3], hi = vh[j % 3]; const bf16x8 vf = (bf16x8){lo[0], lo[1], lo[2], lo[3], hi[0], hi[1], hi[2], hi[3]};
                    o[(j >> 1) & 3] = MFMA32(pa[2 * (j >> 3) + (j & 1)], vf, o[(j >> 1) & 3]); }
#undef ATT_KF
#undef ATT_VOFF
            }
            if (more) asm volatile("s_waitcnt vmcnt(3)" ::: "memory"); else VM_WAIT();
            __syncthreads();
            cur = (cur == 2) ? 0 : cur + 1; nx2 = (nx2 == 2) ? 0 : nx2 + 1;
        }
#undef ATT_GLDS
#undef ATT_STAGE
        l = sum_halves(l);
        LAS float* ls = (LAS float*)(lds + A_LS) + wid * 64 + comp * 32;
        if (hh == 0) ls[r32] = l;
        LDS_WAIT(); asm volatile("" ::: "memory");
        float inv[16];
#pragma unroll
        for (int r = 0; r < 16; ++r) inv[r] = 1.0f / ls[crow(r, hh)];
        if (comp == 0) {
#pragma unroll
            for (int e = 0; e < 4; ++e)
#pragma unroll
                for (int i = 0; i < 8; ++i) o0r[e * 8 + i] = pk2(o[e][2 * i] * inv[2 * i], o[e][2 * i + 1] * inv[2 * i + 1]);
        } else {
            float ss[16];
#pragma unroll
            for (int r = 0; r < 16; ++r) ss[r] = 0.f;
#pragma unroll
            for (int e = 0; e < 4; ++e)
#pragma unroll
                for (int i = 0; i < 8; ++i) { const unsigned w = o0r[e * 8 + i];
                    const float v0 = bflo(w) - lam * o[e][2 * i] * inv[2 * i], v1 = bfhi(w) - lam * o[e][2 * i + 1] * inv[2 * i + 1];
                    o[e][2 * i] = v0; o[e][2 * i + 1] = v1; ss[2 * i] += v0 * v0; ss[2 * i + 1] += v1 * v1; }
#pragma unroll
            for (int r = 0; r < 16; ++r) { float s = ss[r]; s += sx<1>(s); s += sx<2>(s); s += sx<4>(s); s += sx<8>(s); s += sx<16>(s);
                ss[r] = rsqrtf(s * (1.0f / 128.0f) + EPS) * oscale; }
            LAS unsigned char* stg = lds + A_O0 + wid * 8192;
            const int lane_e = olane(), r32e = lane_e & 31;
            LDS_WAIT(); asm volatile("" ::: "memory");
#pragma unroll
            for (int e = 0; e < 4; ++e) { const float gsub = subg[32 * e + r32e] * FP8_ACT_SCALE;
#pragma unroll
                for (int r = 0; r < 16; r += 2) { const float y0 = ((DBG_GROUPS & 2) != 0) ? o[e][r] * ss[r] * gsub : 0.f, y1 = ((DBG_GROUPS & 2) != 0) ? o[e][r + 1] * ss[r + 1] * gsub : 0.f;
                    const int w = __builtin_amdgcn_cvt_pk_fp8_f32(y0, y1, 0, false);
                    *(LAS unsigned char*)(stg + crow(r, hh) * 128 + 32 * e + r32) = (unsigned char)(w & 0xff); *(LAS unsigned char*)(stg + crow(r + 1, hh) * 128 + 32 * e + r32) = (unsigned char)((w >> 8) & 0xff); } }
            LDS_WAIT(); asm volatile("" ::: "memory");
            { unsigned ob = (unsigned)((q0 + (lane_e >> 3)) * DM + 256 + (lane_e & 7) * 16); unsigned char* Mb = MIX + rowbase * DM + h * 128;
#pragma unroll
              for (int i = 0; i < 4; ++i) { const u32x4 w = *(const LAS u32x4*)(stg + ((lane_e >> 3) + 8 * i) * 128 + (lane_e & 7) * 16); *(u32x4*)(Mb + ob + i * 8 * DM) = w; } }
            LDS_WAIT(); asm volatile("" ::: "memory");
        }
    }
    __syncthreads();
}
}

struct Args { const float* in[25]; float* out; unsigned char* ws; int ph_lo, ph_hi; };
static_assert(sizeof(Args) == 27 * 8 + 8, "Args has no padding");
constexpr int NPHASE = 1 + 9 * DEPTH;

__global__ void __launch_bounds__(NWAVES * 64, 2) fwd(Args args) {
    extern __shared__ __attribute__((aligned(16))) unsigned char lds_raw[];
    LAS unsigned char* lds = (LAS unsigned char*)lds_raw;
    const int wave = __builtin_amdgcn_readfirstlane((int)threadIdx.x >> 6); const int g_wave = wave; const int tid0 = otid();
    const int G = gridDim.x; const int bx = blockIdx.x; const int vcu = (G % 8 == 0) ? (bx % 8) * (G / 8) + bx / 8 : bx;
    const int gw = vcu * NWAVES + wave, NGW = G * NWAVES;
    __builtin_assume(gw >= 0 && gw < 4096 && vcu >= 0 && vcu < 512 && G > 0 && G <= 512);
    unsigned char* ws = args.ws;
    unsigned* ctl = (unsigned*)(ws + WS_CTL);
    for (int u = tid0; u < (LDS_BYTES - LDSCTL_OFF) / 4; u += NWAVES * 64) ((LAS unsigned*)(lds + LDSCTL_OFF))[u] = 0u;
    __syncthreads();
    XcdBarrier bar; bar.bar = ctl + CW_BAR; bar.x = 0; bar.st = nullptr;
    if (MK_N_LAUNCHES == 1) bar = xcd_barrier_post(ctl + CW_BAR, (volatile LAS unsigned*)(lds + MISC_OFF) + 8, tid0 == 0);
    const int lo = args.ph_lo, hi = args.ph_hi;
#ifndef PHMASK
#define PHMASK 0x3ff
#endif
#define IN(k) (lo <= (k) && (k) < hi)
#define PHON(j) ((PHMASK >> (j)) & 1)
#define SEAM(k) do { if (IN(k) && IN((k) + 1)) { xcd_barrier(bar, otid() == 0); if (RPT_PHASE == 90) { xcd_barrier(bar, otid() == 0); xcd_barrier(bar, otid() == 0); } } } while (0)
    if (tid0 == 0) {
#pragma unroll
        for (int k = 0; k < 25; ++k) ((LAS unsigned long long*)(lds + PTR_OFF))[k] = (unsigned long long)args.in[k];
        ((LAS unsigned long long*)(lds + PTR_OFF))[25] = (unsigned long long)args.out;
    }
    __syncthreads();
#define WSP(Tp, off) ((Tp*)(wsl + (off)))
#define WSL() unsigned char* wsl = ws; asm volatile("" : "+s"(wsl))

    if (PHON(0) && IN(0)) {
        const int tid = otid(), lane = tid & 63; WSL();
        const float* c_in = INF(1); const int* pos_in = (const int*)INF(2); const float* w_mod = INF(3); const float* b_mod = INF(4); const float* w_in = INF(7);
        const float* diff_q_g = INF(9); const float* diff_k_g = INF(10); const float* lam_q1 = INF(11); const float* lam_k1 = INF(12); const float* lam_q2 = INF(13); const float* lam_k2 = INF(14);
        const float* gla_w_a2 = INF(16); const float* w_out = INF(19); const float* w_gate = INF(22); const float* w_up = INF(23); const float* w_down = INF(24);
        float* mod = WSP(float, WS_MOD); float* scal = WSP(float, WS_SCAL); f32x2* csr = WSP(f32x2, WS_CSR); f32x2* csd = WSP(f32x2, WS_CSD);
        LAS unsigned char* scr = lds + wave * 8704;
        LAS float* sact = (LAS float*)(lds + 69632);
        for (int i = tid; i < 8 * 1024; i += NWAVES * 64) sact[i] = silu_f(c_in[i]);
        __syncthreads();
        { unsigned char* Winq = WSP(unsigned char, WS_WIN); float* swin = WSP(float, WS_SWIN);
          constexpr int U_WIN = 2 * 53, U_LA = 4, U_W1 = 2 * 32 * 16;
#pragma unroll 1
          for (int bu = vcu; bu < U_WIN; bu += G) { const int l = bu / 53, st = bu % 53; quant_strip<false>(lds, w_in + (size_t)l * 1024 * IN_W, IN_W, 64 * st, Winq + (size_t)l * NP * 1024, swin + l * NP, 1, nullptr, wave, lane); }
#pragma unroll 1
          for (int bu = vcu; bu < U_W1; bu += G) { const int le = bu >> 4, st = bu & 15;
              quant_strip<false>(lds, (st < 8 ? w_gate : w_up) + (size_t)le * 1024 * 512, 512, 64 * (st & 7), WSP(unsigned char, WS_W1) + (size_t)le * 1024 * 1024, WSP(float, WS_SW1) + (size_t)le * 1024, st < 8 ? 2 : 3, nullptr, wave, lane); }
#pragma unroll 1
          for (int bu = G - 1 - vcu; bu < U_LA; bu += G) { const int l = bu >> 1, st = bu & 1; quant_strip<true>(lds, w_in + (size_t)l * 1024 * IN_W, IN_W, 64 * st, Winq + (size_t)l * NP * 1024, swin + l * NP, 1, gla_w_a2 + (size_t)l * 16 * 128, wave, lane); }
        }
        constexpr int I_MOD = 2 * 384, I_TABR = 1024, I_TABD = 1024, I_ZERO = 256, I_SC = 2;
        constexpr int I_WOUT = 16 * 16, I_DN = 8 * 16, I_LAYER = I_WOUT + 32 * I_DN;
        constexpr int I_PRE = I_MOD + I_TABR + I_TABD + I_ZERO + I_SC, NITEMS = I_PRE + 2 * I_LAYER;
        _Pragma("unroll 1") for (int rep_ = 0; rep_ < 1 + (RPT_PHASE == 100 ? RPT_N : 0); ++rep_)
        for (int it = gw; it < NITEMS; it += NGW) {
            int r = it;
            if (r < I_MOD) {
                const int l = r / 384, col = (r % 384) * 16 + (lane & 15), ks = lane >> 4;
                float acc[8] = {0.f, 0.f, 0.f, 0.f, 0.f, 0.f, 0.f, 0.f};
                const float* wp = w_mod + (size_t)l * 1024 * 6144 + col;
#pragma unroll 16
                for (int k = ks; k < 1024; k += 4) { const float w = wp[(size_t)k * 6144];
#pragma unroll
                    for (int b = 0; b < 8; ++b) acc[b] += sact[b * 1024 + k] * w; }
#pragma unroll
                for (int b = 0; b < 8; ++b) { float a = acc[b]; a += sx<16>(a); a = sum_halves(a); if (ks == 0) mod[((size_t)l * 8 + b) * 6144 + col] = a + b_mod[l * 6144 + col]; }
                continue; }
            r -= I_MOD;
            if (r < I_TABR) {
                const int i = lane & 31; const float inv_freq = exp2f(-((float)i * (1.0f / 32.0f)) * 13.287712379549449f);
                for (int s = 0; s < 32; ++s) { const int t = r * 64 + 2 * s + (lane >> 5); const float ang = (float)pos_in[t] * inv_freq; float sn, cs; sincosf(ang, &sn, &cs); csr[(size_t)t * 32 + i] = (f32x2){cs, sn}; }
                continue; }
            r -= I_TABR;
            if (r < I_TABD) {
                const int i = lane & 7; const float inv_freq = exp2f(-((float)i * (1.0f / 8.0f)) * 18.931568569324174f);
                for (int s = 0; s < 8; ++s) { const int t = r * 64 + 8 * s + (lane >> 3); const float ang = (float)pos_in[t] * inv_freq; float sn, cs; sincosf(ang, &sn, &cs); csd[(size_t)t * 8 + i] = (f32x2){cs, sn}; }
                continue; }
            r -= I_TABD;
            if (r < I_ZERO) {
                const int l = r >> 7, j = r & 127; u32x4* p = (u32x4*)(WSP(unsigned char, WS_WIN) + ((size_t)l * NP + C_PAD + j) * 1024);
                p[lane] = (u32x4){0u, 0u, 0u, 0u}; if (lane == 0) WSP(float, WS_SWIN)[l * NP + C_PAD + j] = 1.0f;
                continue; }
            r -= I_ZERO;
            if (r < I_SC) {
                const int l = r; const float s1 = wave_sum(lam_q1[l * 64 + lane] * lam_k1[l * 64 + lane]), s2 = wave_sum(lam_q2[l * 64 + lane] * lam_k2[l * 64 + lane]);
                const float mq = wave_max(fabsf(diff_q_g[l * 64 + lane])), mk = wave_max(fabsf(diff_k_g[l * 64 + lane]));
                const float lam_init = 0.8f - 0.6f * expf(-0.3f * (float)l);
                if (lane == 0) { scal[l * 4 + 0] = expf(s1) - expf(s2) + lam_init; scal[l * 4 + 1] = -(8.0f * mq * mk * LOG2E + 0.5f); scal[l * 4 + 2] = 1.0f - lam_init; }
                continue; }
            r -= I_SC;
            const int l = r / I_LAYER; r -= l * I_LAYER;
            if (r < I_WOUT) { tr_item8(w_out + (size_t)l * 1024 * 1024, 1024, 1024, WSP(unsigned char, WS_WOUT) + (size_t)l * 1024 * 1024, 1024, scr, r, lane); continue; } r -= I_WOUT;
            const int e = r / I_DN; r -= e * I_DN; const size_t le = (size_t)l * 32 + e;
            tr_item8(w_down + le * 512 * 1024, 512, 1024, WSP(unsigned char, WS_W2) + le * 1024 * 512, 512, scr, r, lane);
        }
        __syncthreads();
    }
    SEAM(0);

    for (int l = 0; l < DEPTH; ++l) {
        const int pb = 1 + 9 * l;
#define MODL (WSP(const float, WS_MOD) + (size_t)l * 8 * 6144)
        if (PHON(1) && IN(pb + 0)) {
            const int tid = otid(), lane = tid & 63; (void)tid; (void)lane; WSL();
            const float* xf = (l == 0) ? INF(0) : nullptr; const bf16* XB = WSP(const bf16, WS_XB); const float* modl = MODL; const float* norm1_g = INF(5); unsigned char* ACTq = WSP(unsigned char, WS_ACT); float* sa1 = WSP(float, WS_SA1);
            const float* g1 = norm1_g + l * 1024;
            _Pragma("unroll 1") for (int rep_ = 0; rep_ < 1 + (RPT_PHASE == 1 ? RPT_N : 0); ++rep_)
            for (int m0 = gw; m0 < T; m0 += 4 * NGW) {
                f32x4 v[4][4];
#pragma unroll
                for (int q = 0; q < 4; ++q) { const int mq = m0 + q * NGW, m = mq < T ? mq : T - 1;
#pragma unroll
                    for (int j = 0; j < 4; ++j) v[q][j] = ldx4(xf, XB, (size_t)m * DM + 4 * lane + 256 * j); }
#pragma unroll
                for (int q = 0; q < 4; ++q) { const int m = m0 + q * NGW; if (m < T) {
                    const int b = m >> 13; const float* mb = modl + (size_t)b * 6144; float s = 0.f;
#pragma unroll
                    for (int j = 0; j < 4; ++j) s += (v[q][j][0] * v[q][j][0] + v[q][j][1] * v[q][j][1]) + (v[q][j][2] * v[q][j][2] + v[q][j][3] * v[q][j][3]);
                    const float rstd = rsqrtf(wave_sum(s) * (1.0f / 1024.0f) + EPS);
                    f32x4 y[4]; float am = 0.f;
#pragma unroll
                    for (int j = 0; j < 4; ++j) { const int k = 4 * lane + 256 * j; const f32x4 gg = *(const f32x4*)(g1 + k), sh = *(const f32x4*)(mb + k), sc = *(const f32x4*)(mb + 1024 + k);
                        y[j] = v[q][j] * rstd * gg * (sc + 1.0f) + sh; am = fmaxf(am, fmaxf(fmaxf(fabsf(y[j][0]), fabsf(y[j][1])), fmaxf(fabsf(y[j][2]), fabsf(y[j][3])))); }
                    am = wave_max(am); const float inv = am > 0.f ? 127.0f / am : 0.f;
                    if (lane == 0) sa1[m] = am > 0.f ? am * (1.0f / 127.0f) : 1.0f;
                    unsigned* o4 = (unsigned*)(ACTq + (size_t)m * 1024) + lane;
#pragma unroll
                    for (int j = 0; j < 4; ++j) { unsigned w = 0u;
#pragma unroll
                        for (int e = 0; e < 4; ++e) w |= ((unsigned)(int)__builtin_rintf(y[j][e] * inv) & 0xffu) << (8 * e);
                        o4[64 * j] = w; } } }
            }
        }
        SEAM(pb + 0);
        if (PHON(2) && IN(pb + 1)) {
            const int tid = otid(), lane = tid & 63; (void)tid; (void)lane; WSL();
            bf16* ACT = WSP(bf16, WS_ACT); bf16* P = WSP(bf16, WS_P);
            pg8::Gemm g{ACT, (const bf16*)(WSP(unsigned char, WS_WIN) + (size_t)l * NP * 1024), 512, 512, 512}; pg8::StaticOrder<T / 256, NP / 256> S; S.init(G, bx);
            pg8::EpiInproj E{P, NP, WSP(const float, WS_SA1), WSP(const float, WS_SWIN) + l * NP, INF(9) + l * 64, INF(10) + l * 64, WSP(const f32x2, WS_CSD)};
            _Pragma("unroll 1") for (int rep_ = 0; rep_ < 1 + (RPT_PHASE == 2 ? RPT_N : 0); ++rep_)
            pg8::gemm_phase<pg8::EpiInproj, pg8::StaticOrder<T / 256, NP / 256>, 0, 1>(lds, g, S, E, g_wave);
        }
        SEAM(pb + 1);
        if (PHON(3) && IN(pb + 2)) {
            const int tid = otid(), lane = tid & 63; (void)tid; (void)lane; WSL();
            const float* diff_q_g = INF(9); const float* diff_k_g = INF(10); const float* gla_b_a = INF(17); bf16* P = WSP(bf16, WS_P); unsigned char* ACT = WSP(unsigned char, WS_ACT); f32x2* csr = WSP(f32x2, WS_CSR);
            float* Eret = WSP(float, WS_EST); float* Egla = WSP(float, WS_EGL); float* Asr = WSP(float, WS_ASR); float* Asg = WSP(float, WS_ASG);
            _Pragma("unroll 1") for (int rep_ = 0; rep_ < 1 + (RPT_PHASE == 31 ? RPT_N : 0); ++rep_)
            for (int u = vcu; u < 1024; u += G) {
                const int r = u & 511, bh = r >> 4, seg = r & 15;
                if (u < 512) lin::unit<64, true, false>(lds, P, ACT, csr, bh >> 2, bh & 3, seg, nullptr, nullptr, Eret, Asr, g_wave);
                else lin::unit<32, false, false>(lds, P, ACT, csr, bh >> 2, bh & 3, seg, gla_b_a + l * 128, nullptr, Egla, Asg, g_wave);
            }
        }
        SEAM(pb + 2);
        if (PHON(4) && IN(pb + 3)) {
            const int tid = otid(), lane = tid & 63; (void)tid; (void)lane; WSL();
            const float* scal = WSP(const float, WS_SCAL); const float* diff_sub_g = INF(15); const float* ret_norm_g = INF(8); const float* gla_norm_g = INF(18); const float* gla_b_a = INF(17); bf16* P = WSP(bf16, WS_P); unsigned char* ACT = WSP(unsigned char, WS_ACT); f32x2* csr = WSP(f32x2, WS_CSR);
            float* Eret = WSP(float, WS_EST); float* Egla = WSP(float, WS_EGL); float* Asr = WSP(float, WS_ASR); float* Asg = WSP(float, WS_ASG);
            const float lam = scal[l * 4 + 0], negM = scal[l * 4 + 1], osc = scal[l * 4 + 2];
#ifndef NO_ATT
            _Pragma("unroll 1") for (int rep_ = 0; rep_ < 1 + (RPT_PHASE == 41 ? RPT_N : 0); ++rep_)
            for (int pu = vcu; pu < 512; pu += G) {
                const int bh = pu >> 4, jp = pu & 15;
                att::unit(lds, P, ACT, bh >> 2, bh & 3, jp, lam, negM, diff_sub_g + l * 128, osc, g_wave);
                att::unit(lds, P, ACT, bh >> 2, bh & 3, 31 - jp, lam, negM, diff_sub_g + l * 128, osc, g_wave);
            }
#endif
#ifndef NO_LIN2
            _Pragma("unroll 1") for (int rep_ = 0; rep_ < 1 + ((RPT_PHASE == 42 || RPT_PHASE == 43 || RPT_PHASE == 44) ? RPT_N : 0); ++rep_)
            for (int u = vcu + ((RPT_PHASE == 44 && rep_ > 0) ? 512 : 0); u < ((RPT_PHASE == 43 && rep_ > 0) ? 512 : 1024); u += G) {
                const int r = u & 511, bh = r >> 4, seg = ((r & 15) + 8 * (r >> 8) + (u < 512 ? 0 : 4)) & 15;
                if (u < 512) lin::unit<64, true, true>(lds, P, ACT, csr, bh >> 2, bh & 3, seg, nullptr, ret_norm_g + l * 64, Eret, Asr, g_wave);
                else lin::unit<32, false, true>(lds, P, ACT, csr, bh >> 2, bh & 3, seg, gla_b_a + l * 128, gla_norm_g + l * 64, Egla, Asg, g_wave);
            }
#endif
        }
        SEAM(pb + 3);
        if (PHON(5) && IN(pb + 4)) {
            const int tid = otid(), lane = tid & 63; (void)tid; (void)lane; WSL();
            const float* modl = MODL;
            pg8::Gemm g{WSP(const bf16, WS_ACT), (const bf16*)(WSP(unsigned char, WS_WOUT) + (size_t)l * 1024 * 1024), 512, 512, 512}; pg8::StaticOrder<T / 256, 4> S; S.init(G, bx);
            pg8::EpiResid E{(l == 0) ? INF(0) : nullptr, WSP(bf16, WS_XB), modl + 2048};
            _Pragma("unroll 1") for (int rep_ = 0; rep_ < 1 + ((RPT_PHASE == 5 && l == 0) ? RPT_N : 0); ++rep_)
            pg8::gemm_phase<pg8::EpiResid, pg8::StaticOrder<T / 256, 4>, 0, 2>(lds, g, S, E, g_wave);
        }
        SEAM(pb + 4);
        if (PHON(6) && IN(pb + 5)) {
            const int tid = otid(), lane = tid & 63; (void)tid; (void)lane; WSL();
            const float* modl = MODL; const float* router_w = INF(20); const float* router_b = INF(21); const float* norm2_g = INF(6); const bf16* XB = WSP(const bf16, WS_XB); bf16* ACT = WSP(bf16, WS_ACT); int* tokinfo = WSP(int, WS_ROUTE); int* tokS = WSP(int, WS_TOKS); unsigned char* h2q = WSP(unsigned char, WS_H2Q); float* sa2 = WSP(float, WS_SA2);
            constexpr int WR_PITCH = 2064, LG_OFF = 32 * WR_PITCH;
            _Pragma("unroll 1") for (int rep_ = 0; rep_ < 1 + (RPT_PHASE == 6 ? RPT_N : 0); ++rep_) {
            { f32x4 rw[2][8];
#pragma unroll
              for (int q = 0; q < 2; ++q)
#pragma unroll
                  for (int j = 0; j < 8; ++j) rw[q][j] = *(const f32x4*)(router_w + (size_t)(tid + 512 * q) * 32 + 4 * j);
#pragma unroll
              for (int q = 0; q < 2; ++q)
#pragma unroll
                  for (int j = 0; j < 8; ++j)
#pragma unroll
                      for (int e = 0; e < 4; ++e) *(LAS unsigned short*)(lds + (4 * j + e) * WR_PITCH + (tid + 512 * q) * 2) = (unsigned short)(pk2(rw[q][j][e], 0.f) & 0xffffu); }
            LAS unsigned* lcnt = (LAS unsigned*)(lds + 83968);
            if (tid < 64) lcnt[tid] = 0u;
            { int Gl = G; asm volatile("" : "+s"(Gl));
#pragma unroll 1
              for (int i = bx * NWAVES * 64 + tid; i < TPAD; i += Gl * NWAVES * 64) tokS[i] = -1; }
            __syncthreads();
            const float* g2 = norm2_g + l * 1024;
            LAS float* lg = (LAS float*)(lds + LG_OFF + wave * 2112);
            for (int gi = gw; gi < T / 16; gi += NGW) {
                for (int r4 = 0; r4 < 16; r4 += 4) {
                    f32x4 v[4][4];
#pragma unroll
                    for (int q = 0; q < 4; ++q) {
#pragma unroll
                        for (int j = 0; j < 4; ++j) v[q][j] = ldx4(nullptr, XB, (size_t)(gi * 16 + r4 + q) * DM + 4 * lane + 256 * j); }
#pragma unroll
                    for (int q = 0; q < 4; ++q) { const int m = gi * 16 + r4 + q; const int b = m >> 13; const float* mb = modl + (size_t)b * 6144 + 3072; float s = 0.f;
#pragma unroll
                        for (int j = 0; j < 4; ++j) s += (v[q][j][0] * v[q][j][0] + v[q][j][1] * v[q][j][1]) + (v[q][j][2] * v[q][j][2] + v[q][j][3] * v[q][j][3]);
                        const float rstd = rsqrtf(wave_sum(s) * (1.0f / 1024.0f) + EPS);
                        u32x2* o8 = (u32x2*)(ACT + (size_t)m * DM) + lane; f32x4 y[4]; float am = 0.f;
#pragma unroll
                        for (int j = 0; j < 4; ++j) { const int k = 4 * lane + 256 * j; const f32x4 gg = *(const f32x4*)(g2 + k), sh = *(const f32x4*)(mb + k), sc = *(const f32x4*)(mb + 1024 + k);
                            y[j] = v[q][j] * rstd * gg * (sc + 1.0f) + sh; u32x2 w; w.x = pk2(y[j][0], y[j][1]); w.y = pk2(y[j][2], y[j][3]); o8[64 * j] = w;
                            am = fmaxf(am, fmaxf(fmaxf(fabsf(y[j][0]), fabsf(y[j][1])), fmaxf(fabsf(y[j][2]), fabsf(y[j][3])))); }
                        am = wave_max(am); const float inv = am > 0.f ? 127.0f / am : 0.f;
                        if (lane == 0) sa2[m] = am > 0.f ? am * (1.0f / 127.0f) : 1.0f;
                        unsigned* o4 = (unsigned*)(h2q + (size_t)m * 1024) + lane;
#pragma unroll
                        for (int j = 0; j < 4; ++j) { unsigned w = 0u;
#pragma unroll
                            for (int e = 0; e < 4; ++e) w |= ((unsigned)(int)__builtin_rintf(y[j][e] * inv) & 0xffu) << (8 * e);
                            o4[64 * j] = w; } }
                }
                VM_WAIT();
                f32x4 a0 = (f32x4){0.f, 0.f, 0.f, 0.f}, a1 = a0;
                const bf16* ap = ACT + (size_t)(gi * 16 + (lane & 15)) * DM + 8 * (lane >> 4);
#pragma unroll 16
                for (int ks = 0; ks < 32; ++ks) { const bf16x8 a = *(const bf16x8*)(ap + 32 * ks);
                    const bf16x8 b0 = *(const LAS bf16x8*)(lds + (lane & 15) * WR_PITCH + (32 * ks + 8 * (lane >> 4)) * 2), b1 = *(const LAS bf16x8*)(lds + (16 + (lane & 15)) * WR_PITCH + (32 * ks + 8 * (lane >> 4)) * 2);
                    a0 = MFMA16(a, b0, a0); a1 = MFMA16(a, b1, a1); }
#pragma unroll
                for (int r = 0; r < 4; ++r) { lg[(4 * (lane >> 4) + r) * 33 + (lane & 15)] = a0[r]; lg[(4 * (lane >> 4) + r) * 33 + 16 + (lane & 15)] = a1[r]; }
                LDS_WAIT(); asm volatile("" ::: "memory");
                if (lane < 16) {
                    const int m = gi * 16 + lane; float best = -3.0e38f; int bcls = 0; float bwa = 0.f, bwb = 0.f;
#pragma unroll
                    for (int g = 0; g < 8; ++g) {
                        float s[4], a[4];
#pragma unroll
                        for (int i = 0; i < 4; ++i) { s[i] = 1.0f / (1.0f + __expf(-lg[lane * 33 + 4 * g + i])); a[i] = s[i] + router_b[4 * g + i]; }
                        int i1 = 0; float v1 = a[0];
                        if (a[1] > v1) { v1 = a[1]; i1 = 1; } if (a[2] > v1) { v1 = a[2]; i1 = 2; } if (a[3] > v1) { v1 = a[3]; i1 = 3; }
                        int i2 = -1; float v2 = -3.0e38f;
                        if (i1 != 0 && a[0] > v2) { v2 = a[0]; i2 = 0; } if (i1 != 1 && a[1] > v2) { v2 = a[1]; i2 = 1; } if (i1 != 2 && a[2] > v2) { v2 = a[2]; i2 = 2; } if (i1 != 3 && a[3] > v2) { v2 = a[3]; i2 = 3; }
                        const float gsum = v1 + v2;
                        const int ea = i1 < i2 ? i1 : i2, eb = i1 < i2 ? i2 : i1;
                        const float sa = ea == 0 ? s[0] : (ea == 1 ? s[1] : s[2]), sb = eb == 1 ? s[1] : (eb == 2 ? s[2] : s[3]);
                        const int pidx = (ea * (7 - ea)) / 2 + (eb - ea - 1);
                        if (gsum > best) { best = gsum; bcls = g * 6 + pidx; const float den = 1.0f / (sa + sb); bwa = sa * den; bwb = sb * den; }
                    }
                    const unsigned rank = __hip_atomic_fetch_add(lcnt + bcls, 1u, __ATOMIC_RELAXED, __HIP_MEMORY_SCOPE_WORKGROUP);
                    *(u32x4*)(tokinfo + (size_t)m * 4) = (u32x4){(unsigned)bcls, rank, __float_as_uint(bwa), __float_as_uint(bwb)};
                }
                LDS_WAIT(); asm volatile("" ::: "memory");
            }
            __syncthreads();
            if (tid < 64) WSP(int, WS_CNTB)[((size_t)l * 512 + vcu) * 64 + tid] = tid < NCLS ? (int)lcnt[tid] : 0;
            __syncthreads();
            }
        }
        SEAM(pb + 5);
        if (PHON(7) && IN(pb + 6)) {
            const int tid = otid(), lane = tid & 63; (void)tid; (void)lane; WSL();
            const unsigned char* h2q = WSP(const unsigned char, WS_H2Q); unsigned char* H2S = WSP(unsigned char, WS_H2S); const float* sa2 = WSP(const float, WS_SA2); float* saS = WSP(float, WS_SAS); int* tokinfo = WSP(int, WS_ROUTE); int* tokS = WSP(int, WS_TOKS); float* gaS = WSP(float, WS_GAS); float* gbS = WSP(float, WS_GBS); int* tinfo = WSP(int, WS_TINFO);
            LAS int* cst = (LAS int*)lds;
            LAS int* base = (LAS int*)(lds + 1024);
            { const int* cntb = WSP(const int, WS_CNTB) + (size_t)l * 512 * 64;
              for (int i = tid; i < G * NCLS; i += NWAVES * 64) { const int b = i / NCLS, c = i - b * NCLS; base[i] = cntb[b * 64 + c]; }
              __syncthreads();
              if (tid < NCLS) { int run = 0; for (int b = 0; b < G; ++b) { const int n = base[b * NCLS + tid]; base[b * NCLS + tid] = run; run += n; } cst[64 + tid] = run; }
              __syncthreads(); }
            if (tid == 0) { int s = 0, nt = 0;
                for (int c = 0; c < NCLS; ++c) { const int n = cst[64 + c]; cst[c] = s; const int tl = (n + 255) >> 8;
                    if (bx == 0) { const int g = c / 6, p = c % 6; const int a = p < 3 ? 0 : (p < 5 ? 1 : 2); const int bb = p < 3 ? p + 1 : (p < 5 ? p - 1 : 3); const int code = (g * 4 + a) | ((g * 4 + bb) << 8);
                        for (int i = 0; i < tl; ++i) tinfo[1 + nt + i] = code; }
                    nt += tl; s += tl * 256; }
                if (bx == 0) tinfo[0] = nt; }
            __syncthreads();
            _Pragma("unroll 1") for (int rep_ = 0; rep_ < 1 + (RPT_PHASE == 7 ? RPT_N : 0); ++rep_)
            for (int m = gw; m < T; m += NGW) {
                const u32x4 inf = *(const u32x4*)(tokinfo + (size_t)m * 4);
                const int pbk = ((m >> 4) % NGW) >> 3;
                const int slot = cst[inf.x] + base[pbk * NCLS + (int)inf.x] + (int)inf.y;
                const u32x4* src = (const u32x4*)(h2q + (size_t)m * 1024); u32x4* dst = (u32x4*)(H2S + (size_t)slot * 1024);
                dst[lane] = src[lane];
                if (lane == 0) { tokS[slot] = m; gaS[slot] = __uint_as_float(inf.z); gbS[slot] = __uint_as_float(inf.w); saS[slot] = sa2[m]; }
            }
            __syncthreads();
        }
        SEAM(pb + 6);
        if (PHON(8) && IN(pb + 7)) {
            const int tid = otid(), lane = tid & 63; (void)tid; (void)lane; WSL();
            bf16* H2S = WSP(bf16, WS_H2S); unsigned char* U = WSP(unsigned char, WS_U); float* gaS = WSP(float, WS_GAS); float* gbS = WSP(float, WS_GBS); int* tinfo = WSP(int, WS_TINFO);
            pg8::Gemm g{H2S, (const bf16*)(WSP(unsigned char, WS_W1) + (size_t)l * 32 * 1024 * 1024), 512, 512, 512}; pg8::MoeOrder<8, 1> S{tinfo, G, vcu};
            pg8::EpiMoe1 E{U, gaS, gbS, WSP(const float, WS_SAS), WSP(const float, WS_SW1) + (size_t)l * 32 * 1024};
            _Pragma("unroll 1") for (int rep_ = 0; rep_ < 1 + (RPT_PHASE == 8 ? RPT_N : 0); ++rep_)
            pg8::gemm_phase<pg8::EpiMoe1, pg8::MoeOrder<8, 1>, 0, 1>(lds, g, S, E, g_wave);
        }
        SEAM(pb + 7);
        if (PHON(9) && IN(pb + 8)) {
            const int tid = otid(), lane = tid & 63; (void)tid; (void)lane; WSL();
            const float* modl = MODL; int* tokS = WSP(int, WS_TOKS); int* tinfo = WSP(int, WS_TINFO);
            pg8::Gemm g{WSP(const bf16, WS_U), (const bf16*)(WSP(unsigned char, WS_W2) + (size_t)l * 32 * 1024 * 512), 512, 512, 256}; pg8::MoeOrder<4, 2> S{tinfo, G, vcu};
            _Pragma("unroll 1") for (int rep_ = (RPT_PHASE == 9 ? 0 : 1); rep_ < 2; ++rep_) {
            pg8::EpiMoe2 E{WSP(bf16, WS_XB), (l == DEPTH - 1) ? (float*)INF(25) : nullptr, tokS, modl + 5 * 1024, rep_ == 0 ? 1 : 0};
            pg8::gemm_phase<pg8::EpiMoe2, pg8::MoeOrder<4, 2>, 4, 2>(lds, g, S, E, g_wave); }
        }
        SEAM(pb + 8);
    }
#undef IN
#undef SEAM
}

extern "C" void kernel_launch(void* const* d_in, const int* in_sizes, int n_in, void* d_out, int out_size, void* d_ws, size_t ws_size, hipStream_t stream) {
    static int grid = 0;
    if (grid == 0) {
        if (n_in != 25 || in_sizes[0] != T * DM || out_size != T * DM || ws_size < WS_END) { fprintf(stderr, "kernel_launch: unexpected shapes (n_in %d, in0 %d, out %d, ws %zu < %zu)\n", n_in, n_in > 0 ? in_sizes[0] : -1, out_size, ws_size, (size_t)WS_END); grid = -1; return; }
        int dev = 0, cus = 0, per_cu = 0;
        if (hipGetDevice(&dev) != hipSuccess || hipDeviceGetAttribute(&cus, hipDeviceAttributeMultiprocessorCount, dev) != hipSuccess) { grid = -1; return; }
        if (hipFuncSetAttribute((const void*)fwd, hipFuncAttributeMaxDynamicSharedMemorySize, LDS_BYTES) != hipSuccess) { fprintf(stderr, "kernel_launch: hipFuncSetAttribute failed\n"); grid = -1; return; }
        if (hipOccupancyMaxActiveBlocksPerMultiprocessor(&per_cu, (const void*)fwd, NWAVES * 64, LDS_BYTES) != hipSuccess || per_cu < 1) fprintf(stderr, "kernel_launch: occupancy query reports %d\n", per_cu);
        (void)hipGetLastError();
        grid = cus;
    }
    if (grid < 0) return;
    if (hipMemsetAsync((char*)d_ws + WS_CTL, 0, CTL_ZERO_BYTES, stream) != hipSuccess) return;
    Args a{};
    for (int i = 0; i < 25; ++i) a.in[i] = (const float*)d_in[i];
    a.out = (float*)d_out; a.ws = (unsigned char*)d_ws;
#if MK_N_LAUNCHES == 1
    a.ph_lo = 0; a.ph_hi = NPHASE;
    hipLaunchKernelGGL(fwd, dim3(grid), dim3(NWAVES * 64), LDS_BYTES, stream, a);
#else
    for (int p = 0; p < NPHASE; ++p) { a.ph_lo = p; a.ph_hi = p + 1; hipLaunchKernelGGL(fwd, dim3(grid), dim3(NWAVES * 64), LDS_BYTES, stream, a); }
#endif
}
```

```cpp
#include <hip/hip_runtime.h>
#include <cstdio>
#include <cstdint>

#ifndef MK_N_LAUNCHES
#define MK_N_LAUNCHES 1
#endif
#ifndef DBG_GROUPS
#define DBG_GROUPS 7
#endif
#ifndef DBG_MOE
#define DBG_MOE 1
#endif
#ifndef RPT_PHASE
#define RPT_PHASE 0
#endif
#ifndef RPT_N
#define RPT_N 1
#endif

#define LAS __attribute__((address_space(3)))
#define GAS __attribute__((address_space(1)))
typedef unsigned short bf16;
typedef short bf16x8 __attribute__((ext_vector_type(8)));
typedef short s16x4 __attribute__((ext_vector_type(4)));
typedef float f32x4 __attribute__((ext_vector_type(4)));
typedef float f32x16 __attribute__((ext_vector_type(16)));
typedef float f32x2 __attribute__((ext_vector_type(2)));
typedef unsigned u32x4 __attribute__((ext_vector_type(4)));
typedef unsigned u32x2 __attribute__((ext_vector_type(2)));
typedef __bf16 bf16x2_t __attribute__((ext_vector_type(2)));
typedef int i32x4 __attribute__((ext_vector_type(4)));
typedef int i32x8 __attribute__((ext_vector_type(8)));

constexpr int BATCH = 8, SEQ = 8192, DM = 1024, T = BATCH * SEQ, DEPTH = 2;
constexpr int NP = 3584;
constexpr int C_RQ = 0, C_RK = 256, C_RV = 512, C_RG = 768, C_DQ = 1024, C_DK = 1536, C_DV = 2048, C_GQ = 2560, C_GK = 2688, C_GV = 2816, C_LA = 3072, C_GR = 3200, C_PAD = 3456;
constexpr int IN_W = 3344;
constexpr int NCLS = 48, TPAD = T + NCLS * 256, MAXTILES = TPAD / 256;
constexpr float EPS = 1e-6f, LOG2E = 1.4426950408889634f;

constexpr size_t MiB = 1u << 20;
constexpr size_t WS_CTL = 0, CTL_ZERO_BYTES = 1 * MiB;
constexpr size_t WS_MOD = 1 * MiB;
constexpr size_t WS_SCAL = WS_MOD + 400 * 1024;
constexpr size_t WS_CSR = 2 * MiB;
constexpr size_t WS_CSD = 19 * MiB;
constexpr size_t WS_WIN = 24 * MiB;
constexpr size_t WS_WOUT = 38 * MiB;
constexpr size_t WS_W1 = 42 * MiB;
constexpr size_t WS_W2 = 170 * MiB;
constexpr size_t WS_ACT = 234 * MiB;
constexpr size_t WS_P = 362 * MiB;
constexpr size_t WS_H2S = WS_P;
constexpr size_t WS_U = WS_P + 152 * MiB;
constexpr size_t WS_EST = 810 * MiB;
constexpr size_t WS_EGL = WS_EST + 8 * MiB, WS_ASR = WS_EST + 12 * MiB, WS_ASG = WS_ASR + 256 * 1024;
constexpr size_t WS_ROUTE = 824 * MiB;
constexpr size_t WS_TOKS = WS_ROUTE + 1 * MiB, WS_GAS = WS_TOKS + 512 * 1024, WS_GBS = WS_GAS + 512 * 1024, WS_TINFO = WS_GBS + 512 * 1024;
constexpr size_t WS_SA1 = 828 * MiB, WS_SA2 = WS_SA1 + 256 * 1024, WS_SAS = WS_SA2 + 256 * 1024, WS_SWIN = WS_SA1 + 1024 * 1024, WS_SW1 = WS_SWIN + 256 * 1024;
constexpr size_t WS_H2Q = 830 * MiB; constexpr size_t WS_VT8 = WS_H2Q;
constexpr size_t WS_XB = 894 * MiB;
constexpr size_t WS_CNTB = WS_TINFO + 64 * 1024;
constexpr size_t WS_END = 1022 * MiB;
static_assert((size_t)TPAD * 1024 * 2 <= 152 * MiB && WS_U + 152 * MiB <= WS_P + (size_t)T * NP * 2, "aliases fit inside P");
static_assert((size_t)T * NP * 2 == 448 * MiB && WS_P + 448 * MiB == WS_EST, "P size");
constexpr int CW_BAR = 4096;
constexpr int CW_CNT = 16384;

constexpr int RING_BYTES = 131072, LDSCTL_OFF = RING_BYTES, MISC_OFF = LDSCTL_OFF + 320, PTR_OFF = MISC_OFF + 128, LDS_BYTES = 147456;
constexpr int NWAVES = 8;

__device__ __forceinline__ unsigned pk2(float lo, float hi) { f32x2 v = {lo, hi}; bf16x2_t b = __builtin_convertvector(v, bf16x2_t); return __builtin_bit_cast(unsigned, b); }
__device__ __forceinline__ float bflo(unsigned w) { return __uint_as_float(w << 16); }
__device__ __forceinline__ float bfhi(unsigned w) { return __uint_as_float(w & 0xffff0000u); }
template <int K> __device__ __forceinline__ float sx(float v) { static_assert(K >= 1 && K < 32, "sx"); return __int_as_float(__builtin_amdgcn_ds_swizzle(__float_as_int(v), (K << 10) | 0x1f)); }
__device__ __forceinline__ float sum_halves(float v) { auto rr = __builtin_amdgcn_permlane32_swap(__float_as_uint(v), __float_as_uint(v), false, false); return __uint_as_float(rr[0]) + __uint_as_float(rr[1]); }
__device__ __forceinline__ float max_halves(float v) { auto rr = __builtin_amdgcn_permlane32_swap(__float_as_uint(v), __float_as_uint(v), false, false); return fmaxf(__uint_as_float(rr[0]), __uint_as_float(rr[1])); }
__device__ __forceinline__ float wave_sum(float v) { v += sx<1>(v); v += sx<2>(v); v += sx<4>(v); v += sx<8>(v); v += sx<16>(v); return sum_halves(v); }
__device__ __forceinline__ float wave_max(float v) { v = fmaxf(v, sx<1>(v)); v = fmaxf(v, sx<2>(v)); v = fmaxf(v, sx<4>(v)); v = fmaxf(v, sx<8>(v)); v = fmaxf(v, sx<16>(v)); return max_halves(v); }
__device__ __forceinline__ float silu_f(float x) { return x * __builtin_amdgcn_rcpf(1.0f + __expf(-x)); }
__device__ __forceinline__ int olane() { int l; asm volatile("v_mbcnt_lo_u32_b32 %0, -1, 0\n\tv_mbcnt_hi_u32_b32 %0, -1, %0" : "=v"(l)); return l; }
__device__ __forceinline__ int otid_w(int wave) { return wave * 64 + olane(); }
#define otid() otid_w(g_wave)
__device__ __forceinline__ unsigned pk4_fp8(float a, float b, float c, float d) { int w = __builtin_amdgcn_cvt_pk_fp8_f32(a, b, 0, false); w = __builtin_amdgcn_cvt_pk_fp8_f32(c, d, w, true); return (unsigned)w; }
constexpr float FP8_ACT_SCALE = 16.0f, FP8_W_SCALE = 32.0f;   static_assert(FP8_ACT_SCALE == 16.0f, "EpiMoe1 applies it as ldexp(., 4)");
constexpr int FP8_ACT_E8 = 127 - 4, FP8_W_E8 = 127 - 5;
template <class Tp> __device__ __forceinline__ const Tp* inptr(const LAS unsigned char* lds, int k) {
    const LAS unsigned* q = (const LAS unsigned*)(lds + PTR_OFF) + 2 * k; const unsigned lo = __builtin_amdgcn_readfirstlane(q[0]), hi = __builtin_amdgcn_readfirstlane(q[1]);
    return (const Tp*)(((unsigned long long)hi << 32) | lo); }
#define INF(k) inptr<float>(lds, k)
__device__ __forceinline__ f32x4 ldx4(const float* xf, const bf16* xb, size_t idx) {
    if (xf) return *(const f32x4*)(xf + idx);
    const u32x2 w = *(const u32x2*)(xb + idx); return (f32x4){bflo(w.x), bfhi(w.x), bflo(w.y), bfhi(w.y)}; }
#define LDS_WAIT() asm volatile("s_waitcnt lgkmcnt(0)" ::: "memory")
#define VM_WAIT() asm volatile("s_waitcnt vmcnt(0)" ::: "memory")

namespace pg8 {
constexpr int BM = 256, BK = 64, HALF = 128, HTB = HALF * BK * 2, STAGE_BYTES = 8 * HTB, NXCD = 8, WGM = 8;
__device__ __forceinline__ int lds_byte(int r, int c) { const int st = (r >> 4) * 2 + (c >> 5), rr = r & 15, cc = c & 31, ob = rr * 64 + cc * 2; return st * 1024 + (ob ^ (((ob >> 9) & 1) << 5)); }
__device__ __forceinline__ void stage_rc(int b, int& R, int& C) { const int st = b / 1024, sb = b % 1024, swz = sb ^ (((sb >> 9) & 1) << 5); R = (st >> 1) * 16 + swz / 64; C = (st & 1) * 32 + (swz % 64) / 2; }
__device__ __forceinline__ int perm32(int rho) { const int n = rho >> 4, i = rho & 15; return 8 * (i >> 2) + 4 * n + (i & 3); }

struct Unit { int pm, pn, e0, e1; };
struct Gemm { const bf16* A; const bf16* Bt; int K, lda, ldb; };

template <int NM, int NN> struct StaticOrder {
    static constexpr int nM = NM, nN = NN, nwg = NM * NN;
    int G, c;
    __device__ void init(int G_, int c_) { G = G_; c = c_; }
    __device__ bool next(int i, Unit& u) const {
        const int L = i * G + c; if (L >= nwg) return false;
        int wgid = L; { constexpr int q = nwg / NXCD, r = nwg % NXCD; const int xcd = wgid % NXCD, off = wgid / NXCD; wgid = (xcd < r ? xcd * (q + 1) : r * (q + 1) + (xcd - r) * q) + off; }
        constexpr int nig = WGM * nN; static_assert(NM % WGM == 0, "row tiles in whole groups");
        const int gid = wgid / nig, fm = gid * WGM;
        u.pm = fm + ((wgid % nig) % WGM); u.pn = (wgid % nig) / WGM; u.e0 = 0; u.e1 = 0; return true;
    }
    __device__ __forceinline__ const char* a_base(const Gemm& g, const Unit& u) const { return (const char*)g.A + (size_t)u.pm * BM * g.lda * 2; }
    __device__ __forceinline__ const char* b_lo(const Gemm& g, const Unit& u) const { return (const char*)g.Bt + (size_t)u.pn * BM * g.ldb * 2; }
    __device__ __forceinline__ const char* b_hi(const Gemm& g, const Unit& u) const { return b_lo(g, u); }
};
template <int NPN, int WHICH  >
struct MoeOrder {
    const int* tinfo; int G, c;
    __device__ bool next(int i, Unit& u) const {
        const int nT = __builtin_amdgcn_readfirstlane(tinfo[0]);
        const int L = i * G + c; if (L >= nT * NPN) return false;
        const int gF = nT >> 3, full = gF * 8 * NPN;
        if (L < full) { u.pm = (L / (8 * NPN)) * 8 + (L & 7); u.pn = (L >> 3) % NPN; }
        else { const int rT = nT - 8 * gF; int Lr = L - full, pn = 0; while (Lr >= rT) { Lr -= rT; ++pn; } u.pm = gF * 8 + Lr; u.pn = pn; }
        const int code = __builtin_amdgcn_readfirstlane(tinfo[1 + u.pm]); u.e0 = code & 0xff; u.e1 = (code >> 8) & 0xff; return true;
    }
    __device__ __forceinline__ const char* a_base(const Gemm& g, const Unit& u) const { return (const char*)g.A + (size_t)u.pm * BM * g.lda * 2; }
    __device__ __forceinline__ const char* b_lo(const Gemm& g, const Unit& u) const {
        if (WHICH == 1) return (const char*)g.Bt + ((size_t)(u.pn < 4 ? u.e0 : u.e1) * 1024 + (size_t)(u.pn & 3) * BM) * g.ldb * 2;
        return (const char*)g.Bt + ((size_t)u.e0 * 1024 + (size_t)u.pn * BM) * g.ldb * 2;
    }
    __device__ __forceinline__ const char* b_hi(const Gemm& g, const Unit& u) const {
        if (WHICH == 1) return b_lo(g, u);
        return (const char*)g.Bt + ((size_t)u.e1 * 1024 + (size_t)u.pn * BM) * g.ldb * 2 - (size_t)g.K;
    }
};

struct EpiStoreBf16 {
    static constexpr bool PERM = true;
    bf16* O; int ldc;
    __device__ __forceinline__ void operator()(const f32x4 (&acc)[2][2][4][2], const Unit& u, int wr, int wc, int fr, int fq) const {
        { const int l_ = olane(); fr = l_ & 15; fq = l_ >> 4; }
        const int row0 = u.pm * BM + wr * 64 + fr, col0 = u.pn * BM + wc * 32 + 8 * fq;
#pragma unroll
        for (int ai = 0; ai < 2; ++ai)
#pragma unroll
            for (int m = 0; m < 4; ++m) { bf16* rowp = O + (size_t)(row0 + ai * HALF + m * 16) * ldc + col0;
#pragma unroll
                for (int bj = 0; bj < 2; ++bj) { const f32x4 v0 = acc[ai][bj][m][0], v1 = acc[ai][bj][m][1];
                    u32x4 w; w.x = pk2(v0[0], v0[1]); w.y = pk2(v0[2], v0[3]); w.z = pk2(v1[0], v1[1]); w.w = pk2(v1[2], v1[3]);
                    *(u32x4*)(rowp + bj * HALF) = w; } }
    }
};
struct EpiInproj {
    static constexpr bool PERM = true;
    bf16* O; int ldc; const float* sa; const float* sw; const float* gq; const float* gk; const f32x2* csd; unsigned char* vt8;
    __device__ __forceinline__ void operator()(const i32x4 (&acc)[2][2][4][2], const Unit& u, int wr, int wc, int fr, int fq) const {
        { const int l_ = olane(); fr = l_ & 15; fq = l_ >> 4; }
        const int row0 = u.pm * BM + wr * 64 + fr, col0 = u.pn * BM + wc * 32 + 8 * fq;
        f32x4 cs[2][2];
#pragma unroll
        for (int bj = 0; bj < 2; ++bj)
#pragma unroll
            for (int n = 0; n < 2; ++n) cs[bj][n] = *(const f32x4*)(sw + col0 + bj * HALF + 4 * n);
        if (u.pn == 8 || u.pn == 9) {
#pragma unroll
            for (int ai = 0; ai < 2; ++ai)
#pragma unroll
                for (int m = 0; m < 4; ++m) { const int row = row0 + ai * HALF + m * 16; const float rs = sa[row] * 8.0f;
                    const int bb = row >> 13, tk = row & 8191;
#pragma unroll
                    for (int bj = 0; bj < 2; ++bj) { unsigned char* vp = vt8 + ((((size_t)bb * 4 + (u.pn - 8) * 2 + bj) * 128 + (tk >> 6)) * 128 + wc * 32 + 8 * fq) * 64 + (tk & 63);
#pragma unroll
                        for (int n = 0; n < 2; ++n) { const f32x4 v = __builtin_convertvector(acc[ai][bj][m][n], f32x4) * cs[bj][n] * rs; const unsigned w = pk4_fp8(v[0], v[1], v[2], v[3]);
                            vp[(4 * n + 0) * 64] = (unsigned char)(w & 0xff); vp[(4 * n + 1) * 64] = (unsigned char)((w >> 8) & 0xff); vp[(4 * n + 2) * 64] = (unsigned char)((w >> 16) & 0xff); vp[(4 * n + 3) * 64] = (unsigned char)(w >> 24); } } }
        } else if (u.pn < 4 || u.pn >= 8) {
#pragma unroll
            for (int ai = 0; ai < 2; ++ai)
#pragma unroll
                for (int m = 0; m < 4; ++m) { const int row = row0 + ai * HALF + m * 16; const float rs = sa[row]; bf16* rowp = O + (size_t)row * ldc + col0;
#pragma unroll
                    for (int bj = 0; bj < 2; ++bj) { const f32x4 v0 = __builtin_convertvector(acc[ai][bj][m][0], f32x4) * cs[bj][0] * rs, v1 = __builtin_convertvector(acc[ai][bj][m][1], f32x4) * cs[bj][1] * rs;
                        u32x4 w; w.x = pk2(v0[0], v0[1]); w.y = pk2(v0[2], v0[3]); w.z = pk2(v1[0], v1[1]); w.w = pk2(v1[2], v1[3]);
                        *(u32x4*)(rowp + bj * HALF) = w; } }
        } else {
            const bool isq = u.pn < 6; const float* gg = (isq ? gq : gk) + 8 * fq; const float qs = isq ? 0.125f * LOG2E : 1.0f;
            f32x4 gv[2][2];
#pragma unroll
            for (int bj = 0; bj < 2; ++bj)
#pragma unroll
                for (int n = 0; n < 2; ++n) gv[bj][n] = *(const f32x4*)(gg + 32 * bj + 4 * n) * qs;
            const int lcol = u.pn * BM + 64 * wc + 8 * fq;
#pragma unroll
            for (int ai = 0; ai < 2; ++ai)
#pragma unroll
                for (int m = 0; m < 4; ++m) { const int row = row0 + ai * HALF + m * 16; const float rs = sa[row];
                    f32x4 x[2][2]; float ss = 0.f;
#pragma unroll
                    for (int bj = 0; bj < 2; ++bj)
#pragma unroll
                        for (int n = 0; n < 2; ++n) { x[bj][n] = __builtin_convertvector(acc[ai][bj][m][n], f32x4) * cs[bj][n] * rs; ss += (x[bj][n][0] * x[bj][n][0] + x[bj][n][1] * x[bj][n][1]) + (x[bj][n][2] * x[bj][n][2] + x[bj][n][3] * x[bj][n][3]); }
                    ss += sx<16>(ss); ss = sum_halves(ss);
                    const float rstd = rsqrtf(ss * (1.0f / 64.0f) + EPS);
#pragma unroll
                    for (int bj = 0; bj < 2; ++bj)
#pragma unroll
                        for (int n = 0; n < 2; ++n) x[bj][n] = x[bj][n] * gv[bj][n] * rstd;
                    const f32x4* c4 = (const f32x4*)(csd + (size_t)row * 8);
#pragma unroll
                    for (int n = 0; n < 2; ++n) { const f32x4 ca = c4[2 * n], cb = c4[2 * n + 1];
                        f32x4 pr;
#pragma unroll
                        for (int i = 0; i < 4; ++i) pr[i] = sx<16>(x[0][n][i]);
                        const f32x4 co = (f32x4){ca[0], ca[2], cb[0], cb[2]}, sn = (f32x4){ca[1], ca[3], cb[1], cb[3]};
                        const f32x4 r0 = x[0][n] * co - pr * sn, r1 = pr * sn + x[0][n] * co;
                        if (fq == 0) x[0][n] = r0; else if (fq == 1) x[0][n] = r1; }
                    bf16* rowp = O + (size_t)row * ldc + lcol;
#pragma unroll
                    for (int bj = 0; bj < 2; ++bj) { u32x4 w; w.x = pk2(x[bj][0][0], x[bj][0][1]); w.y = pk2(x[bj][0][2], x[bj][0][3]); w.z = pk2(x[bj][1][0], x[bj][1][1]); w.w = pk2(x[bj][1][2], x[bj][1][3]);
                        *(u32x4*)(rowp + 32 * bj) = w; } }
        }
    }
};
struct EpiResid {
    static constexpr bool PERM = true;
    const float* xf; bf16* xb; const float* gate;
    __device__ __forceinline__ void operator()(const f32x4 (&acc)[2][2][4][2], const Unit& u, int wr, int wc, int fr, int fq) const {
        { const int l_ = olane(); fr = l_ & 15; fq = l_ >> 4; }
        const int col0 = u.pn * BM + wc * 32 + 8 * fq; const int b = (u.pm * BM) >> 13;
        f32x4 gv[2][2];
#pragma unroll
        for (int bj = 0; bj < 2; ++bj)
#pragma unroll
            for (int n = 0; n < 2; ++n) gv[bj][n] = *(const f32x4*)(gate + (size_t)b * 6144 + col0 + bj * HALF + 4 * n);
#pragma unroll
        for (int ai = 0; ai < 2; ++ai)
#pragma unroll
            for (int m = 0; m < 4; ++m) { const size_t off = (size_t)(u.pm * BM + ai * HALF + wr * 64 + m * 16 + fr) * DM + col0;
#pragma unroll
                for (int bj = 0; bj < 2; ++bj) { f32x4 x0, x1;
                    if (xf) { x0 = *(const f32x4*)(xf + off + bj * HALF); x1 = *(const f32x4*)(xf + off + bj * HALF + 4); }
                    else { const u32x4 w = *(const u32x4*)(xb + off + bj * HALF); x0 = (f32x4){bflo(w.x), bfhi(w.x), bflo(w.y), bfhi(w.y)}; x1 = (f32x4){bflo(w.z), bfhi(w.z), bflo(w.w), bfhi(w.w)}; }
                    x0 += gv[bj][0] * acc[ai][bj][m][0]; x1 += gv[bj][1] * acc[ai][bj][m][1];
                    u32x4 o; o.x = pk2(x0[0], x0[1]); o.y = pk2(x0[2], x0[3]); o.z = pk2(x1[0], x1[1]); o.w = pk2(x1[2], x1[3]);
                    *(u32x4*)(xb + off + bj * HALF) = o; }
                if (m == 3) asm volatile("" ::: "memory"); }
    }
};
struct EpiMoe1 {
    static constexpr bool PERM = true;
    unsigned char* U; const float* gaS; const float* gbS; const float* saS; const float* sw1;
    __device__ __forceinline__ void operator()(const i32x4 (&acc)[2][2][4][2], const Unit& u, int wr, int wc, int fr, int fq) const {
        { const int l_ = olane(); fr = l_ & 15; fq = l_ >> 4; }
        const float* gs = (u.pn < 4) ? gaS : gbS; const int ucol = u.pn * 128 + wc * 32 + 8 * fq;
        const float* swp = sw1 + (size_t)(u.pn < 4 ? u.e0 : u.e1) * 1024 + (u.pn & 3) * BM + wc * 32 + 8 * fq;
        f32x4 cs[2][2];
#pragma unroll
        for (int bj = 0; bj < 2; ++bj)
#pragma unroll
            for (int n = 0; n < 2; ++n) cs[bj][n] = *(const f32x4*)(swp + bj * HALF + 4 * n);
#pragma unroll
        for (int ai = 0; ai < 2; ++ai)
#pragma unroll
            for (int m = 0; m < 4; ++m) { const int slot = u.pm * BM + ai * HALF + wr * 64 + m * 16 + fr; const float w = __builtin_ldexpf(gs[slot], 4)  , rs = saS[slot];
                float r[8];
#pragma unroll
                for (int n = 0; n < 2; ++n) { const f32x4 gv = __builtin_convertvector(acc[ai][0][m][n], f32x4) * cs[0][n] * rs, uv = __builtin_convertvector(acc[ai][1][m][n], f32x4) * cs[1][n] * (rs * w);
#pragma unroll
                    for (int i = 0; i < 4; ++i) r[n * 4 + i] = silu_f(gv[i]) * uv[i]; }
                u32x2 o; o.x = pk4_fp8(r[0], r[1], r[2], r[3]); o.y = pk4_fp8(r[4], r[5], r[6], r[7]);
                *(u32x2*)(U + (size_t)slot * 1024 + ucol) = o; asm volatile("" ::: "memory"); }
    }
};
struct EpiMoe2 {
    static constexpr bool PERM = true;
    bf16* xb; float* outf; const int* tokS; const float* gate; int dry;
    __device__ __forceinline__ void operator()(const f32x4 (&acc)[2][2][4][2], const Unit& u, int wr, int wc, int fr, int fq) const {
        if (dry) { asm volatile("" :: "v"(acc[0][0][0][0]), "v"(acc[1][1][3][1])); return; }
        { const int l_ = olane(); fr = l_ & 15; fq = l_ >> 4; }
        const int col0 = u.pn * BM + wc * 32 + 8 * fq;
        int tok[2][4];
#pragma unroll
        for (int ai = 0; ai < 2; ++ai)
#pragma unroll
            for (int m = 0; m < 4; ++m) tok[ai][m] = tokS[u.pm * BM + ai * HALF + wr * 64 + m * 16 + fr];
#pragma unroll
        for (int ai = 0; ai < 2; ++ai) {
            u32x4 xw[4][2];
#pragma unroll
            for (int m = 0; m < 4; ++m) { const int tk = tok[ai][m] < 0 ? 0 : tok[ai][m]; const size_t off = (size_t)tk * DM + col0;
#pragma unroll
                for (int bj = 0; bj < 2; ++bj) xw[m][bj] = *(const u32x4*)(xb + off + bj * HALF); }
#pragma unroll
            for (int m = 0; m < 4; ++m) { if (tok[ai][m] >= 0) { const size_t off = (size_t)tok[ai][m] * DM + col0; const float* gp = gate + (size_t)(tok[ai][m] >> 13) * 6144 + col0;
#pragma unroll
                for (int bj = 0; bj < 2; ++bj) { const u32x4 w = xw[m][bj]; const f32x4 g0 = *(const f32x4*)(gp + bj * HALF), g1 = *(const f32x4*)(gp + bj * HALF + 4);
                    const f32x4 x0 = (f32x4){bflo(w.x), bfhi(w.x), bflo(w.y), bfhi(w.y)} + (DBG_MOE ? 1.f : 0.f) * g0 * acc[ai][bj][m][0], x1 = (f32x4){bflo(w.z), bfhi(w.z), bflo(w.w), bfhi(w.w)} + (DBG_MOE ? 1.f : 0.f) * g1 * acc[ai][bj][m][1];
                    if (outf) { *(f32x4*)(outf + off + bj * HALF) = x0; *(f32x4*)(outf + off + bj * HALF + 4) = x1; }
                    else { u32x4 o; o.x = pk2(x0[0], x0[1]); o.y = pk2(x0[2], x0[3]); o.z = pk2(x1[0], x1[1]); o.w = pk2(x1[2], x1[3]); *(u32x4*)(xb + off + bj * HALF) = o; } } } }
            asm volatile("" ::: "memory"); }
    }
};

template <int MODE> struct AccT { typedef f32x4 type; }; template <> struct AccT<1> { typedef i32x4 type; };
template <int MODE> struct Frag { bf16x8 lo, hi; __device__ __forceinline__ void ld(const LAS unsigned char* p) { lo = *(const LAS bf16x8*)p; hi = *(const LAS bf16x8*)(p + 1024); } };
template <> struct Frag<2> { i32x8 v; __device__ __forceinline__ void ld(const LAS unsigned char* p) { const i32x4 l_ = *(const LAS i32x4*)p, h_ = *(const LAS i32x4*)(p + 1024); v = __builtin_shufflevector(l_, h_, 0, 1, 2, 3, 4, 5, 6, 7); } };
__device__ __forceinline__ f32x4 mma2(const Frag<0>& b, const Frag<0>& a, f32x4 c) { c = __builtin_amdgcn_mfma_f32_16x16x32_bf16(b.lo, a.lo, c, 0, 0, 0); return __builtin_amdgcn_mfma_f32_16x16x32_bf16(b.hi, a.hi, c, 0, 0, 0); }
__device__ __forceinline__ i32x4 mma2(const Frag<1>& b, const Frag<1>& a, i32x4 c) {
    c = __builtin_amdgcn_mfma_i32_16x16x64_i8(__builtin_bit_cast(i32x4, b.lo), __builtin_bit_cast(i32x4, a.lo), c, 0, 0, 0); return __builtin_amdgcn_mfma_i32_16x16x64_i8(__builtin_bit_cast(i32x4, b.hi), __builtin_bit_cast(i32x4, a.hi), c, 0, 0, 0); }
__device__ __forceinline__ f32x4 mma2(const Frag<2>& b, const Frag<2>& a, f32x4 c) {
    return __builtin_amdgcn_mfma_scale_f32_16x16x128_f8f6f4(b.v, a.v, c, 0, 0, 0, FP8_W_E8, 0, FP8_ACT_E8); }
template <class Epi, class Sched, int KSPLIT  , int MODE = 0>
__device__ __forceinline__ void gemm_phase(LAS unsigned char* lds, const Gemm g, const Sched& S, const Epi& E, const int g_wave) {
    const int tid = otid(), wid = __builtin_amdgcn_readfirstlane(tid >> 6), lane = tid & 63, wr = wid >> 2, wc = wid & 3, fr = lane & 15, fq = lane >> 4;
    const int K = g.K, nt = K / BK;
    unsigned voffA[2], voffB[2];
#pragma unroll
    for (int i = 0; i < 2; ++i) { int R, C; stage_rc(tid * 16 + i * 8192, R, C); const int Rb = Epi::PERM ? ((R & ~31) + perm32(R & 31)) : R;
        voffA[i] = (unsigned)(R * g.lda + C) * 2u; voffB[i] = (unsigned)(Rb * g.ldb + C) * 2u; }
    const size_t kstep = (size_t)(BK * 2);
    const size_t hstepA = (size_t)HALF * g.lda * 2, hstepB = (size_t)HALF * g.ldb * 2;
    const unsigned ldsw = (unsigned)wid * 1024u;
    const int aoff = lds_byte(wr * 64 + fr, fq * 8), boff = lds_byte(wc * 32 + fr, fq * 8);
#define PG8_SA(b, h) (((b) * 2 + (h)) * HTB)
#define PG8_SB(b, h) ((4 + (b) * 2 + (h)) * HTB)
#define PG8_STAGE(bufoff, gbase, voff) do { _Pragma("unroll") for (int _i = 0; _i < 2; ++_i) \
        __builtin_amdgcn_global_load_lds((const unsigned*)((const char*)(gbase) + (voff)[_i]), (LAS unsigned*)(lds + (bufoff) + ldsw + _i * 8192), 16, 0, 0); } while (0)
#define PG8_LDA(dst, b, h) do { _Pragma("unroll") for (int m = 0; m < 4; ++m) dst[m].ld(lds + PG8_SA(b, h) + aoff + m * 2048); } while (0)
#define PG8_LDB(dst, b, h) do { _Pragma("unroll") for (int n = 0; n < 2; ++n) dst[n].ld(lds + PG8_SB(b, h) + boff + n * 2048); } while (0)
#define PG8_MMA(ai, bj, At, Bt) do { __builtin_amdgcn_s_setprio(1); _Pragma("unroll") for (int m = 0; m < 4; ++m) _Pragma("unroll") for (int n = 0; n < 2; ++n) \
        acc[ai][bj][m][n] = mma2(Bt[n], At[m], acc[ai][bj][m][n]); \
        if (MODE == 2) { _Pragma("unroll") for (int m = 0; m < 4; ++m) _Pragma("unroll") for (int n = 0; n < 2; ++n) asm volatile("" : "+v"(acc[ai][bj][m][n])); }     \
        __builtin_amdgcn_s_setprio(0); } while (0)
#define PG8_WAIT_V(n) asm volatile("s_waitcnt vmcnt(" #n ")" ::: "memory")
#define PG8_WAIT_L(n) asm volatile("s_waitcnt lgkmcnt(" #n ")" ::: "memory")
#define PG8_BAR __builtin_amdgcn_s_barrier()
#define PG8_SCHED __builtin_amdgcn_sched_barrier(0)
    Unit cur, nxt; int ui = 0;
    if (!S.next(0, cur)) return;
    typedef typename AccT<MODE>::type acc_t;
    acc_t acc[2][2][4][2];
#pragma unroll
    for (int a = 0; a < 2; ++a)
#pragma unroll
        for (int b = 0; b < 2; ++b)
#pragma unroll
            for (int m = 0; m < 4; ++m)
#pragma unroll
                for (int n = 0; n < 2; ++n) acc[a][b][m][n] = (acc_t){0, 0, 0, 0};
    Frag<MODE> At[4], B0[2], B1[2];
    const char* cA = S.a_base(g, cur); const char* cB = S.b_lo(g, cur); const char* cBh = S.b_hi(g, cur);
    PG8_STAGE(PG8_SB(0, 0), cB, voffB); PG8_STAGE(PG8_SB(0, 1), cB + hstepB, voffB); PG8_STAGE(PG8_SA(0, 0), cA, voffA); PG8_STAGE(PG8_SA(0, 1), cA + hstepA, voffA);
    if (wr == 1) PG8_BAR;
    PG8_WAIT_V(2); PG8_BAR;
    PG8_STAGE(PG8_SB(1, 0), cB + kstep, voffB); PG8_STAGE(PG8_SA(1, 0), cA + kstep, voffA); PG8_STAGE(PG8_SB(1, 1), cB + hstepB + kstep, voffB);
    PG8_WAIT_V(6); PG8_BAR;
    for (;;) {
        const bool has_next = S.next(ui + 1, nxt);
        const char* nA = has_next ? S.a_base(g, nxt) : cA; const char* nB = has_next ? S.b_lo(g, nxt) : cB; const char* nBh = has_next ? S.b_hi(g, nxt) : cBh;
        for (int t = 0; t < nt; t += 2) {
            const bool last = (t == nt - 2);
            const char* a1 = cA + (size_t)(t + 1) * kstep;
            const char* bsel = (KSPLIT != 0 && (t + 2) >= KSPLIT) ? cBh : cB;
            const char* a2 = last ? nA : cA + (size_t)(t + 2) * kstep; const char* b2 = last ? nB : bsel + (size_t)(t + 2) * kstep;
            const char* a3 = a2 + kstep; const char* b3 = b2 + kstep;
            PG8_LDB(B0, 0, 0); PG8_LDB(B1, 0, 1); PG8_SCHED; PG8_LDA(At, 0, 0); PG8_STAGE(PG8_SA(1, 1), a1 + hstepA, voffA);
            PG8_WAIT_V(8); PG8_WAIT_L(0); PG8_BAR; PG8_MMA(0, 0, At, B0); PG8_MMA(0, 1, At, B1); PG8_BAR; PG8_SCHED;
            PG8_LDA(At, 0, 1); PG8_STAGE(PG8_SB(0, 0), b2, voffB); PG8_STAGE(PG8_SB(0, 1), b2 + hstepB, voffB); PG8_STAGE(PG8_SA(0, 0), a2, voffA);
            PG8_WAIT_V(8); PG8_WAIT_L(0); PG8_BAR; PG8_MMA(1, 0, At, B0); PG8_MMA(1, 1, At, B1); PG8_BAR; PG8_SCHED;
            PG8_LDB(B0, 1, 0); PG8_LDB(B1, 1, 1); PG8_SCHED; PG8_LDA(At, 1, 0); PG8_STAGE(PG8_SA(0, 1), a2 + hstepA, voffA);
            PG8_WAIT_V(8); PG8_WAIT_L(0); PG8_BAR; PG8_MMA(0, 0, At, B0); PG8_MMA(0, 1, At, B1); PG8_BAR; PG8_SCHED;
            PG8_LDA(At, 1, 1); PG8_STAGE(PG8_SB(1, 0), b3, voffB); PG8_STAGE(PG8_SB(1, 1), b3 + hstepB, voffB); PG8_STAGE(PG8_SA(1, 0), a3, voffA);
            PG8_WAIT_V(8); PG8_WAIT_L(0); PG8_BAR; PG8_MMA(1, 0, At, B0); PG8_MMA(1, 1, At, B1); PG8_BAR; PG8_SCHED;
        }
        if (wr == 0) PG8_BAR;
        E(acc, cur, wr, wc, fr, fq);
        if (!has_next) break;
#pragma unroll
        for (int a = 0; a < 2; ++a)
#pragma unroll
            for (int b = 0; b < 2; ++b)
#pragma unroll
                for (int m = 0; m < 4; ++m)
#pragma unroll
                    for (int n = 0; n < 2; ++n) acc[a][b][m][n] = (acc_t){0, 0, 0, 0};
        cur = nxt; cA = nA; cB = nB; cBh = nBh; ++ui;
        if (wr == 1) PG8_BAR;
    }
    PG8_WAIT_V(0);
    PG8_BAR;
#undef PG8_SA
#undef PG8_SB
#undef PG8_STAGE
#undef PG8_LDA
#undef PG8_LDB
#undef PG8_MMA
#undef PG8_WAIT_V
#undef PG8_WAIT_L
#undef PG8_BAR
#undef PG8_SCHED
}
}

#define XB_TMO      128
#define XB_XCNT(j)  (256  + 64 * (j))
#define XB_XSUB(j)  (1280 + 64 * (j))
#define XB_XGEN(j)  (2304 + 64 * (j))
#define XB_TOP      3328
#define XB_TOPGEN   3392
#define XCD_BAR_WORDS 3456
#define XB_SPIN_CAP (1u << 21)
__device__ __forceinline__ unsigned xb_ld(unsigned* p)              { return __hip_atomic_load(p, __ATOMIC_RELAXED, __HIP_MEMORY_SCOPE_AGENT); }
__device__ __forceinline__ unsigned xb_add(unsigned* p, unsigned v) { return __hip_atomic_fetch_add(p, v, __ATOMIC_RELAXED, __HIP_MEMORY_SCOPE_AGENT); }
__device__ __forceinline__ unsigned xb_xcc_id() { return (unsigned)__builtin_amdgcn_s_getreg((3 << 11) | 20) & 0xFu; }
#define XB_SPIN(cond, bar) do { unsigned _sp = 0; while (cond) { __builtin_amdgcn_s_sleep(1); \
    if ((++_sp & 255u) == 0u) { if (xb_ld(&(bar)[XB_TMO])) break; if (_sp > XB_SPIN_CAP) { atomicAdd(&(bar)[XB_TMO], 1u); break; } } } } while (0)
struct XcdBarrier { unsigned* bar; unsigned x; volatile LAS unsigned* st; };
__device__ __forceinline__ XcdBarrier xcd_barrier_post(unsigned* bar, volatile LAS unsigned* st, bool leader) {
    XcdBarrier b; b.bar = bar; b.x = xb_xcc_id(); b.st = st;
    if (leader) (void)xb_add(&bar[XB_XCNT(b.x)], 1u);
    return b;
}
__device__ __forceinline__ void xcd_barrier_complete(unsigned* bar, unsigned x, unsigned& nloc, unsigned& nx) {
    const unsigned G = gridDim.x * gridDim.y * gridDim.z;
    unsigned sum, cnt, mine, sp = 0u;
    for (;;) {
        sum = 0u; cnt = 0u; mine = 0u;
#pragma unroll
        for (unsigned j = 0; j < 16; ++j) { const unsigned c = xb_ld(&bar[XB_XCNT(j)]); sum += c; cnt += (c > 0u) ? 1u : 0u; }
        mine = xb_ld(&bar[XB_XCNT(x)]);
        if (sum == G) break;
        __builtin_amdgcn_s_sleep(1);
        if ((++sp & 255u) == 0u) { if (xb_ld(&bar[XB_TMO])) break; if (sp > XB_SPIN_CAP) { atomicAdd(&bar[XB_TMO], 1u); break; } }
    }
    nloc = mine > 0u ? mine : 1u; nx = cnt > 0u ? cnt : 1u;
}
__device__ __forceinline__ void xcd_barrier(const XcdBarrier& b, bool leader) {
    asm volatile("s_waitcnt vmcnt(0)" ::: "memory");
    __syncthreads();
    if (leader) {
        unsigned* bar = b.bar;
        __builtin_amdgcn_s_waitcnt(0);
        unsigned nloc = b.st[0], nx = b.st[1];
        if (nloc == 0u) { xcd_barrier_complete(bar, b.x, nloc, nx); b.st[0] = nloc; b.st[1] = nx; }
        const unsigned old = xb_add(&bar[XB_XSUB(b.x)], 1u);
        const unsigned gen = old / nloc;
        if (old + 1u == (gen + 1u) * nloc) {
            __builtin_amdgcn_fence(__ATOMIC_RELEASE, "agent");
            asm volatile("s_waitcnt vmcnt(0)" ::: "memory");
            const unsigned og = xb_add(&bar[XB_TOP], 1u);
            const unsigned tg = og / nx;
            if (og + 1u == (tg + 1u) * nx) xb_add(&bar[XB_TOPGEN], 1u);
            else XB_SPIN(xb_ld(&bar[XB_TOPGEN]) == tg, bar);
            __builtin_amdgcn_fence(__ATOMIC_ACQUIRE, "agent");
            xb_add(&bar[XB_XGEN(b.x)], 1u);
            asm volatile("s_waitcnt vmcnt(0)" ::: "memory");
        } else {
            XB_SPIN(xb_ld(&bar[XB_XGEN(b.x)]) == gen, bar);
            __builtin_amdgcn_fence(__ATOMIC_ACQUIRE, "agent");
            asm volatile("s_waitcnt vmcnt(0)" ::: "memory");
        }
    }
    __syncthreads();
}

__device__ __forceinline__ int tr_row(int kind, int n) {
    if (kind == 0) return n;
    if (kind == 1) { if (n >= 1024 && n < 2048) { const int lc = (n - 1024) & 255, sh = lc >> 6, d = lc & 63; return (n & ~255) + 128 * (d >> 5) + 32 * sh + (d & 31); }
                     return n < 3072 ? n : (n < 3088 ? -1 : n + 112); }
    return (n >> 7) * 256 + (n & 127) + (kind == 3 ? 128 : 0);
}
__device__ __forceinline__ void tr_item(const float* W, int K, int N, bf16* WT, int ldt, int kind, LAS unsigned char* scr, int item, int lane) {
    const int nblk = (N + 63) / 64, kb = item / nblk, nb = item % nblk, k0 = 64 * kb, n0 = 64 * nb;
    const int n4 = (lane & 15) * 4; const bool inr = (n0 + n4) < N;
    f32x4 v[16];
#pragma unroll
    for (int i = 0; i < 16; ++i) { const int kk = 4 * i + (lane >> 4); v[i] = inr ? *(const f32x4*)(W + (size_t)(k0 + kk) * N + n0 + n4) : (f32x4){0.f, 0.f, 0.f, 0.f}; }
#pragma unroll
    for (int i = 0; i < 16; ++i) { const int kk = 4 * i + (lane >> 4); const unsigned w0 = pk2(v[i][0], v[i][1]), w1 = pk2(v[i][2], v[i][3]);
        *(LAS unsigned short*)(scr + (n4 + 0) * 132 + kk * 2) = (unsigned short)(w0 & 0xffffu); *(LAS unsigned short*)(scr + (n4 + 1) * 132 + kk * 2) = (unsigned short)(w0 >> 16);
        *(LAS unsigned short*)(scr + (n4 + 2) * 132 + kk * 2) = (unsigned short)(w1 & 0xffffu); *(LAS unsigned short*)(scr + (n4 + 3) * 132 + kk * 2) = (unsigned short)(w1 >> 16); }
    LDS_WAIT(); asm volatile("" ::: "memory");
#pragma unroll
    for (int j = 0; j < 8; ++j) { const int idx = lane + 64 * j, n = idx >> 3, c = idx & 7; const LAS unsigned* sp = (const LAS unsigned*)(scr + n * 132 + c * 16);
        u32x4 o; o.x = sp[0]; o.y = sp[1]; o.z = sp[2]; o.w = sp[3];
        const int gn = n0 + n; const int r = (gn < N) ? tr_row(kind, gn) : -1;
        if (r >= 0) *(u32x4*)(WT + (size_t)r * ldt + k0 + 8 * c) = o; }
    LDS_WAIT(); asm volatile("" ::: "memory");
}

__device__ __forceinline__ void tr_item8(const float* W, int K, int N, unsigned char* WT8, int ldt, LAS unsigned char* scr, int item, int lane) {
    const int nblk = N / 64, kb = item / nblk, nb = item % nblk, k0 = 64 * kb, n0 = 64 * nb;
    const int a = lane & 15, kg = lane >> 4;
    f32x4 v[16];
#pragma unroll
    for (int i = 0; i < 16; ++i) { const int kk = 16 * (i >> 2) + 4 * kg + (i & 3); v[i] = *(const f32x4*)(W + (size_t)(k0 + kk) * N + n0 + 4 * a); }
#pragma unroll
    for (int g = 0; g < 4; ++g)
#pragma unroll
        for (int e = 0; e < 4; ++e) *(LAS unsigned*)(scr + (4 * a + e) * 68 + 16 * g + 4 * kg) = pk4_fp8(v[4 * g][e] * FP8_W_SCALE, v[4 * g + 1][e] * FP8_W_SCALE, v[4 * g + 2][e] * FP8_W_SCALE, v[4 * g + 3][e] * FP8_W_SCALE);
    LDS_WAIT(); asm volatile("" ::: "memory");
#pragma unroll
    for (int j = 0; j < 4; ++j) { const int idx = lane + 64 * j, n = idx >> 2, c = idx & 3; const LAS unsigned* sp = (const LAS unsigned*)(scr + n * 68 + c * 16);
        u32x4 o; o.x = sp[0]; o.y = sp[1]; o.z = sp[2]; o.w = sp[3];
        *(u32x4*)(WT8 + (size_t)(n0 + n) * ldt + k0 + 16 * c) = o; }
    LDS_WAIT(); asm volatile("" ::: "memory");
}

template <bool LA>
__device__ __forceinline__ void quant_strip(LAS unsigned char* lds, const float* W, int N, int n0, unsigned char* Q, float* SW, int kind, const float* a2, int wave, int lane) {
    lane = olane();
    const int a = lane & 15, kg = lane >> 4; const int ncl = (n0 + 4 * a) < N ? (n0 + 4 * a) : (N - 4);
    f32x4 v[2][16];
#pragma unroll
    for (int t = 0; t < 2; ++t)
#pragma unroll
        for (int i = 0; i < 16; ++i) { const int kk = 128 * wave + 64 * t + 16 * (i >> 2) + 4 * kg + (i & 3);
            if (!LA) v[t][i] = *(const f32x4*)(W + (size_t)kk * N + ncl);
            else { f32x4 acc = (f32x4){0.f, 0.f, 0.f, 0.f}; const float* wr = W + (size_t)kk * N + 3072;
#pragma unroll 4
                for (int r = 0; r < 16; ++r) acc += *(const f32x4*)(a2 + r * 128 + n0 + 4 * a) * wr[r];
                v[t][i] = acc; } }
    f32x4 cm = (f32x4){0.f, 0.f, 0.f, 0.f};
#pragma unroll
    for (int t = 0; t < 2; ++t)
#pragma unroll
        for (int i = 0; i < 16; ++i) cm = __builtin_elementwise_max(cm, __builtin_elementwise_abs(v[t][i]));
    LAS float* cmax = (LAS float*)(lds + 67584);
#pragma unroll
    for (int e = 0; e < 4; ++e) { float m = cm[e]; m = fmaxf(m, sx<16>(m)); m = max_halves(m); if (kg == 0) cmax[wave * 64 + 4 * a + e] = m; }
    __syncthreads();
    float inv[4], scl[4];
#pragma unroll
    for (int e = 0; e < 4; ++e) { float m = 0.f;
#pragma unroll
        for (int w = 0; w < 8; ++w) m = fmaxf(m, cmax[w * 64 + 4 * a + e]);
        scl[e] = m > 0.f ? m * (1.0f / 127.0f) : 1.0f; inv[e] = m > 0.f ? 127.0f / m : 0.f; }
    LAS unsigned char* tile = lds + wave * 8448;
#pragma unroll
    for (int t = 0; t < 2; ++t)
#pragma unroll
        for (int g = 0; g < 4; ++g)
#pragma unroll
            for (int e = 0; e < 4; ++e) { unsigned w = 0u;
#pragma unroll
                for (int j = 0; j < 4; ++j) { const int q = (int)__builtin_rintf(v[t][4 * g + j][e] * inv[e]); w |= ((unsigned)q & 0xffu) << (8 * j); }
                *(LAS unsigned*)(tile + (4 * a + e) * 132 + 64 * t + 16 * g + 4 * kg) = w; }
    LDS_WAIT(); asm volatile("" ::: "memory");
#pragma unroll
    for (int j = 0; j < 8; ++j) { const int idx = lane + 64 * j, n = idx >> 3, c = idx & 7; const LAS unsigned* sp = (const LAS unsigned*)(tile + n * 132 + c * 16);
        u32x4 o; o.x = sp[0]; o.y = sp[1]; o.z = sp[2]; o.w = sp[3];
        const int gn = n0 + n; const int r = LA ? (C_LA + gn) : ((gn < N) ? tr_row(kind, gn) : -1);
        if (r >= 0) *(u32x4*)(Q + (size_t)r * 1024 + 128 * wave + 16 * c) = o; }
    if (wave == 0 && kg == 0) {
#pragma unroll
        for (int e = 0; e < 4; ++e) { const int gn = n0 + 4 * a + e; const int r = LA ? (C_LA + gn) : ((gn < N) ? tr_row(kind, gn) : -1); if (r >= 0) SW[r] = scl[e]; } }
    __syncthreads();
}

namespace lin {
constexpr int L_QL = 0, L_QU = 9216, L_KL = 18432, L_KU = 27648, L_KLT = 36864, L_VT = 46080, L_AM = 55296, L_ST = 64512, L_OUT = 73728, L_G = 90368, L_GL = 98560, L_END = 98816;
constexpr int NSEG = 16, LSEG = 8;
#define MFMA16(a, b, c) __builtin_amdgcn_mfma_f32_16x16x32_bf16(a, b, c, 0, 0, 0)
__device__ __forceinline__ bf16x8 frag(const LAS unsigned char* base, int pitchB, int r0, int ks, int lane) {
    return *(const LAS bf16x8*)(base + (r0 + (lane & 15)) * pitchB + (32 * ks + 8 * (lane >> 4)) * 2);
}
typedef short v4i16_t __attribute__((ext_vector_type(4)));
__device__ __forceinline__ bf16x8 trfrag(const LAS unsigned char* base, int pitchB, int k0, int n0, int lane) {
    const LAS unsigned char* p = base + (k0 + 8 * (lane >> 4) + ((lane & 15) >> 2)) * pitchB + (n0 + 4 * (lane & 3)) * 2;
    const s16x4 lo = __builtin_bit_cast(s16x4, __builtin_amdgcn_ds_read_tr16_b64_v4i16((LAS v4i16_t*)p));
    const s16x4 hi = __builtin_bit_cast(s16x4, __builtin_amdgcn_ds_read_tr16_b64_v4i16((LAS v4i16_t*)(p + 4 * pitchB)));
    return (bf16x8){lo[0], lo[1], lo[2], lo[3], hi[0], hi[1], hi[2], hi[3]};
}
template <int DK, bool RET, bool PH2>
__device__ __forceinline__ void unit(LAS unsigned char* lds, const bf16* P, unsigned char* MIX, const f32x2* csr, int b, int h, int seg,
                                     const float* b_a, const float* gnorm, float* Est, float* Aseg, const int g_wave) {
    constexpr int PQ = (DK + 8) * 2;
    constexpr int PS = 144;
    constexpr int NT = DK / 32;
    const int tid = otid(), lane = tid & 63, wid = __builtin_amdgcn_readfirstlane(tid >> 6);
    const int row = tid >> 3, c8 = tid & 7;
    const int entry = (b * 4 + h) * NSEG + seg;
    const float lng = RET ? __logf(1.0f - exp2f(-5.0f - (float)h)) : 0.f;
    const int cq = RET ? C_RQ + h * 64 : C_GQ + h * 32, ck = RET ? C_RK + h * 64 : C_GK + h * 32, cv = RET ? C_RV + h * 64 : C_GV + h * 64, cg = RET ? C_RG + h * 64 : C_GR + h * 64;
    f32x4 st[NT]; float ac[NT];
    int eb[NT], db[NT];
#pragma unroll
    for (int j = 0; j < NT; ++j) { const int i = wid + 8 * j; if (DK == 64) { eb[j] = i >> 2; db[j] = i & 3; } else { eb[j] = i >> 1; db[j] = i & 1; } st[j] = (f32x4){0.f, 0.f, 0.f, 0.f}; ac[j] = 1.f; }
    if (PH2) {
#pragma unroll 4
        for (int sp = 0; sp < seg; ++sp) { const int en = (b * 4 + h) * NSEG + sp;
#pragma unroll
            for (int j = 0; j < NT; ++j) { const int d = db[j] * 16 + (lane & 15); const float a = Aseg[(size_t)en * DK + d];
                { const f32x4 ev = *(const f32x4*)(Est + ((size_t)en * DK + d) * 64 + eb[j] * 16 + 4 * (lane >> 4)); st[j] = st[j] * a + ev; } } }
    }
    float gn8[8] = {0.f, 0.f, 0.f, 0.f, 0.f, 0.f, 0.f, 0.f}, ba4[4] = {0.f, 0.f, 0.f, 0.f};
    if (PH2) {
#pragma unroll
        for (int i = 0; i < 8; ++i) gn8[i] = gnorm[8 * c8 + i]; }
    if (!RET) {
#pragma unroll
        for (int i = 0; i < 4; ++i) ba4[i] = b_a[h * 32 + 4 * wid + i]; }
    u32x4 rq_ = (u32x4){0u, 0u, 0u, 0u}, rk_ = rq_, rq2_ = rq_, rk2_ = rq_, pv = rq_, pgt = rq_; f32x4 pcs[4]; u32x2 pla = (u32x2){0u, 0u};
#pragma unroll
    for (int i = 0; i < 4; ++i) pcs[i] = (f32x4){0.f, 0.f, 0.f, 0.f};
    const int d0 = 8 * c8; const bool qk_on = RET || c8 < 4;
#define LIN_LOAD(cc) do { const size_t mr_ = (size_t)b * SEQ + (size_t)(seg * LSEG + (cc)) * 64 + row; \
        if (!RET) pla = *(const u32x2*)(P + ((size_t)b * SEQ + (size_t)(seg * LSEG + (cc)) * 64 + lane) * NP + C_LA + h * 32 + 4 * wid); \
        if (qk_on) { rk_ = *(const u32x4*)(P + mr_ * NP + ck + d0); if (PH2) rq_ = *(const u32x4*)(P + mr_ * NP + cq + d0); \
            if (RET) { rk2_ = *(const u32x4*)(P + mr_ * NP + ck + (d0 ^ 32)); if (PH2) rq2_ = *(const u32x4*)(P + mr_ * NP + cq + (d0 ^ 32)); \
                const f32x4* cs4_ = (const f32x4*)(csr + mr_ * 32 + (d0 & 31)); pcs[0] = cs4_[0]; pcs[1] = cs4_[1]; pcs[2] = cs4_[2]; pcs[3] = cs4_[3]; } } \
        pv = *(const u32x4*)(P + mr_ * NP + cv + 8 * c8); if (PH2) pgt = *(const u32x4*)(P + mr_ * NP + cg + 8 * c8); } while (0)
    LIN_LOAD(0);
    for (int c = 0; c < LSEG; ++c) {
        const size_t m0 = (size_t)b * SEQ + (size_t)(seg * LSEG + c) * 64;
        if (!RET) {
            const u32x2 w = pla;
            float x[4] = {bflo(w.x), bfhi(w.x), bflo(w.y), bfhi(w.y)};
#pragma unroll
            for (int i = 0; i < 4; ++i) { const float z = x[i] + ba4[i]; float v = (fminf(z, 0.f) - log1pf(__expf(-fabsf(z)))) * (1.0f / 16.0f);
#pragma unroll
                for (int o = 1; o < 64; o <<= 1) { const float u = __int_as_float(__builtin_amdgcn_ds_bpermute((lane - o) << 2, __float_as_int(v))); if (lane >= o) v += u; }
                ((LAS float*)(lds + L_G))[lane * 32 + 4 * wid + i] = v; if (lane == 63) ((LAS float*)(lds + L_GL))[4 * wid + i] = v; }
            __syncthreads();
        }
        u32x4 gcur = pgt;
        {
            if (qk_on) {
                const u32x4 kw = rk_, qw = rq_;
                float qv[8], kv[8], eg[8], ieg[8];
                { const unsigned* qp = (const unsigned*)&qw; const unsigned* kp = (const unsigned*)&kw;
#pragma unroll
                  for (int i = 0; i < 4; ++i) { qv[2 * i] = bflo(qp[i]); qv[2 * i + 1] = bfhi(qp[i]); kv[2 * i] = bflo(kp[i]); kv[2 * i + 1] = bfhi(kp[i]); } }
                if (RET) {
                    const u32x4 kw2 = rk2_, qw2 = rq2_;
                    const unsigned* qp2 = (const unsigned*)&qw2; const unsigned* kp2 = (const unsigned*)&kw2;
                    const float g = (float)(row + 1) * lng; const float e1 = __expf(g), e2 = __expf(-g);
#pragma unroll
                    for (int i = 0; i < 4; ++i) { const f32x4 cc = pcs[i];
                        const float qa = bflo(qp2[i]), qb = bfhi(qp2[i]), ka = bflo(kp2[i]), kb = bfhi(kp2[i]);
                        if (c8 < 4) { const float q0 = qv[2 * i] * cc[0] - qa * cc[1], q1 = qv[2 * i + 1] * cc[2] - qb * cc[3]; const float k0 = kv[2 * i] * cc[0] - ka * cc[1], k1 = kv[2 * i + 1] * cc[2] - kb * cc[3];
                            qv[2 * i] = q0; qv[2 * i + 1] = q1; kv[2 * i] = k0; kv[2 * i + 1] = k1; }
                        else { const float q0 = qa * cc[1] + qv[2 * i] * cc[0], q1 = qb * cc[3] + qv[2 * i + 1] * cc[2]; const float k0 = ka * cc[1] + kv[2 * i] * cc[0], k1 = kb * cc[3] + kv[2 * i + 1] * cc[2];
                            qv[2 * i] = q0; qv[2 * i + 1] = q1; kv[2 * i] = k0; kv[2 * i + 1] = k1; } }
#pragma unroll
                    for (int i = 0; i < 8; ++i) { kv[i] *= 0.125f; eg[i] = e1; ieg[i] = e2; }
                } else {
#pragma unroll
                    for (int i = 0; i < 8; ++i) { const float g = ((const LAS float*)(lds + L_G))[row * 32 + d0 + i]; eg[i] = __expf(g); ieg[i] = __expf(-g); qv[i] *= 0.17677669529663687f; }
                }
                float kl[8];
#pragma unroll
                for (int i = 0; i < 8; ++i) kl[i] = kv[i] * ieg[i];
                if (PH2) {
                    u32x4 o;
                    o.x = pk2(qv[0] * eg[0], qv[1] * eg[1]); o.y = pk2(qv[2] * eg[2], qv[3] * eg[3]); o.z = pk2(qv[4] * eg[4], qv[5] * eg[5]); o.w = pk2(qv[6] * eg[6], qv[7] * eg[7]);
                    *(LAS u32x4*)(lds + L_QL + row * PQ + d0 * 2) = o;
                    o.x = pk2(qv[0] * ieg[0], qv[1] * ieg[1]); o.y = pk2(qv[2] * ieg[2], qv[3] * ieg[3]); o.z = pk2(qv[4] * ieg[4], qv[5] * ieg[5]); o.w = pk2(qv[6] * ieg[6], qv[7] * ieg[7]);
                    *(LAS u32x4*)(lds + L_QU + row * PQ + d0 * 2) = o;
                    o.x = pk2(kv[0] * eg[0], kv[1] * eg[1]); o.y = pk2(kv[2] * eg[2], kv[3] * eg[3]); o.z = pk2(kv[4] * eg[4], kv[5] * eg[5]); o.w = pk2(kv[6] * eg[6], kv[7] * eg[7]);
                    *(LAS u32x4*)(lds + L_KU + row * PQ + d0 * 2) = o;
                }
                { u32x4 o; o.x = pk2(kl[0], kl[1]); o.y = pk2(kl[2], kl[3]); o.z = pk2(kl[4], kl[5]); o.w = pk2(kl[6], kl[7]);
                  *(LAS u32x4*)(lds + L_KL + row * PQ + d0 * 2) = o; }
            }
            *(LAS u32x4*)(lds + L_VT + row * PS + c8 * 16) = pv;
        }
        if (c + 1 < LSEG) LIN_LOAD(c + 1);
        __syncthreads();
#pragma unroll
        for (int j = 0; j < NT; ++j) {
            const int d = db[j] * 16 + (lane & 15);
            if (PH2) {
#pragma unroll
                for (int r = 0; r < 4; ++r) { const int e = eb[j] * 16 + 4 * (lane >> 4) + r; *(LAS unsigned short*)(lds + L_ST + e * PQ + d * 2) = (unsigned short)(pk2(st[j][r], 0.f) & 0xffffu); }
            }
            f32x4 u = (f32x4){0.f, 0.f, 0.f, 0.f};
#pragma unroll
            for (int ks = 0; ks < 2; ++ks) u = MFMA16(trfrag(lds + L_VT, PS, 32 * ks, eb[j] * 16, lane), trfrag(lds + L_KL, PQ, 32 * ks, db[j] * 16, lane), u);
            const float egl = RET ? __expf(64.f * lng) : __expf(((const LAS float*)(lds + L_GL))[d]);
#pragma unroll
            for (int r = 0; r < 4; ++r) st[j][r] = egl * (st[j][r] + u[r]);
            ac[j] *= egl;
        }
        if (PH2) {
#pragma unroll
            for (int j = 0; j < 2; ++j) { const int i = wid + 8 * j, tb = i >> 2, sb = i & 3;
                f32x4 lo = (f32x4){0.f, 0.f, 0.f, 0.f}, up = (f32x4){0.f, 0.f, 0.f, 0.f};
                if (sb <= tb) {
#pragma unroll
                    for (int ks = 0; ks < DK / 32; ++ks) lo = MFMA16(frag(lds + L_QL, PQ, tb * 16, ks, lane), frag(lds + L_KL, PQ, sb * 16, ks, lane), lo); }
                if (sb >= tb) {
#pragma unroll
                    for (int ks = 0; ks < DK / 32; ++ks) up = MFMA16(frag(lds + L_QU, PQ, tb * 16, ks, lane), frag(lds + L_KU, PQ, sb * 16, ks, lane), up); }
                const int s = sb * 16 + (lane & 15);
#pragma unroll
                for (int r = 0; r < 4; ++r) { const int t = tb * 16 + 4 * (lane >> 4) + r; const float v = (s <= t) ? lo[r] : up[r];
                    *(LAS unsigned short*)(lds + L_AM + t * PS + s * 2) = (unsigned short)(pk2(v, 0.f) & 0xffffu); } }
        }
        __syncthreads();
        if (PH2) {
#pragma unroll
            for (int j = 0; j < 2; ++j) { const int i = wid + 8 * j, tb = i >> 2, ob = i & 3;
                f32x4 o = (f32x4){0.f, 0.f, 0.f, 0.f};
#pragma unroll
                for (int ks = 0; ks < 2; ++ks) o = MFMA16(frag(lds + L_AM, PS, tb * 16, ks, lane), trfrag(lds + L_VT, PS, 32 * ks, ob * 16, lane), o);
#pragma unroll
                for (int ks = 0; ks < DK / 32; ++ks) o = MFMA16(frag(lds + L_QL, PQ, tb * 16, ks, lane), frag(lds + L_ST, PQ, ob * 16, ks, lane), o);
#pragma unroll
                for (int r = 0; r < 4; ++r) ((LAS float*)(lds + L_OUT))[(tb * 16 + 4 * (lane >> 4) + r) * 65 + ob * 16 + (lane & 15)] = o[r]; }
            __syncthreads();
            { const size_t m = m0 + row; const int e0 = 8 * c8; float v[8]; float ss = 0.f;
#pragma unroll
              for (int i = 0; i < 8; ++i) { v[i] = ((const LAS float*)(lds + L_OUT))[row * 65 + e0 + i]; ss += v[i] * v[i]; }
              ss += sx<1>(ss); ss += sx<2>(ss); ss += sx<4>(ss);
              const float rstd = rsqrtf(ss * (1.0f / 64.0f) + EPS);
              const u32x4 gw = gcur; const unsigned* gp = (const unsigned*)&gw; float y[8];
#pragma unroll
              for (int i = 0; i < 4; ++i) { y[2 * i] = v[2 * i] * rstd * gn8[2 * i] * silu_f(bflo(gp[i])); y[2 * i + 1] = v[2 * i + 1] * rstd * gn8[2 * i + 1] * silu_f(bfhi(gp[i])); }
              const bool on = RET ? ((DBG_GROUPS & 1) != 0) : ((DBG_GROUPS & 4) != 0);
              u32x2 o; o.x = pk4_fp8(y[0] * FP8_ACT_SCALE, y[1] * FP8_ACT_SCALE, y[2] * FP8_ACT_SCALE, y[3] * FP8_ACT_SCALE); o.y = pk4_fp8(y[4] * FP8_ACT_SCALE, y[5] * FP8_ACT_SCALE, y[6] * FP8_ACT_SCALE, y[7] * FP8_ACT_SCALE);
              if (!on) o = (u32x2){0u, 0u};
              *(u32x2*)(MIX + m * DM + (RET ? 0 : 768) + h * 64 + e0) = o; }
        }
    }
#undef LIN_LOAD
    if (!PH2) {
#pragma unroll
        for (int j = 0; j < NT; ++j) { const int d = db[j] * 16 + (lane & 15);
            *(f32x4*)(Est + ((size_t)entry * DK + d) * 64 + eb[j] * 16 + 4 * (lane >> 4)) = st[j];
            if (eb[j] == 0 && (lane >> 4) == 0) Aseg[(size_t)entry * DK + d] = ac[j]; }
    }
    __syncthreads();
}
}

namespace att {
constexpr int A_K = 0, A_V = 24576, A_O0 = 0, A_LS = 73728, A_END = 75776;
#define MFMA32(a, b, c) __builtin_amdgcn_mfma_f32_32x32x16_bf16(a, b, c, 0, 0, 0)
typedef short v4i16_t __attribute__((ext_vector_type(4)));
__device__ __forceinline__ s16x4 vtr(const LAS unsigned char* p) { return __builtin_bit_cast(s16x4, __builtin_amdgcn_ds_read_tr16_b64_v4i16((LAS v4i16_t*)p)); }
__device__ __forceinline__ int crow(int r, int hi) { return (r & 3) + 8 * (r >> 2) + 4 * hi; }
__device__ __forceinline__ void unit(LAS unsigned char* lds, const bf16* P, const unsigned char* VT8, unsigned char* MIX, int b, int h, int jq, float lam, float negM, const float* subg, float oscale, const int g_wave) {
    const int tid = otid(), lane = tid & 63, r32 = lane & 31, hh = lane >> 5, wid = __builtin_amdgcn_readfirstlane(tid >> 6);
    const size_t rowbase = (size_t)b * SEQ;
    const int q0 = jq * 256 + wid * 32;
    const int ntile = 4 * jq + 4, my_nt = 4 * jq + (wid >> 1) + 1;
    const int krow = tid >> 3, kch = (tid & 7) ^ ((krow >> 1) & 7);
    const unsigned vgo = (unsigned)((tid >> 2) * 64 + (((tid & 3) ^ ((tid >> 4) & 3)) << 4));
    const unsigned ldsw = (unsigned)wid * 1024u;
    const unsigned vrd0 = (unsigned)(r32 * 64 + ((hh ^ ((r32 >> 2) & 3)) << 4)), vrd1 = (unsigned)(r32 * 64 + (((2 + hh) ^ ((r32 >> 2) & 3)) << 4));
    unsigned o0r[32];
#pragma unroll
    for (int i = 0; i < 32; ++i) o0r[i] = 0u;
#pragma unroll 1
    for (int comp = 0; comp < 2; ++comp) {
        bf16x8 qf[4];
        const char* Pb = (const char*)(P + rowbase * NP + h * 128);
        { const unsigned qo = (unsigned)(((q0 + r32) * NP + C_DQ + comp * 64 + hh * 8) * 2);
#pragma unroll
          for (int ks = 0; ks < 4; ++ks) qf[ks] = *(const bf16x8*)(Pb + qo + 32 * ks); }
        const unsigned kgo = (unsigned)((krow * NP + C_DK + comp * 64 + kch * 8) * 2);
        const char* Vtb = (const char*)(VT8 + (((size_t)b * 4 + h) * 128) * 8192);
        f32x16 o[4];
#pragma unroll
        for (int e = 0; e < 4; ++e)
#pragma unroll
            for (int r = 0; r < 16; ++r) o[e][r] = 0.f;
        float l = 0.f;
#define ATT_GLDS(sb, vo, dst) do { unsigned keep_; asm volatile("s_mov_b32 %0, m0\n\ts_mov_b32 m0, %3\n\ts_nop 0\n\tglobal_load_lds_dwordx4 %1, %2\n\ts_mov_b32 m0, %0" \
            : "=&s"(keep_) : "v"(vo), "s"(sb), "s"(dst) : "memory"); } while (0)
#define ATT_STAGE(buf, tt) do { const char* Pt = Pb + (size_t)(tt) * 64 * NP * 2; \
            ATT_GLDS(Pt, kgo, (unsigned)__builtin_amdgcn_readfirstlane((int)(ldsb + A_K + (buf) * 8192 + ldsw))); \
            ATT_GLDS(Vtb + (size_t)(tt) * 8192, vgo, (unsigned)__builtin_amdgcn_readfirstlane((int)(ldsb + A_V + (buf) * 16384 + ldsw))); } while (0)
        const unsigned ldsb = (unsigned)(size_t)lds;
        unsigned kro[4];
        const int kpi = (r32 & 3) + 4 * (r32 >> 3) + 16 * ((r32 >> 2) & 1);
#pragma unroll
        for (int ks = 0; ks < 4; ++ks) kro[ks] = (unsigned)(kpi * 128 + (((2 * ks + hh) ^ ((kpi >> 1) & 7)) << 4));
        ATT_STAGE(0, 0);
        if (ntile > 1) ATT_STAGE(1, 1);
        __builtin_amdgcn_s_waitcnt(0x0F70);
        VM_WAIT(); __syncthreads();
        int cur = 0, nx2 = 2;
        for (int t = 0; t < ntile; ++t) {
            const bool more = (t + 2 < ntile);
            if (more) ATT_STAGE(nx2, t + 2);
            if (t < my_nt) {
                const LAS unsigned char* Kb = lds + A_K + cur * 8192; const LAS unsigned char* Vb = lds + A_V + cur * 16384;
#define ATT_KF(j) (*(const LAS bf16x8*)(Kb + kro[(j) & 3] + ((j) >> 2) * 4096))
                bf16x8 kr[3]; kr[0] = ATT_KF(0); kr[1] = ATT_KF(1);
                const f32x16 m5 = {-5.f, -5.f, -5.f, -5.f, -5.f, -5.f, -5.f, -5.f, -5.f, -5.f, -5.f, -5.f, -5.f, -5.f, -5.f, -5.f};
                f32x16 s0, s1;
#pragma unroll
                for (int j = 0; j < 8; ++j) { if (j + 2 < 8) kr[(j + 2) % 3] = ATT_KF(j + 2);
                    if (j < 4) s0 = MFMA32(kr[j % 3], qf[j & 3], j == 0 ? m5 : s0); else s1 = MFMA32(kr[j % 3], qf[j & 3], j == 4 ? m5 : s1); }
                i32x4 va[4], vb[4];
#pragma unroll
                for (int e = 0; e < 4; ++e) { va[e] = *(const LAS i32x4*)(Vb + e * 2048 + vrd0); vb[e] = *(const LAS i32x4*)(Vb + e * 2048 + vrd1); }
#pragma unroll
                for (int r = 0; r < 16; ++r) { s0[r] = __builtin_amdgcn_exp2f(s0[r]); l += s0[r]; }
#pragma unroll
                for (int r = 0; r < 16; ++r) { s1[r] = __builtin_amdgcn_exp2f(s1[r]); l += s1[r]; }
                const i32x8 pf = {(int)pk4_fp8(s0[0], s0[1], s0[2], s0[3]), (int)pk4_fp8(s0[4], s0[5], s0[6], s0[7]), (int)pk4_fp8(s0[8], s0[9], s0[10], s0[11]), (int)pk4_fp8(s0[12], s0[13], s0[14], s0[15]),
                                  (int)pk4_fp8(s1[0], s1[1], s1[2], s1[3]), (int)pk4_fp8(s1[4], s1[5], s1[6], s1[7]), (int)pk4_fp8(s1[8], s1[9], s1[10], s1[11]), (int)pk4_fp8(s1[12], s1[13], s1[14], s1[15])};
#pragma unroll
                for (int e = 0; e < 4; ++e) { const i32x8 vf = {va[e][0], va[e][1], va[e][2], va[e][3], vb[e][0], vb[e][1], vb[e][2], vb[e][3]};
                    o[e] = __builtin_amdgcn_mfma_scale_f32_32x32x64_f8f6f4(pf, vf, o[e], 0, 0, 0, 127, 0, 124); }
#undef ATT_KF
            }
            if (more) asm volatile("s_waitcnt vmcnt(2)" ::: "memory"); else VM_WAIT();
            __syncthreads();
            cur = (cur == 2) ? 0 : cur + 1; nx2 = (nx2 == 2) ? 0 : nx2 + 1;
        }
#undef ATT_GLDS
#undef ATT_STAGE
        l = sum_halves(l);
        LAS float* ls = (LAS float*)(lds + A_LS) + wid * 64 + comp * 32;
        if (hh == 0) ls[r32] = l;
        LDS_WAIT(); asm volatile("" ::: "memory");
        float inv[16];
#pragma unroll
        for (int r = 0; r < 16; ++r) inv[r] = 1.0f / ls[crow(r, hh)];
        if (comp == 0) {
#pragma unroll
            for (int e = 0; e < 4; ++e)
#pragma unroll
                for (int i = 0; i < 8; ++i) o0r[e * 8 + i] = pk2(o[e][2 * i] * inv[2 * i], o[e][2 * i + 1] * inv[2 * i + 1]);
        } else {
            float ss[16];
#pragma unroll
            for (int r = 0; r < 16; ++r) ss[r] = 0.f;
#pragma unroll
            for (int e = 0; e < 4; ++e)
#pragma unroll
                for (int i = 0; i < 8; ++i) { const unsigned w = o0r[e * 8 + i];
                    const float v0 = bflo(w) - lam * o[e][2 * i] * inv[2 * i], v1 = bfhi(w) - lam * o[e][2 * i + 1] * inv[2 * i + 1];
                    o[e][2 * i] = v0; o[e][2 * i + 1] = v1; ss[2 * i] += v0 * v0; ss[2 * i + 1] += v1 * v1; }
#pragma unroll
            for (int r = 0; r < 16; ++r) { float s = ss[r]; s += sx<1>(s); s += sx<2>(s); s += sx<4>(s); s += sx<8>(s); s += sx<16>(s);
                ss[r] = rsqrtf(s * (1.0f / 128.0f) + EPS) * oscale; }
            LAS unsigned char* stg = lds + A_O0 + wid * 8192;
            const int lane_e = olane(), r32e = lane_e & 31;
            LDS_WAIT(); asm volatile("" ::: "memory");
#pragma unroll
            for (int e = 0; e < 4; ++e) { const float gsub = subg[32 * e + r32e] * FP8_ACT_SCALE;
#pragma unroll
                for (int r = 0; r < 16; r += 2) { const float y0 = ((DBG_GROUPS & 2) != 0) ? o[e][r] * ss[r] * gsub : 0.f, y1 = ((DBG_GROUPS & 2) != 0) ? o[e][r + 1] * ss[r + 1] * gsub : 0.f;
                    const int w = __builtin_amdgcn_cvt_pk_fp8_f32(y0, y1, 0, false);
                    *(LAS unsigned char*)(stg + crow(r, hh) * 128 + 32 * e + r32) = (unsigned char)(w & 0xff); *(LAS unsigned char*)(stg + crow(r + 1, hh) * 128 + 32 * e + r32) = (unsigned char)((w >> 8) & 0xff); } }
            LDS_WAIT(); asm volatile("" ::: "memory");
            { unsigned ob = (unsigned)((q0 + (lane_e >> 3)) * DM + 256 + (lane_e & 7) * 16); unsigned char* Mb = MIX + rowbase * DM + h * 128;
#pragma unroll
              for (int i = 0; i < 4; ++i) { const u32x4 w = *(const LAS u32x4*)(stg + ((lane_e >> 3) + 8 * i) * 128 + (lane_e & 7) * 16); *(u32x4*)(Mb + ob + i * 8 * DM) = w; } }
            LDS_WAIT(); asm volatile("" ::: "memory");
        }
    }
    __syncthreads();
}
}

struct Args { const float* in[25]; float* out; unsigned char* ws; int ph_lo, ph_hi; };
static_assert(sizeof(Args) == 27 * 8 + 8, "Args has no padding");
constexpr int NPHASE = 1 + 9 * DEPTH;

__global__ void __launch_bounds__(NWAVES * 64, 2) fwd(Args args) {
    extern __shared__ __attribute__((aligned(16))) unsigned char lds_raw[];
    LAS unsigned char* lds = (LAS unsigned char*)lds_raw;
    const int wave = __builtin_amdgcn_readfirstlane((int)threadIdx.x >> 6); const int g_wave = wave; const int tid0 = otid();
    const int G = gridDim.x; const int bx = blockIdx.x; const int vcu = (G % 8 == 0) ? (bx % 8) * (G / 8) + bx / 8 : bx;
    const int gw = vcu * NWAVES + wave, NGW = G * NWAVES;
    __builtin_assume(gw >= 0 && gw < 4096 && vcu >= 0 && vcu < 512 && G > 0 && G <= 512);
    unsigned char* ws = args.ws;
    unsigned* ctl = (unsigned*)(ws + WS_CTL);
    for (int u = tid0; u < (LDS_BYTES - LDSCTL_OFF) / 4; u += NWAVES * 64) ((LAS unsigned*)(lds + LDSCTL_OFF))[u] = 0u;
    __syncthreads();
    XcdBarrier bar; bar.bar = ctl + CW_BAR; bar.x = 0; bar.st = nullptr;
    if (MK_N_LAUNCHES == 1) bar = xcd_barrier_post(ctl + CW_BAR, (volatile LAS unsigned*)(lds + MISC_OFF) + 8, tid0 == 0);
    const int lo = args.ph_lo, hi = args.ph_hi;
#ifndef PHMASK
#define PHMASK 0x3ff
#endif
#define IN(k) (lo <= (k) && (k) < hi)
#define PHON(j) ((PHMASK >> (j)) & 1)
#define SEAM(k) do { if (IN(k) && IN((k) + 1)) { xcd_barrier(bar, otid() == 0); if (RPT_PHASE == 90) { xcd_barrier(bar, otid() == 0); xcd_barrier(bar, otid() == 0); } } } while (0)
    if (tid0 == 0) {
#pragma unroll
        for (int k = 0; k < 25; ++k) ((LAS unsigned long long*)(lds + PTR_OFF))[k] = (unsigned long long)args.in[k];
        ((LAS unsigned long long*)(lds + PTR_OFF))[25] = (unsigned long long)args.out;
    }
    __syncthreads();
#define WSP(Tp, off) ((Tp*)(wsl + (off)))
#define WSL() unsigned char* wsl = ws; asm volatile("" : "+s"(wsl))

    if (PHON(0) && IN(0)) {
        const int tid = otid(), lane = tid & 63; WSL();
        const float* c_in = INF(1); const int* pos_in = (const int*)INF(2); const float* w_mod = INF(3); const float* b_mod = INF(4); const float* w_in = INF(7);
        const float* diff_q_g = INF(9); const float* diff_k_g = INF(10); const float* lam_q1 = INF(11); const float* lam_k1 = INF(12); const float* lam_q2 = INF(13); const float* lam_k2 = INF(14);
        const float* gla_w_a2 = INF(16); const float* w_out = INF(19); const float* w_gate = INF(22); const float* w_up = INF(23); const float* w_down = INF(24);
        float* mod = WSP(float, WS_MOD); float* scal = WSP(float, WS_SCAL); f32x2* csr = WSP(f32x2, WS_CSR); f32x2* csd = WSP(f32x2, WS_CSD);
        LAS unsigned char* scr = lds + wave * 8704;
        LAS float* sact = (LAS float*)(lds + 69632);
        for (int i = tid; i < 8 * 1024; i += NWAVES * 64) sact[i] = silu_f(c_in[i]);
        __syncthreads();
        { unsigned char* Winq = WSP(unsigned char, WS_WIN); float* swin = WSP(float, WS_SWIN);
          constexpr int U_WIN = 2 * 53, U_LA = 4, U_W1 = 2 * 32 * 16;
#pragma unroll 1
          for (int bu = vcu; bu < U_WIN; bu += G) { const int l = bu / 53, st = bu % 53; quant_strip<false>(lds, w_in + (size_t)l * 1024 * IN_W, IN_W, 64 * st, Winq + (size_t)l * NP * 1024, swin + l * NP, 1, nullptr, wave, lane); }
#pragma unroll 1
          for (int bu = vcu; bu < U_W1; bu += G) { const int le = bu >> 4, st = bu & 15;
              quant_strip<false>(lds, (st < 8 ? w_gate : w_up) + (size_t)le * 1024 * 512, 512, 64 * (st & 7), WSP(unsigned char, WS_W1) + (size_t)le * 1024 * 1024, WSP(float, WS_SW1) + (size_t)le * 1024, st < 8 ? 2 : 3, nullptr, wave, lane); }
#pragma unroll 1
          for (int bu = G - 1 - vcu; bu < U_LA; bu += G) { const int l = bu >> 1, st = bu & 1; quant_strip<true>(lds, w_in + (size_t)l * 1024 * IN_W, IN_W, 64 * st, Winq + (size_t)l * NP * 1024, swin + l * NP, 1, gla_w_a2 + (size_t)l * 16 * 128, wave, lane); }
        }
        constexpr int I_MOD = 2 * 384, I_TABR = 1024, I_TABD = 1024, I_ZERO = 256, I_SC = 2;
        constexpr int I_WOUT = 16 * 16, I_DN = 8 * 16, I_LAYER = I_WOUT + 32 * I_DN;
        constexpr int I_PRE = I_MOD + I_TABR + I_TABD + I_ZERO + I_SC, NITEMS = I_PRE + 2 * I_LAYER;
        _Pragma("unroll 1") for (int rep_ = 0; rep_ < 1 + (RPT_PHASE == 100 ? RPT_N : 0); ++rep_)
        for (int it = gw; it < NITEMS; it += NGW) {
            int r = it;
            if (r < I_MOD) {
                const int l = r / 384, col = (r % 384) * 16 + (lane & 15), ks = lane >> 4;
                float acc[8] = {0.f, 0.f, 0.f, 0.f, 0.f, 0.f, 0.f, 0.f};
                const float* wp = w_mod + (size_t)l * 1024 * 6144 + col;
#pragma unroll 16
                for (int k = ks; k < 1024; k += 4) { const float w = wp[(size_t)k * 6144];
#pragma unroll
                    for (int b = 0; b < 8; ++b) acc[b] += sact[b * 1024 + k] * w; }
#pragma unroll
                for (int b = 0; b < 8; ++b) { float a = acc[b]; a += sx<16>(a); a = sum_halves(a); if (ks == 0) mod[((size_t)l * 8 + b) * 6144 + col] = a + b_mod[l * 6144 + col]; }
                continue; }
            r -= I_MOD;
            if (r < I_TABR) {
                const int i = lane & 31; const float inv_freq = exp2f(-((float)i * (1.0f / 32.0f)) * 13.287712379549449f);
                for (int s = 0; s < 32; ++s) { const int t = r * 64 + 2 * s + (lane >> 5); const float ang = (float)pos_in[t] * inv_freq; float sn, cs; sincosf(ang, &sn, &cs); csr[(size_t)t * 32 + i] = (f32x2){cs, sn}; }
                continue; }
            r -= I_TABR;
            if (r < I_TABD) {
                const int i = lane & 7; const float inv_freq = exp2f(-((float)i * (1.0f / 8.0f)) * 18.931568569324174f);
                for (int s = 0; s < 8; ++s) { const int t = r * 64 + 8 * s + (lane >> 3); const float ang = (float)pos_in[t] * inv_freq; float sn, cs; sincosf(ang, &sn, &cs); csd[(size_t)t * 8 + i] = (f32x2){cs, sn}; }
                continue; }
            r -= I_TABD;
            if (r < I_ZERO) {
                const int l = r >> 7, j = r & 127; u32x4* p = (u32x4*)(WSP(unsigned char, WS_WIN) + ((size_t)l * NP + C_PAD + j) * 1024);
                p[lane] = (u32x4){0u, 0u, 0u, 0u}; if (lane == 0) WSP(float, WS_SWIN)[l * NP + C_PAD + j] = 1.0f;
                continue; }
            r -= I_ZERO;
            if (r < I_SC) {
                const int l = r; const float s1 = wave_sum(lam_q1[l * 64 + lane] * lam_k1[l * 64 + lane]), s2 = wave_sum(lam_q2[l * 64 + lane] * lam_k2[l * 64 + lane]);
                const float mq = wave_max(fabsf(diff_q_g[l * 64 + lane])), mk = wave_max(fabsf(diff_k_g[l * 64 + lane]));
                const float lam_init = 0.8f - 0.6f * expf(-0.3f * (float)l);
                if (lane == 0) { scal[l * 4 + 0] = expf(s1) - expf(s2) + lam_init; scal[l * 4 + 1] = -(8.0f * mq * mk * LOG2E + 0.5f); scal[l * 4 + 2] = 1.0f - lam_init; }
                continue; }
            r -= I_SC;
            const int l = r / I_LAYER; r -= l * I_LAYER;
            if (r < I_WOUT) { tr_item8(w_out + (size_t)l * 1024 * 1024, 1024, 1024, WSP(unsigned char, WS_WOUT) + (size_t)l * 1024 * 1024, 1024, scr, r, lane); continue; } r -= I_WOUT;
            const int e = r / I_DN; r -= e * I_DN; const size_t le = (size_t)l * 32 + e;
            tr_item8(w_down + le * 512 * 1024, 512, 1024, WSP(unsigned char, WS_W2) + le * 1024 * 512, 512, scr, r, lane);
        }
        __syncthreads();
    }
    SEAM(0);

    for (int l = 0; l < DEPTH; ++l) {
        const int pb = 1 + 9 * l;
#define MODL (WSP(const float, WS_MOD) + (size_t)l * 8 * 6144)
        if (PHON(1) && IN(pb + 0)) {
            const int tid = otid(), lane = tid & 63; (void)tid; (void)lane; WSL();
            const float* xf = (l == 0) ? INF(0) : nullptr; const bf16* XB = WSP(const bf16, WS_XB); const float* modl = MODL; const float* norm1_g = INF(5); unsigned char* ACTq = WSP(unsigned char, WS_ACT); float* sa1 = WSP(float, WS_SA1);
            const float* g1 = norm1_g + l * 1024;
            _Pragma("unroll 1") for (int rep_ = 0; rep_ < 1 + (RPT_PHASE == 1 ? RPT_N : 0); ++rep_)
            for (int m0 = gw; m0 < T; m0 += 4 * NGW) {
                f32x4 v[4][4];
#pragma unroll
                for (int q = 0; q < 4; ++q) { const int mq = m0 + q * NGW, m = mq < T ? mq : T - 1;
#pragma unroll
                    for (int j = 0; j < 4; ++j) v[q][j] = ldx4(xf, XB, (size_t)m * DM + 4 * lane + 256 * j); }
#pragma unroll
                for (int q = 0; q < 4; ++q) { const int m = m0 + q * NGW; if (m < T) {
                    const int b = m >> 13; const float* mb = modl + (size_t)b * 6144; float s = 0.f;
#pragma unroll
                    for (int j = 0; j < 4; ++j) s += (v[q][j][0] * v[q][j][0] + v[q][j][1] * v[q][j][1]) + (v[q][j][2] * v[q][j][2] + v[q][j][3] * v[q][j][3]);
                    const float rstd = rsqrtf(wave_sum(s) * (1.0f / 1024.0f) + EPS);
                    f32x4 y[4]; float am = 0.f;
#pragma unroll
                    for (int j = 0; j < 4; ++j) { const int k = 4 * lane + 256 * j; const f32x4 gg = *(const f32x4*)(g1 + k), sh = *(const f32x4*)(mb + k), sc = *(const f32x4*)(mb + 1024 + k);
                        y[j] = v[q][j] * rstd * gg * (sc + 1.0f) + sh; am = fmaxf(am, fmaxf(fmaxf(fabsf(y[j][0]), fabsf(y[j][1])), fmaxf(fabsf(y[j][2]), fabsf(y[j][3])))); }
                    am = wave_max(am); const float inv = am > 0.f ? 127.0f / am : 0.f;
                    if (lane == 0) sa1[m] = am > 0.f ? am * (1.0f / 127.0f) : 1.0f;
                    unsigned* o4 = (unsigned*)(ACTq + (size_t)m * 1024) + lane;
#pragma unroll
                    for (int j = 0; j < 4; ++j) { unsigned w = 0u;
#pragma unroll
                        for (int e = 0; e < 4; ++e) w |= ((unsigned)(int)__builtin_rintf(y[j][e] * inv) & 0xffu) << (8 * e);
                        o4[64 * j] = w; } } }
            }
        }
        SEAM(pb + 0);
        if (PHON(2) && IN(pb + 1)) {
            const int tid = otid(), lane = tid & 63; (void)tid; (void)lane; WSL();
            bf16* ACT = WSP(bf16, WS_ACT); bf16* P = WSP(bf16, WS_P);
            pg8::Gemm g{ACT, (const bf16*)(WSP(unsigned char, WS_WIN) + (size_t)l * NP * 1024), 512, 512, 512}; pg8::StaticOrder<T / 256, NP / 256> S; S.init(G, bx);
            pg8::EpiInproj E{P, NP, WSP(const float, WS_SA1), WSP(const float, WS_SWIN) + l * NP, INF(9) + l * 64, INF(10) + l * 64, WSP(const f32x2, WS_CSD), WSP(unsigned char, WS_VT8)};
            _Pragma("unroll 1") for (int rep_ = 0; rep_ < 1 + (RPT_PHASE == 2 ? RPT_N : 0); ++rep_)
            pg8::gemm_phase<pg8::EpiInproj, pg8::StaticOrder<T / 256, NP / 256>, 0, 1>(lds, g, S, E, g_wave);
        }
        SEAM(pb + 1);
        if (PHON(3) && IN(pb + 2)) {
            const int tid = otid(), lane = tid & 63; (void)tid; (void)lane; WSL();
            const float* diff_q_g = INF(9); const float* diff_k_g = INF(10); const float* gla_b_a = INF(17); bf16* P = WSP(bf16, WS_P); unsigned char* ACT = WSP(unsigned char, WS_ACT); f32x2* csr = WSP(f32x2, WS_CSR);
            float* Eret = WSP(float, WS_EST); float* Egla = WSP(float, WS_EGL); float* Asr = WSP(float, WS_ASR); float* Asg = WSP(float, WS_ASG);
            _Pragma("unroll 1") for (int rep_ = 0; rep_ < 1 + (RPT_PHASE == 31 ? RPT_N : 0); ++rep_)
            for (int u = vcu; u < 1024; u += G) {
                const int r = u & 511, bh = r >> 4, seg = r & 15;
                if (u < 512) lin::unit<64, true, false>(lds, P, ACT, csr, bh >> 2, bh & 3, seg, nullptr, nullptr, Eret, Asr, g_wave);
                else lin::unit<32, false, false>(lds, P, ACT, csr, bh >> 2, bh & 3, seg, gla_b_a + l * 128, nullptr, Egla, Asg, g_wave);
            }
        }
        SEAM(pb + 2);
        if (PHON(4) && IN(pb + 3)) {
            const int tid = otid(), lane = tid & 63; (void)tid; (void)lane; WSL();
            const float* scal = WSP(const float, WS_SCAL); const float* diff_sub_g = INF(15); const float* ret_norm_g = INF(8); const float* gla_norm_g = INF(18); const float* gla_b_a = INF(17); bf16* P = WSP(bf16, WS_P); unsigned char* ACT = WSP(unsigned char, WS_ACT); f32x2* csr = WSP(f32x2, WS_CSR);
            float* Eret = WSP(float, WS_EST); float* Egla = WSP(float, WS_EGL); float* Asr = WSP(float, WS_ASR); float* Asg = WSP(float, WS_ASG);
            const float lam = scal[l * 4 + 0], negM = scal[l * 4 + 1], osc = scal[l * 4 + 2];
#ifndef NO_ATT
            _Pragma("unroll 1") for (int rep_ = 0; rep_ < 1 + (RPT_PHASE == 41 ? RPT_N : 0); ++rep_)
            for (int pu = vcu; pu < 512; pu += G) {
                const int bh = pu >> 4, jp = pu & 15;
                att::unit(lds, P, WSP(const unsigned char, WS_VT8), ACT, bh >> 2, bh & 3, jp, lam, negM, diff_sub_g + l * 128, osc, g_wave);
                att::unit(lds, P, WSP(const unsigned char, WS_VT8), ACT, bh >> 2, bh & 3, 31 - jp, lam, negM, diff_sub_g + l * 128, osc, g_wave);
            }
#endif
#ifndef NO_LIN2
            _Pragma("unroll 1") for (int rep_ = 0; rep_ < 1 + ((RPT_PHASE == 42 || RPT_PHASE == 43 || RPT_PHASE == 44) ? RPT_N : 0); ++rep_)
            for (int u = vcu + ((RPT_PHASE == 44 && rep_ > 0) ? 512 : 0); u < ((RPT_PHASE == 43 && rep_ > 0) ? 512 : 1024); u += G) {
                const int r = u & 511, bh = r >> 4, seg = ((r & 15) + 8 * (r >> 8) + (u < 512 ? 0 : 4)) & 15;
                if (u < 512) lin::unit<64, true, true>(lds, P, ACT, csr, bh >> 2, bh & 3, seg, nullptr, ret_norm_g + l * 64, Eret, Asr, g_wave);
                else lin::unit<32, false, true>(lds, P, ACT, csr, bh >> 2, bh & 3, seg, gla_b_a + l * 128, gla_norm_g + l * 64, Egla, Asg, g_wave);
            }
#endif
        }
        SEAM(pb + 3);
        if (PHON(5) && IN(pb + 4)) {
            const int tid = otid(), lane = tid & 63; (void)tid; (void)lane; WSL();
            const float* modl = MODL;
            pg8::Gemm g{WSP(const bf16, WS_ACT), (const bf16*)(WSP(unsigned char, WS_WOUT) + (size_t)l * 1024 * 1024), 512, 512, 512}; pg8::StaticOrder<T / 256, 4> S; S.init(G, bx);
            pg8::EpiResid E{(l == 0) ? INF(0) : nullptr, WSP(bf16, WS_XB), modl + 2048};
            _Pragma("unroll 1") for (int rep_ = 0; rep_ < 1 + ((RPT_PHASE == 5 && l == 0) ? RPT_N : 0); ++rep_)
            pg8::gemm_phase<pg8::EpiResid, pg8::StaticOrder<T / 256, 4>, 0, 2>(lds, g, S, E, g_wave);
        }
        SEAM(pb + 4);
        if (PHON(6) && IN(pb + 5)) {
            const int tid = otid(), lane = tid & 63; (void)tid; (void)lane; WSL();
            const float* modl = MODL; const float* router_w = INF(20); const float* router_b = INF(21); const float* norm2_g = INF(6); const bf16* XB = WSP(const bf16, WS_XB); bf16* ACT = WSP(bf16, WS_ACT); int* tokinfo = WSP(int, WS_ROUTE); int* tokS = WSP(int, WS_TOKS); unsigned char* h2q = WSP(unsigned char, WS_H2Q); float* sa2 = WSP(float, WS_SA2);
            constexpr int WR_PITCH = 2064, LG_OFF = 32 * WR_PITCH;
            _Pragma("unroll 1") for (int rep_ = 0; rep_ < 1 + (RPT_PHASE == 6 ? RPT_N : 0); ++rep_) {
            { f32x4 rw[2][8];
#pragma unroll
              for (int q = 0; q < 2; ++q)
#pragma unroll
                  for (int j = 0; j < 8; ++j) rw[q][j] = *(const f32x4*)(router_w + (size_t)(tid + 512 * q) * 32 + 4 * j);
#pragma unroll
              for (int q = 0; q < 2; ++q)
#pragma unroll
                  for (int j = 0; j < 8; ++j)
#pragma unroll
                      for (int e = 0; e < 4; ++e) *(LAS unsigned short*)(lds + (4 * j + e) * WR_PITCH + (tid + 512 * q) * 2) = (unsigned short)(pk2(rw[q][j][e], 0.f) & 0xffffu); }
            LAS unsigned* lcnt = (LAS unsigned*)(lds + 83968);
            if (tid < 64) lcnt[tid] = 0u;
            { int Gl = G; asm volatile("" : "+s"(Gl));
#pragma unroll 1
              for (int i = bx * NWAVES * 64 + tid; i < TPAD; i += Gl * NWAVES * 64) tokS[i] = -1; }
            __syncthreads();
            const float* g2 = norm2_g + l * 1024;
            LAS float* lg = (LAS float*)(lds + LG_OFF + wave * 2112);
            for (int gi = gw; gi < T / 16; gi += NGW) {
                for (int r4 = 0; r4 < 16; r4 += 4) {
                    f32x4 v[4][4];
#pragma unroll
                    for (int q = 0; q < 4; ++q) {
#pragma unroll
                        for (int j = 0; j < 4; ++j) v[q][j] = ldx4(nullptr, XB, (size_t)(gi * 16 + r4 + q) * DM + 4 * lane + 256 * j); }
#pragma unroll
                    for (int q = 0; q < 4; ++q) { const int m = gi * 16 + r4 + q; const int b = m >> 13; const float* mb = modl + (size_t)b * 6144 + 3072; float s = 0.f;
#pragma unroll
                        for (int j = 0; j < 4; ++j) s += (v[q][j][0] * v[q][j][0] + v[q][j][1] * v[q][j][1]) + (v[q][j][2] * v[q][j][2] + v[q][j][3] * v[q][j][3]);
                        const float rstd = rsqrtf(wave_sum(s) * (1.0f / 1024.0f) + EPS);
                        u32x2* o8 = (u32x2*)(ACT + (size_t)m * DM) + lane; f32x4 y[4]; float am = 0.f;
#pragma unroll
                        for (int j = 0; j < 4; ++j) { const int k = 4 * lane + 256 * j; const f32x4 gg = *(const f32x4*)(g2 + k), sh = *(const f32x4*)(mb + k), sc = *(const f32x4*)(mb + 1024 + k);
                            y[j] = v[q][j] * rstd * gg * (sc + 1.0f) + sh; u32x2 w; w.x = pk2(y[j][0], y[j][1]); w.y = pk2(y[j][2], y[j][3]); o8[64 * j] = w;
                            am = fmaxf(am, fmaxf(fmaxf(fabsf(y[j][0]), fabsf(y[j][1])), fmaxf(fabsf(y[j][2]), fabsf(y[j][3])))); }
                        am = wave_max(am); const float inv = am > 0.f ? 127.0f / am : 0.f;
                        if (lane == 0) sa2[m] = am > 0.f ? am * (1.0f / 127.0f) : 1.0f;
                        unsigned* o4 = (unsigned*)(h2q + (size_t)m * 1024) + lane;
#pragma unroll
                        for (int j = 0; j < 4; ++j) { unsigned w = 0u;
#pragma unroll
                            for (int e = 0; e < 4; ++e) w |= ((unsigned)(int)__builtin_rintf(y[j][e] * inv) & 0xffu) << (8 * e);
                            o4[64 * j] = w; } }
                }
                VM_WAIT();
                f32x4 a0 = (f32x4){0.f, 0.f, 0.f, 0.f}, a1 = a0;
                const bf16* ap = ACT + (size_t)(gi * 16 + (lane & 15)) * DM + 8 * (lane >> 4);
#pragma unroll 16
                for (int ks = 0; ks < 32; ++ks) { const bf16x8 a = *(const bf16x8*)(ap + 32 * ks);
                    const bf16x8 b0 = *(const LAS bf16x8*)(lds + (lane & 15) * WR_PITCH + (32 * ks + 8 * (lane >> 4)) * 2), b1 = *(const LAS bf16x8*)(lds + (16 + (lane & 15)) * WR_PITCH + (32 * ks + 8 * (lane >> 4)) * 2);
                    a0 = MFMA16(a, b0, a0); a1 = MFMA16(a, b1, a1); }
#pragma unroll
                for (int r = 0; r < 4; ++r) { lg[(4 * (lane >> 4) + r) * 33 + (lane & 15)] = a0[r]; lg[(4 * (lane >> 4) + r) * 33 + 16 + (lane & 15)] = a1[r]; }
                LDS_WAIT(); asm volatile("" ::: "memory");
                if (lane < 16) {
                    const int m = gi * 16 + lane; float best = -3.0e38f; int bcls = 0; float bwa = 0.f, bwb = 0.f;
#pragma unroll
                    for (int g = 0; g < 8; ++g) {
                        float s[4], a[4];
#pragma unroll
                        for (int i = 0; i < 4; ++i) { s[i] = 1.0f / (1.0f + __expf(-lg[lane * 33 + 4 * g + i])); a[i] = s[i] + router_b[4 * g + i]; }
                        int i1 = 0; float v1 = a[0];
                        if (a[1] > v1) { v1 = a[1]; i1 = 1; } if (a[2] > v1) { v1 = a[2]; i1 = 2; } if (a[3] > v1) { v1 = a[3]; i1 = 3; }
                        int i2 = -1; float v2 = -3.0e38f;
                        if (i1 != 0 && a[0] > v2) { v2 = a[0]; i2 = 0; } if (i1 != 1 && a[1] > v2) { v2 = a[1]; i2 = 1; } if (i1 != 2 && a[2] > v2) { v2 = a[2]; i2 = 2; } if (i1 != 3 && a[3] > v2) { v2 = a[3]; i2 = 3; }
                        const float gsum = v1 + v2;
                        const int ea = i1 < i2 ? i1 : i2, eb = i1 < i2 ? i2 : i1;
                        const float sa = ea == 0 ? s[0] : (ea == 1 ? s[1] : s[2]), sb = eb == 1 ? s[1] : (eb == 2 ? s[2] : s[3]);
                        const int pidx = (ea * (7 - ea)) / 2 + (eb - ea - 1);
                        if (gsum > best) { best = gsum; bcls = g * 6 + pidx; const float den = 1.0f / (sa + sb); bwa = sa * den; bwb = sb * den; }
                    }
                    const unsigned rank = __hip_atomic_fetch_add(lcnt + bcls, 1u, __ATOMIC_RELAXED, __HIP_MEMORY_SCOPE_WORKGROUP);
                    *(u32x4*)(tokinfo + (size_t)m * 4) = (u32x4){(unsigned)bcls, rank, __float_as_uint(bwa), __float_as_uint(bwb)};
                }
                LDS_WAIT(); asm volatile("" ::: "memory");
            }
            __syncthreads();
            if (tid < 64) WSP(int, WS_CNTB)[((size_t)l * 512 + vcu) * 64 + tid] = tid < NCLS ? (int)lcnt[tid] : 0;
            __syncthreads();
            }
        }
        SEAM(pb + 5);
        if (PHON(7) && IN(pb + 6)) {
            const int tid = otid(), lane = tid & 63; (void)tid; (void)lane; WSL();
            const unsigned char* h2q = WSP(const unsigned char, WS_H2Q); unsigned char* H2S = WSP(unsigned char, WS_H2S); const float* sa2 = WSP(const float, WS_SA2); float* saS = WSP(float, WS_SAS); int* tokinfo = WSP(int, WS_ROUTE); int* tokS = WSP(int, WS_TOKS); float* gaS = WSP(float, WS_GAS); float* gbS = WSP(float, WS_GBS); int* tinfo = WSP(int, WS_TINFO);
            LAS int* cst = (LAS int*)lds;
            LAS int* base = (LAS int*)(lds + 1024);
            { const int* cntb = WSP(const int, WS_CNTB) + (size_t)l * 512 * 64;
              for (int i = tid; i < G * NCLS; i += NWAVES * 64) { const int b = i / NCLS, c = i - b * NCLS; base[i] = cntb[b * 64 + c]; }
              __syncthreads();
              if (tid < NCLS) { int run = 0; for (int b = 0; b < G; ++b) { const int n = base[b * NCLS + tid]; base[b * NCLS + tid] = run; run += n; } cst[64 + tid] = run; }
              __syncthreads(); }
            if (tid == 0) { int s = 0, nt = 0;
                for (int c = 0; c < NCLS; ++c) { const int n = cst[64 + c]; cst[c] = s; const int tl = (n + 255) >> 8;
                    if (bx == 0) { const int g = c / 6, p = c % 6; const int a = p < 3 ? 0 : (p < 5 ? 1 : 2); const int bb = p < 3 ? p + 1 : (p < 5 ? p - 1 : 3); const int code = (g * 4 + a) | ((g * 4 + bb) << 8);
                        for (int i = 0; i < tl; ++i) tinfo[1 + nt + i] = code; }
                    nt += tl; s += tl * 256; }
                if (bx == 0) tinfo[0] = nt; }
            __syncthreads();
            _Pragma("unroll 1") for (int rep_ = 0; rep_ < 1 + (RPT_PHASE == 7 ? RPT_N : 0); ++rep_)
            for (int m = gw; m < T; m += NGW) {
                const u32x4 inf = *(const u32x4*)(tokinfo + (size_t)m * 4);
                const int pbk = ((m >> 4) % NGW) >> 3;
                const int slot = cst[inf.x] + base[pbk * NCLS + (int)inf.x] + (int)inf.y;
                const u32x4* src = (const u32x4*)(h2q + (size_t)m * 1024); u32x4* dst = (u32x4*)(H2S + (size_t)slot * 1024);
                dst[lane] = src[lane];
                if (lane == 0) { tokS[slot] = m; gaS[slot] = __uint_as_float(inf.z); gbS[slot] = __uint_as_float(inf.w); saS[slot] = sa2[m]; }
            }
            __syncthreads();
        }
        SEAM(pb + 6);
        if (PHON(8) && IN(pb + 7)) {
            const int tid = otid(), lane = tid & 63; (void)tid; (void)lane; WSL();
            bf16* H2S = WSP(bf16, WS_H2S); unsigned char* U = WSP(unsigned char, WS_U); float* gaS = WSP(float, WS_GAS); float* gbS = WSP(float, WS_GBS); int* tinfo = WSP(int, WS_TINFO);
            pg8::Gemm g{H2S, (const bf16*)(WSP(unsigned char, WS_W1) + (size_t)l * 32 * 1024 * 1024), 512, 512, 512}; pg8::MoeOrder<8, 1> S{tinfo, G, vcu};
            pg8::EpiMoe1 E{U, gaS, gbS, WSP(const float, WS_SAS), WSP(const float, WS_SW1) + (size_t)l * 32 * 1024};
            _Pragma("unroll 1") for (int rep_ = 0; rep_ < 1 + (RPT_PHASE == 8 ? RPT_N : 0); ++rep_)
            pg8::gemm_phase<pg8::EpiMoe1, pg8::MoeOrder<8, 1>, 0, 1>(lds, g, S, E, g_wave);
        }
        SEAM(pb + 7);
        if (PHON(9) && IN(pb + 8)) {
            const int tid = otid(), lane = tid & 63; (void)tid; (void)lane; WSL();
            const float* modl = MODL; int* tokS = WSP(int, WS_TOKS); int* tinfo = WSP(int, WS_TINFO);
            pg8::Gemm g{WSP(const bf16, WS_U), (const bf16*)(WSP(unsigned char, WS_W2) + (size_t)l * 32 * 1024 * 512), 512, 512, 256}; pg8::MoeOrder<4, 2> S{tinfo, G, vcu};
            _Pragma("unroll 1") for (int rep_ = (RPT_PHASE == 9 ? 0 : 1); rep_ < 2; ++rep_) {
            pg8::EpiMoe2 E{WSP(bf16, WS_XB), (l == DEPTH - 1) ? (float*)INF(25) : nullptr, tokS, modl + 5 * 1024, rep_ == 0 ? 1 : 0};
            pg8::gemm_phase<pg8::EpiMoe2, pg8::MoeOrder<4, 2>, 4, 2>(lds, g, S, E, g_wave); }
        }
        SEAM(pb + 8);
    }
#undef IN
#undef SEAM
}

extern "C" void kernel_launch(void* const* d_in, const int* in_sizes, int n_in, void* d_out, int out_size, void* d_ws, size_t ws_size, hipStream_t stream) {
    static int grid = 0;
    if (grid == 0) {
        if (n_in != 25 || in_sizes[0] != T * DM || out_size != T * DM || ws_size < WS_END) { fprintf(stderr, "kernel_launch: unexpected shapes (n_in %d, in0 %d, out %d, ws %zu < %zu)\n", n_in, n_in > 0 ? in_sizes[0] : -1, out_size, ws_size, (size_t)WS_END); grid = -1; return; }
        int dev = 0, cus = 0, per_cu = 0;
        if (hipGetDevice(&dev) != hipSuccess || hipDeviceGetAttribute(&cus, hipDeviceAttributeMultiprocessorCount, dev) != hipSuccess) { grid = -1; return; }
        if (hipFuncSetAttribute((const void*)fwd, hipFuncAttributeMaxDynamicSharedMemorySize, LDS_BYTES) != hipSuccess) { fprintf(stderr, "kernel_launch: hipFuncSetAttribute failed\n"); grid = -1; return; }
        if (hipOccupancyMaxActiveBlocksPerMultiprocessor(&per_cu, (const void*)fwd, NWAVES * 64, LDS_BYTES) != hipSuccess || per_cu < 1) fprintf(stderr, "kernel_launch: occupancy query reports %d\n", per_cu);
        (void)hipGetLastError();
        grid = cus;
    }
    if (grid < 0) return;
    if (hipMemsetAsync((char*)d_ws + WS_CTL, 0, CTL_ZERO_BYTES, stream) != hipSuccess) return;
    Args a{};
    for (int i = 0; i < 25; ++i) a.in[i] = (const float*)d_in[i];
    a.out = (float*)d_out; a.ws = (unsigned char*)d_ws;
#if MK_N_LAUNCHES == 1
    a.ph_lo = 0; a.ph_hi = NPHASE;
    hipLaunchKernelGGL(fwd, dim3(grid), dim3(NWAVES * 64), LDS_BYTES, stream, a);
#else
    for (int p = 0; p < NPHASE; ++p) { a.ph_lo = p; a.ph_hi = p + 1; hipLaunchKernelGGL(fwd, dim3(grid), dim3(NWAVES * 64), LDS_BYTES, stream, a); }
#endif
}
```

```cpp
#include <hip/hip_runtime.h>
#include <cstdio>
#include <cstdint>

#ifndef MK_N_LAUNCHES
#define MK_N_LAUNCHES 1
#endif
#ifndef DBG_GROUPS
#define DBG_GROUPS 7
#endif
#ifndef DBG_MOE
#define DBG_MOE 1
#endif
#ifndef RPT_PHASE
#define RPT_PHASE 0
#endif
#ifndef RPT_N
#define RPT_N 1
#endif

#define LAS __attribute__((address_space(3)))
#define GAS __attribute__((address_space(1)))
typedef unsigned short bf16;
typedef short bf16x8 __attribute__((ext_vector_type(8)));
typedef short s16x4 __attribute__((ext_vector_type(4)));
typedef float f32x4 __attribute__((ext_vector_type(4)));
typedef float f32x16 __attribute__((ext_vector_type(16)));
typedef float f32x2 __attribute__((ext_vector_type(2)));
typedef unsigned u32x4 __attribute__((ext_vector_type(4)));
typedef unsigned u32x2 __attribute__((ext_vector_type(2)));
typedef __bf16 bf16x2_t __attribute__((ext_vector_type(2)));
typedef int i32x4 __attribute__((ext_vector_type(4)));
typedef int i32x8 __attribute__((ext_vector_type(8)));

constexpr int BATCH = 8, SEQ = 8192, DM = 1024, T = BATCH * SEQ, DEPTH = 2;
constexpr int NP = 3584;
constexpr int C_RQ = 0, C_RK = 256, C_RV = 512, C_RG = 768, C_DQ = 1024, C_DK = 1536, C_DV = 2048, C_GQ = 2560, C_GK = 2688, C_GV = 2816, C_LA = 3072, C_GR = 3200, C_PAD = 3456;
constexpr int IN_W = 3344;
constexpr int NCLS = 48, TPAD = T + NCLS * 256, MAXTILES = TPAD / 256;
constexpr float EPS = 1e-6f, LOG2E = 1.4426950408889634f;

constexpr size_t MiB = 1u << 20;
constexpr size_t WS_CTL = 0, CTL_ZERO_BYTES = 1 * MiB;
constexpr size_t WS_MOD = 1 * MiB;
constexpr size_t WS_SCAL = WS_MOD + 400 * 1024;
constexpr size_t WS_CSR = 2 * MiB;
constexpr size_t WS_CSD = 19 * MiB;
constexpr size_t WS_WIN = 24 * MiB;
constexpr size_t WS_WOUT = 38 * MiB;
constexpr size_t WS_W1 = 42 * MiB;
constexpr size_t WS_W2 = 170 * MiB;
constexpr size_t WS_ACT = 234 * MiB;
constexpr size_t WS_QK8 = WS_ACT + 64 * MiB;
constexpr size_t WS_P = 362 * MiB;
constexpr size_t WS_H2S = WS_P;
constexpr size_t WS_U = WS_P + 152 * MiB;
constexpr size_t WS_EST = 810 * MiB;
constexpr size_t WS_EGL = WS_EST + 8 * MiB, WS_ASR = WS_EST + 12 * MiB, WS_ASG = WS_ASR + 256 * 1024;
constexpr size_t WS_ROUTE = 824 * MiB;
constexpr size_t WS_TOKS = WS_ROUTE + 1 * MiB, WS_GAS = WS_TOKS + 512 * 1024, WS_GBS = WS_GAS + 512 * 1024, WS_TINFO = WS_GBS + 512 * 1024;
constexpr size_t WS_SA1 = 828 * MiB, WS_SA2 = WS_SA1 + 256 * 1024, WS_SAS = WS_SA2 + 256 * 1024, WS_SWIN = WS_SA1 + 1024 * 1024, WS_SW1 = WS_SWIN + 256 * 1024;
constexpr size_t WS_H2Q = 830 * MiB; constexpr size_t WS_VT8 = WS_H2Q;
constexpr size_t WS_XB = 894 * MiB;
constexpr size_t WS_CNTB = WS_TINFO + 64 * 1024;
constexpr size_t WS_END = 1022 * MiB;
static_assert((size_t)TPAD * 1024 * 2 <= 152 * MiB && WS_U + 152 * MiB <= WS_P + (size_t)T * NP * 2, "aliases fit inside P");
static_assert((size_t)T * NP * 2 == 448 * MiB && WS_P + 448 * MiB == WS_EST, "P size");
constexpr int CW_BAR = 4096;
constexpr int CW_CNT = 16384;

constexpr int RING_BYTES = 131072, LDSCTL_OFF = RING_BYTES, MISC_OFF = LDSCTL_OFF + 320, PTR_OFF = MISC_OFF + 128, LDS_BYTES = 147456;
constexpr int NWAVES = 8;

__device__ __forceinline__ unsigned pk2(float lo, float hi) { f32x2 v = {lo, hi}; bf16x2_t b = __builtin_convertvector(v, bf16x2_t); return __builtin_bit_cast(unsigned, b); }
__device__ __forceinline__ float bflo(unsigned w) { return __uint_as_float(w << 16); }
__device__ __forceinline__ float bfhi(unsigned w) { return __uint_as_float(w & 0xffff0000u); }
template <int K> __device__ __forceinline__ float sx(float v) { static_assert(K >= 1 && K < 32, "sx"); return __int_as_float(__builtin_amdgcn_ds_swizzle(__float_as_int(v), (K << 10) | 0x1f)); }
__device__ __forceinline__ float sum_halves(float v) { auto rr = __builtin_amdgcn_permlane32_swap(__float_as_uint(v), __float_as_uint(v), false, false); return __uint_as_float(rr[0]) + __uint_as_float(rr[1]); }
__device__ __forceinline__ float max_halves(float v) { auto rr = __builtin_amdgcn_permlane32_swap(__float_as_uint(v), __float_as_uint(v), false, false); return fmaxf(__uint_as_float(rr[0]), __uint_as_float(rr[1])); }
__device__ __forceinline__ float wave_sum(float v) { v += sx<1>(v); v += sx<2>(v); v += sx<4>(v); v += sx<8>(v); v += sx<16>(v); return sum_halves(v); }
__device__ __forceinline__ float wave_max(float v) { v = fmaxf(v, sx<1>(v)); v = fmaxf(v, sx<2>(v)); v = fmaxf(v, sx<4>(v)); v = fmaxf(v, sx<8>(v)); v = fmaxf(v, sx<16>(v)); return max_halves(v); }
__device__ __forceinline__ float silu_f(float x) { return x * __builtin_amdgcn_rcpf(1.0f + __expf(-x)); }
__device__ __forceinline__ int olane() { int l; asm volatile("v_mbcnt_lo_u32_b32 %0, -1, 0\n\tv_mbcnt_hi_u32_b32 %0, -1, %0" : "=v"(l)); return l; }
__device__ __forceinline__ int otid_w(int wave) { return wave * 64 + olane(); }
#define otid() otid_w(g_wave)
__device__ __forceinline__ unsigned pk4_fp8(float a, float b, float c, float d) { int w = __builtin_amdgcn_cvt_pk_fp8_f32(a, b, 0, false); w = __builtin_amdgcn_cvt_pk_fp8_f32(c, d, w, true); return (unsigned)w; }
constexpr float FP8_ACT_SCALE = 16.0f, FP8_W_SCALE = 32.0f;   static_assert(FP8_ACT_SCALE == 16.0f, "EpiMoe1 applies it as ldexp(., 4)");
constexpr int FP8_ACT_E8 = 127 - 4, FP8_W_E8 = 127 - 5;
template <class Tp> __device__ __forceinline__ const Tp* inptr(const LAS unsigned char* lds, int k) {
    const LAS unsigned* q = (const LAS unsigned*)(lds + PTR_OFF) + 2 * k; const unsigned lo = __builtin_amdgcn_readfirstlane(q[0]), hi = __builtin_amdgcn_readfirstlane(q[1]);
    return (const Tp*)(((unsigned long long)hi << 32) | lo); }
#define INF(k) inptr<float>(lds, k)
__device__ __forceinline__ f32x4 ldx4(const float* xf, const bf16* xb, size_t idx) {
    if (xf) return *(const f32x4*)(xf + idx);
    const u32x2 w = *(const u32x2*)(xb + idx); return (f32x4){bflo(w.x), bfhi(w.x), bflo(w.y), bfhi(w.y)}; }
#define LDS_WAIT() asm volatile("s_waitcnt lgkmcnt(0)" ::: "memory")
#define VM_WAIT() asm volatile("s_waitcnt vmcnt(0)" ::: "memory")

namespace pg8 {
constexpr int BM = 256, BK = 64, HALF = 128, HTB = HALF * BK * 2, STAGE_BYTES = 8 * HTB, NXCD = 8, WGM = 8;
__device__ __forceinline__ int lds_byte(int r, int c) { const int st = (r >> 4) * 2 + (c >> 5), rr = r & 15, cc = c & 31, ob = rr * 64 + cc * 2; return st * 1024 + (ob ^ (((ob >> 9) & 1) << 5)); }
__device__ __forceinline__ void stage_rc(int b, int& R, int& C) { const int st = b / 1024, sb = b % 1024, swz = sb ^ (((sb >> 9) & 1) << 5); R = (st >> 1) * 16 + swz / 64; C = (st & 1) * 32 + (swz % 64) / 2; }
__device__ __forceinline__ int perm32(int rho) { const int n = rho >> 4, i = rho & 15; return 8 * (i >> 2) + 4 * n + (i & 3); }

struct Unit { int pm, pn, e0, e1; };
struct Gemm { const bf16* A; const bf16* Bt; int K, lda, ldb; };

template <int NM, int NN> struct StaticOrder {
    static constexpr int nM = NM, nN = NN, nwg = NM * NN;
    int G, c;
    __device__ void init(int G_, int c_) { G = G_; c = c_; }
    __device__ bool next(int i, Unit& u) const {
        const int L = i * G + c; if (L >= nwg) return false;
        int wgid = L; { constexpr int q = nwg / NXCD, r = nwg % NXCD; const int xcd = wgid % NXCD, off = wgid / NXCD; wgid = (xcd < r ? xcd * (q + 1) : r * (q + 1) + (xcd - r) * q) + off; }
        constexpr int nig = WGM * nN; static_assert(NM % WGM == 0, "row tiles in whole groups");
        const int gid = wgid / nig, fm = gid * WGM;
        u.pm = fm + ((wgid % nig) % WGM); u.pn = (wgid % nig) / WGM; u.e0 = 0; u.e1 = 0; return true;
    }
    __device__ __forceinline__ const char* a_base(const Gemm& g, const Unit& u) const { return (const char*)g.A + (size_t)u.pm * BM * g.lda * 2; }
    __device__ __forceinline__ const char* b_lo(const Gemm& g, const Unit& u) const { return (const char*)g.Bt + (size_t)u.pn * BM * g.ldb * 2; }
    __device__ __forceinline__ const char* b_hi(const Gemm& g, const Unit& u) const { return b_lo(g, u); }
};
template <int NPN, int WHICH  >
struct MoeOrder {
    const int* tinfo; int G, c;
    __device__ bool next(int i, Unit& u) const {
        const int nT = __builtin_amdgcn_readfirstlane(tinfo[0]);
        const int L = i * G + c; if (L >= nT * NPN) return false;
        const int gF = nT >> 3, full = gF * 8 * NPN;
        if (L < full) { u.pm = (L / (8 * NPN)) * 8 + (L & 7); u.pn = (L >> 3) % NPN; }
        else { const int rT = nT - 8 * gF; int Lr = L - full, pn = 0; while (Lr >= rT) { Lr -= rT; ++pn; } u.pm = gF * 8 + Lr; u.pn = pn; }
        const int code = __builtin_amdgcn_readfirstlane(tinfo[1 + u.pm]); u.e0 = code & 0xff; u.e1 = (code >> 8) & 0xff; return true;
    }
    __device__ __forceinline__ const char* a_base(const Gemm& g, const Unit& u) const { return (const char*)g.A + (size_t)u.pm * BM * g.lda * 2; }
    __device__ __forceinline__ const char* b_lo(const Gemm& g, const Unit& u) const {
        if (WHICH == 1) return (const char*)g.Bt + ((size_t)(u.pn < 4 ? u.e0 : u.e1) * 1024 + (size_t)(u.pn & 3) * BM) * g.ldb * 2;
        return (const char*)g.Bt + ((size_t)u.e0 * 1024 + (size_t)u.pn * BM) * g.ldb * 2;
    }
    __device__ __forceinline__ const char* b_hi(const Gemm& g, const Unit& u) const {
        if (WHICH == 1) return b_lo(g, u);
        return (const char*)g.Bt + ((size_t)u.e1 * 1024 + (size_t)u.pn * BM) * g.ldb * 2 - (size_t)g.K;
    }
};

struct EpiStoreBf16 {
    static constexpr bool PERM = true;
    bf16* O; int ldc;
    __device__ __forceinline__ void operator()(const f32x4 (&acc)[2][2][4][2], const Unit& u, int wr, int wc, int fr, int fq) const {
        { const int l_ = olane(); fr = l_ & 15; fq = l_ >> 4; }
        const int row0 = u.pm * BM + wr * 64 + fr, col0 = u.pn * BM + wc * 32 + 8 * fq;
#pragma unroll
        for (int ai = 0; ai < 2; ++ai)
#pragma unroll
            for (int m = 0; m < 4; ++m) { bf16* rowp = O + (size_t)(row0 + ai * HALF + m * 16) * ldc + col0;
#pragma unroll
                for (int bj = 0; bj < 2; ++bj) { const f32x4 v0 = acc[ai][bj][m][0], v1 = acc[ai][bj][m][1];
                    u32x4 w; w.x = pk2(v0[0], v0[1]); w.y = pk2(v0[2], v0[3]); w.z = pk2(v1[0], v1[1]); w.w = pk2(v1[2], v1[3]);
                    *(u32x4*)(rowp + bj * HALF) = w; } }
    }
};
struct EpiInproj {
    static constexpr bool PERM = true;
    bf16* O; int ldc; const float* sa; const float* sw; const float* gq; const float* gk; const f32x2* csd; unsigned char* vt8; unsigned char* qk8;
    __device__ __forceinline__ void operator()(const i32x4 (&acc)[2][2][4][2], const Unit& u, int wr, int wc, int fr, int fq) const {
        { const int l_ = olane(); fr = l_ & 15; fq = l_ >> 4; }
        const int row0 = u.pm * BM + wr * 64 + fr, col0 = u.pn * BM + wc * 32 + 8 * fq;
        f32x4 cs[2][2];
#pragma unroll
        for (int bj = 0; bj < 2; ++bj)
#pragma unroll
            for (int n = 0; n < 2; ++n) cs[bj][n] = *(const f32x4*)(sw + col0 + bj * HALF + 4 * n);
        if (u.pn == 8 || u.pn == 9) {
#pragma unroll
            for (int ai = 0; ai < 2; ++ai)
#pragma unroll
                for (int m = 0; m < 4; ++m) { const int row = row0 + ai * HALF + m * 16; const float rs = sa[row] * 8.0f;
                    const int bb = row >> 13, tk = row & 8191;
#pragma unroll
                    for (int bj = 0; bj < 2; ++bj) { unsigned char* vp = vt8 + ((((size_t)bb * 4 + (u.pn - 8) * 2 + bj) * 128 + (tk >> 6)) * 128 + wc * 32 + 8 * fq) * 64 + (tk & 63);
#pragma unroll
                        for (int n = 0; n < 2; ++n) { const f32x4 v = __builtin_convertvector(acc[ai][bj][m][n], f32x4) * cs[bj][n] * rs; const unsigned w = pk4_fp8(v[0], v[1], v[2], v[3]);
                            vp[(4 * n + 0) * 64] = (unsigned char)(w & 0xff); vp[(4 * n + 1) * 64] = (unsigned char)((w >> 8) & 0xff); vp[(4 * n + 2) * 64] = (unsigned char)((w >> 16) & 0xff); vp[(4 * n + 3) * 64] = (unsigned char)(w >> 24); } } }
        } else if (u.pn < 4 || u.pn >= 8) {
#pragma unroll
            for (int ai = 0; ai < 2; ++ai)
#pragma unroll
                for (int m = 0; m < 4; ++m) { const int row = row0 + ai * HALF + m * 16; const float rs = sa[row]; bf16* rowp = O + (size_t)row * ldc + col0;
#pragma unroll
                    for (int bj = 0; bj < 2; ++bj) { const f32x4 v0 = __builtin_convertvector(acc[ai][bj][m][0], f32x4) * cs[bj][0] * rs, v1 = __builtin_convertvector(acc[ai][bj][m][1], f32x4) * cs[bj][1] * rs;
                        u32x4 w; w.x = pk2(v0[0], v0[1]); w.y = pk2(v0[2], v0[3]); w.z = pk2(v1[0], v1[1]); w.w = pk2(v1[2], v1[3]);
                        *(u32x4*)(rowp + bj * HALF) = w; } }
        } else {
            const bool isq = u.pn < 6; const float* gg = (isq ? gq : gk) + 8 * fq; const float qs = isq ? 0.125f * LOG2E * 16.0f : 8.0f;
            f32x4 gv[2][2];
#pragma unroll
            for (int bj = 0; bj < 2; ++bj)
#pragma unroll
                for (int n = 0; n < 2; ++n) gv[bj][n] = *(const f32x4*)(gg + 32 * bj + 4 * n) * qs;
            const int lcol = u.pn * BM + 64 * wc + 8 * fq;
#pragma unroll
            for (int ai = 0; ai < 2; ++ai)
#pragma unroll
                for (int m = 0; m < 4; ++m) { const int row = row0 + ai * HALF + m * 16; const float rs = sa[row];
                    f32x4 x[2][2]; float ss = 0.f;
#pragma unroll
                    for (int bj = 0; bj < 2; ++bj)
#pragma unroll
                        for (int n = 0; n < 2; ++n) { x[bj][n] = __builtin_convertvector(acc[ai][bj][m][n], f32x4) * cs[bj][n] * rs; ss += (x[bj][n][0] * x[bj][n][0] + x[bj][n][1] * x[bj][n][1]) + (x[bj][n][2] * x[bj][n][2] + x[bj][n][3] * x[bj][n][3]); }
                    ss += sx<16>(ss); ss = sum_halves(ss);
                    const float rstd = rsqrtf(ss * (1.0f / 64.0f) + EPS);
#pragma unroll
                    for (int bj = 0; bj < 2; ++bj)
#pragma unroll
                        for (int n = 0; n < 2; ++n) x[bj][n] = x[bj][n] * gv[bj][n] * rstd;
                    const f32x4* c4 = (const f32x4*)(csd + (size_t)row * 8);
#pragma unroll
                    for (int n = 0; n < 2; ++n) { const f32x4 ca = c4[2 * n], cb = c4[2 * n + 1];
                        f32x4 pr;
#pragma unroll
                        for (int i = 0; i < 4; ++i) pr[i] = sx<16>(x[0][n][i]);
                        const f32x4 co = (f32x4){ca[0], ca[2], cb[0], cb[2]}, sn = (f32x4){ca[1], ca[3], cb[1], cb[3]};
                        const f32x4 r0 = x[0][n] * co - pr * sn, r1 = pr * sn + x[0][n] * co;
                        if (fq == 0) x[0][n] = r0; else if (fq == 1) x[0][n] = r1; }
                    unsigned char* rowp = qk8 + (size_t)row * 1024 + (lcol - C_DQ);
#pragma unroll
                    for (int bj = 0; bj < 2; ++bj) { u32x2 w; w.x = pk4_fp8(x[bj][0][0], x[bj][0][1], x[bj][0][2], x[bj][0][3]); w.y = pk4_fp8(x[bj][1][0], x[bj][1][1], x[bj][1][2], x[bj][1][3]);
                        *(u32x2*)(rowp + 32 * bj) = w; } }
        }
    }
};
struct EpiResid {
    static constexpr bool PERM = true;
    const float* xf; bf16* xb; const float* gate;
    __device__ __forceinline__ void operator()(const f32x4 (&acc)[2][2][4][2], const Unit& u, int wr, int wc, int fr, int fq) const {
        { const int l_ = olane(); fr = l_ & 15; fq = l_ >> 4; }
        const int col0 = u.pn * BM + wc * 32 + 8 * fq; const int b = (u.pm * BM) >> 13;
        f32x4 gv[2][2];
#pragma unroll
        for (int bj = 0; bj < 2; ++bj)
#pragma unroll
            for (int n = 0; n < 2; ++n) gv[bj][n] = *(const f32x4*)(gate + (size_t)b * 6144 + col0 + bj * HALF + 4 * n);
#pragma unroll
        for (int ai = 0; ai < 2; ++ai)
#pragma unroll
            for (int m = 0; m < 4; ++m) { const size_t off = (size_t)(u.pm * BM + ai * HALF + wr * 64 + m * 16 + fr) * DM + col0;
#pragma unroll
                for (int bj = 0; bj < 2; ++bj) { f32x4 x0, x1;
                    if (xf) { x0 = *(const f32x4*)(xf + off + bj * HALF); x1 = *(const f32x4*)(xf + off + bj * HALF + 4); }
                    else { const u32x4 w = *(const u32x4*)(xb + off + bj * HALF); x0 = (f32x4){bflo(w.x), bfhi(w.x), bflo(w.y), bfhi(w.y)}; x1 = (f32x4){bflo(w.z), bfhi(w.z), bflo(w.w), bfhi(w.w)}; }
                    x0 += gv[bj][0] * acc[ai][bj][m][0]; x1 += gv[bj][1] * acc[ai][bj][m][1];
                    u32x4 o; o.x = pk2(x0[0], x0[1]); o.y = pk2(x0[2], x0[3]); o.z = pk2(x1[0], x1[1]); o.w = pk2(x1[2], x1[3]);
                    *(u32x4*)(xb + off + bj * HALF) = o; }
                if (m == 3) asm volatile("" ::: "memory"); }
    }
};
struct EpiMoe1 {
    static constexpr bool PERM = true;
    unsigned char* U; const float* gaS; const float* gbS; const float* saS; const float* sw1;
    __device__ __forceinline__ void operator()(const i32x4 (&acc)[2][2][4][2], const Unit& u, int wr, int wc, int fr, int fq) const {
        { const int l_ = olane(); fr = l_ & 15; fq = l_ >> 4; }
        const float* gs = (u.pn < 4) ? gaS : gbS; const int ucol = u.pn * 128 + wc * 32 + 8 * fq;
        const float* swp = sw1 + (size_t)(u.pn < 4 ? u.e0 : u.e1) * 1024 + (u.pn & 3) * BM + wc * 32 + 8 * fq;
        f32x4 cs[2][2];
#pragma unroll
        for (int bj = 0; bj < 2; ++bj)
#pragma unroll
            for (int n = 0; n < 2; ++n) cs[bj][n] = *(const f32x4*)(swp + bj * HALF + 4 * n);
#pragma unroll
        for (int ai = 0; ai < 2; ++ai)
#pragma unroll
            for (int m = 0; m < 4; ++m) { const int slot = u.pm * BM + ai * HALF + wr * 64 + m * 16 + fr; const float w = __builtin_ldexpf(gs[slot], 4)  , rs = saS[slot];
                float r[8];
#pragma unroll
                for (int n = 0; n < 2; ++n) { const f32x4 gv = __builtin_convertvector(acc[ai][0][m][n], f32x4) * cs[0][n] * rs, uv = __builtin_convertvector(acc[ai][1][m][n], f32x4) * cs[1][n] * (rs * w);
#pragma unroll
                    for (int i = 0; i < 4; ++i) r[n * 4 + i] = silu_f(gv[i]) * uv[i]; }
                u32x2 o; o.x = pk4_fp8(r[0], r[1], r[2], r[3]); o.y = pk4_fp8(r[4], r[5], r[6], r[7]);
                *(u32x2*)(U + (size_t)slot * 1024 + ucol) = o; asm volatile("" ::: "memory"); }
    }
};
struct EpiMoe2 {
    static constexpr bool PERM = true;
    bf16* xb; float* outf; const int* tokS; const float* gate; int dry;
    __device__ __forceinline__ void operator()(const f32x4 (&acc)[2][2][4][2], const Unit& u, int wr, int wc, int fr, int fq) const {
        if (dry) { asm volatile("" :: "v"(acc[0][0][0][0]), "v"(acc[1][1][3][1])); return; }
        { const int l_ = olane(); fr = l_ & 15; fq = l_ >> 4; }
        const int col0 = u.pn * BM + wc * 32 + 8 * fq;
        int tok[2][4];
#pragma unroll
        for (int ai = 0; ai < 2; ++ai)
#pragma unroll
            for (int m = 0; m < 4; ++m) tok[ai][m] = tokS[u.pm * BM + ai * HALF + wr * 64 + m * 16 + fr];
#pragma unroll
        for (int ai = 0; ai < 2; ++ai) {
            u32x4 xw[4][2];
#pragma unroll
            for (int m = 0; m < 4; ++m) { const int tk = tok[ai][m] < 0 ? 0 : tok[ai][m]; const size_t off = (size_t)tk * DM + col0;
#pragma unroll
                for (int bj = 0; bj < 2; ++bj) xw[m][bj] = *(const u32x4*)(xb + off + bj * HALF); }
#pragma unroll
            for (int m = 0; m < 4; ++m) { if (tok[ai][m] >= 0) { const size_t off = (size_t)tok[ai][m] * DM + col0; const float* gp = gate + (size_t)(tok[ai][m] >> 13) * 6144 + col0;
#pragma unroll
                for (int bj = 0; bj < 2; ++bj) { const u32x4 w = xw[m][bj]; const f32x4 g0 = *(const f32x4*)(gp + bj * HALF), g1 = *(const f32x4*)(gp + bj * HALF + 4);
                    const f32x4 x0 = (f32x4){bflo(w.x), bfhi(w.x), bflo(w.y), bfhi(w.y)} + (DBG_MOE ? 1.f : 0.f) * g0 * acc[ai][bj][m][0], x1 = (f32x4){bflo(w.z), bfhi(w.z), bflo(w.w), bfhi(w.w)} + (DBG_MOE ? 1.f : 0.f) * g1 * acc[ai][bj][m][1];
                    if (outf) { *(f32x4*)(outf + off + bj * HALF) = x0; *(f32x4*)(outf + off + bj * HALF + 4) = x1; }
                    else { u32x4 o; o.x = pk2(x0[0], x0[1]); o.y = pk2(x0[2], x0[3]); o.z = pk2(x1[0], x1[1]); o.w = pk2(x1[2], x1[3]); *(u32x4*)(xb + off + bj * HALF) = o; } } } }
            asm volatile("" ::: "memory"); }
    }
};

template <int MODE> struct AccT { typedef f32x4 type; }; template <> struct AccT<1> { typedef i32x4 type; };
template <int MODE> struct Frag { bf16x8 lo, hi; __device__ __forceinline__ void ld(const LAS unsigned char* p) { lo = *(const LAS bf16x8*)p; hi = *(const LAS bf16x8*)(p + 1024); } };
template <> struct Frag<2> { i32x8 v; __device__ __forceinline__ void ld(const LAS unsigned char* p) { const i32x4 l_ = *(const LAS i32x4*)p, h_ = *(const LAS i32x4*)(p + 1024); v = __builtin_shufflevector(l_, h_, 0, 1, 2, 3, 4, 5, 6, 7); } };
__device__ __forceinline__ f32x4 mma2(const Frag<0>& b, const Frag<0>& a, f32x4 c) { c = __builtin_amdgcn_mfma_f32_16x16x32_bf16(b.lo, a.lo, c, 0, 0, 0); return __builtin_amdgcn_mfma_f32_16x16x32_bf16(b.hi, a.hi, c, 0, 0, 0); }
__device__ __forceinline__ i32x4 mma2(const Frag<1>& b, const Frag<1>& a, i32x4 c) {
    c = __builtin_amdgcn_mfma_i32_16x16x64_i8(__builtin_bit_cast(i32x4, b.lo), __builtin_bit_cast(i32x4, a.lo), c, 0, 0, 0); return __builtin_amdgcn_mfma_i32_16x16x64_i8(__builtin_bit_cast(i32x4, b.hi), __builtin_bit_cast(i32x4, a.hi), c, 0, 0, 0); }
__device__ __forceinline__ f32x4 mma2(const Frag<2>& b, const Frag<2>& a, f32x4 c) {
    return __builtin_amdgcn_mfma_scale_f32_16x16x128_f8f6f4(b.v, a.v, c, 0, 0, 0, FP8_W_E8, 0, FP8_ACT_E8); }
template <class Epi, class Sched, int KSPLIT  , int MODE = 0>
__device__ __forceinline__ void gemm_phase(LAS unsigned char* lds, const Gemm g, const Sched& S, const Epi& E, const int g_wave) {
    const int tid = otid(), wid = __builtin_amdgcn_readfirstlane(tid >> 6), lane = tid & 63, wr = wid >> 2, wc = wid & 3, fr = lane & 15, fq = lane >> 4;
    const int K = g.K, nt = K / BK;
    unsigned voffA[2], voffB[2];
#pragma unroll
    for (int i = 0; i < 2; ++i) { int R, C; stage_rc(tid * 16 + i * 8192, R, C); const int Rb = Epi::PERM ? ((R & ~31) + perm32(R & 31)) : R;
        voffA[i] = (unsigned)(R * g.lda + C) * 2u; voffB[i] = (unsigned)(Rb * g.ldb + C) * 2u; }
    const size_t kstep = (size_t)(BK * 2);
    const size_t hstepA = (size_t)HALF * g.lda * 2, hstepB = (size_t)HALF * g.ldb * 2;
    const unsigned ldsw = (unsigned)wid * 1024u;
    const int aoff = lds_byte(wr * 64 + fr, fq * 8), boff = lds_byte(wc * 32 + fr, fq * 8);
#define PG8_SA(b, h) (((b) * 2 + (h)) * HTB)
#define PG8_SB(b, h) ((4 + (b) * 2 + (h)) * HTB)
#define PG8_STAGE(bufoff, gbase, voff) do { _Pragma("unroll") for (int _i = 0; _i < 2; ++_i) \
        __builtin_amdgcn_global_load_lds((const unsigned*)((const char*)(gbase) + (voff)[_i]), (LAS unsigned*)(lds + (bufoff) + ldsw + _i * 8192), 16, 0, 0); } while (0)
#define PG8_LDA(dst, b, h) do { _Pragma("unroll") for (int m = 0; m < 4; ++m) dst[m].ld(lds + PG8_SA(b, h) + aoff + m * 2048); } while (0)
#define PG8_LDB(dst, b, h) do { _Pragma("unroll") for (int n = 0; n < 2; ++n) dst[n].ld(lds + PG8_SB(b, h) + boff + n * 2048); } while (0)
#define PG8_MMA(ai, bj, At, Bt) do { __builtin_amdgcn_s_setprio(1); _Pragma("unroll") for (int m = 0; m < 4; ++m) _Pragma("unroll") for (int n = 0; n < 2; ++n) \
        acc[ai][bj][m][n] = mma2(Bt[n], At[m], acc[ai][bj][m][n]); \
        if (MODE == 2) { _Pragma("unroll") for (int m = 0; m < 4; ++m) _Pragma("unroll") for (int n = 0; n < 2; ++n) asm volatile("" : "+v"(acc[ai][bj][m][n])); }     \
        __builtin_amdgcn_s_setprio(0); } while (0)
#define PG8_WAIT_V(n) asm volatile("s_waitcnt vmcnt(" #n ")" ::: "memory")
#define PG8_WAIT_L(n) asm volatile("s_waitcnt lgkmcnt(" #n ")" ::: "memory")
#define PG8_BAR __builtin_amdgcn_s_barrier()
#define PG8_SCHED __builtin_amdgcn_sched_barrier(0)
    Unit cur, nxt; int ui = 0;
    if (!S.next(0, cur)) return;
    typedef typename AccT<MODE>::type acc_t;
    acc_t acc[2][2][4][2];
#pragma unroll
    for (int a = 0; a < 2; ++a)
#pragma unroll
        for (int b = 0; b < 2; ++b)
#pragma unroll
            for (int m = 0; m < 4; ++m)
#pragma unroll
                for (int n = 0; n < 2; ++n) acc[a][b][m][n] = (acc_t){0, 0, 0, 0};
    Frag<MODE> At[4], B0[2], B1[2];
    const char* cA = S.a_base(g, cur); const char* cB = S.b_lo(g, cur); const char* cBh = S.b_hi(g, cur);
    PG8_STAGE(PG8_SB(0, 0), cB, voffB); PG8_STAGE(PG8_SB(0, 1), cB + hstepB, voffB); PG8_STAGE(PG8_SA(0, 0), cA, voffA); PG8_STAGE(PG8_SA(0, 1), cA + hstepA, voffA);
    if (wr == 1) PG8_BAR;
    PG8_WAIT_V(2); PG8_BAR;
    PG8_STAGE(PG8_SB(1, 0), cB + kstep, voffB); PG8_STAGE(PG8_SA(1, 0), cA + kstep, voffA); PG8_STAGE(PG8_SB(1, 1), cB + hstepB + kstep, voffB);
    PG8_WAIT_V(6); PG8_BAR;
    for (;;) {
        const bool has_next = S.next(ui + 1, nxt);
        const char* nA = has_next ? S.a_base(g, nxt) : cA; const char* nB = has_next ? S.b_lo(g, nxt) : cB; const char* nBh = has_next ? S.b_hi(g, nxt) : cBh;
        for (int t = 0; t < nt; t += 2) {
            const bool last = (t == nt - 2);
            const char* a1 = cA + (size_t)(t + 1) * kstep;
            const char* bsel = (KSPLIT != 0 && (t + 2) >= KSPLIT) ? cBh : cB;
            const char* a2 = last ? nA : cA + (size_t)(t + 2) * kstep; const char* b2 = last ? nB : bsel + (size_t)(t + 2) * kstep;
            const char* a3 = a2 + kstep; const char* b3 = b2 + kstep;
            PG8_LDB(B0, 0, 0); PG8_LDB(B1, 0, 1); PG8_SCHED; PG8_LDA(At, 0, 0); PG8_STAGE(PG8_SA(1, 1), a1 + hstepA, voffA);
            PG8_WAIT_V(8); PG8_WAIT_L(0); PG8_BAR; PG8_MMA(0, 0, At, B0); PG8_MMA(0, 1, At, B1); PG8_BAR; PG8_SCHED;
            PG8_LDA(At, 0, 1); PG8_STAGE(PG8_SB(0, 0), b2, voffB); PG8_STAGE(PG8_SB(0, 1), b2 + hstepB, voffB); PG8_STAGE(PG8_SA(0, 0), a2, voffA);
            PG8_WAIT_V(8); PG8_WAIT_L(0); PG8_BAR; PG8_MMA(1, 0, At, B0); PG8_MMA(1, 1, At, B1); PG8_BAR; PG8_SCHED;
            PG8_LDB(B0, 1, 0); PG8_LDB(B1, 1, 1); PG8_SCHED; PG8_LDA(At, 1, 0); PG8_STAGE(PG8_SA(0, 1), a2 + hstepA, voffA);
            PG8_WAIT_V(8); PG8_WAIT_L(0); PG8_BAR; PG8_MMA(0, 0, At, B0); PG8_MMA(0, 1, At, B1); PG8_BAR; PG8_SCHED;
            PG8_LDA(At, 1, 1); PG8_STAGE(PG8_SB(1, 0), b3, voffB); PG8_STAGE(PG8_SB(1, 1), b3 + hstepB, voffB); PG8_STAGE(PG8_SA(1, 0), a3, voffA);
            PG8_WAIT_V(8); PG8_WAIT_L(0); PG8_BAR; PG8_MMA(1, 0, At, B0); PG8_MMA(1, 1, At, B1); PG8_BAR; PG8_SCHED;
        }
        if (wr == 0) PG8_BAR;
        E(acc, cur, wr, wc, fr, fq);
        if (!has_next) break;
#pragma unroll
        for (int a = 0; a < 2; ++a)
#pragma unroll
            for (int b = 0; b < 2; ++b)
#pragma unroll
                for (int m = 0; m < 4; ++m)
#pragma unroll
                    for (int n = 0; n < 2; ++n) acc[a][b][m][n] = (acc_t){0, 0, 0, 0};
        cur = nxt; cA = nA; cB = nB; cBh = nBh; ++ui;
        if (wr == 1) PG8_BAR;
    }
    PG8_WAIT_V(0);
    PG8_BAR;
#undef PG8_SA
#undef PG8_SB
#undef PG8_STAGE
#undef PG8_LDA
#undef PG8_LDB
#undef PG8_MMA
#undef PG8_WAIT_V
#undef PG8_WAIT_L
#undef PG8_BAR
#undef PG8_SCHED
}
}

#define XB_TMO      128
#define XB_XCNT(j)  (256  + 64 * (j))
#define XB_XSUB(j)  (1280 + 64 * (j))
#define XB_XGEN(j)  (2304 + 64 * (j))
#define XB_TOP      3328
#define XB_TOPGEN   3392
#define XCD_BAR_WORDS 3456
#define XB_SPIN_CAP (1u << 21)
__device__ __forceinline__ unsigned xb_ld(unsigned* p)              { return __hip_atomic_load(p, __ATOMIC_RELAXED, __HIP_MEMORY_SCOPE_AGENT); }
__device__ __forceinline__ unsigned xb_add(unsigned* p, unsigned v) { return __hip_atomic_fetch_add(p, v, __ATOMIC_RELAXED, __HIP_MEMORY_SCOPE_AGENT); }
__device__ __forceinline__ unsigned xb_xcc_id() { return (unsigned)__builtin_amdgcn_s_getreg((3 << 11) | 20) & 0xFu; }
#define XB_SPIN(cond, bar) do { unsigned _sp = 0; while (cond) { __builtin_amdgcn_s_sleep(1); \
    if ((++_sp & 255u) == 0u) { if (xb_ld(&(bar)[XB_TMO])) break; if (_sp > XB_SPIN_CAP) { atomicAdd(&(bar)[XB_TMO], 1u); break; } } } } while (0)
struct XcdBarrier { unsigned* bar; unsigned x; volatile LAS unsigned* st; };
__device__ __forceinline__ XcdBarrier xcd_barrier_post(unsigned* bar, volatile LAS unsigned* st, bool leader) {
    XcdBarrier b; b.bar = bar; b.x = xb_xcc_id(); b.st = st;
    if (leader) (void)xb_add(&bar[XB_XCNT(b.x)], 1u);
    return b;
}
__device__ __forceinline__ void xcd_barrier_complete(unsigned* bar, unsigned x, unsigned& nloc, unsigned& nx) {
    const unsigned G = gridDim.x * gridDim.y * gridDim.z;
    unsigned sum, cnt, mine, sp = 0u;
    for (;;) {
        sum = 0u; cnt = 0u; mine = 0u;
#pragma unroll
        for (unsigned j = 0; j < 16; ++j) { const unsigned c = xb_ld(&bar[XB_XCNT(j)]); sum += c; cnt += (c > 0u) ? 1u : 0u; }
        mine = xb_ld(&bar[XB_XCNT(x)]);
        if (sum == G) break;
        __builtin_amdgcn_s_sleep(1);
        if ((++sp & 255u) == 0u) { if (xb_ld(&bar[XB_TMO])) break; if (sp > XB_SPIN_CAP) { atomicAdd(&bar[XB_TMO], 1u); break; } }
    }
    nloc = mine > 0u ? mine : 1u; nx = cnt > 0u ? cnt : 1u;
}
__device__ __forceinline__ void xcd_barrier(const XcdBarrier& b, bool leader) {
    asm volatile("s_waitcnt vmcnt(0)" ::: "memory");
    __syncthreads();
    if (leader) {
        unsigned* bar = b.bar;
        __builtin_amdgcn_s_waitcnt(0);
        unsigned nloc = b.st[0], nx = b.st[1];
        if (nloc == 0u) { xcd_barrier_complete(bar, b.x, nloc, nx); b.st[0] = nloc; b.st[1] = nx; }
        const unsigned old = xb_add(&bar[XB_XSUB(b.x)], 1u);
        const unsigned gen = old / nloc;
        if (old + 1u == (gen + 1u) * nloc) {
            __builtin_amdgcn_fence(__ATOMIC_RELEASE, "agent");
            asm volatile("s_waitcnt vmcnt(0)" ::: "memory");
            const unsigned og = xb_add(&bar[XB_TOP], 1u);
            const unsigned tg = og / nx;
            if (og + 1u == (tg + 1u) * nx) xb_add(&bar[XB_TOPGEN], 1u);
            else XB_SPIN(xb_ld(&bar[XB_TOPGEN]) == tg, bar);
            __builtin_amdgcn_fence(__ATOMIC_ACQUIRE, "agent");
            xb_add(&bar[XB_XGEN(b.x)], 1u);
            asm volatile("s_waitcnt vmcnt(0)" ::: "memory");
        } else {
            XB_SPIN(xb_ld(&bar[XB_XGEN(b.x)]) == gen, bar);
            __builtin_amdgcn_fence(__ATOMIC_ACQUIRE, "agent");
            asm volatile("s_waitcnt vmcnt(0)" ::: "memory");
        }
    }
    __syncthreads();
}

__device__ __forceinline__ int tr_row(int kind, int n) {
    if (kind == 0) return n;
    if (kind == 1) { if (n >= 1024 && n < 2048) { const int lc = (n - 1024) & 255, sh = lc >> 6, d = lc & 63; return (n & ~255) + 128 * (d >> 5) + 32 * sh + (d & 31); }
                     return n < 3072 ? n : (n < 3088 ? -1 : n + 112); }
    return (n >> 7) * 256 + (n & 127) + (kind == 3 ? 128 : 0);
}
__device__ __forceinline__ void tr_item(const float* W, int K, int N, bf16* WT, int ldt, int kind, LAS unsigned char* scr, int item, int lane) {
    const int nblk = (N + 63) / 64, kb = item / nblk, nb = item % nblk, k0 = 64 * kb, n0 = 64 * nb;
    const int n4 = (lane & 15) * 4; const bool inr = (n0 + n4) < N;
    f32x4 v[16];
#pragma unroll
    for (int i = 0; i < 16; ++i) { const int kk = 4 * i + (lane >> 4); v[i] = inr ? *(const f32x4*)(W + (size_t)(k0 + kk) * N + n0 + n4) : (f32x4){0.f, 0.f, 0.f, 0.f}; }
#pragma unroll
    for (int i = 0; i < 16; ++i) { const int kk = 4 * i + (lane >> 4); const unsigned w0 = pk2(v[i][0], v[i][1]), w1 = pk2(v[i][2], v[i][3]);
        *(LAS unsigned short*)(scr + (n4 + 0) * 132 + kk * 2) = (unsigned short)(w0 & 0xffffu); *(LAS unsigned short*)(scr + (n4 + 1) * 132 + kk * 2) = (unsigned short)(w0 >> 16);
        *(LAS unsigned short*)(scr + (n4 + 2) * 132 + kk * 2) = (unsigned short)(w1 & 0xffffu); *(LAS unsigned short*)(scr + (n4 + 3) * 132 + kk * 2) = (unsigned short)(w1 >> 16); }
    LDS_WAIT(); asm volatile("" ::: "memory");
#pragma unroll
    for (int j = 0; j < 8; ++j) { const int idx = lane + 64 * j, n = idx >> 3, c = idx & 7; const LAS unsigned* sp = (const LAS unsigned*)(scr + n * 132 + c * 16);
        u32x4 o; o.x = sp[0]; o.y = sp[1]; o.z = sp[2]; o.w = sp[3];
        const int gn = n0 + n; const int r = (gn < N) ? tr_row(kind, gn) : -1;
        if (r >= 0) *(u32x4*)(WT + (size_t)r * ldt + k0 + 8 * c) = o; }
    LDS_WAIT(); asm volatile("" ::: "memory");
}

__device__ __forceinline__ void tr_item8(const float* W, int K, int N, unsigned char* WT8, int ldt, LAS unsigned char* scr, int item, int lane) {
    const int nblk = N / 64, kb = item / nblk, nb = item % nblk, k0 = 64 * kb, n0 = 64 * nb;
    const int a = lane & 15, kg = lane >> 4;
    f32x4 v[16];
#pragma unroll
    for (int i = 0; i < 16; ++i) { const int kk = 16 * (i >> 2) + 4 * kg + (i & 3); v[i] = *(const f32x4*)(W + (size_t)(k0 + kk) * N + n0 + 4 * a); }
#pragma unroll
    for (int g = 0; g < 4; ++g)
#pragma unroll
        for (int e = 0; e < 4; ++e) *(LAS unsigned*)(scr + (4 * a + e) * 68 + 16 * g + 4 * kg) = pk4_fp8(v[4 * g][e] * FP8_W_SCALE, v[4 * g + 1][e] * FP8_W_SCALE, v[4 * g + 2][e] * FP8_W_SCALE, v[4 * g + 3][e] * FP8_W_SCALE);
    LDS_WAIT(); asm volatile("" ::: "memory");
#pragma unroll
    for (int j = 0; j < 4; ++j) { const int idx = lane + 64 * j, n = idx >> 2, c = idx & 3; const LAS unsigned* sp = (const LAS unsigned*)(scr + n * 68 + c * 16);
        u32x4 o; o.x = sp[0]; o.y = sp[1]; o.z = sp[2]; o.w = sp[3];
        *(u32x4*)(WT8 + (size_t)(n0 + n) * ldt + k0 + 16 * c) = o; }
    LDS_WAIT(); asm volatile("" ::: "memory");
}

template <bool LA>
__device__ __forceinline__ void quant_strip(LAS unsigned char* lds, const float* W, int N, int n0, unsigned char* Q, float* SW, int kind, const float* a2, int wave, int lane) {
    lane = olane();
    const int a = lane & 15, kg = lane >> 4; const int ncl = (n0 + 4 * a) < N ? (n0 + 4 * a) : (N - 4);
    f32x4 v[2][16];
#pragma unroll
    for (int t = 0; t < 2; ++t)
#pragma unroll
        for (int i = 0; i < 16; ++i) { const int kk = 128 * wave + 64 * t + 16 * (i >> 2) + 4 * kg + (i & 3);
            if (!LA) v[t][i] = *(const f32x4*)(W + (size_t)kk * N + ncl);
            else { f32x4 acc = (f32x4){0.f, 0.f, 0.f, 0.f}; const float* wr = W + (size_t)kk * N + 3072;
#pragma unroll 4
                for (int r = 0; r < 16; ++r) acc += *(const f32x4*)(a2 + r * 128 + n0 + 4 * a) * wr[r];
                v[t][i] = acc; } }
    f32x4 cm = (f32x4){0.f, 0.f, 0.f, 0.f};
#pragma unroll
    for (int t = 0; t < 2; ++t)
#pragma unroll
        for (int i = 0; i < 16; ++i) cm = __builtin_elementwise_max(cm, __builtin_elementwise_abs(v[t][i]));
    LAS float* cmax = (LAS float*)(lds + 67584);
#pragma unroll
    for (int e = 0; e < 4; ++e) { float m = cm[e]; m = fmaxf(m, sx<16>(m)); m = max_halves(m); if (kg == 0) cmax[wave * 64 + 4 * a + e] = m; }
    __syncthreads();
    float inv[4], scl[4];
#pragma unroll
    for (int e = 0; e < 4; ++e) { float m = 0.f;
#pragma unroll
        for (int w = 0; w < 8; ++w) m = fmaxf(m, cmax[w * 64 + 4 * a + e]);
        scl[e] = m > 0.f ? m * (1.0f / 127.0f) : 1.0f; inv[e] = m > 0.f ? 127.0f / m : 0.f; }
    LAS unsigned char* tile = lds + wave * 8448;
#pragma unroll
    for (int t = 0; t < 2; ++t)
#pragma unroll
        for (int g = 0; g < 4; ++g)
#pragma unroll
            for (int e = 0; e < 4; ++e) { unsigned w = 0u;
#pragma unroll
                for (int j = 0; j < 4; ++j) { const int q = (int)__builtin_rintf(v[t][4 * g + j][e] * inv[e]); w |= ((unsigned)q & 0xffu) << (8 * j); }
                *(LAS unsigned*)(tile + (4 * a + e) * 132 + 64 * t + 16 * g + 4 * kg) = w; }
    LDS_WAIT(); asm volatile("" ::: "memory");
#pragma unroll
    for (int j = 0; j < 8; ++j) { const int idx = lane + 64 * j, n = idx >> 3, c = idx & 7; const LAS unsigned* sp = (const LAS unsigned*)(tile + n * 132 + c * 16);
        u32x4 o; o.x = sp[0]; o.y = sp[1]; o.z = sp[2]; o.w = sp[3];
        const int gn = n0 + n; const int r = LA ? (C_LA + gn) : ((gn < N) ? tr_row(kind, gn) : -1);
        if (r >= 0) *(u32x4*)(Q + (size_t)r * 1024 + 128 * wave + 16 * c) = o; }
    if (wave == 0 && kg == 0) {
#pragma unroll
        for (int e = 0; e < 4; ++e) { const int gn = n0 + 4 * a + e; const int r = LA ? (C_LA + gn) : ((gn < N) ? tr_row(kind, gn) : -1); if (r >= 0) SW[r] = scl[e]; } }
    __syncthreads();
}

namespace lin {
constexpr int L_QL = 0, L_QU = 9216, L_KL = 18432, L_KU = 27648, L_KLT = 36864, L_VT = 46080, L_AM = 55296, L_ST = 64512, L_OUT = 73728, L_G = 90368, L_GL = 98560, L_END = 98816;
constexpr int NSEG = 16, LSEG = 8;
#define MFMA16(a, b, c) __builtin_amdgcn_mfma_f32_16x16x32_bf16(a, b, c, 0, 0, 0)
__device__ __forceinline__ bf16x8 frag(const LAS unsigned char* base, int pitchB, int r0, int ks, int lane) {
    return *(const LAS bf16x8*)(base + (r0 + (lane & 15)) * pitchB + (32 * ks + 8 * (lane >> 4)) * 2);
}
typedef short v4i16_t __attribute__((ext_vector_type(4)));
__device__ __forceinline__ bf16x8 trfrag(const LAS unsigned char* base, int pitchB, int k0, int n0, int lane) {
    const LAS unsigned char* p = base + (k0 + 8 * (lane >> 4) + ((lane & 15) >> 2)) * pitchB + (n0 + 4 * (lane & 3)) * 2;
    const s16x4 lo = __builtin_bit_cast(s16x4, __builtin_amdgcn_ds_read_tr16_b64_v4i16((LAS v4i16_t*)p));
    const s16x4 hi = __builtin_bit_cast(s16x4, __builtin_amdgcn_ds_read_tr16_b64_v4i16((LAS v4i16_t*)(p + 4 * pitchB)));
    return (bf16x8){lo[0], lo[1], lo[2], lo[3], hi[0], hi[1], hi[2], hi[3]};
}
template <int DK, bool RET, bool PH2>
__device__ __forceinline__ void unit(LAS unsigned char* lds, const bf16* P, unsigned char* MIX, const f32x2* csr, int b, int h, int seg,
                                     const float* b_a, const float* gnorm, float* Est, float* Aseg, const int g_wave) {
    constexpr int PQ = (DK + 8) * 2;
    constexpr int PS = 144;
    constexpr int NT = DK / 32;
    const int tid = otid(), lane = tid & 63, wid = __builtin_amdgcn_readfirstlane(tid >> 6);
    const int row = tid >> 3, c8 = tid & 7;
    const int entry = (b * 4 + h) * NSEG + seg;
    const float lng = RET ? __logf(1.0f - exp2f(-5.0f - (float)h)) : 0.f;
    const int cq = RET ? C_RQ + h * 64 : C_GQ + h * 32, ck = RET ? C_RK + h * 64 : C_GK + h * 32, cv = RET ? C_RV + h * 64 : C_GV + h * 64, cg = RET ? C_RG + h * 64 : C_GR + h * 64;
    f32x4 st[NT]; float ac[NT];
    int eb[NT], db[NT];
#pragma unroll
    for (int j = 0; j < NT; ++j) { const int i = wid + 8 * j; if (DK == 64) { eb[j] = i >> 2; db[j] = i & 3; } else { eb[j] = i >> 1; db[j] = i & 1; } st[j] = (f32x4){0.f, 0.f, 0.f, 0.f}; ac[j] = 1.f; }
    if (PH2) {
#pragma unroll 4
        for (int sp = 0; sp < seg; ++sp) { const int en = (b * 4 + h) * NSEG + sp;
#pragma unroll
            for (int j = 0; j < NT; ++j) { const int d = db[j] * 16 + (lane & 15); const float a = Aseg[(size_t)en * DK + d];
                { const f32x4 ev = *(const f32x4*)(Est + ((size_t)en * DK + d) * 64 + eb[j] * 16 + 4 * (lane >> 4)); st[j] = st[j] * a + ev; } } }
    }
    float gn8[8] = {0.f, 0.f, 0.f, 0.f, 0.f, 0.f, 0.f, 0.f}, ba4[4] = {0.f, 0.f, 0.f, 0.f};
    if (PH2) {
#pragma unroll
        for (int i = 0; i < 8; ++i) gn8[i] = gnorm[8 * c8 + i]; }
    if (!RET) {
#pragma unroll
        for (int i = 0; i < 4; ++i) ba4[i] = b_a[h * 32 + 4 * wid + i]; }
    u32x4 rq_ = (u32x4){0u, 0u, 0u, 0u}, rk_ = rq_, rq2_ = rq_, rk2_ = rq_, pv = rq_, pgt = rq_; f32x4 pcs[4]; u32x2 pla = (u32x2){0u, 0u};
#pragma unroll
    for (int i = 0; i < 4; ++i) pcs[i] = (f32x4){0.f, 0.f, 0.f, 0.f};
    const int d0 = 8 * c8; const bool qk_on = RET || c8 < 4;
#define LIN_LOAD(cc) do { const size_t mr_ = (size_t)b * SEQ + (size_t)(seg * LSEG + (cc)) * 64 + row; \
        if (!RET) pla = *(const u32x2*)(P + ((size_t)b * SEQ + (size_t)(seg * LSEG + (cc)) * 64 + lane) * NP + C_LA + h * 32 + 4 * wid); \
        if (qk_on) { rk_ = *(const u32x4*)(P + mr_ * NP + ck + d0); if (PH2) rq_ = *(const u32x4*)(P + mr_ * NP + cq + d0); \
            if (RET) { rk2_ = *(const u32x4*)(P + mr_ * NP + ck + (d0 ^ 32)); if (PH2) rq2_ = *(const u32x4*)(P + mr_ * NP + cq + (d0 ^ 32)); \
                const f32x4* cs4_ = (const f32x4*)(csr + mr_ * 32 + (d0 & 31)); pcs[0] = cs4_[0]; pcs[1] = cs4_[1]; pcs[2] = cs4_[2]; pcs[3] = cs4_[3]; } } \
        pv = *(const u32x4*)(P + mr_ * NP + cv + 8 * c8); if (PH2) pgt = *(const u32x4*)(P + mr_ * NP + cg + 8 * c8); } while (0)
    LIN_LOAD(0);
    for (int c = 0; c < LSEG; ++c) {
        const size_t m0 = (size_t)b * SEQ + (size_t)(seg * LSEG + c) * 64;
        if (!RET) {
            const u32x2 w = pla;
            float x[4] = {bflo(w.x), bfhi(w.x), bflo(w.y), bfhi(w.y)};
#pragma unroll
            for (int i = 0; i < 4; ++i) { const float z = x[i] + ba4[i]; float v = (fminf(z, 0.f) - log1pf(__expf(-fabsf(z)))) * (1.0f / 16.0f);
#pragma unroll
                for (int o = 1; o < 64; o <<= 1) { const float u = __int_as_float(__builtin_amdgcn_ds_bpermute((lane - o) << 2, __float_as_int(v))); if (lane >= o) v += u; }
                ((LAS float*)(lds + L_G))[lane * 32 + 4 * wid + i] = v; if (lane == 63) ((LAS float*)(lds + L_GL))[4 * wid + i] = v; }
            __syncthreads();
        }
        u32x4 gcur = pgt;
        {
            if (qk_on) {
                const u32x4 kw = rk_, qw = rq_;
                float qv[8], kv[8], eg[8], ieg[8];
                { const unsigned* qp = (const unsigned*)&qw; const unsigned* kp = (const unsigned*)&kw;
#pragma unroll
                  for (int i = 0; i < 4; ++i) { qv[2 * i] = bflo(qp[i]); qv[2 * i + 1] = bfhi(qp[i]); kv[2 * i] = bflo(kp[i]); kv[2 * i + 1] = bfhi(kp[i]); } }
                if (RET) {
                    const u32x4 kw2 = rk2_, qw2 = rq2_;
                    const unsigned* qp2 = (const unsigned*)&qw2; const unsigned* kp2 = (const unsigned*)&kw2;
                    const float g = (float)(row + 1) * lng; const float e1 = __expf(g), e2 = __expf(-g);
#pragma unroll
                    for (int i = 0; i < 4; ++i) { const f32x4 cc = pcs[i];
                        const float qa = bflo(qp2[i]), qb = bfhi(qp2[i]), ka = bflo(kp2[i]), kb = bfhi(kp2[i]);
                        if (c8 < 4) { const float q0 = qv[2 * i] * cc[0] - qa * cc[1], q1 = qv[2 * i + 1] * cc[2] - qb * cc[3]; const float k0 = kv[2 * i] * cc[0] - ka * cc[1], k1 = kv[2 * i + 1] * cc[2] - kb * cc[3];
                            qv[2 * i] = q0; qv[2 * i + 1] = q1; kv[2 * i] = k0; kv[2 * i + 1] = k1; }
                        else { const float q0 = qa * cc[1] + qv[2 * i] * cc[0], q1 = qb * cc[3] + qv[2 * i + 1] * cc[2]; const float k0 = ka * cc[1] + kv[2 * i] * cc[0], k1 = kb * cc[3] + kv[2 * i + 1] * cc[2];
                            qv[2 * i] = q0; qv[2 * i + 1] = q1; kv[2 * i] = k0; kv[2 * i + 1] = k1; } }
#pragma unroll
                    for (int i = 0; i < 8; ++i) { kv[i] *= 0.125f; eg[i] = e1; ieg[i] = e2; }
                } else {
#pragma unroll
                    for (int i = 0; i < 8; ++i) { const float g = ((const LAS float*)(lds + L_G))[row * 32 + d0 + i]; eg[i] = __expf(g); ieg[i] = __expf(-g); qv[i] *= 0.17677669529663687f; }
                }
                float kl[8];
#pragma unroll
                for (int i = 0; i < 8; ++i) kl[i] = kv[i] * ieg[i];
                if (PH2) {
                    u32x4 o;
                    o.x = pk2(qv[0] * eg[0], qv[1] * eg[1]); o.y = pk2(qv[2] * eg[2], qv[3] * eg[3]); o.z = pk2(qv[4] * eg[4], qv[5] * eg[5]); o.w = pk2(qv[6] * eg[6], qv[7] * eg[7]);
                    *(LAS u32x4*)(lds + L_QL + row * PQ + d0 * 2) = o;
                    o.x = pk2(qv[0] * ieg[0], qv[1] * ieg[1]); o.y = pk2(qv[2] * ieg[2], qv[3] * ieg[3]); o.z = pk2(qv[4] * ieg[4], qv[5] * ieg[5]); o.w = pk2(qv[6] * ieg[6], qv[7] * ieg[7]);
                    *(LAS u32x4*)(lds + L_QU + row * PQ + d0 * 2) = o;
                    o.x = pk2(kv[0] * eg[0], kv[1] * eg[1]); o.y = pk2(kv[2] * eg[2], kv[3] * eg[3]); o.z = pk2(kv[4] * eg[4], kv[5] * eg[5]); o.w = pk2(kv[6] * eg[6], kv[7] * eg[7]);
                    *(LAS u32x4*)(lds + L_KU + row * PQ + d0 * 2) = o;
                }
                { u32x4 o; o.x = pk2(kl[0], kl[1]); o.y = pk2(kl[2], kl[3]); o.z = pk2(kl[4], kl[5]); o.w = pk2(kl[6], kl[7]);
                  *(LAS u32x4*)(lds + L_KL + row * PQ + d0 * 2) = o; }
            }
            *(LAS u32x4*)(lds + L_VT + row * PS + c8 * 16) = pv;
        }
        if (c + 1 < LSEG) LIN_LOAD(c + 1);
        __syncthreads();
#pragma unroll
        for (int j = 0; j < NT; ++j) {
            const int d = db[j] * 16 + (lane & 15);
            if (PH2) {
#pragma unroll
                for (int r = 0; r < 4; ++r) { const int e = eb[j] * 16 + 4 * (lane >> 4) + r; *(LAS unsigned short*)(lds + L_ST + e * PQ + d * 2) = (unsigned short)(pk2(st[j][r], 0.f) & 0xffffu); }
            }
            f32x4 u = (f32x4){0.f, 0.f, 0.f, 0.f};
#pragma unroll
            for (int ks = 0; ks < 2; ++ks) u = MFMA16(trfrag(lds + L_VT, PS, 32 * ks, eb[j] * 16, lane), trfrag(lds + L_KL, PQ, 32 * ks, db[j] * 16, lane), u);
            const float egl = RET ? __expf(64.f * lng) : __expf(((const LAS float*)(lds + L_GL))[d]);
#pragma unroll
            for (int r = 0; r < 4; ++r) st[j][r] = egl * (st[j][r] + u[r]);
            ac[j] *= egl;
        }
        if (PH2) {
#pragma unroll
            for (int j = 0; j < 2; ++j) { const int i = wid + 8 * j, tb = i >> 2, sb = i & 3;
                f32x4 lo = (f32x4){0.f, 0.f, 0.f, 0.f}, up = (f32x4){0.f, 0.f, 0.f, 0.f};
                if (sb <= tb) {
#pragma unroll
                    for (int ks = 0; ks < DK / 32; ++ks) lo = MFMA16(frag(lds + L_QL, PQ, tb * 16, ks, lane), frag(lds + L_KL, PQ, sb * 16, ks, lane), lo); }
                if (sb >= tb) {
#pragma unroll
                    for (int ks = 0; ks < DK / 32; ++ks) up = MFMA16(frag(lds + L_QU, PQ, tb * 16, ks, lane), frag(lds + L_KU, PQ, sb * 16, ks, lane), up); }
                const int s = sb * 16 + (lane & 15);
#pragma unroll
                for (int r = 0; r < 4; ++r) { const int t = tb * 16 + 4 * (lane >> 4) + r; const float v = (s <= t) ? lo[r] : up[r];
                    *(LAS unsigned short*)(lds + L_AM + t * PS + s * 2) = (unsigned short)(pk2(v, 0.f) & 0xffffu); } }
        }
        __syncthreads();
        if (PH2) {
#pragma unroll
            for (int j = 0; j < 2; ++j) { const int i = wid + 8 * j, tb = i >> 2, ob = i & 3;
                f32x4 o = (f32x4){0.f, 0.f, 0.f, 0.f};
#pragma unroll
                for (int ks = 0; ks < 2; ++ks) o = MFMA16(frag(lds + L_AM, PS, tb * 16, ks, lane), trfrag(lds + L_VT, PS, 32 * ks, ob * 16, lane), o);
#pragma unroll
                for (int ks = 0; ks < DK / 32; ++ks) o = MFMA16(frag(lds + L_QL, PQ, tb * 16, ks, lane), frag(lds + L_ST, PQ, ob * 16, ks, lane), o);
#pragma unroll
                for (int r = 0; r < 4; ++r) ((LAS float*)(lds + L_OUT))[(tb * 16 + 4 * (lane >> 4) + r) * 65 + ob * 16 + (lane & 15)] = o[r]; }
            __syncthreads();
            { const size_t m = m0 + row; const int e0 = 8 * c8; float v[8]; float ss = 0.f;
#pragma unroll
              for (int i = 0; i < 8; ++i) { v[i] = ((const LAS float*)(lds + L_OUT))[row * 65 + e0 + i]; ss += v[i] * v[i]; }
              ss += sx<1>(ss); ss += sx<2>(ss); ss += sx<4>(ss);
              const float rstd = rsqrtf(ss * (1.0f / 64.0f) + EPS);
              const u32x4 gw = gcur; const unsigned* gp = (const unsigned*)&gw; float y[8];
#pragma unroll
              for (int i = 0; i < 4; ++i) { y[2 * i] = v[2 * i] * rstd * gn8[2 * i] * silu_f(bflo(gp[i])); y[2 * i + 1] = v[2 * i + 1] * rstd * gn8[2 * i + 1] * silu_f(bfhi(gp[i])); }
              const bool on = RET ? ((DBG_GROUPS & 1) != 0) : ((DBG_GROUPS & 4) != 0);
              u32x2 o; o.x = pk4_fp8(y[0] * FP8_ACT_SCALE, y[1] * FP8_ACT_SCALE, y[2] * FP8_ACT_SCALE, y[3] * FP8_ACT_SCALE); o.y = pk4_fp8(y[4] * FP8_ACT_SCALE, y[5] * FP8_ACT_SCALE, y[6] * FP8_ACT_SCALE, y[7] * FP8_ACT_SCALE);
              if (!on) o = (u32x2){0u, 0u};
              *(u32x2*)(MIX + m * DM + (RET ? 0 : 768) + h * 64 + e0) = o; }
        }
    }
#undef LIN_LOAD
    if (!PH2) {
#pragma unroll
        for (int j = 0; j < NT; ++j) { const int d = db[j] * 16 + (lane & 15);
            *(f32x4*)(Est + ((size_t)entry * DK + d) * 64 + eb[j] * 16 + 4 * (lane >> 4)) = st[j];
            if (eb[j] == 0 && (lane >> 4) == 0) Aseg[(size_t)entry * DK + d] = ac[j]; }
    }
    __syncthreads();
}
}

namespace att {
constexpr int A_K = 0, A_V = 24576, A_O0 = 0, A_LS = 73728, A_END = 75776;
#define MFMA32(a, b, c) __builtin_amdgcn_mfma_f32_32x32x16_bf16(a, b, c, 0, 0, 0)
typedef short v4i16_t __attribute__((ext_vector_type(4)));
__device__ __forceinline__ s16x4 vtr(const LAS unsigned char* p) { return __builtin_bit_cast(s16x4, __builtin_amdgcn_ds_read_tr16_b64_v4i16((LAS v4i16_t*)p)); }
__device__ __forceinline__ int crow(int r, int hi) { return (r & 3) + 8 * (r >> 2) + 4 * hi; }
__device__ __forceinline__ void unit(LAS unsigned char* lds, const unsigned char* QK8, const unsigned char* VT8, unsigned char* MIX, int b, int h, int jq, float lam, float negM, const float* subg, float oscale, const int g_wave) {
    const int tid = otid(), lane = tid & 63, r32 = lane & 31, hh = lane >> 5, wid = __builtin_amdgcn_readfirstlane(tid >> 6);
    const size_t rowbase = (size_t)b * SEQ;
    const int q0 = jq * 256 + wid * 32;
    const int ntile = 4 * jq + 4, my_nt = 4 * jq + (wid >> 1) + 1;
    const int krow = (tid >> 2) & 63, kch = (tid & 3) ^ ((krow >> 2) & 3);
    const unsigned vgo = (unsigned)((tid >> 2) * 64 + (((tid & 3) ^ ((tid >> 4) & 3)) << 4));
    const unsigned ldsw = (unsigned)wid * 1024u;
    const unsigned vrd0 = (unsigned)(r32 * 64 + ((hh ^ ((r32 >> 2) & 3)) << 4)), vrd1 = (unsigned)(r32 * 64 + (((2 + hh) ^ ((r32 >> 2) & 3)) << 4));
    unsigned o0r[32];
#pragma unroll
    for (int i = 0; i < 32; ++i) o0r[i] = 0u;
#pragma unroll 1
    for (int comp = 0; comp < 2; ++comp) {
        const char* Pb = (const char*)(QK8 + rowbase * 1024 + h * 128 + comp * 64);
        i32x8 qf;
        { const unsigned qo = (unsigned)((q0 + r32) * 1024 + 32 * hh); const i32x4 lo_ = *(const i32x4*)(Pb + qo), hi_ = *(const i32x4*)(Pb + qo + 16); qf = __builtin_shufflevector(lo_, hi_, 0, 1, 2, 3, 4, 5, 6, 7); }
        const unsigned kgo = (unsigned)(krow * 1024 + 512 + kch * 16);
        const char* Vtb = (const char*)(VT8 + (((size_t)b * 4 + h) * 128) * 8192);
        f32x16 o[4];
#pragma unroll
        for (int e = 0; e < 4; ++e)
#pragma unroll
            for (int r = 0; r < 16; ++r) o[e][r] = 0.f;
        float l = 0.f;
#define ATT_GLDS(sb, vo, dst) do { unsigned keep_; asm volatile("s_mov_b32 %0, m0\n\ts_mov_b32 m0, %3\n\ts_nop 0\n\tglobal_load_lds_dwordx4 %1, %2\n\ts_mov_b32 m0, %0" \
            : "=&s"(keep_) : "v"(vo), "s"(sb), "s"(dst) : "memory"); } while (0)
#define ATT_STAGE(buf, tt) do { const char* Pt = Pb + (size_t)(tt) * 64 * 1024; \
            if (wid < 4) ATT_GLDS(Pt, kgo, (unsigned)__builtin_amdgcn_readfirstlane((int)(ldsb + A_K + (buf) * 8192 + ldsw))); \
            ATT_GLDS(Vtb + (size_t)(tt) * 8192, vgo, (unsigned)__builtin_amdgcn_readfirstlane((int)(ldsb + A_V + (buf) * 16384 + ldsw))); } while (0)
        const unsigned ldsb = (unsigned)(size_t)lds;
        const int kpi = (r32 & 3) + 4 * (r32 >> 3) + 16 * ((r32 >> 2) & 1);
        const unsigned kro0 = (unsigned)(kpi * 64 + (((2 * hh) ^ ((kpi >> 2) & 3)) << 4)), kro1 = (unsigned)(kpi * 64 + (((2 * hh + 1) ^ ((kpi >> 2) & 3)) << 4));
        ATT_STAGE(0, 0);
        if (ntile > 1) ATT_STAGE(1, 1);
        __builtin_amdgcn_s_waitcnt(0x0F70);
        VM_WAIT(); __syncthreads();
        int cur = 0, nx2 = 2;
        for (int t = 0; t < ntile; ++t) {
            const bool more = (t + 2 < ntile);
            if (more) ATT_STAGE(nx2, t + 2);
            if (t < my_nt) {
                const LAS unsigned char* Kb = lds + A_K + cur * 8192; const LAS unsigned char* Vb = lds + A_V + cur * 16384;
                const f32x16 m5 = {-5.f, -5.f, -5.f, -5.f, -5.f, -5.f, -5.f, -5.f, -5.f, -5.f, -5.f, -5.f, -5.f, -5.f, -5.f, -5.f};
                f32x16 s0, s1;
                { const i32x4 a0 = *(const LAS i32x4*)(Kb + kro0), a1 = *(const LAS i32x4*)(Kb + kro1), b0 = *(const LAS i32x4*)(Kb + 2048 + kro0), b1 = *(const LAS i32x4*)(Kb + 2048 + kro1);
                  const i32x8 ka = {a0[0], a0[1], a0[2], a0[3], a1[0], a1[1], a1[2], a1[3]}, kb = {b0[0], b0[1], b0[2], b0[3], b1[0], b1[1], b1[2], b1[3]};
                  s0 = __builtin_amdgcn_mfma_scale_f32_32x32x64_f8f6f4(ka, qf, m5, 0, 0, 0, 124, 0, 123);
                  s1 = __builtin_amdgcn_mfma_scale_f32_32x32x64_f8f6f4(kb, qf, m5, 0, 0, 0, 124, 0, 123); }
                i32x4 va[4], vb[4];
#pragma unroll
                for (int e = 0; e < 4; ++e) { va[e] = *(const LAS i32x4*)(Vb + e * 2048 + vrd0); vb[e] = *(const LAS i32x4*)(Vb + e * 2048 + vrd1); }
#pragma unroll
                for (int r = 0; r < 16; ++r) { s0[r] = __builtin_amdgcn_exp2f(s0[r]); l += s0[r]; }
#pragma unroll
                for (int r = 0; r < 16; ++r) { s1[r] = __builtin_amdgcn_exp2f(s1[r]); l += s1[r]; }
                const i32x8 pf = {(int)pk4_fp8(s0[0], s0[1], s0[2], s0[3]), (int)pk4_fp8(s0[4], s0[5], s0[6], s0[7]), (int)pk4_fp8(s0[8], s0[9], s0[10], s0[11]), (int)pk4_fp8(s0[12], s0[13], s0[14], s0[15]),
                                  (int)pk4_fp8(s1[0], s1[1], s1[2], s1[3]), (int)pk4_fp8(s1[4], s1[5], s1[6], s1[7]), (int)pk4_fp8(s1[8], s1[9], s1[10], s1[11]), (int)pk4_fp8(s1[12], s1[13], s1[14], s1[15])};
#pragma unroll
                for (int e = 0; e < 4; ++e) { const i32x8 vf = {va[e][0], va[e][1], va[e][2], va[e][3], vb[e][0], vb[e][1], vb[e][2], vb[e][3]};
                    o[e] = __builtin_amdgcn_mfma_scale_f32_32x32x64_f8f6f4(pf, vf, o[e], 0, 0, 0, 127, 0, 124); }
            }
            if (!more) VM_WAIT(); else if (wid < 4) asm volatile("s_waitcnt vmcnt(2)" ::: "memory"); else asm volatile("s_waitcnt vmcnt(1)" ::: "memory");
            __syncthreads();
            cur = (cur == 2) ? 0 : cur + 1; nx2 = (nx2 == 2) ? 0 : nx2 + 1;
        }
#undef ATT_GLDS
#undef ATT_STAGE
        l = sum_halves(l);
        LAS float* ls = (LAS float*)(lds + A_LS) + wid * 64 + comp * 32;
        if (hh == 0) ls[r32] = l;
        LDS_WAIT(); asm volatile("" ::: "memory");
        float inv[16];
#pragma unroll
        for (int r = 0; r < 16; ++r) inv[r] = 1.0f / ls[crow(r, hh)];
        if (comp == 0) {
#pragma unroll
            for (int e = 0; e < 4; ++e)
#pragma unroll
                for (int i = 0; i < 8; ++i) o0r[e * 8 + i] = pk2(o[e][2 * i] * inv[2 * i], o[e][2 * i + 1] * inv[2 * i + 1]);
        } else {
            float ss[16];
#pragma unroll
            for (int r = 0; r < 16; ++r) ss[r] = 0.f;
#pragma unroll
            for (int e = 0; e < 4; ++e)
#pragma unroll
                for (int i = 0; i < 8; ++i) { const unsigned w = o0r[e * 8 + i];
                    const float v0 = bflo(w) - lam * o[e][2 * i] * inv[2 * i], v1 = bfhi(w) - lam * o[e][2 * i + 1] * inv[2 * i + 1];
                    o[e][2 * i] = v0; o[e][2 * i + 1] = v1; ss[2 * i] += v0 * v0; ss[2 * i + 1] += v1 * v1; }
#pragma unroll
            for (int r = 0; r < 16; ++r) { float s = ss[r]; s += sx<1>(s); s += sx<2>(s); s += sx<4>(s); s += sx<8>(s); s += sx<16>(s);
                ss[r] = rsqrtf(s * (1.0f / 128.0f) + EPS) * oscale; }
            LAS unsigned char* stg = lds + A_O0 + wid * 8192;
            const int lane_e = olane(), r32e = lane_e & 31;
            LDS_WAIT(); asm volatile("" ::: "memory");
#pragma unroll
            for (int e = 0; e < 4; ++e) { const float gsub = subg[32 * e + r32e] * FP8_ACT_SCALE;
#pragma unroll
                for (int r = 0; r < 16; r += 2) { const float y0 = ((DBG_GROUPS & 2) != 0) ? o[e][r] * ss[r] * gsub : 0.f, y1 = ((DBG_GROUPS & 2) != 0) ? o[e][r + 1] * ss[r + 1] * gsub : 0.f;
                    const int w = __builtin_amdgcn_cvt_pk_fp8_f32(y0, y1, 0, false);
                    *(LAS unsigned char*)(stg + crow(r, hh) * 128 + 32 * e + r32) = (unsigned char)(w & 0xff); *(LAS unsigned char*)(stg + crow(r + 1, hh) * 128 + 32 * e + r32) = (unsigned char)((w >> 8) & 0xff); } }
            LDS_WAIT(); asm volatile("" ::: "memory");
            { unsigned ob = (unsigned)((q0 + (lane_e >> 3)) * DM + 256 + (lane_e & 7) * 16); unsigned char* Mb = MIX + rowbase * DM + h * 128;
#pragma unroll
              for (int i = 0; i < 4; ++i) { const u32x4 w = *(const LAS u32x4*)(stg + ((lane_e >> 3) + 8 * i) * 128 + (lane_e & 7) * 16); *(u32x4*)(Mb + ob + i * 8 * DM) = w; } }
            LDS_WAIT(); asm volatile("" ::: "memory");
        }
    }
    __syncthreads();
}
}

struct Args { const float* in[25]; float* out; unsigned char* ws; int ph_lo, ph_hi; };
static_assert(sizeof(Args) == 27 * 8 + 8, "Args has no padding");
constexpr int NPHASE = 1 + 9 * DEPTH;

__global__ void __launch_bounds__(NWAVES * 64, 2) fwd(Args args) {
    extern __shared__ __attribute__((aligned(16))) unsigned char lds_raw[];
    LAS unsigned char* lds = (LAS unsigned char*)lds_raw;
    const int wave = __builtin_amdgcn_readfirstlane((int)threadIdx.x >> 6); const int g_wave = wave; const int tid0 = otid();
    const int G = gridDim.x; const int bx = blockIdx.x; const int vcu = (G % 8 == 0) ? (bx % 8) * (G / 8) + bx / 8 : bx;
    const int gw = vcu * NWAVES + wave, NGW = G * NWAVES;
    __builtin_assume(gw >= 0 && gw < 4096 && vcu >= 0 && vcu < 512 && G > 0 && G <= 512);
    unsigned char* ws = args.ws;
    unsigned* ctl = (unsigned*)(ws + WS_CTL);
    for (int u = tid0; u < (LDS_BYTES - LDSCTL_OFF) / 4; u += NWAVES * 64) ((LAS unsigned*)(lds + LDSCTL_OFF))[u] = 0u;
    __syncthreads();
    XcdBarrier bar; bar.bar = ctl + CW_BAR; bar.x = 0; bar.st = nullptr;
    if (MK_N_LAUNCHES == 1) bar = xcd_barrier_post(ctl + CW_BAR, (volatile LAS unsigned*)(lds + MISC_OFF) + 8, tid0 == 0);
    const int lo = args.ph_lo, hi = args.ph_hi;
#ifndef PHMASK
#define PHMASK 0x3ff
#endif
#define IN(k) (lo <= (k) && (k) < hi)
#define PHON(j) ((PHMASK >> (j)) & 1)
#define SEAM(k) do { if (IN(k) && IN((k) + 1)) { xcd_barrier(bar, otid() == 0); if (RPT_PHASE == 90) { xcd_barrier(bar, otid() == 0); xcd_barrier(bar, otid() == 0); } } } while (0)
    if (tid0 == 0) {
#pragma unroll
        for (int k = 0; k < 25; ++k) ((LAS unsigned long long*)(lds + PTR_OFF))[k] = (unsigned long long)args.in[k];
        ((LAS unsigned long long*)(lds + PTR_OFF))[25] = (unsigned long long)args.out;
    }
    __syncthreads();
#define WSP(Tp, off) ((Tp*)(wsl + (off)))
#define WSL() unsigned char* wsl = ws; asm volatile("" : "+s"(wsl))

    if (PHON(0) && IN(0)) {
        const int tid = otid(), lane = tid & 63; WSL();
        const float* c_in = INF(1); const int* pos_in = (const int*)INF(2); const float* w_mod = INF(3); const float* b_mod = INF(4); const float* w_in = INF(7);
        const float* diff_q_g = INF(9); const float* diff_k_g = INF(10); const float* lam_q1 = INF(11); const float* lam_k1 = INF(12); const float* lam_q2 = INF(13); const float* lam_k2 = INF(14);
        const float* gla_w_a2 = INF(16); const float* w_out = INF(19); const float* w_gate = INF(22); const float* w_up = INF(23); const float* w_down = INF(24);
        float* mod = WSP(float, WS_MOD); float* scal = WSP(float, WS_SCAL); f32x2* csr = WSP(f32x2, WS_CSR); f32x2* csd = WSP(f32x2, WS_CSD);
        LAS unsigned char* scr = lds + wave * 8704;
        LAS float* sact = (LAS float*)(lds + 69632);
        for (int i = tid; i < 8 * 1024; i += NWAVES * 64) sact[i] = silu_f(c_in[i]);
        __syncthreads();
        { unsigned char* Winq = WSP(unsigned char, WS_WIN); float* swin = WSP(float, WS_SWIN);
          constexpr int U_WIN = 2 * 53, U_LA = 4, U_W1 = 2 * 32 * 16;
#pragma unroll 1
          for (int bu = vcu; bu < U_WIN; bu += G) { const int l = bu / 53, st = bu % 53; quant_strip<false>(lds, w_in + (size_t)l * 1024 * IN_W, IN_W, 64 * st, Winq + (size_t)l * NP * 1024, swin + l * NP, 1, nullptr, wave, lane); }
#pragma unroll 1
          for (int bu = vcu; bu < U_W1; bu += G) { const int le = bu >> 4, st = bu & 15;
              quant_strip<false>(lds, (st < 8 ? w_gate : w_up) + (size_t)le * 1024 * 512, 512, 64 * (st & 7), WSP(unsigned char, WS_W1) + (size_t)le * 1024 * 1024, WSP(float, WS_SW1) + (size_t)le * 1024, st < 8 ? 2 : 3, nullptr, wave, lane); }
#pragma unroll 1
          for (int bu = G - 1 - vcu; bu < U_LA; bu += G) { const int l = bu >> 1, st = bu & 1; quant_strip<true>(lds, w_in + (size_t)l * 1024 * IN_W, IN_W, 64 * st, Winq + (size_t)l * NP * 1024, swin + l * NP, 1, gla_w_a2 + (size_t)l * 16 * 128, wave, lane); }
        }
        constexpr int I_MOD = 2 * 384, I_TABR = 1024, I_TABD = 1024, I_ZERO = 256, I_SC = 2;
        constexpr int I_WOUT = 16 * 16, I_DN = 8 * 16, I_LAYER = I_WOUT + 32 * I_DN;
        constexpr int I_PRE = I_MOD + I_TABR + I_TABD + I_ZERO + I_SC, NITEMS = I_PRE + 2 * I_LAYER;
        _Pragma("unroll 1") for (int rep_ = 0; rep_ < 1 + (RPT_PHASE == 100 ? RPT_N : 0); ++rep_)
        for (int it = gw; it < NITEMS; it += NGW) {
            int r = it;
            if (r < I_MOD) {
                const int l = r / 384, col = (r % 384) * 16 + (lane & 15), ks = lane >> 4;
                float acc[8] = {0.f, 0.f, 0.f, 0.f, 0.f, 0.f, 0.f, 0.f};
                const float* wp = w_mod + (size_t)l * 1024 * 6144 + col;
#pragma unroll 16
                for (int k = ks; k < 1024; k += 4) { const float w = wp[(size_t)k * 6144];
#pragma unroll
                    for (int b = 0; b < 8; ++b) acc[b] += sact[b * 1024 + k] * w; }
#pragma unroll
                for (int b = 0; b < 8; ++b) { float a = acc[b]; a += sx<16>(a); a = sum_halves(a); if (ks == 0) mod[((size_t)l * 8 + b) * 6144 + col] = a + b_mod[l * 6144 + col]; }
                continue; }
            r -= I_MOD;
            if (r < I_TABR) {
                const int i = lane & 31; const float inv_freq = exp2f(-((float)i * (1.0f / 32.0f)) * 13.287712379549449f);
                for (int s = 0; s < 32; ++s) { const int t = r * 64 + 2 * s + (lane >> 5); const float ang = (float)pos_in[t] * inv_freq; float sn, cs; sincosf(ang, &sn, &cs); csr[(size_t)t * 32 + i] = (f32x2){cs, sn}; }
                continue; }
            r -= I_TABR;
            if (r < I_TABD) {
                const int i = lane & 7; const float inv_freq = exp2f(-((float)i * (1.0f / 8.0f)) * 18.931568569324174f);
                for (int s = 0; s < 8; ++s) { const int t = r * 64 + 8 * s + (lane >> 3); const float ang = (float)pos_in[t] * inv_freq; float sn, cs; sincosf(ang, &sn, &cs); csd[(size_t)t * 8 + i] = (f32x2){cs, sn}; }
                continue; }
            r -= I_TABD;
            if (r < I_ZERO) {
                const int l = r >> 7, j = r & 127; u32x4* p = (u32x4*)(WSP(unsigned char, WS_WIN) + ((size_t)l * NP + C_PAD + j) * 1024);
                p[lane] = (u32x4){0u, 0u, 0u, 0u}; if (lane == 0) WSP(float, WS_SWIN)[l * NP + C_PAD + j] = 1.0f;
                continue; }
            r -= I_ZERO;
            if (r < I_SC) {
                const int l = r; const float s1 = wave_sum(lam_q1[l * 64 + lane] * lam_k1[l * 64 + lane]), s2 = wave_sum(lam_q2[l * 64 + lane] * lam_k2[l * 64 + lane]);
                const float mq = wave_max(fabsf(diff_q_g[l * 64 + lane])), mk = wave_max(fabsf(diff_k_g[l * 64 + lane]));
                const float lam_init = 0.8f - 0.6f * expf(-0.3f * (float)l);
                if (lane == 0) { scal[l * 4 + 0] = expf(s1) - expf(s2) + lam_init; scal[l * 4 + 1] = -(8.0f * mq * mk * LOG2E + 0.5f); scal[l * 4 + 2] = 1.0f - lam_init; }
                continue; }
            r -= I_SC;
            const int l = r / I_LAYER; r -= l * I_LAYER;
            if (r < I_WOUT) { tr_item8(w_out + (size_t)l * 1024 * 1024, 1024, 1024, WSP(unsigned char, WS_WOUT) + (size_t)l * 1024 * 1024, 1024, scr, r, lane); continue; } r -= I_WOUT;
            const int e = r / I_DN; r -= e * I_DN; const size_t le = (size_t)l * 32 + e;
            tr_item8(w_down + le * 512 * 1024, 512, 1024, WSP(unsigned char, WS_W2) + le * 1024 * 512, 512, scr, r, lane);
        }
        __syncthreads();
    }
    SEAM(0);

    for (int l = 0; l < DEPTH; ++l) {
        const int pb = 1 + 9 * l;
#define MODL (WSP(const float, WS_MOD) + (size_t)l * 8 * 6144)
        if (PHON(1) && IN(pb + 0)) {
            const int tid = otid(), lane = tid & 63; (void)tid; (void)lane; WSL();
            const float* xf = (l == 0) ? INF(0) : nullptr; const bf16* XB = WSP(const bf16, WS_XB); const float* modl = MODL; const float* norm1_g = INF(5); unsigned char* ACTq = WSP(unsigned char, WS_ACT); float* sa1 = WSP(float, WS_SA1);
            const float* g1 = norm1_g + l * 1024;
            _Pragma("unroll 1") for (int rep_ = 0; rep_ < 1 + (RPT_PHASE == 1 ? RPT_N : 0); ++rep_)
            for (int m0 = gw; m0 < T; m0 += 4 * NGW) {
                f32x4 v[4][4];
#pragma unroll
                for (int q = 0; q < 4; ++q) { const int mq = m0 + q * NGW, m = mq < T ? mq : T - 1;
#pragma unroll
                    for (int j = 0; j < 4; ++j) v[q][j] = ldx4(xf, XB, (size_t)m * DM + 4 * lane + 256 * j); }
#pragma unroll
                for (int q = 0; q < 4; ++q) { const int m = m0 + q * NGW; if (m < T) {
                    const int b = m >> 13; const float* mb = modl + (size_t)b * 6144; float s = 0.f;
#pragma unroll
                    for (int j = 0; j < 4; ++j) s += (v[q][j][0] * v[q][j][0] + v[q][j][1] * v[q][j][1]) + (v[q][j][2] * v[q][j][2] + v[q][j][3] * v[q][j][3]);
                    const float rstd = rsqrtf(wave_sum(s) * (1.0f / 1024.0f) + EPS);
                    f32x4 y[4]; float am = 0.f;
#pragma unroll
                    for (int j = 0; j < 4; ++j) { const int k = 4 * lane + 256 * j; const f32x4 gg = *(const f32x4*)(g1 + k), sh = *(const f32x4*)(mb + k), sc = *(const f32x4*)(mb + 1024 + k);
                        y[j] = v[q][j] * rstd * gg * (sc + 1.0f) + sh; am = fmaxf(am, fmaxf(fmaxf(fabsf(y[j][0]), fabsf(y[j][1])), fmaxf(fabsf(y[j][2]), fabsf(y[j][3])))); }
                    am = wave_max(am); const float inv = am > 0.f ? 127.0f / am : 0.f;
                    if (lane == 0) sa1[m] = am > 0.f ? am * (1.0f / 127.0f) : 1.0f;
                    unsigned* o4 = (unsigned*)(ACTq + (size_t)m * 1024) + lane;
#pragma unroll
                    for (int j = 0; j < 4; ++j) { unsigned w = 0u;
#pragma unroll
                        for (int e = 0; e < 4; ++e) w |= ((unsigned)(int)__builtin_rintf(y[j][e] * inv) & 0xffu) << (8 * e);
                        o4[64 * j] = w; } } }
            }
        }
        SEAM(pb + 0);
        if (PHON(2) && IN(pb + 1)) {
            const int tid = otid(), lane = tid & 63; (void)tid; (void)lane; WSL();
            bf16* ACT = WSP(bf16, WS_ACT); bf16* P = WSP(bf16, WS_P);
            pg8::Gemm g{ACT, (const bf16*)(WSP(unsigned char, WS_WIN) + (size_t)l * NP * 1024), 512, 512, 512}; pg8::StaticOrder<T / 256, NP / 256> S; S.init(G, bx);
            pg8::EpiInproj E{P, NP, WSP(const float, WS_SA1), WSP(const float, WS_SWIN) + l * NP, INF(9) + l * 64, INF(10) + l * 64, WSP(const f32x2, WS_CSD), WSP(unsigned char, WS_VT8), WSP(unsigned char, WS_QK8)};
            _Pragma("unroll 1") for (int rep_ = 0; rep_ < 1 + (RPT_PHASE == 2 ? RPT_N : 0); ++rep_)
            pg8::gemm_phase<pg8::EpiInproj, pg8::StaticOrder<T / 256, NP / 256>, 0, 1>(lds, g, S, E, g_wave);
        }
        SEAM(pb + 1);
        if (PHON(3) && IN(pb + 2)) {
            const int tid = otid(), lane = tid & 63; (void)tid; (void)lane; WSL();
            const float* diff_q_g = INF(9); const float* diff_k_g = INF(10); const float* gla_b_a = INF(17); bf16* P = WSP(bf16, WS_P); unsigned char* ACT = WSP(unsigned char, WS_ACT); f32x2* csr = WSP(f32x2, WS_CSR);
            float* Eret = WSP(float, WS_EST); float* Egla = WSP(float, WS_EGL); float* Asr = WSP(float, WS_ASR); float* Asg = WSP(float, WS_ASG);
            _Pragma("unroll 1") for (int rep_ = 0; rep_ < 1 + (RPT_PHASE == 31 ? RPT_N : 0); ++rep_)
            for (int u = vcu; u < 1024; u += G) {
                const int r = u & 511, bh = r >> 4, seg = r & 15;
                if (u < 512) lin::unit<64, true, false>(lds, P, ACT, csr, bh >> 2, bh & 3, seg, nullptr, nullptr, Eret, Asr, g_wave);
                else lin::unit<32, false, false>(lds, P, ACT, csr, bh >> 2, bh & 3, seg, gla_b_a + l * 128, nullptr, Egla, Asg, g_wave);
            }
        }
        SEAM(pb + 2);
        if (PHON(4) && IN(pb + 3)) {
            const int tid = otid(), lane = tid & 63; (void)tid; (void)lane; WSL();
            const float* scal = WSP(const float, WS_SCAL); const float* diff_sub_g = INF(15); const float* ret_norm_g = INF(8); const float* gla_norm_g = INF(18); const float* gla_b_a = INF(17); bf16* P = WSP(bf16, WS_P); unsigned char* ACT = WSP(unsigned char, WS_ACT); f32x2* csr = WSP(f32x2, WS_CSR);
            float* Eret = WSP(float, WS_EST); float* Egla = WSP(float, WS_EGL); float* Asr = WSP(float, WS_ASR); float* Asg = WSP(float, WS_ASG);
            const float lam = scal[l * 4 + 0], negM = scal[l * 4 + 1], osc = scal[l * 4 + 2];
#ifndef NO_ATT
            _Pragma("unroll 1") for (int rep_ = 0; rep_ < 1 + (RPT_PHASE == 41 ? RPT_N : 0); ++rep_)
            for (int pu = vcu; pu < 512; pu += G) {
                const int bh = pu >> 4, jp = pu & 15;
                att::unit(lds, WSP(const unsigned char, WS_QK8), WSP(const unsigned char, WS_VT8), ACT, bh >> 2, bh & 3, jp, lam, negM, diff_sub_g + l * 128, osc, g_wave);
                att::unit(lds, WSP(const unsigned char, WS_QK8), WSP(const unsigned char, WS_VT8), ACT, bh >> 2, bh & 3, 31 - jp, lam, negM, diff_sub_g + l * 128, osc, g_wave);
            }
#endif
#ifndef NO_LIN2
            _Pragma("unroll 1") for (int rep_ = 0; rep_ < 1 + ((RPT_PHASE == 42 || RPT_PHASE == 43 || RPT_PHASE == 44) ? RPT_N : 0); ++rep_)
            for (int u = vcu + ((RPT_PHASE == 44 && rep_ > 0) ? 512 : 0); u < ((RPT_PHASE == 43 && rep_ > 0) ? 512 : 1024); u += G) {
                const int r = u & 511, bh = r >> 4, seg = ((r & 15) + 8 * (r >> 8) + (u < 512 ? 0 : 4)) & 15;
                if (u < 512) lin::unit<64, true, true>(lds, P, ACT, csr, bh >> 2, bh & 3, seg, nullptr, ret_norm_g + l * 64, Eret, Asr, g_wave);
                else lin::unit<32, false, true>(lds, P, ACT, csr, bh >> 2, bh & 3, seg, gla_b_a + l * 128, gla_norm_g + l * 64, Egla, Asg, g_wave);
            }
#endif
        }
        SEAM(pb + 3);
        if (PHON(5) && IN(pb + 4)) {
            const int tid = otid(), lane = tid & 63; (void)tid; (void)lane; WSL();
            const float* modl = MODL;
            pg8::Gemm g{WSP(const bf16, WS_ACT), (const bf16*)(WSP(unsigned char, WS_WOUT) + (size_t)l * 1024 * 1024), 512, 512, 512}; pg8::StaticOrder<T / 256, 4> S; S.init(G, bx);
            pg8::EpiResid E{(l == 0) ? INF(0) : nullptr, WSP(bf16, WS_XB), modl + 2048};
            _Pragma("unroll 1") for (int rep_ = 0; rep_ < 1 + ((RPT_PHASE == 5 && l == 0) ? RPT_N : 0); ++rep_)
            pg8::gemm_phase<pg8::EpiResid, pg8::StaticOrder<T / 256, 4>, 0, 2>(lds, g, S, E, g_wave);
        }
        SEAM(pb + 4);
        if (PHON(6) && IN(pb + 5)) {
            const int tid = otid(), lane = tid & 63; (void)tid; (void)lane; WSL();
            const float* modl = MODL; const float* router_w = INF(20); const float* router_b = INF(21); const float* norm2_g = INF(6); const bf16* XB = WSP(const bf16, WS_XB); bf16* ACT = WSP(bf16, WS_ACT); int* tokinfo = WSP(int, WS_ROUTE); int* tokS = WSP(int, WS_TOKS); unsigned char* h2q = WSP(unsigned char, WS_H2Q); float* sa2 = WSP(float, WS_SA2);
            constexpr int WR_PITCH = 2064, LG_OFF = 32 * WR_PITCH;
            _Pragma("unroll 1") for (int rep_ = 0; rep_ < 1 + (RPT_PHASE == 6 ? RPT_N : 0); ++rep_) {
            { f32x4 rw[2][8];
#pragma unroll
              for (int q = 0; q < 2; ++q)
#pragma unroll
                  for (int j = 0; j < 8; ++j) rw[q][j] = *(const f32x4*)(router_w + (size_t)(tid + 512 * q) * 32 + 4 * j);
#pragma unroll
              for (int q = 0; q < 2; ++q)
#pragma unroll
                  for (int j = 0; j < 8; ++j)
#pragma unroll
                      for (int e = 0; e < 4; ++e) *(LAS unsigned short*)(lds + (4 * j + e) * WR_PITCH + (tid + 512 * q) * 2) = (unsigned short)(pk2(rw[q][j][e], 0.f) & 0xffffu); }
            LAS unsigned* lcnt = (LAS unsigned*)(lds + 83968);
            if (tid < 64) lcnt[tid] = 0u;
            { int Gl = G; asm volatile("" : "+s"(Gl));
#pragma unroll 1
              for (int i = bx * NWAVES * 64 + tid; i < TPAD; i += Gl * NWAVES * 64) tokS[i] = -1; }
            __syncthreads();
            const float* g2 = norm2_g + l * 1024;
            LAS float* lg = (LAS float*)(lds + LG_OFF + wave * 2112);
            for (int gi = gw; gi < T / 16; gi += NGW) {
                for (int r4 = 0; r4 < 16; r4 += 4) {
                    f32x4 v[4][4];
#pragma unroll
                    for (int q = 0; q < 4; ++q) {
#pragma unroll
                        for (int j = 0; j < 4; ++j) v[q][j] = ldx4(nullptr, XB, (size_t)(gi * 16 + r4 + q) * DM + 4 * lane + 256 * j); }
#pragma unroll
                    for (int q = 0; q < 4; ++q) { const int m = gi * 16 + r4 + q; const int b = m >> 13; const float* mb = modl + (size_t)b * 6144 + 3072; float s = 0.f;
#pragma unroll
                        for (int j = 0; j < 4; ++j) s += (v[q][j][0] * v[q][j][0] + v[q][j][1] * v[q][j][1]) + (v[q][j][2] * v[q][j][2] + v[q][j][3] * v[q][j][3]);
                        const float rstd = rsqrtf(wave_sum(s) * (1.0f / 1024.0f) + EPS);
                        u32x2* o8 = (u32x2*)(ACT + (size_t)m * DM) + lane; f32x4 y[4]; float am = 0.f;
#pragma unroll
                        for (int j = 0; j < 4; ++j) { const int k = 4 * lane + 256 * j; const f32x4 gg = *(const f32x4*)(g2 + k), sh = *(const f32x4*)(mb + k), sc = *(const f32x4*)(mb + 1024 + k);
                            y[j] = v[q][j] * rstd * gg * (sc + 1.0f) + sh; u32x2 w; w.x = pk2(y[j][0], y[j][1]); w.y = pk2(y[j][2], y[j][3]); o8[64 * j] = w;
                            am = fmaxf(am, fmaxf(fmaxf(fabsf(y[j][0]), fabsf(y[j][1])), fmaxf(fabsf(y[j][2]), fabsf(y[j][3])))); }
                        am = wave_max(am); const float inv = am > 0.f ? 127.0f / am : 0.f;
                        if (lane == 0) sa2[m] = am > 0.f ? am * (1.0f / 127.0f) : 1.0f;
                        unsigned* o4 = (unsigned*)(h2q + (size_t)m * 1024) + lane;
#pragma unroll
                        for (int j = 0; j < 4; ++j) { unsigned w = 0u;
#pragma unroll
                            for (int e = 0; e < 4; ++e) w |= ((unsigned)(int)__builtin_rintf(y[j][e] * inv) & 0xffu) << (8 * e);
                            o4[64 * j] = w; } }
                }
                VM_WAIT();
                f32x4 a0 = (f32x4){0.f, 0.f, 0.f, 0.f}, a1 = a0;
                const bf16* ap = ACT + (size_t)(gi * 16 + (lane & 15)) * DM + 8 * (lane >> 4);
#pragma unroll 16
                for (int ks = 0; ks < 32; ++ks) { const bf16x8 a = *(const bf16x8*)(ap + 32 * ks);
                    const bf16x8 b0 = *(const LAS bf16x8*)(lds + (lane & 15) * WR_PITCH + (32 * ks + 8 * (lane >> 4)) * 2), b1 = *(const LAS bf16x8*)(lds + (16 + (lane & 15)) * WR_PITCH + (32 * ks + 8 * (lane >> 4)) * 2);
                    a0 = MFMA16(a, b0, a0); a1 = MFMA16(a, b1, a1); }
#pragma unroll
                for (int r = 0; r < 4; ++r) { lg[(4 * (lane >> 4) + r) * 33 + (lane & 15)] = a0[r]; lg[(4 * (lane >> 4) + r) * 33 + 16 + (lane & 15)] = a1[r]; }
                LDS_WAIT(); asm volatile("" ::: "memory");
                if (lane < 16) {
                    const int m = gi * 16 + lane; float best = -3.0e38f; int bcls = 0; float bwa = 0.f, bwb = 0.f;
#pragma unroll
                    for (int g = 0; g < 8; ++g) {
                        float s[4], a[4];
#pragma unroll
                        for (int i = 0; i < 4; ++i) { s[i] = 1.0f / (1.0f + __expf(-lg[lane * 33 + 4 * g + i])); a[i] = s[i] + router_b[4 * g + i]; }
                        int i1 = 0; float v1 = a[0];
                        if (a[1] > v1) { v1 = a[1]; i1 = 1; } if (a[2] > v1) { v1 = a[2]; i1 = 2; } if (a[3] > v1) { v1 = a[3]; i1 = 3; }
                        int i2 = -1; float v2 = -3.0e38f;
                        if (i1 != 0 && a[0] > v2) { v2 = a[0]; i2 = 0; } if (i1 != 1 && a[1] > v2) { v2 = a[1]; i2 = 1; } if (i1 != 2 && a[2] > v2) { v2 = a[2]; i2 = 2; } if (i1 != 3 && a[3] > v2) { v2 = a[3]; i2 = 3; }
                        const float gsum = v1 + v2;
                        const int ea = i1 < i2 ? i1 : i2, eb = i1 < i2 ? i2 : i1;
                        const float sa = ea == 0 ? s[0] : (ea == 1 ? s[1] : s[2]), sb = eb == 1 ? s[1] : (eb == 2 ? s[2] : s[3]);
                        const int pidx = (ea * (7 - ea)) / 2 + (eb - ea - 1);
                        if (gsum > best) { best = gsum; bcls = g * 6 + pidx; const float den = 1.0f / (sa + sb); bwa = sa * den; bwb = sb * den; }
                    }
                    const unsigned rank = __hip_atomic_fetch_add(lcnt + bcls, 1u, __ATOMIC_RELAXED, __HIP_MEMORY_SCOPE_WORKGROUP);
                    *(u32x4*)(tokinfo + (size_t)m * 4) = (u32x4){(unsigned)bcls, rank, __float_as_uint(bwa), __float_as_uint(bwb)};
                }
                LDS_WAIT(); asm volatile("" ::: "memory");
            }
            __syncthreads();
            if (tid < 64) WSP(int, WS_CNTB)[((size_t)l * 512 + vcu) * 64 + tid] = tid < NCLS ? (int)lcnt[tid] : 0;
            __syncthreads();
            }
        }
        SEAM(pb + 5);
        if (PHON(7) && IN(pb + 6)) {
            const int tid = otid(), lane = tid & 63; (void)tid; (void)lane; WSL();
            const unsigned char* h2q = WSP(const unsigned char, WS_H2Q); unsigned char* H2S = WSP(unsigned char, WS_H2S); const float* sa2 = WSP(const float, WS_SA2); float* saS = WSP(float, WS_SAS); int* tokinfo = WSP(int, WS_ROUTE); int* tokS = WSP(int, WS_TOKS); float* gaS = WSP(float, WS_GAS); float* gbS = WSP(float, WS_GBS); int* tinfo = WSP(int, WS_TINFO);
            LAS int* cst = (LAS int*)lds;
            LAS int* base = (LAS int*)(lds + 1024);
            { const int* cntb = WSP(const int, WS_CNTB) + (size_t)l * 512 * 64;
              for (int i = tid; i < G * NCLS; i += NWAVES * 64) { const int b = i / NCLS, c = i - b * NCLS; base[i] = cntb[b * 64 + c]; }
              __syncthreads();
              if (tid < NCLS) { int run = 0; for (int b = 0; b < G; ++b) { const int n = base[b * NCLS + tid]; base[b * NCLS + tid] = run; run += n; } cst[64 + tid] = run; }
              __syncthreads(); }
            if (tid == 0) { int s = 0, nt = 0;
                for (int c = 0; c < NCLS; ++c) { const int n = cst[64 + c]; cst[c] = s; const int tl = (n + 255) >> 8;
                    if (bx == 0) { const int g = c / 6, p = c % 6; const int a = p < 3 ? 0 : (p < 5 ? 1 : 2); const int bb = p < 3 ? p + 1 : (p < 5 ? p - 1 : 3); const int code = (g * 4 + a) | ((g * 4 + bb) << 8);
                        for (int i = 0; i < tl; ++i) tinfo[1 + nt + i] = code; }
                    nt += tl; s += tl * 256; }
                if (bx == 0) tinfo[0] = nt; }
            __syncthreads();
            _Pragma("unroll 1") for (int rep_ = 0; rep_ < 1 + (RPT_PHASE == 7 ? RPT_N : 0); ++rep_)
            for (int m = gw; m < T; m += NGW) {
                const u32x4 inf = *(const u32x4*)(tokinfo + (size_t)m * 4);
                const int pbk = ((m >> 4) % NGW) >> 3;
                const int slot = cst[inf.x] + base[pbk * NCLS + (int)inf.x] + (int)inf.y;
                const u32x4* src = (const u32x4*)(h2q + (size_t)m * 1024); u32x4* dst = (u32x4*)(H2S + (size_t)slot * 1024);
                dst[lane] = src[lane];
                if (lane == 0) { tokS[slot] = m; gaS[slot] = __uint_as_float(inf.z); gbS[slot] = __uint_as_float(inf.w); saS[slot] = sa2[m]; }
            }
            __syncthreads();
        }
        SEAM(pb + 6);
        if (PHON(8) && IN(pb + 7)) {
            const int tid = otid(), lane = tid & 63; (void)tid; (void)lane; WSL();
            bf16* H2S = WSP(bf16, WS_H2S); unsigned char* U = WSP(unsigned char, WS_U); float* gaS = WSP(float, WS_GAS); float* gbS = WSP(float, WS_GBS); int* tinfo = WSP(int, WS_TINFO);
            pg8::Gemm g{H2S, (const bf16*)(WSP(unsigned char, WS_W1) + (size_t)l * 32 * 1024 * 1024), 512, 512, 512}; pg8::MoeOrder<8, 1> S{tinfo, G, vcu};
            pg8::EpiMoe1 E{U, gaS, gbS, WSP(const float, WS_SAS), WSP(const float, WS_SW1) + (size_t)l * 32 * 1024};
            _Pragma("unroll 1") for (int rep_ = 0; rep_ < 1 + (RPT_PHASE == 8 ? RPT_N : 0); ++rep_)
            pg8::gemm_phase<pg8::EpiMoe1, pg8::MoeOrder<8, 1>, 0, 1>(lds, g, S, E, g_wave);
        }
        SEAM(pb + 7);
        if (PHON(9) && IN(pb + 8)) {
            const int tid = otid(), lane = tid & 63; (void)tid; (void)lane; WSL();
            const float* modl = MODL; int* tokS = WSP(int, WS_TOKS); int* tinfo = WSP(int, WS_TINFO);
            pg8::Gemm g{WSP(const bf16, WS_U), (const bf16*)(WSP(unsigned char, WS_W2) + (size_t)l * 32 * 1024 * 512), 512, 512, 256}; pg8::MoeOrder<4, 2> S{tinfo, G, vcu};
            _Pragma("unroll 1") for (int rep_ = (RPT_PHASE == 9 ? 0 : 1); rep_ < 2; ++rep_) {
            pg8::EpiMoe2 E{WSP(bf16, WS_XB), (l == DEPTH - 1) ? (float*)INF(25) : nullptr, tokS, modl + 5 * 1024, rep_ == 0 ? 1 : 0};
            pg8::gemm_phase<pg8::EpiMoe2, pg8::MoeOrder<4, 2>, 4, 2>(lds, g, S, E, g_wave); }
        }
        SEAM(pb + 8);
    }
#undef IN
#undef SEAM
}

extern "C" void kernel_launch(void* const* d_in, const int* in_sizes, int n_in, void* d_out, int out_size, void* d_ws, size_t ws_size, hipStream_t stream) {
    static int grid = 0;
    if (grid == 0) {
        if (n_in != 25 || in_sizes[0] != T * DM || out_size != T * DM || ws_size < WS_END) { fprintf(stderr, "kernel_launch: unexpected shapes (n_in %d, in0 %d, out %d, ws %zu < %zu)\n", n_in, n_in > 0 ? in_sizes[0] : -1, out_size, ws_size, (size_t)WS_END); grid = -1; return; }
        int dev = 0, cus = 0, per_cu = 0;
        if (hipGetDevice(&dev) != hipSuccess || hipDeviceGetAttribute(&cus, hipDeviceAttributeMultiprocessorCount, dev) != hipSuccess) { grid = -1; return; }
        if (hipFuncSetAttribute((const void*)fwd, hipFuncAttributeMaxDynamicSharedMemorySize, LDS_BYTES) != hipSuccess) { fprintf(stderr, "kernel_launch: hipFuncSetAttribute failed\n"); grid = -1; return; }
        if (hipOccupancyMaxActiveBlocksPerMultiprocessor(&per_cu, (const void*)fwd, NWAVES * 64, LDS_BYTES) != hipSuccess || per_cu < 1) fprintf(stderr, "kernel_launch: occupancy query reports %d\n", per_cu);
        (void)hipGetLastError();
        grid = cus;
    }
    if (grid < 0) return;
    if (hipMemsetAsync((char*)d_ws + WS_CTL, 0, CTL_ZERO_BYTES, stream) != hipSuccess) return;
    Args a{};
    for (int i = 0; i < 25; ++i) a.in[i] = (const float*)d_in[i];
    a.out = (float*)d_out; a.ws = (unsigned char*)d_ws;
#if MK_N_LAUNCHES == 1
    a.ph_lo = 0; a.ph_hi = NPHASE;
    hipLaunchKernelGGL(fwd, dim3(grid), dim3(NWAVES * 64), LDS_BYTES, stream, a);
#else
    for (int p = 0; p < NPHASE; ++p) { a.ph_lo = p; a.ph_hi = p + 1; hipLaunchKernelGGL(fwd, dim3(grid), dim3(NWAVES * 64), LDS_BYTES, stream, a); }
#endif
}
```
